# Optimizing an MI355X kernel written in HIP

```python
import jax, jax.numpy as jnp
from jax import lax
import numpy as np

D_MODEL = 1024
BATCH = 8
SEQ = 4096
DEPTH = 1

MEM_LEN = 256
RW_HEADS = 8
RW_HEAD_DIM = 64
RW_WIDTH = RW_HEADS * RW_HEAD_DIM
DECAY_LORA = 64
AAA_LORA = 64
GATE_LORA = 128
RW_COLS = 3 * RW_WIDTH + DECAY_LORA + AAA_LORA + GATE_LORA
GN_EPS = 64e-5
ML_HEADS = 4
ML_HEAD_DIM = 128
ML_WIDTH = ML_HEADS * ML_HEAD_DIM
ML_CONV = 4
ML_CHUNK = 64
ML_COLS = 4 * ML_WIDTH + 2 * ML_HEADS
ML_NORM_EPS = 1e-6
IN_COLS = RW_COLS + ML_COLS + 2 * D_MODEL
D_FF = 2816
FFN_HALF = 0.5
XA_HEADS = 4
XA_HEAD_DIM = D_MODEL // XA_HEADS
NORM_EPS = 1e-5

kernel_name = "hybrid_rwkv7_mlstm_macaron_memxattn"


def _split(z, sizes):
    idx = np.cumsum(sizes)[:-1].tolist()
    return jnp.split(z, idx, axis=-1)


def _shift(u, j):
    if j == 0:
        return u
    return jnp.pad(u[:, :-j], ((0, 0), (j, 0), (0, 0)))


def _rmsnorm(x, g):
    xf = x.astype(jnp.float32)
    r = xf * lax.rsqrt(jnp.mean(xf * xf, axis=-1, keepdims=True) + NORM_EPS)
    return (r * g.astype(jnp.float32)).astype(x.dtype)


def _swiglu(h, w_gate, w_up, w_down):
    return (jax.nn.silu(h @ w_gate) * (h @ w_up)) @ w_down


def _causal_conv(u, w, b):
    out = b
    for j in range(ML_CONV):
        out = out + w[j] * _shift(u, j)
    return out


def _rwkv7_scan(r, decay, k, v, kk, kka):
    bsz, _, nh, n = r.shape

    def step(state, xs):
        r_t, w_t, k_t, v_t, kk_t, b_t = xs
        sa = jnp.einsum('bhvk,bhk->bhv', state, -kk_t)
        state = (state * w_t[:, :, None, :] + sa[..., None] * b_t[:, :, None, :]
                 + v_t[..., None] * k_t[:, :, None, :])
        return state, jnp.einsum('bhvk,bhk->bhv', state, r_t)

    xs = tuple(jnp.moveaxis(t, 1, 0) for t in (r, decay, k, v, kk, kka))
    init = jnp.zeros((bsz, nh, n, n), jnp.float32)
    _, y = lax.scan(step, init, xs)
    return jnp.moveaxis(y, 0, 1)


def _mlstm_chunkwise(q, k, v, i_pre, f_pre):
    bsz, seq, nh, dk = q.shape
    dv = v.shape[-1]
    nc, cl = seq // ML_CHUNK, ML_CHUNK

    def chunks(t):
        t = t.astype(jnp.float32).reshape((bsz, nc, cl, nh) + t.shape[3:])
        return jnp.moveaxis(t, 3, 1)

    q = chunks(q) * (dk ** -0.5)
    k, v = chunks(k), chunks(v)
    ig = chunks(i_pre)
    b = jnp.cumsum(jax.nn.log_sigmoid(chunks(f_pre)), axis=-1)
    b_end = b[..., -1]

    log_w_end = b_end[..., None] - b + ig
    m_chunk = jnp.max(log_w_end, axis=-1)
    w_end = jnp.exp(log_w_end - m_chunk[..., None])
    c_chunk = jnp.einsum('bhcl,bhclv,bhclk->bhcvk', w_end, v, k)
    n_chunk = jnp.einsum('bhcl,bhclk->bhck', w_end, k)

    def step(carry, xs):
        c, n, m = carry
        be, mc, cc, nck = xs
        m_new = jnp.maximum(be + m, mc)
        dec = jnp.exp(be + m - m_new)
        sc = jnp.exp(mc - m_new)
        c_new = dec[..., None, None] * c + sc[..., None, None] * cc
        n_new = dec[..., None] * n + sc[..., None] * nck
        return (c_new, n_new, m_new), (c, n, m)

    init = (jnp.zeros((bsz, nh, dv, dk), jnp.float32),
            jnp.zeros((bsz, nh, dk), jnp.float32),
            jnp.zeros((bsz, nh), jnp.float32))
    xs = tuple(jnp.moveaxis(t, 2, 0) for t in (b_end, m_chunk, c_chunk, n_chunk))
    _, (c_prev, n_prev, m_prev) = lax.scan(step, init, xs)
    c_prev = jnp.moveaxis(c_prev, 0, 2)
    n_prev = jnp.moveaxis(n_prev, 0, 2)
    m_prev = jnp.moveaxis(m_prev, 0, 2)

    causal = jnp.tril(jnp.ones((cl, cl), dtype=bool))
    log_d = jnp.where(causal, b[..., :, None] - b[..., None, :] + ig[..., None, :], -jnp.inf)
    log_inter = b + m_prev[..., None]
    m_row = jnp.maximum(log_inter, jnp.max(log_d, axis=-1))
    p = jnp.exp(log_d - m_row[..., None]) * jnp.einsum('bhcsk,bhcrk->bhcsr', q, k)
    w_inter = jnp.exp(log_inter - m_row)
    num = (jnp.einsum('bhcsr,bhcrv->bhcsv', p, v)
           + w_inter[..., None] * jnp.einsum('bhcvk,bhcsk->bhcsv', c_prev, q))
    den = jnp.sum(p, axis=-1) + w_inter * jnp.einsum('bhck,bhcsk->bhcs', n_prev, q)
    h = num / jnp.maximum(jnp.abs(den), jnp.exp(-m_row))[..., None]
    return jnp.moveaxis(h, 1, 3).reshape(bsz, seq, nh, dv)


def _token_mix(h, w_in, rw_mu, rw_w0, rw_w2, rw_a0, rw_a2, rw_g2, rw_k_k, rw_k_a, rw_r_k,
               rw_gn_w, rw_gn_b, ml_conv_w, ml_conv_b, ml_i_b, ml_f_b, ml_norm,
               w_up_rw, w_up_ml, w_out):
    bsz, seq, _ = h.shape
    f32 = jnp.float32
    z = h @ w_in
    z_rw, z_ml, z_gate = _split(z, [RW_COLS, ML_COLS, 2 * D_MODEL])

    z_rw = z_rw + (_shift(z_rw, 1) - z_rw) * rw_mu
    r, k, v, w_d, a_d, g_d = _split(z_rw, [RW_WIDTH] * 3 + [DECAY_LORA, AAA_LORA, GATE_LORA])
    w_raw = (rw_w0 + jnp.tanh(w_d) @ rw_w2).astype(f32)
    decay = jnp.exp(-jnp.exp(-jax.nn.softplus(-w_raw) - 0.5))
    a = jax.nn.sigmoid((rw_a0 + a_d @ rw_a2).astype(f32))
    g = (jax.nn.sigmoid(g_d) @ rw_g2).astype(f32)

    def heads(t):
        return t.astype(f32).reshape(bsz, seq, RW_HEADS, RW_HEAD_DIM)

    kf = k.astype(f32)
    kk = heads(kf * rw_k_k)
    kk = kk / jnp.maximum(jnp.linalg.norm(kk, axis=-1, keepdims=True), 1e-12)
    k_mod = heads(kf * (1.0 + (a - 1.0) * rw_k_a))
    r_h, v_h, a_h, w_h = heads(r), heads(v), heads(a), heads(decay)
    y = _rwkv7_scan(r_h, w_h, k_mod, v_h, kk, kk * a_h)
    mu = jnp.mean(y, axis=-1, keepdims=True)
    var = jnp.mean(jnp.square(y - mu), axis=-1, keepdims=True)
    gn_w = rw_gn_w.astype(f32).reshape(RW_HEADS, RW_HEAD_DIM)
    gn_b = rw_gn_b.astype(f32).reshape(RW_HEADS, RW_HEAD_DIM)
    y = (y - mu) * lax.rsqrt(var + GN_EPS) * gn_w + gn_b
    y = y + jnp.sum(r_h * k_mod * rw_r_k, axis=-1, keepdims=True) * v_h
    y_rw = y.reshape(bsz, seq, RW_WIDTH) * g

    q2, k2, v2, o2, i_pre, f_pre = _split(z_ml, [ML_WIDTH] * 4 + [ML_HEADS] * 2)
    qk = jax.nn.silu(_causal_conv(jnp.concatenate([q2, k2], axis=-1), ml_conv_w, ml_conv_b))
    q2, k2 = _split(qk, [ML_WIDTH, ML_WIDTH])

    def mh(t):
        return t.reshape(bsz, seq, ML_HEADS, ML_HEAD_DIM)

    hm = _mlstm_chunkwise(mh(q2), mh(k2), mh(v2), i_pre + ml_i_b, f_pre + ml_f_b)
    mu = jnp.mean(hm, axis=-1, keepdims=True)
    var = jnp.mean(jnp.square(hm - mu), axis=-1, keepdims=True)
    hm = ((hm - mu) * lax.rsqrt(var + ML_NORM_EPS)).reshape(bsz, seq, ML_WIDTH)
    y_ml = hm * ml_norm.astype(f32) * jax.nn.sigmoid(o2.astype(f32))

    g_a, g_b = _split(z_gate, [D_MODEL, D_MODEL])
    dt = h.dtype
    merged = (jax.nn.sigmoid(g_a) * (y_rw.astype(dt) @ w_up_rw)
              + jax.nn.sigmoid(g_b) * (y_ml.astype(dt) @ w_up_ml))
    return merged @ w_out


def _memory_attention(hq, hm, wq, wkv, wo):
    bsz, seq, _ = hq.shape
    mlen = hm.shape[1]
    q = (hq @ wq).reshape(bsz, seq, XA_HEADS, XA_HEAD_DIM)
    k, v = _split(hm @ wkv, [D_MODEL, D_MODEL])
    k = k.reshape(bsz, mlen, XA_HEADS, XA_HEAD_DIM)
    v = v.reshape(bsz, mlen, XA_HEADS, XA_HEAD_DIM)
    s = jnp.einsum('bshd,bmhd->bhsm', q, k).astype(jnp.float32) * (XA_HEAD_DIM ** -0.5)
    p = jax.nn.softmax(s, axis=-1).astype(hq.dtype)
    o = jnp.einsum('bhsm,bmhd->bshd', p, v).reshape(bsz, seq, D_MODEL)
    return o @ wo


def setup_inputs(seed: int = 0) -> dict:
    key = jax.random.key(seed)
    ks = iter(jax.random.split(key, 64))
    d = D_MODEL

    def nrm(shape, scale):
        return jax.random.normal(next(ks), (DEPTH,) + shape, jnp.float32) * scale

    def gain(shape):
        return 1.0 + 0.05 * jax.random.normal(next(ks), (DEPTH,) + shape, jnp.float32)

    def unif(shape, lo, hi):
        return jax.random.uniform(next(ks), (DEPTH,) + shape, jnp.float32, lo, hi)

    return {
        "x": jax.random.normal(next(ks), (BATCH, SEQ, d), jnp.float32),
        "mem": jax.random.normal(next(ks), (BATCH, MEM_LEN, d), jnp.float32),
        "ffn1_norm": gain((d,)),
        "ffn1_w_gate": nrm((d, D_FF), d ** -0.5),
        "ffn1_w_up": nrm((d, D_FF), d ** -0.5),
        "ffn1_w_down": nrm((D_FF, d), D_FF ** -0.5),
        "mix_norm": gain((d,)),
        "w_in": nrm((d, IN_COLS), d ** -0.5),
        "rw_mu": unif((RW_COLS,), 0.0, 1.0),
        "rw_w0": unif((RW_WIDTH,), -4.0, 1.0),
        "rw_w2": nrm((DECAY_LORA, RW_WIDTH), 0.5 * DECAY_LORA ** -0.5),
        "rw_a0": nrm((RW_WIDTH,), 0.1),
        "rw_a2": nrm((AAA_LORA, RW_WIDTH), AAA_LORA ** -0.5),
        "rw_g2": nrm((GATE_LORA, RW_WIDTH), GATE_LORA ** -0.5),
        "rw_k_k": 0.85 + nrm((RW_WIDTH,), 0.05),
        "rw_k_a": gain((RW_WIDTH,)),
        "rw_r_k": nrm((RW_HEADS, RW_HEAD_DIM), 0.1),
        "rw_gn_w": gain((RW_WIDTH,)),
        "rw_gn_b": nrm((RW_WIDTH,), 0.01),
        "ml_conv_w": nrm((ML_CONV, 2 * ML_WIDTH), ML_CONV ** -0.5),
        "ml_conv_b": nrm((2 * ML_WIDTH,), 0.01),
        "ml_i_b": unif((ML_HEADS,), -2.0, 0.0),
        "ml_f_b": unif((ML_HEADS,), 3.0, 6.0),
        "ml_norm": gain((ML_WIDTH,)),
        "w_up_rw": nrm((RW_WIDTH, d), RW_WIDTH ** -0.5),
        "w_up_ml": nrm((ML_WIDTH, d), ML_WIDTH ** -0.5),
        "w_out": nrm((d, d), d ** -0.5),
        "xa_norm": gain((d,)),
        "mem_norm": gain((d,)),
        "xa_wq": nrm((d, d), d ** -0.5),
        "xa_wkv": nrm((d, 2 * d), d ** -0.5),
        "xa_wo": nrm((d, d), d ** -0.5),
        "ffn2_norm": gain((d,)),
        "ffn2_w_gate": nrm((d, D_FF), d ** -0.5),
        "ffn2_w_up": nrm((d, D_FF), d ** -0.5),
        "ffn2_w_down": nrm((D_FF, d), D_FF ** -0.5),
        "final_norm": 1.0 + 0.05 * jax.random.normal(next(ks), (d,), jnp.float32),
    }


def reference(x, mem, ffn1_norm, ffn1_w_gate, ffn1_w_up, ffn1_w_down, mix_norm, w_in,
              rw_mu, rw_w0, rw_w2, rw_a0, rw_a2, rw_g2, rw_k_k, rw_k_a, rw_r_k, rw_gn_w, rw_gn_b,
              ml_conv_w, ml_conv_b, ml_i_b, ml_f_b, ml_norm, w_up_rw, w_up_ml, w_out,
              xa_norm, mem_norm, xa_wq, xa_wkv, xa_wo,
              ffn2_norm, ffn2_w_gate, ffn2_w_up, ffn2_w_down, final_norm):
    for l in range(DEPTH):
        x = x + FFN_HALF * _swiglu(_rmsnorm(x, ffn1_norm[l]), ffn1_w_gate[l], ffn1_w_up[l], ffn1_w_down[l])
        x = x + _token_mix(_rmsnorm(x, mix_norm[l]), w_in[l], rw_mu[l], rw_w0[l], rw_w2[l], rw_a0[l],
                           rw_a2[l], rw_g2[l], rw_k_k[l], rw_k_a[l], rw_r_k[l], rw_gn_w[l], rw_gn_b[l],
                           ml_conv_w[l], ml_conv_b[l], ml_i_b[l], ml_f_b[l], ml_norm[l],
                           w_up_rw[l], w_up_ml[l], w_out[l])
        x = x + _memory_attention(_rmsnorm(x, xa_norm[l]), _rmsnorm(mem, mem_norm[l]),
                                  xa_wq[l], xa_wkv[l], xa_wo[l])
        x = x + FFN_HALF * _swiglu(_rmsnorm(x, ffn2_norm[l]), ffn2_w_gate[l], ffn2_w_up[l], ffn2_w_down[l])
    return _rmsnorm(x, final_norm)
```

```cpp
#include <hip/hip_runtime.h>
#include <hip/hip_cooperative_groups.h>
#include <cstdio>
#include <cstdint>
#include <cstring>
namespace cg = cooperative_groups;

#define LAS __attribute__((address_space(3)))
typedef unsigned short bf16_t;
typedef short bf16x8 __attribute__((ext_vector_type(8)));
typedef float f32x4 __attribute__((ext_vector_type(4)));
typedef float f32x2 __attribute__((ext_vector_type(2)));
typedef unsigned u32x4 __attribute__((ext_vector_type(4)));
typedef unsigned u32x2 __attribute__((ext_vector_type(2)));

#ifndef MK_DBG_HI
#define MK_DBG_HI 13
#endif
#ifndef MK_PER_PHASE
#define MK_PER_PHASE 0
#endif

constexpr int NTOK = 32768, DM = 1024, SEQ = 4096, NB = 8, DFF = 2816, MEMTOK = 2048;
constexpr int ZLD = 3840;
constexpr float NORM_EPS = 1e-5f;
constexpr int NPHASE = 13;
constexpr int LDS_BYTES = 160 * 1024;
constexpr int XCH_OFF = 131072;

constexpr size_t MiB = 1048576;
constexpr size_t OFF_SSQ0 = 0, OFF_SSQ1 = 131072, OFF_SSQ2 = 262144, OFF_SSQ3 = 393216, OFF_SSQ4 = 524288, OFF_SSQM = 655360;
constexpr size_t OFF_IF = 1 * MiB;
constexpr size_t OFF_GATES = 2 * MiB;
constexpr size_t OFF_BARW = 720896;
constexpr size_t OFF_STATS = 444 * MiB;
constexpr size_t OFF_W = 4 * MiB;
constexpr size_t SZ_WGU = (size_t)5632 * 1024 * 2, SZ_WD = (size_t)1024 * 2816 * 2, SZ_WIN = (size_t)4096 * 1024 * 2, SZ_WG = (size_t)2048 * 1024 * 2, SZ_SQ = (size_t)1024 * 1024 * 2;
constexpr size_t OFF_WGU1 = OFF_W, OFF_WD1 = OFF_WGU1 + SZ_WGU, OFF_WIN = OFF_WD1 + SZ_WD, OFF_WG = OFF_WIN + SZ_WIN, OFF_WUP = OFF_WG + SZ_WG, OFF_WOUT = OFF_WUP + SZ_SQ,
                 OFF_WQ = OFF_WOUT + SZ_SQ, OFF_WK = OFF_WQ + SZ_SQ, OFF_WV = OFF_WK + SZ_SQ, OFF_WO = OFF_WV + SZ_SQ, OFF_WGU2 = OFF_WO + SZ_SQ, OFF_WD2 = OFF_WGU2 + SZ_WGU,
                 OFF_W2T = OFF_WD2 + SZ_WD, OFF_A2T = OFF_W2T + 65536, OFF_G2T = OFF_A2T + 65536, OFF_WEND = OFF_G2T + 131072;
static_assert(OFF_WEND <= 64 * MiB, "weights");
constexpr size_t OFF_XB = 64 * MiB, OFF_Y = 128 * MiB, OFF_MEMB = 192 * MiB, OFF_KB = 196 * MiB, OFF_VT = 200 * MiB, OFF_BIG = 204 * MiB, WS_END = 460 * MiB;
constexpr size_t OFF_U = OFF_BIG, OFF_Z = OFF_BIG, OFF_SCRS = OFF_BIG, OFF_SCRM = OFF_BIG + 32 * MiB, OFF_MG = OFF_BIG + 96 * MiB, OFF_Q = OFF_BIG, OFF_P = OFF_BIG + 64 * MiB, OFF_O = OFF_BIG + 128 * MiB;

typedef __bf16 bf16x2_t __attribute__((ext_vector_type(2)));
__device__ __forceinline__ unsigned cvt_pk_bf16(float lo, float hi) { f32x2 v = {lo, hi}; bf16x2_t b = __builtin_convertvector(v, bf16x2_t); return __builtin_bit_cast(unsigned, b); }
__device__ __forceinline__ float bflo(unsigned u) { return __builtin_bit_cast(float, u << 16); }
__device__ __forceinline__ float bfhi(unsigned u) { return __builtin_bit_cast(float, u & 0xffff0000u); }
__device__ __forceinline__ float bf2f(bf16_t b) { return __builtin_bit_cast(float, (unsigned)b << 16); }
__device__ __forceinline__ bf16_t f2bf(float f) { return (bf16_t)(cvt_pk_bf16(f, 0.f) & 0xffffu); }
__device__ __forceinline__ float fsigmoid(float x) { return __builtin_amdgcn_rcpf(1.f + __expf(-x)); }
__device__ __forceinline__ float wave_sum(float v) {
#pragma unroll
    for (int o = 1; o < 64; o <<= 1) v += __shfl_xor(v, o);
    return v;
}
template <int CTRL> __device__ __forceinline__ float dpp_f(float x) { return __builtin_bit_cast(float, __builtin_amdgcn_update_dpp(0, __builtin_bit_cast(int, x), CTRL, 0xF, 0xF, true)); }
__device__ __forceinline__ float red8(float x) {
    x += dpp_f<0xB1>(x); x += dpp_f<0x4E>(x); x += dpp_f<0x141>(x); return x;
}
#define LDS_WAIT() asm volatile("s_waitcnt lgkmcnt(0)" ::: "memory")
#define WG_BAR() do { asm volatile("s_waitcnt lgkmcnt(0)" ::: "memory"); __builtin_amdgcn_s_barrier(); asm volatile("" ::: "memory"); } while (0)
#define WG_BAR_ALL() do { asm volatile("s_waitcnt vmcnt(0) lgkmcnt(0)" ::: "memory"); __builtin_amdgcn_s_barrier(); asm volatile("" ::: "memory"); } while (0)

constexpr int BM = 256, BK = 64, HALF = 128, HTB = HALF * BK * 2;
__host__ __device__ __forceinline__ int lds_byte(int r, int c) { const int st = (r >> 4) * 2 + (c >> 5), rr = r & 15, cc = c & 31, ob = rr * 64 + cc * 2; return st * 1024 + (ob ^ (((ob >> 9) & 1) << 5)); }
__host__ __device__ __forceinline__ void stage_rc(int b, int& R, int& C) { const int st = b / 1024, sb = b % 1024, swz = sb ^ (((sb >> 9) & 1) << 5); R = (st >> 1) * 16 + swz / 64; C = (st & 1) * 32 + (swz % 64) / 2; }
__host__ __device__ __forceinline__ int perm32(int rho) { const int n = rho >> 4, i = rho & 15; return 8 * (i >> 2) + 4 * n + (i & 3); }

struct Unit { const char* A; const char* B; int nt, pm, pn, tag; };

__device__ __forceinline__ void tile_of(int L, int nM, int nN, int& pm, int& pn) {
    const int nwg = nM * nN; int wgid = L;
    { const int q = nwg / 8, r = nwg % 8, xcd = wgid % 8, off = wgid / 8; wgid = (xcd < r ? xcd * (q + 1) : r * (q + 1) + (xcd - r) * q) + off; }
    const int nig = 8 * nN, gid = wgid / nig, fm = gid * 8, gsz = (nM - fm) < 8 ? (nM - fm) : 8;
    pm = fm + ((wgid % nig) % gsz); pn = (wgid % nig) / gsz;
}
struct SchedStatic {
    const char* A; const char* B; size_t tstep; int nM, nN, nt, G, c;
    __device__ __forceinline__ bool next(int i, Unit& u) const {
        const long L = (long)i * G + c; if (L >= (long)nM * nN) return false;
        int pm, pn; tile_of((int)L, nM, nN, pm, pn);
        u.A = A + (size_t)pm * tstep; u.B = B + (size_t)pn * tstep; u.nt = nt; u.pm = pm; u.pn = pn; u.tag = 0; return true;
    }
};

template <class Epi, class Sched>
__device__ __forceinline__ void gemm_phase(LAS unsigned char* lds, const int ld, const Sched& S, const Epi& E) {
    const int tid = threadIdx.x, wid = __builtin_amdgcn_readfirstlane(tid >> 6), lane = tid & 63, wr = wid >> 2, wc = wid & 3, fr = lane & 15, fq = lane >> 4;
    unsigned voffA[2], voffB[2];
#pragma unroll
    for (int i = 0; i < 2; ++i) { int R, C; stage_rc(tid * 16 + i * 8192, R, C); const int Rb = (R & ~31) + perm32(R & 31);
        voffA[i] = (unsigned)(R * ld + C) * 2u; voffB[i] = (unsigned)(Rb * ld + C) * 2u; }
    const size_t kstep = (size_t)(BK * 2);
    const size_t hstep = (size_t)HALF * ld * 2;
    const unsigned ldsw = (unsigned)wid * 1024u;
    const int aoff = lds_byte(wr * 64 + fr, fq * 8), boff = lds_byte(wc * 32 + fr, fq * 8);
#define PG8_SA(b, h) (((b) * 2 + (h)) * HTB)
#define PG8_SB(b, h) ((4 + (b) * 2 + (h)) * HTB)
#define PG8_STAGE(bufoff, gbase, voff) do { _Pragma("unroll") for (int _i = 0; _i < 2; ++_i) \
        __builtin_amdgcn_global_load_lds((const unsigned*)((const char*)(gbase) + (voff)[_i]), (LAS unsigned*)(lds + (bufoff) + ldsw + _i * 8192), 16, 0, 0); } while (0)
#define PG8_LDA(dst, b, h) do { _Pragma("unroll") for (int m = 0; m < 4; ++m) _Pragma("unroll") for (int k = 0; k < 2; ++k) dst[m][k] = *(const LAS bf16x8*)(lds + PG8_SA(b, h) + aoff + m * 2048 + k * 1024); } while (0)
#define PG8_LDB(dst, b, h) do { _Pragma("unroll") for (int n = 0; n < 2; ++n) _Pragma("unroll") for (int k = 0; k < 2; ++k) dst[n][k] = *(const LAS bf16x8*)(lds + PG8_SB(b, h) + boff + n * 2048 + k * 1024); } while (0)
#define PG8_MMA(ai, bj, At, Bt) do { __builtin_amdgcn_s_setprio(1); _Pragma("unroll") for (int m = 0; m < 4; ++m) _Pragma("unroll") for (int n = 0; n < 2; ++n) _Pragma("unroll") for (int k = 0; k < 2; ++k) \
        acc[ai][bj][m][n] = __builtin_amdgcn_mfma_f32_16x16x32_bf16(Bt[n][k], At[m][k], acc[ai][bj][m][n], 0, 0, 0); __builtin_amdgcn_s_setprio(0); } while (0)
#define PG8_WAIT_V(n) asm volatile("s_waitcnt vmcnt(" #n ")" ::: "memory")
#define PG8_WAIT_L(n) asm volatile("s_waitcnt lgkmcnt(" #n ")" ::: "memory")
#define PG8_BAR __builtin_amdgcn_s_barrier()
#define PG8_SCHED __builtin_amdgcn_sched_barrier(0)
    Unit cur, nxt; int ui = 0;
    if (!S.next(0, cur)) return;
    f32x4 acc[2][2][4][2];
#pragma unroll
    for (int a = 0; a < 2; ++a)
#pragma unroll
        for (int b = 0; b < 2; ++b)
#pragma unroll
            for (int m = 0; m < 4; ++m)
#pragma unroll
                for (int n = 0; n < 2; ++n) acc[a][b][m][n] = (f32x4){0.f, 0.f, 0.f, 0.f};
    bf16x8 At[4][2], B0[2][2], B1[2][2];
    const char* cA = cur.A; const char* cB = cur.B; int nt = cur.nt; asm volatile("" : "+s"(nt));
    PG8_STAGE(PG8_SB(0, 0), cB, voffB); PG8_STAGE(PG8_SB(0, 1), cB + hstep, voffB); PG8_STAGE(PG8_SA(0, 0), cA, voffA); PG8_STAGE(PG8_SA(0, 1), cA + hstep, voffA);
    if (wr == 1) PG8_BAR;
    PG8_WAIT_V(2); PG8_BAR;
    PG8_STAGE(PG8_SB(1, 0), cB + kstep, voffB); PG8_STAGE(PG8_SA(1, 0), cA + kstep, voffA); PG8_STAGE(PG8_SB(1, 1), cB + hstep + kstep, voffB);
    PG8_WAIT_V(6); PG8_BAR;
#pragma unroll 1
    for (;;) {
        asm volatile("" : "+s"(ui));
        const bool has_next = S.next(ui + 1, nxt);
        const char* nA = has_next ? nxt.A : cA; const char* nB = has_next ? nxt.B : cB;
#pragma unroll 1
        for (int t = 0; t < nt; t += 2) {
            const bool last = (t == nt - 2);
            const char* a1 = cA + (size_t)(t + 1) * kstep;
            const char* a2 = last ? nA : cA + (size_t)(t + 2) * kstep; const char* b2 = last ? nB : cB + (size_t)(t + 2) * kstep;
            const char* a3 = a2 + kstep; const char* b3 = b2 + kstep;
            PG8_LDB(B0, 0, 0); PG8_LDB(B1, 0, 1); PG8_SCHED; PG8_LDA(At, 0, 0); PG8_STAGE(PG8_SA(1, 1), a1 + hstep, voffA);
            PG8_WAIT_V(8); PG8_WAIT_L(0); PG8_BAR; PG8_MMA(0, 0, At, B0); PG8_MMA(0, 1, At, B1); PG8_BAR; PG8_SCHED;
            PG8_LDA(At, 0, 1); PG8_STAGE(PG8_SB(0, 0), b2, voffB); PG8_STAGE(PG8_SB(0, 1), b2 + hstep, voffB); PG8_STAGE(PG8_SA(0, 0), a2, voffA);
            PG8_WAIT_V(8); PG8_WAIT_L(0); PG8_BAR; PG8_MMA(1, 0, At, B0); PG8_MMA(1, 1, At, B1); PG8_BAR; PG8_SCHED;
            PG8_LDB(B0, 1, 0); PG8_LDB(B1, 1, 1); PG8_SCHED; PG8_LDA(At, 1, 0); PG8_STAGE(PG8_SA(0, 1), a2 + hstep, voffA);
            PG8_WAIT_V(8); PG8_WAIT_L(0); PG8_BAR; PG8_MMA(0, 0, At, B0); PG8_MMA(0, 1, At, B1); PG8_BAR; PG8_SCHED;
            PG8_LDA(At, 1, 1); PG8_STAGE(PG8_SB(1, 0), b3, voffB); PG8_STAGE(PG8_SB(1, 1), b3 + hstep, voffB); PG8_STAGE(PG8_SA(1, 0), a3, voffA);
            PG8_WAIT_V(8); PG8_WAIT_L(0); PG8_BAR; PG8_MMA(1, 0, At, B0); PG8_MMA(1, 1, At, B1); PG8_BAR; PG8_SCHED;
        }
        if (wr == 0) PG8_BAR;
        E(acc, cur, wr, wc, fr, fq, lds);
        if (!has_next) break;
#pragma unroll
        for (int a = 0; a < 2; ++a)
#pragma unroll
            for (int b = 0; b < 2; ++b)
#pragma unroll
                for (int m = 0; m < 4; ++m)
#pragma unroll
                    for (int n = 0; n < 2; ++n) acc[a][b][m][n] = (f32x4){0.f, 0.f, 0.f, 0.f};
        cur = nxt; cA = nA; cB = nB; nt = cur.nt; asm volatile("" : "+s"(nt)); ++ui;
        if (wr == 1) PG8_BAR;
    }
    PG8_WAIT_V(0);
    PG8_BAR;
#undef PG8_SA
#undef PG8_SB
#undef PG8_STAGE
#undef PG8_LDA
#undef PG8_LDB
#undef PG8_MMA
#undef PG8_WAIT_V
#undef PG8_WAIT_L
#undef PG8_BAR
#undef PG8_SCHED
}

typedef f32x4 (&AccRef)[2][2][4][2];
#define EPI_ROWS_BEGIN _Pragma("unroll") for (int ai = 0; ai < 2; ++ai) _Pragma("unroll") for (int m = 0; m < 4; ++m) { const int rl = ai * 128 + wr * 64 + m * 16 + fr;
#define EPI_ROWS_END }

struct EpiSwiglu {
    bf16_t* U; const float* ssq;
    __device__ __forceinline__ void operator()(AccRef acc, const Unit& u, int wr, int wc, int fr, int fq, LAS unsigned char*) const {
        EPI_ROWS_BEGIN
            const int row = u.pm * 256 + rl; const float rs = rsqrtf(ssq[row] * (1.f / 1024.f) + NORM_EPS);
            float o[8];
#pragma unroll
            for (int n = 0; n < 2; ++n)
#pragma unroll
                for (int j = 0; j < 4; ++j) { const float g = acc[ai][0][m][n][j] * rs, up = acc[ai][1][m][n][j] * rs; o[n * 4 + j] = g * fsigmoid(g) * up; }
            u32x4 w; w.x = cvt_pk_bf16(o[0], o[1]); w.y = cvt_pk_bf16(o[2], o[3]); w.z = cvt_pk_bf16(o[4], o[5]); w.w = cvt_pk_bf16(o[6], o[7]);
            *(u32x4*)(U + (size_t)row * DFF + u.pn * 128 + wc * 32 + fq * 8) = w;
        EPI_ROWS_END
    }
};
template <bool WB> struct EpiResid {
    const float* xin; float* xout; bf16_t* xb; float* ssq; float scale;
    __device__ __forceinline__ void operator()(AccRef acc, const Unit& u, int wr, int wc, int fr, int fq, LAS unsigned char*) const {
        EPI_ROWS_BEGIN
            const int row = u.pm * 256 + rl; float ss = 0.f;
#pragma unroll
            for (int bj = 0; bj < 2; ++bj) {
                const size_t o = (size_t)row * DM + u.pn * 256 + bj * 128 + wc * 32 + fq * 8;
                f32x4 v0 = *(const f32x4*)(xin + o), v1 = *(const f32x4*)(xin + o + 4);
                v0 = v0 + acc[ai][bj][m][0] * scale; v1 = v1 + acc[ai][bj][m][1] * scale;
                *(f32x4*)(xout + o) = v0; *(f32x4*)(xout + o + 4) = v1;
                ss += v0[0] * v0[0] + v0[1] * v0[1] + v0[2] * v0[2] + v0[3] * v0[3] + v1[0] * v1[0] + v1[1] * v1[1] + v1[2] * v1[2] + v1[3] * v1[3];
                if (WB) { u32x4 w; w.x = cvt_pk_bf16(v0[0], v0[1]); w.y = cvt_pk_bf16(v0[2], v0[3]); w.z = cvt_pk_bf16(v1[0], v1[1]); w.w = cvt_pk_bf16(v1[2], v1[3]); *(u32x4*)(xb + o) = w; }
            }
            ss += __shfl_xor(ss, 16); ss += __shfl_xor(ss, 32);
            if (fq == 0) atomicAdd(ssq + row, ss);
        EPI_ROWS_END
    }
};
template <int MODE> struct EpiRowScale {
    bf16_t* O; const float* ssq; float* IFb;
    __device__ __forceinline__ void operator()(AccRef acc, const Unit& u, int wr, int wc, int fr, int fq, LAS unsigned char*) const {
        constexpr int LDO = MODE == 0 ? ZLD : DM;
        EPI_ROWS_BEGIN
            const int row = u.pm * 256 + rl; const float rs = rsqrtf(ssq[row] * (1.f / 1024.f) + NORM_EPS);
            if (MODE == 0 && u.pn == 15) {
                if (wc == 0 && fq == 0) { *(f32x4*)(IFb + (size_t)row * 8) = acc[ai][0][m][0] * rs; *(f32x4*)(IFb + (size_t)row * 8 + 4) = acc[ai][0][m][1] * rs; }
            } else {
#pragma unroll
                for (int bj = 0; bj < 2; ++bj) { const f32x4 v0 = acc[ai][bj][m][0] * rs, v1 = acc[ai][bj][m][1] * rs;
                    u32x4 w; w.x = cvt_pk_bf16(v0[0], v0[1]); w.y = cvt_pk_bf16(v0[2], v0[3]); w.z = cvt_pk_bf16(v1[0], v1[1]); w.w = cvt_pk_bf16(v1[2], v1[3]);
                    *(u32x4*)(O + (size_t)row * LDO + u.pn * 256 + bj * 128 + wc * 32 + fq * 8) = w; }
            }
        EPI_ROWS_END
    }
};
struct EpiKV {
    bf16_t* Kb; bf16_t* VT; const float* ssqm;
    __device__ __forceinline__ void operator()(AccRef acc, const Unit& u, int wr, int wc, int fr, int fq, LAS unsigned char*) const {
        EPI_ROWS_BEGIN
            const int row = u.pm * 256 + rl;
#pragma unroll
            for (int bj = 0; bj < 2; ++bj) {
                const int cl = bj * 128 + wc * 32 + fq * 8; f32x4 v0 = acc[ai][bj][m][0], v1 = acc[ai][bj][m][1]; bf16_t* dst;
                if (u.tag == 0) { const float rs = rsqrtf(ssqm[row] * (1.f / 1024.f) + NORM_EPS); v0 = v0 * rs; v1 = v1 * rs; dst = Kb + (size_t)row * DM + u.pn * 256 + cl; }
                else { const int tok = u.pn * 256 + cl; const f32x4 s0 = *(const f32x4*)(ssqm + tok), s1 = *(const f32x4*)(ssqm + tok + 4);
#pragma unroll
                    for (int j = 0; j < 4; ++j) { v0[j] *= rsqrtf(s0[j] * (1.f / 1024.f) + NORM_EPS); v1[j] *= rsqrtf(s1[j] * (1.f / 1024.f) + NORM_EPS); }
                    dst = VT + (size_t)(u.pn >> 2) * 1048576 + (size_t)row * 1024 + (u.pn & 3) * 256 + cl; }
                u32x4 w; w.x = cvt_pk_bf16(v0[0], v0[1]); w.y = cvt_pk_bf16(v0[2], v0[3]); w.z = cvt_pk_bf16(v1[0], v1[1]); w.w = cvt_pk_bf16(v1[2], v1[3]);
                *(u32x4*)dst = w;
            }
        EPI_ROWS_END
    }
};
struct EpiMerge {
    u32x4* scrS; f32x4* scrM; bf16_t* MG; const float* ssq;
    __device__ __forceinline__ void operator()(AccRef acc, const Unit& u, int wr, int wc, int fr, int fq, LAS unsigned char*) const {
        char* sS = (char*)scrS + (threadIdx.x >> 6) * 16384u + (threadIdx.x & 63) * 16u; char* sM = (char*)scrM + (threadIdx.x >> 6) * 16384u + (threadIdx.x & 63) * 16u; asm volatile("" : "+v"(sS), "+v"(sM));
        if (u.tag == 0 || u.tag == 2) {
            EPI_ROWS_BEGIN
                const int row = u.pm * 256 + rl; const float rs = rsqrtf(ssq[row] * (1.f / 1024.f) + NORM_EPS);
#pragma unroll
                for (int bj = 0; bj < 2; ++bj) {
                    const int i = (ai * 4 + m) * 2 + bj; const f32x4 a0 = acc[ai][bj][m][0], a1 = acc[ai][bj][m][1];
                    u32x4 w; w.x = cvt_pk_bf16(fsigmoid(a0[0] * rs), fsigmoid(a0[1] * rs)); w.y = cvt_pk_bf16(fsigmoid(a0[2] * rs), fsigmoid(a0[3] * rs));
                    w.z = cvt_pk_bf16(fsigmoid(a1[0] * rs), fsigmoid(a1[1] * rs)); w.w = cvt_pk_bf16(fsigmoid(a1[2] * rs), fsigmoid(a1[3] * rs));
                    *(u32x4*)(sS + i * 1024) = w;
                }
            EPI_ROWS_END
        } else if (u.tag == 1) {
            EPI_ROWS_BEGIN
#pragma unroll
                for (int bj = 0; bj < 2; ++bj) {
                    const int i = (ai * 4 + m) * 2 + bj; const f32x4 a0 = acc[ai][bj][m][0], a1 = acc[ai][bj][m][1];
                    const u32x4 sg = *(const u32x4*)(sS + i * 1024);
                    u32x4 pm_; pm_.x = cvt_pk_bf16(bflo(sg.x) * a0[0], bfhi(sg.x) * a0[1]); pm_.y = cvt_pk_bf16(bflo(sg.y) * a0[2], bfhi(sg.y) * a0[3]);
                    pm_.z = cvt_pk_bf16(bflo(sg.z) * a1[0], bfhi(sg.z) * a1[1]); pm_.w = cvt_pk_bf16(bflo(sg.w) * a1[2], bfhi(sg.w) * a1[3]);
                    *(u32x4*)(sM + i * 1024) = pm_;
                }
                asm volatile("" ::: "memory");
            EPI_ROWS_END
        } else {
            EPI_ROWS_BEGIN
                const int row = u.pm * 256 + rl;
#pragma unroll
                for (int bj = 0; bj < 2; ++bj) {
                    const int i = (ai * 4 + m) * 2 + bj; const f32x4 a0 = acc[ai][bj][m][0], a1 = acc[ai][bj][m][1];
                    const u32x4 sg = *(const u32x4*)(sS + i * 1024);
                    const u32x4 pm_ = *(const u32x4*)(sM + i * 1024);
                    f32x4 m0 = (f32x4){bflo(pm_.x), bfhi(pm_.x), bflo(pm_.y), bfhi(pm_.y)}, m1 = (f32x4){bflo(pm_.z), bfhi(pm_.z), bflo(pm_.w), bfhi(pm_.w)};
                    m0 = m0 + (f32x4){bflo(sg.x) * a0[0], bfhi(sg.x) * a0[1], bflo(sg.y) * a0[2], bfhi(sg.y) * a0[3]};
                    m1 = m1 + (f32x4){bflo(sg.z) * a1[0], bfhi(sg.z) * a1[1], bflo(sg.w) * a1[2], bfhi(sg.w) * a1[3]};
                    u32x4 w; w.x = cvt_pk_bf16(m0[0], m0[1]); w.y = cvt_pk_bf16(m0[2], m0[3]); w.z = cvt_pk_bf16(m1[0], m1[1]); w.w = cvt_pk_bf16(m1[2], m1[3]);
                    *(u32x4*)(MG + (size_t)row * DM + u.pn * 256 + bj * 128 + wc * 32 + fq * 8) = w;
                }
                asm volatile("" ::: "memory");
            EPI_ROWS_END
        }
    }
};
struct EpiAttn {
    bf16_t* Pb; bf16_t* Ob; bf16_t* Qb; const float* ssq;
    __device__ __forceinline__ void operator()(AccRef acc, const Unit& u, int wr, int wc, int fr, int fq, LAS unsigned char* lds) const {
        LAS float* xm = (LAS float*)(lds + XCH_OFF); LAS float* xs = xm + 1024;
        if (u.tag == 2) {
            EPI_ROWS_BEGIN
                const int row = u.pm * 256 + rl; const float rs = rsqrtf(ssq[row] * (1.f / 1024.f) + NORM_EPS);
#pragma unroll
                for (int bj = 0; bj < 2; ++bj) { const f32x4 v0 = acc[ai][bj][m][0] * rs, v1 = acc[ai][bj][m][1] * rs;
                    u32x4 w; w.x = cvt_pk_bf16(v0[0], v0[1]); w.y = cvt_pk_bf16(v0[2], v0[3]); w.z = cvt_pk_bf16(v1[0], v1[1]); w.w = cvt_pk_bf16(v1[2], v1[3]);
                    *(u32x4*)(Qb + (size_t)row * DM + u.pn * 256 + bj * 128 + wc * 32 + fq * 8) = w; }
            EPI_ROWS_END
            return;
        }
        if (u.tag == 1) {
            EPI_ROWS_BEGIN
                const int row = u.pm * 256 + rl;
#pragma unroll
                for (int bj = 0; bj < 2; ++bj) { const f32x4 v0 = acc[ai][bj][m][0], v1 = acc[ai][bj][m][1];
                    u32x4 w; w.x = cvt_pk_bf16(v0[0], v0[1]); w.y = cvt_pk_bf16(v0[2], v0[3]); w.z = cvt_pk_bf16(v1[0], v1[1]); w.w = cvt_pk_bf16(v1[2], v1[3]);
                    *(u32x4*)(Ob + (size_t)row * DM + u.pn * 256 + bj * 128 + wc * 32 + fq * 8) = w; }
            EPI_ROWS_END
            return;
        }
        EPI_ROWS_BEGIN
            float v = -3.0e38f;
#pragma unroll
            for (int bj = 0; bj < 2; ++bj)
#pragma unroll
                for (int n = 0; n < 2; ++n)
#pragma unroll
                    for (int j = 0; j < 4; ++j) v = fmaxf(v, acc[ai][bj][m][n][j]);
            v = fmaxf(v, __shfl_xor(v, 16)); v = fmaxf(v, __shfl_xor(v, 32));
            if (fq == 0) xm[rl * 4 + wc] = v;
        EPI_ROWS_END
        WG_BAR();
        EPI_ROWS_BEGIN
            const f32x4 q = *(const LAS f32x4*)(xm + rl * 4); const float M = fmaxf(fmaxf(q[0], q[1]), fmaxf(q[2], q[3]));
            float sum = 0.f;
#pragma unroll
            for (int bj = 0; bj < 2; ++bj)
#pragma unroll
                for (int n = 0; n < 2; ++n)
#pragma unroll
                    for (int j = 0; j < 4; ++j) sum += __expf(acc[ai][bj][m][n][j] - M);
            sum += __shfl_xor(sum, 16); sum += __shfl_xor(sum, 32);
            if (fq == 0) xs[rl * 4 + wc] = sum;
        EPI_ROWS_END
        WG_BAR();
        EPI_ROWS_BEGIN
            const int row = u.pm * 256 + rl;
            const f32x4 q = *(const LAS f32x4*)(xm + rl * 4); const float M = fmaxf(fmaxf(q[0], q[1]), fmaxf(q[2], q[3]));
            const f32x4 qs = *(const LAS f32x4*)(xs + rl * 4); const float inv = __builtin_amdgcn_rcpf((qs[0] + qs[1]) + (qs[2] + qs[3]));
#pragma unroll
            for (int bj = 0; bj < 2; ++bj) { const f32x4 a0 = acc[ai][bj][m][0], a1 = acc[ai][bj][m][1];
                u32x4 w; w.x = cvt_pk_bf16(__expf(a0[0] - M) * inv, __expf(a0[1] - M) * inv); w.y = cvt_pk_bf16(__expf(a0[2] - M) * inv, __expf(a0[3] - M) * inv);
                w.z = cvt_pk_bf16(__expf(a1[0] - M) * inv, __expf(a1[1] - M) * inv); w.w = cvt_pk_bf16(__expf(a1[2] - M) * inv, __expf(a1[3] - M) * inv);
                *(u32x4*)(Pb + (size_t)row * DM + u.pn * 256 + bj * 128 + wc * 32 + fq * 8) = w; }
            asm volatile("" ::: "memory");
        EPI_ROWS_END
        WG_BAR();
    }
};

struct TJob { const float* src; const float* gain; bf16_t* dst; int K, ldsrc, col0, ncols, dst_ld, dst_row0, dst_k0, mode; float scale; int item0; };
struct Params { const float* in[37]; float* out; unsigned char* ws; TJob jobs[20]; int njobs, nitems, ph_lo, ph_hi, coop, nearly; };

__device__ __forceinline__ void transpose_item(const TJob& J, int item, LAS float* scr, int lane) {
    const int nblk = (J.ncols + 31) >> 5, kb = item / nblk, nb = item - kb * nblk, k0 = 64 * kb, n0 = 32 * nb;
    const bool nok = (n0 + (lane & 31)) < J.ncols;
#pragma unroll
    for (int i = 0; i < 32; ++i) { const int kk = 2 * i + (lane >> 5);
        float v = 0.f; if (nok) { v = J.src[(size_t)(k0 + kk) * J.ldsrc + J.col0 + n0 + (lane & 31)] * J.scale; if (J.gain) v *= J.gain[k0 + kk]; }
        scr[kk * 33 + (lane & 31)] = v; }
    LDS_WAIT();
    const int c = lane & 7;
#pragma unroll
    for (int j = 0; j < 4; ++j) { const int n = n0 + (lane >> 3) + 8 * j; const LAS float* s = scr + (8 * c) * 33 + (n - n0);
        if (n < J.ncols) { u32x4 o; o.x = cvt_pk_bf16(s[0], s[33]); o.y = cvt_pk_bf16(s[66], s[99]); o.z = cvt_pk_bf16(s[132], s[165]); o.w = cvt_pk_bf16(s[198], s[231]);
            const int dr = (J.mode ? ((n >> 7) * 256 + (n & 127)) : n) + J.dst_row0;
            *(u32x4*)(J.dst + (size_t)dr * J.dst_ld + J.dst_k0 + k0 + 8 * c) = o; } }
    LDS_WAIT();
}
__device__ __forceinline__ void row_to_bf16_ssq(const float* xrow, bf16_t* orow, float* ssq, int lane) {
    const f32x4* xr = (const f32x4*)xrow + lane; f32x4 v[4]; float s = 0.f;
#pragma unroll
    for (int j = 0; j < 4; ++j) { v[j] = xr[64 * j]; s += (v[j].x * v[j].x + v[j].y * v[j].y) + (v[j].z * v[j].z + v[j].w * v[j].w); }
    s = wave_sum(s); if (lane == 0) *ssq = s;
    u32x2* o8 = (u32x2*)orow + lane;
#pragma unroll
    for (int j = 0; j < 4; ++j) { u32x2 w; w.x = cvt_pk_bf16(v[j].x, v[j].y); w.y = cvt_pk_bf16(v[j].z, v[j].w); o8[64 * j] = w; }
}
__device__ __forceinline__ void rows4_to_bf16_ssq(const float* xrow, bf16_t* orow, float* ssq, int lane) {
    f32x4 v[4][4]; float s[4];
#pragma unroll
    for (int r = 0; r < 4; ++r)
#pragma unroll
        for (int j = 0; j < 4; ++j) v[r][j] = ((const f32x4*)(xrow + (size_t)r * DM) + lane)[64 * j];
#pragma unroll
    for (int r = 0; r < 4; ++r) { s[r] = 0.f;
#pragma unroll
        for (int j = 0; j < 4; ++j) s[r] += (v[r][j].x * v[r][j].x + v[r][j].y * v[r][j].y) + (v[r][j].z * v[r][j].z + v[r][j].w * v[r][j].w); }
#pragma unroll
    for (int o = 1; o < 64; o <<= 1) {
#pragma unroll
        for (int r = 0; r < 4; ++r) s[r] += __shfl_xor(s[r], o); }
    if (lane < 4) ssq[lane] = lane == 0 ? s[0] : (lane == 1 ? s[1] : (lane == 2 ? s[2] : s[3]));
#pragma unroll
    for (int r = 0; r < 4; ++r) { u32x2* o8 = (u32x2*)(orow + (size_t)r * DM) + lane;
#pragma unroll
        for (int j = 0; j < 4; ++j) { u32x2 w; w.x = cvt_pk_bf16(v[r][j].x, v[r][j].y); w.y = cvt_pk_bf16(v[r][j].z, v[r][j].w); o8[64 * j] = w; } }
}
__device__ __forceinline__ void phase_prep(const Params& P, LAS unsigned char* lds) {
    const int tid = threadIdx.x, lane = tid & 63, wave = tid >> 6; unsigned char* ws = P.ws;
    const int gw = blockIdx.x * 8 + wave, NGW = gridDim.x * 8;
    LAS float* scr = (LAS float*)(lds + wave * 16384);
    for (int it = gw; it < P.nearly; it += NGW) {
        int j = 0;
        while (j + 1 < P.njobs && it >= P.jobs[j + 1].item0) ++j;
        transpose_item(P.jobs[j], it - P.jobs[j].item0, scr, lane);
    }
    for (int m = gw * 4; m < NTOK; m += NGW * 4) rows4_to_bf16_ssq(P.in[0] + (size_t)m * DM, (bf16_t*)(ws + OFF_XB) + (size_t)m * DM, (float*)(ws + OFF_SSQ0) + m, lane);
    for (int m = gw * 4; m < MEMTOK; m += NGW * 4) rows4_to_bf16_ssq(P.in[1] + (size_t)m * DM, (bf16_t*)(ws + OFF_MEMB) + (size_t)m * DM, (float*)(ws + OFF_SSQM) + m, lane);
    const int gt = blockIdx.x * 512 + tid, NGT = gridDim.x * 512;
    for (int i = gt; i < 4 * NTOK; i += NGT) ((float*)(ws + OFF_SSQ1))[i] = 0.f;
    for (int i = gt; i < (int)(8 * MiB / 16); i += NGT) ((u32x4*)(ws + OFF_STATS))[i] = (u32x4){0u, 0u, 0u, 0u};
    for (int i = gt; i < 248 * 1024 / 8; i += NGT) ((u32x4*)(ws + OFF_WIN + (size_t)3848 * 2048))[i] = (u32x4){0u, 0u, 0u, 0u};
}

#define RLX_AGENT __ATOMIC_RELAXED, __HIP_MEMORY_SCOPE_AGENT
__device__ __forceinline__ float red16(float x) {
    x += dpp_f<0xB1>(x); x += dpp_f<0x4E>(x); x += dpp_f<0x141>(x); x += dpp_f<0x140>(x); return x;
}
#define RWA_COL(ty_, cv_, h_, rg_) ((ty_) == 0 ? 1664 + (cv_) * 8 : ((ty_) == 1 ? 1536 + (cv_) * 8 : ((ty_) == 2 ? 1600 + (cv_) * 8 : ((ty_) == 3 ? (h_) * 64 + (cv_) * 8 : ((ty_) == 4 ? 512 + (h_) * 64 + (cv_) * 8 : 1024 + (h_) * 64 + (rg_) * 32 + (cv_) * 8)))))
#define RWA_MAP(p_, lane_, h_, rg_) \
    int ty0, ty1, cv0, cv1, tq0, tq1; bool act0 = true, act1 = true; \
    if ((p_) == 0) { ty0 = 0; cv0 = (lane_) & 7; ty1 = 3; cv1 = (lane_) & 7; tq0 = tq1 = (lane_) >> 3; } \
    else if ((p_) == 1) { ty0 = 0; cv0 = 8 + ((lane_) & 7); ty1 = 4; cv1 = (lane_) & 7; tq0 = tq1 = (lane_) >> 3; } \
    else if ((p_) == 2) { ty0 = 1; cv0 = (lane_) & 7; ty1 = 2; cv1 = (lane_) & 7; tq0 = tq1 = (lane_) >> 3; } \
    else { ty0 = 5; cv0 = (lane_) & 3; tq0 = ((lane_) >> 2) & 7; act0 = (lane_) < 32; ty1 = 5; cv1 = 0; tq1 = 0; act1 = false; } \
    const int col0 = RWA_COL(ty0, cv0, h_, rg_), col1 = RWA_COL(ty1, cv1, h_, rg_);
__device__ __forceinline__ void rwkv_item(const Params& P, LAS unsigned char* lds, int item) {
    const int bh = item >> 1, rg = item & 1, b = bh >> 3, h = bh & 7; unsigned char* ws = P.ws;
    const bf16_t* Z = (const bf16_t*)(ws + OFF_Z); bf16_t* Yb = (bf16_t*)(ws + OFF_Y);
    unsigned long long* gran = (unsigned long long*)(ws + OFF_STATS);
    const float* mu = P.in[8]; const float* w0 = P.in[9]; const float* a0 = P.in[11]; const float* k_k = P.in[14]; const float* k_a = P.in[15]; const float* r_k = P.in[16];
    const float* gn_w = P.in[17]; const float* gn_b = P.in[18];
#define OPS_RR(s_) ((LAS float*)(lds + (s_) * 40960))
#define OPS_WW(s_) ((LAS float*)(lds + (s_) * 40960 + 8192))
#define OPS_BV(s_) ((LAS float*)(lds + (s_) * 40960 + 16384))
#define OPS_KM(s_) ((LAS float*)(lds + (s_) * 40960 + 24576))
#define OPS_KK(s_) ((LAS float*)(lds + (s_) * 40960 + 32768))
    LAS bf16_t* AW = (LAS bf16_t*)(lds + 81920); LAS bf16_t* AA = (LAS bf16_t*)(lds + 86528); LAS bf16_t* AG = (LAS bf16_t*)(lds + 91136);
    LAS float* KS = (LAS float*)(lds + 99840); LAS float* Aa = (LAS float*)(lds + 108032);
#define VV(s_) ((LAS float*)(lds + 116224 + (s_) * 4096))
#define YY(j_) ((LAS float*)(lds + 124416 + (j_) * 4096))
    LAS float* Gt = (LAS float*)(lds + 140800);
#define Q1B(j_) ((LAS bf16_t*)(lds + 144896 + (j_) * 2048))
#define Q2B(j_) ((LAS bf16_t*)(lds + 153088 + (j_) * 2048))
    LAS float* PRM = (LAS float*)(lds + 161280);
    LAS unsigned* GB = (LAS unsigned*)(lds + 162816);
    {
        const int tid = threadIdx.x;
        if (tid < 64) { PRM[tid] = k_k[h * 64 + tid]; PRM[64 + tid] = k_a[h * 64 + tid]; PRM[128 + tid] = r_k[h * 64 + tid]; PRM[192 + tid] = w0[h * 64 + tid]; PRM[256 + tid] = a0[h * 64 + tid]; }
        if (tid < 32) { PRM[320 + tid] = gn_w[h * 64 + rg * 32 + tid]; PRM[352 + tid] = gn_b[h * 64 + rg * 32 + tid]; }
        if (tid == 0) GB[0] = 0u;
    }
    bf16x8 bw[2][2], ba[2][2], bg[4];
    {
        const int lane = threadIdx.x & 63, fr = lane & 15, fq = lane >> 4, p = (threadIdx.x >> 6) & 3, kp = p >> 1;
#pragma unroll
        for (int q = 0; q < 2; ++q) { const int ch = h * 64 + (2 * kp + q) * 16 + fr;
#pragma unroll
            for (int ks = 0; ks < 2; ++ks) { bw[q][ks] = *(const bf16x8*)((const bf16_t*)(ws + OFF_W2T) + (size_t)ch * 64 + ks * 32 + fq * 8); ba[q][ks] = *(const bf16x8*)((const bf16_t*)(ws + OFF_A2T) + (size_t)ch * 64 + ks * 32 + fq * 8); } }
#pragma unroll
        for (int ks = 0; ks < 4; ++ks) bg[ks] = *(const bf16x8*)((const bf16_t*)(ws + OFF_G2T) + (size_t)(h * 64 + rg * 32 + kp * 16 + fr) * 128 + ks * 32 + fq * 8);
    }
    f32x2 S2[4] = {{0.f, 0.f}, {0.f, 0.f}, {0.f, 0.f}, {0.f, 0.f}};
    float muA[8], muB[8]; u32x4 pzA[4], pzB[4], ppA, ppB; unsigned gbgen = 0u; float ps1 = 0.f, ps2 = 0.f;
    {
        RWA_MAP(((int)(threadIdx.x >> 6)) & 3, (int)(threadIdx.x & 63), h, rg)
        (void)act0; (void)act1; (void)tq0; (void)tq1;
        const f32x4 m0 = *(const f32x4*)(mu + col0), m1 = *(const f32x4*)(mu + col0 + 4), n0 = *(const f32x4*)(mu + col1), n1 = *(const f32x4*)(mu + col1 + 4);
#pragma unroll
        for (int j = 0; j < 4; ++j) { muA[j] = m0[j]; muA[4 + j] = m1[j]; muB[j] = n0[j]; muB[4 + j] = n1[j]; }
    }
#define RW_PF1(cn, pz_, pp_, act_, tq_, col_) do { pp_ = (u32x4){0u, 0u, 0u, 0u}; _Pragma("unroll") for (int i_ = 0; i_ < 4; ++i_) pz_[i_] = pp_; \
        if (act_) { const size_t tok = (size_t)b * SEQ + (cn) * 32 + (tq_) * 4; if ((cn) * 32 + (tq_) * 4 > 0) pp_ = *(const u32x4*)(Z + (tok - 1) * ZLD + (col_)); \
            _Pragma("unroll") for (int i_ = 0; i_ < 4; ++i_) pz_[i_] = *(const u32x4*)(Z + (tok + i_) * ZLD + (col_)); } } while (0)
#define RW_PREFETCH(cn) do { RW_PF1(cn, pzA, ppA, act0, tq0, col0); RW_PF1(cn, pzB, ppB, act1, tq1, col1); } while (0)
#define GRP_BAR() do { asm volatile("s_waitcnt lgkmcnt(0)" ::: "memory"); gbgen += 1u; if (lane == 0) (void)__hip_atomic_fetch_add(GB, 1u, __ATOMIC_RELAXED, __HIP_MEMORY_SCOPE_WORKGROUP); \
        { unsigned sp_ = 0; while (__hip_atomic_load(GB, __ATOMIC_RELAXED, __HIP_MEMORY_SCOPE_WORKGROUP) < gbgen * 4u) { if (++sp_ > (1u << 24)) break; } } asm volatile("" ::: "memory"); } while (0)
    {
        RWA_MAP(((int)(threadIdx.x >> 6)) & 3, (int)(threadIdx.x & 63), h, rg)
        act0 = act0 && threadIdx.x >= 256; act1 = act1 && threadIdx.x >= 256;
        RW_PREFETCH(0);
    }
    WG_BAR();
#pragma unroll 1
    for (int it = 0; it < 131; ++it) {
        int tl_ = threadIdx.x; asm volatile("" : "+v"(tl_));
        const int tid = tl_, lane = tid & 63, wave = __builtin_amdgcn_readfirstlane(tid >> 6), fr = lane & 15, fq = lane >> 4;
        if (wave >= 4) {
            unsigned long long g0 = 0ull, g1 = 0ull;
            if (wave == 7 && it >= 3) {
                const unsigned long long* gb3 = gran + (((size_t)bh * 128 + (it - 3)) * 2) * 64 + (lane & 31) * 2 + (rg ^ 1) * 64;
                g0 = __hip_atomic_load(gb3, RLX_AGENT); g1 = __hip_atomic_load(gb3 + 1, RLX_AGENT);
            }
            if (it < 128) {
                const int c = it, os = c & 1, qj = c & 3;
                const int tidp = tid - 256, p = wave - 4, tt = p & 1, kp = p >> 1;
                RWA_MAP(p, lane, h, rg)
                LAS float* Rr = OPS_RR(os); LAS float* Ww = OPS_WW(os); LAS float* Bv = OPS_BV(os); LAS float* KM = OPS_KM(os); LAS float* KK = OPS_KK(os); LAS float* Vv = VV(os);
#define RWA_SEG(pz_, pp_, mu_, act_, ty_, cv_, tq_) do { if (act_) { _Pragma("unroll") for (int i = 0; i < 4; ++i) { \
                    const int t = (tq_) * 4 + i; const u32x4 zc = pz_[i], zp = (i == 0) ? pp_ : pz_[i > 0 ? i - 1 : 0]; \
                    float z[8]; const float c8[8] = {bflo(zc.x), bfhi(zc.x), bflo(zc.y), bfhi(zc.y), bflo(zc.z), bfhi(zc.z), bflo(zc.w), bfhi(zc.w)}; \
                    const float p8[8] = {bflo(zp.x), bfhi(zp.x), bflo(zp.y), bfhi(zp.y), bflo(zp.z), bfhi(zp.z), bflo(zp.w), bfhi(zp.w)}; \
                    _Pragma("unroll") for (int j = 0; j < 8; ++j) z[j] = c8[j] + (p8[j] - c8[j]) * mu_[j]; \
                    if ((ty_) >= 3) { LAS float* dst = (ty_) == 3 ? Rr + t * 64 + (cv_) * 8 : ((ty_) == 4 ? KS + t * 64 + (cv_) * 8 : Vv + t * 32 + (cv_) * 8); \
                        *(LAS f32x4*)dst = (f32x4){z[0], z[1], z[2], z[3]}; *(LAS f32x4*)(dst + 4) = (f32x4){z[4], z[5], z[6], z[7]}; } \
                    else { LAS bf16_t* dst; \
                        if ((ty_) == 1) { dst = AW + t * 72 + (cv_) * 8; _Pragma("unroll") for (int j = 0; j < 8; ++j) z[j] = 1.f - 2.f * __builtin_amdgcn_rcpf(__expf(2.f * z[j]) + 1.f); } \
                        else if ((ty_) == 2) dst = AA + t * 72 + (cv_) * 8; \
                        else { dst = AG + t * 136 + (cv_) * 8; _Pragma("unroll") for (int j = 0; j < 8; ++j) z[j] = fsigmoid(z[j]); } \
                        u32x4 w; w.x = cvt_pk_bf16(z[0], z[1]); w.y = cvt_pk_bf16(z[2], z[3]); w.z = cvt_pk_bf16(z[4], z[5]); w.w = cvt_pk_bf16(z[6], z[7]); \
                        *(LAS u32x4*)dst = w; } } } } while (0)
                RWA_SEG(pzA, ppA, muA, act0, ty0, cv0, tq0);
                RWA_SEG(pzB, ppB, muB, act1, ty1, cv1, tq1);
#undef RWA_SEG
                if (c < 127) RW_PREFETCH(c + 1);
                GRP_BAR();
                {
                    bf16x8 aw[2], aa[2];
#pragma unroll
                    for (int ks = 0; ks < 2; ++ks) { aw[ks] = *(const LAS bf16x8*)(AW + (tt * 16 + fr) * 72 + ks * 32 + fq * 8); aa[ks] = *(const LAS bf16x8*)(AA + (tt * 16 + fr) * 72 + ks * 32 + fq * 8); }
                    const int t = tt * 16 + fr;
#pragma unroll
                    for (int q = 0; q < 2; ++q) {
                        f32x4 cw = (f32x4){0.f, 0.f, 0.f, 0.f}, ca = cw;
#pragma unroll
                        for (int ks = 0; ks < 2; ++ks) { cw = __builtin_amdgcn_mfma_f32_16x16x32_bf16(bw[q][ks], aw[ks], cw, 0, 0, 0); ca = __builtin_amdgcn_mfma_f32_16x16x32_bf16(ba[q][ks], aa[ks], ca, 0, 0, 0); }
                        const int kl = (2 * kp + q) * 16 + fq * 4;
                        const f32x4 w0v = *(const LAS f32x4*)(PRM + 192 + kl), a0v = *(const LAS f32x4*)(PRM + 256 + kl);
                        f32x4 dw, av;
#pragma unroll
                        for (int j = 0; j < 4; ++j) { dw[j] = __expf(-0.6065306597f * fsigmoid(w0v[j] + cw[j])); av[j] = fsigmoid(a0v[j] + ca[j]); }
                        *(LAS f32x4*)(Ww + t * 64 + kl) = dw; *(LAS f32x4*)(Aa + t * 64 + kl) = av;
                    }
                    f32x4 cg_ = (f32x4){0.f, 0.f, 0.f, 0.f};
#pragma unroll
                    for (int ks = 0; ks < 4; ++ks) { const bf16x8 ag = *(const LAS bf16x8*)(AG + (tt * 16 + fr) * 136 + ks * 32 + fq * 8); cg_ = __builtin_amdgcn_mfma_f32_16x16x32_bf16(bg[ks], ag, cg_, 0, 0, 0); }
                    *(LAS f32x4*)(Gt + t * 32 + kp * 16 + fq * 4) = cg_;
                }
                GRP_BAR();
                {
                    const int t = tidp >> 3, k8 = tidp & 7, k0 = k8 * 8;
                    float ks8[8], a8[8], r8[8], kk8[8], km8[8], pk[8], pa[8], pr[8]; float n2 = 0.f, bon = 0.f;
#pragma unroll
                    for (int i = 0; i < 2; ++i) { const f32x4 x0 = *(const LAS f32x4*)(KS + t * 64 + k0 + 4 * i), x1 = *(const LAS f32x4*)(Aa + t * 64 + k0 + 4 * i), x2 = *(const LAS f32x4*)(Rr + t * 64 + k0 + 4 * i);
                        const f32x4 y0 = *(const LAS f32x4*)(PRM + k0 + 4 * i), y1 = *(const LAS f32x4*)(PRM + 64 + k0 + 4 * i), y2 = *(const LAS f32x4*)(PRM + 128 + k0 + 4 * i);
#pragma unroll
                        for (int j = 0; j < 4; ++j) { ks8[4 * i + j] = x0[j]; a8[4 * i + j] = x1[j]; r8[4 * i + j] = x2[j]; pk[4 * i + j] = y0[j]; pa[4 * i + j] = y1[j]; pr[4 * i + j] = y2[j]; } }
#pragma unroll
                    for (int i = 0; i < 8; ++i) { kk8[i] = ks8[i] * pk[i]; n2 += kk8[i] * kk8[i]; km8[i] = ks8[i] * (1.f + (a8[i] - 1.f) * pa[i]); bon += r8[i] * km8[i] * pr[i]; }
                    n2 = red8(n2); bon = red8(bon);
                    const float inv = 1.f / fmaxf(sqrtf(n2), 1e-12f);
                    f32x4 o0[2], o1[2], o2[2];
#pragma unroll
                    for (int i = 0; i < 8; ++i) { const float kn = kk8[i] * inv; o0[i >> 2][i & 3] = -kn; o1[i >> 2][i & 3] = km8[i]; o2[i >> 2][i & 3] = kn * a8[i]; }
#pragma unroll
                    for (int i = 0; i < 2; ++i) { *(LAS f32x4*)(KK + t * 64 + k0 + 4 * i) = o0[i]; *(LAS f32x4*)(KM + t * 64 + k0 + 4 * i) = o1[i]; *(LAS f32x4*)(Bv + t * 64 + k0 + 4 * i) = o2[i]; }
                    const int r4 = k8 * 4;
                    const f32x4 g4 = *(const LAS f32x4*)(Gt + t * 32 + r4), v4 = *(const LAS f32x4*)(Vv + t * 32 + r4), gw4 = *(const LAS f32x4*)(PRM + 320 + r4), gb4 = *(const LAS f32x4*)(PRM + 352 + r4);
                    u32x2 q1, q2;
                    q1.x = cvt_pk_bf16(g4[0] * gw4[0], g4[1] * gw4[1]); q1.y = cvt_pk_bf16(g4[2] * gw4[2], g4[3] * gw4[3]);
                    q2.x = cvt_pk_bf16(g4[0] * (gb4[0] + bon * v4[0]), g4[1] * (gb4[1] + bon * v4[1])); q2.y = cvt_pk_bf16(g4[2] * (gb4[2] + bon * v4[2]), g4[3] * (gb4[3] + bon * v4[3]));
                    *(LAS u32x2*)(Q1B(qj) + t * 32 + r4) = q1; *(LAS u32x2*)(Q2B(qj) + t * 32 + r4) = q2;
                }
            }
            if (wave == 7 && it >= 2) {
                const int t = lane & 31;
                float ns1 = 0.f, ns2 = 0.f;
                if (it <= 129) {
                    const int c = it - 2, yj = c & 3;
#pragma unroll
                    for (int i = 0; i < 8; ++i) { const f32x4 y = *(const LAS f32x4*)(YY(yj) + t * 32 + 4 * i); ns1 += (y[0] + y[1]) + (y[2] + y[3]); ns2 += (y[0] * y[0] + y[1] * y[1]) + (y[2] * y[2] + y[3] * y[3]); }
                    const unsigned long long ep = (unsigned long long)(unsigned)(c + 1) << 32;
                    unsigned long long* gbase = gran + (((size_t)bh * 128 + c) * 2) * 64 + t * 2;
                    if (lane < 32) { __hip_atomic_store(gbase + rg * 64, ep | __builtin_bit_cast(unsigned, ns1), RLX_AGENT); __hip_atomic_store(gbase + rg * 64 + 1, ep | __builtin_bit_cast(unsigned, ns2), RLX_AGENT); }
                }
                if (it >= 3) {
                    const int c = it - 3, yj = c & 3;
                    unsigned long long* gb3 = gran + (((size_t)bh * 128 + c) * 2) * 64 + t * 2 + (rg ^ 1) * 64;
                    unsigned spins = 0;
                    for (;;) {
                        const bool ok = ((g0 >> 32) == (unsigned long long)(unsigned)(c + 1)) && ((g1 >> 32) == (unsigned long long)(unsigned)(c + 1));
                        if (__all(ok)) break;
                        __builtin_amdgcn_s_sleep(2); if (++spins > (1u << 20)) break;
                        g0 = __hip_atomic_load(gb3, RLX_AGENT); g1 = __hip_atomic_load(gb3 + 1, RLX_AGENT);
                    }
                    const float s1 = ps1 + __builtin_bit_cast(float, (unsigned)g0), s2 = ps2 + __builtin_bit_cast(float, (unsigned)g1);
                    const float mean = s1 * (1.f / 64.f), var = fmaxf(s2 * (1.f / 64.f) - mean * mean, 0.f), rstd = rsqrtf(var + 64e-5f);
                    if (lane < 32) {
                        bf16_t* dst = Yb + ((size_t)b * SEQ + c * 32 + t) * DM + h * 64 + rg * 32;
#pragma unroll
                        for (int i = 0; i < 4; ++i) {
                            const f32x4 ya = *(const LAS f32x4*)(YY(yj) + t * 32 + 8 * i), yb = *(const LAS f32x4*)(YY(yj) + t * 32 + 8 * i + 4);
                            const u32x4 q1 = *(const LAS u32x4*)(Q1B(yj) + t * 32 + 8 * i), q2 = *(const LAS u32x4*)(Q2B(yj) + t * 32 + 8 * i);
                            u32x4 w;
                            w.x = cvt_pk_bf16((ya[0] - mean) * rstd * bflo(q1.x) + bflo(q2.x), (ya[1] - mean) * rstd * bfhi(q1.x) + bfhi(q2.x));
                            w.y = cvt_pk_bf16((ya[2] - mean) * rstd * bflo(q1.y) + bflo(q2.y), (ya[3] - mean) * rstd * bfhi(q1.y) + bfhi(q2.y));
                            w.z = cvt_pk_bf16((yb[0] - mean) * rstd * bflo(q1.z) + bflo(q2.z), (yb[1] - mean) * rstd * bfhi(q1.z) + bfhi(q2.z));
                            w.w = cvt_pk_bf16((yb[2] - mean) * rstd * bflo(q1.w) + bflo(q2.w), (yb[3] - mean) * rstd * bfhi(q1.w) + bfhi(q2.w));
                            *(u32x4*)(dst + 8 * i) = w;
                        }
                    }
                }
                ps1 = ns1; ps2 = ns2;
            }
        } else if (it >= 1 && it <= 128) {
            const int c = it - 1, os = c & 1, yj = c & 3, grp = tid >> 4, kq = tid & 15;
            LAS const unsigned char* ob = (LAS const unsigned char*)OPS_RR(os) + kq * 16;
            LAS const unsigned char* vp = (LAS const unsigned char*)VV(os) + grp * 8; LAS unsigned char* yp = (LAS unsigned char*)YY(yj) + grp * 8;
            f32x4 wA, bA, mA, kA, rA, wB, bB, mB, kB, rB; f32x2 vA, vB;
#define RW_LD(X, d) do { r##X = *(const LAS f32x4*)(ob + (d) * 256); w##X = *(const LAS f32x4*)(ob + (d) * 256 + 8192); b##X = *(const LAS f32x4*)(ob + (d) * 256 + 16384); m##X = *(const LAS f32x4*)(ob + (d) * 256 + 24576); \
                k##X = *(const LAS f32x4*)(ob + (d) * 256 + 32768); v##X = *(const LAS f32x2*)(vp + (d) * 128); } while (0)
#define RW_LVL(a_, b_, C) do { a_ += dpp_f<C>(a_); b_ += dpp_f<C>(b_); asm volatile("" : "+v"(a_), "+v"(b_)); } while (0)
#define RW_RED2(x) do { float a_ = x[0], b_ = x[1]; RW_LVL(a_, b_, 0xB1); RW_LVL(a_, b_, 0x4E); RW_LVL(a_, b_, 0x141); RW_LVL(a_, b_, 0x140); x = (f32x2){a_, b_}; } while (0)
#define RW_STEP(X, t) do { f32x2 sa = S2[0] * k##X[0]; sa = S2[1] * k##X[1] + sa; sa = S2[2] * k##X[2] + sa; sa = S2[3] * k##X[3] + sa; RW_RED2(sa); \
                _Pragma("unroll") for (int i = 0; i < 4; ++i) S2[i] = S2[i] * w##X[i] + (sa * b##X[i] + v##X * m##X[i]); \
                f32x2 y = S2[0] * r##X[0]; y = S2[1] * r##X[1] + y; y = S2[2] * r##X[2] + y; y = S2[3] * r##X[3] + y; RW_RED2(y); \
                if (kq == 0) *(LAS f32x2*)(yp + (t) * 128) = y; } while (0)
            RW_LD(A, 0);
#pragma unroll 1
            for (int t = 0; t < 32; t += 2) {
                RW_LD(B, 1); __builtin_amdgcn_sched_barrier(0);
                RW_STEP(A, 0); __builtin_amdgcn_sched_barrier(0);
                if (t == 30) { ob -= 30 * 256; vp -= 30 * 128; }
                RW_LD(A, 2); __builtin_amdgcn_sched_barrier(0);
                RW_STEP(B, 1); __builtin_amdgcn_sched_barrier(0);
                ob += 512; vp += 256; yp += 256;
            }
#undef RW_LD
#undef RW_STEP
#undef RW_RED2
#undef RW_LVL
        }
        WG_BAR();
    }
#undef RW_PREFETCH
#undef RW_PF1
#undef GRP_BAR
#undef OPS_RR
#undef OPS_WW
#undef OPS_BV
#undef OPS_KM
#undef OPS_KK
#undef VV
#undef YY
#undef Q1B
#undef Q2B
}

#define TRI(r, t) ((r) * 72 + (((((t) >> 3) ^ (((r) >> 3) & 7))) << 3) + ((t) & 7))
#define TRB(r, blk) ((r) * 72 + (((blk) ^ (((r) >> 3) & 7)) << 3))
__device__ __forceinline__ void mlstm_item(const Params& P, LAS unsigned char* lds, int bh) {
    const int tid = threadIdx.x, lane = tid & 63, wave = tid >> 6, fr = lane & 15, fq = lane >> 4;
    const int b = bh >> 2, h = bh & 3; unsigned char* ws = P.ws;
    const bf16_t* Z = (const bf16_t*)(ws + OFF_Z); bf16_t* Yb = (bf16_t*)(ws + OFF_Y); const float* IFb = (const float*)(ws + OFF_IF);
    const float* cw = P.in[19]; const float* cb = P.in[20]; const float ib = P.in[21][h], fb = P.in[22][h]; const float* mln = P.in[23];
    LAS bf16_t* Qs = (LAS bf16_t*)(lds); LAS bf16_t* Ks = (LAS bf16_t*)(lds + 17408); LAS bf16_t* KT = (LAS bf16_t*)(lds + 34816); LAS bf16_t* VT = (LAS bf16_t*)(lds + 53248);
    LAS bf16_t* VwT = (LAS bf16_t*)(lds + 71680); LAS bf16_t* Pp = (LAS bf16_t*)(lds + 90112); LAS bf16_t* Cb = (LAS bf16_t*)(lds + 99328);
    LAS float* F = (LAS float*)(lds + 134144);
    LAS float* ga = F, *gu = F + 64, *gwl = F + 128, *gwi = F + 192, *gei = F + 256, *dn = F + 320, *nq = F + 384, *lnx = F + 448  , *ns = F + 704  , *sc = F + 832;
    LAS float* CWL = (LAS float*)(lds + 138240);
    LAS float* CBL = CWL + 1024; LAS float* MLN = CWL + 1280;
    for (int i = tid; i < 1024; i += 512) { const int j = i >> 8, cc = i & 255; CWL[i] = cw[j * 1024 + (cc < 128 ? h * 128 + cc : 512 + h * 128 + cc - 128)]; }
    if (tid < 256) CBL[tid] = cb[tid < 128 ? h * 128 + tid : 512 + h * 128 + tid - 128];
    if (tid < 128) MLN[tid] = mln[h * 128 + tid];
    f32x4 Cacc[8];
#pragma unroll
    for (int i = 0; i < 8; ++i) Cacc[i] = (f32x4){0.f, 0.f, 0.f, 0.f};
    const int pcv = tid & 31, ptg = tid >> 5; const bool pisk = pcv >= 16; const int pc8 = (pcv & 15) * 8;
    const int pzcol = (pisk ? 2304 : 1792) + h * 128 + pc8;
    u32x4 rw[7], vx[2]; u32x2 ogp[4]; float pfb = 0.f, pfu = 0.f, pfp = 0.f, pfe = 0.f, pfm = 0.f;
#define ML_PF_QKV(cn) do { _Pragma("unroll") for (int d = 0; d < 7; ++d) { const int tl = (cn) * 64 + ptg * 4 - 3 + d; rw[d] = (u32x4){0u, 0u, 0u, 0u}; if (tl >= 0) rw[d] = *(const u32x4*)(Z + ((size_t)b * SEQ + tl) * ZLD + pzcol); } \
        _Pragma("unroll") for (int rep = 0; rep < 2; ++rep) { const int v = tid + rep * 512; vx[rep] = *(const u32x4*)(Z + ((size_t)b * SEQ + (cn) * 64 + (v >> 4)) * ZLD + 2816 + h * 128 + (v & 15) * 8); } } while (0)
#define ML_PF_IF(cn) do { if (wave == 0) { pfb = GS[(cn) * 64 + lane]; pfu = GS[4096 + (cn) * 64 + lane]; pfp = GS[8192 + (cn) * 64 + lane]; pfe = GS[12288 + (cn)]; pfm = GS[12352 + (cn)]; } } while (0)
#define ML_PF_OG(cn) do { _Pragma("unroll") for (int q = 0; q < 4; ++q) ogp[q] = *(const u32x2*)(Z + ((size_t)b * SEQ + (cn) * 64 + (wave & 3) * 16 + fr) * ZLD + 3328 + h * 128 + ((wave >> 2) * 4 + q) * 16 + fq * 4); } while (0)
    float* GS = (float*)(ws + OFF_GATES) + (size_t)bh * 12416;
    for (int cc = wave; cc < 64; cc += 8) {
        const size_t tk = (size_t)b * SEQ + cc * 64 + lane;
        const float ig = IFb[tk * 8 + h] + ib, fg = IFb[tk * 8 + 4 + h] + fb;
        const float lf = fminf(fg, 0.f) - __logf(1.f + __expf(-fabsf(fg)));
        float bc = lf;
#pragma unroll
        for (int o = 1; o < 64; o <<= 1) { const float t = __shfl_up(bc, o); if (lane >= o) bc += t; }
        const float bend = __shfl(bc, 63), u = ig - bc;
        float mc = bend + u;
#pragma unroll
        for (int o = 1; o < 64; o <<= 1) mc = fmaxf(mc, __shfl_xor(mc, o));
        float pm = u;
#pragma unroll
        for (int o = 1; o < 64; o <<= 1) { const float t = __shfl_up(pm, o); if (lane >= o) pm = fmaxf(pm, t); }
        GS[cc * 64 + lane] = bc; GS[4096 + cc * 64 + lane] = u; GS[8192 + cc * 64 + lane] = pm;
        if (lane == 0) { GS[12288 + cc] = bend; GS[12352 + cc] = mc; }
    }
    WG_BAR_ALL();
    ML_PF_IF(0); ML_PF_QKV(0); ML_PF_OG(0);
    for (int i = tid; i < 128 * 136 / 2; i += 512) ((LAS unsigned*)Cb)[i] = 0u;
    if (tid < 128) ns[tid] = 0.f;
    float mprev = 0.f;
    WG_BAR();
#pragma unroll 1
    for (int c = 0; c < 64; ++c) {
        int tl_ = threadIdx.x; asm volatile("" : "+v"(tl_));
        const int tid = tl_, lane = tid & 63, wave = tid >> 6, fr = lane & 15, fq = lane >> 4;
        const int pcv = tid & 31, ptg = tid >> 5; const bool pisk = pcv >= 16; const int pc8 = (pcv & 15) * 8;
        const int pzcol = (pisk ? 2304 : 1792) + h * 128 + pc8;
        const size_t tokc = (size_t)b * SEQ + c * 64;
        if (wave == 0) {
            const float bc = pfb, u = pfu, pm = pfp, bend = pfe, mc = pfm;
            ML_PF_IF((c + 1) & 63);
            const float lw = bend + u;
            const float mnew = fmaxf(bend + mprev, mc), dec = __expf(bend + mprev - mnew);
            const float linter = bc + mprev, mrow = fmaxf(linter, bc + pm);
            ga[lane] = bc - mrow; gu[lane] = u; gwl[lane] = __expf(lw - mnew); gwi[lane] = __expf(linter - mrow); gei[lane] = __expf(-mrow); dn[lane] = 0.f;
            if (lane == 0) { sc[0] = dec; sc[1] = mnew; }
        }
        WG_BAR();
        {
            const int tg = ptg; const bool isk = pisk; const int c8 = pc8, lch = (isk ? 128 : 0) + c8;
            float wt[4][8], bs[8];
#pragma unroll
            for (int j = 0; j < 4; ++j) { const f32x4 x0 = *(const LAS f32x4*)(CWL + j * 256 + lch), x1 = *(const LAS f32x4*)(CWL + j * 256 + lch + 4);
#pragma unroll
                for (int i = 0; i < 4; ++i) { wt[j][i] = x0[i]; wt[j][4 + i] = x1[i]; } }
            { const f32x4 x0 = *(const LAS f32x4*)(CBL + lch), x1 = *(const LAS f32x4*)(CBL + lch + 4);
#pragma unroll
              for (int i = 0; i < 4; ++i) { bs[i] = x0[i]; bs[4 + i] = x1[i]; } }
#pragma unroll
            for (int q = 0; q < 4; ++q) {
                const int t = tg * 4 + q; float o[8];
#pragma unroll
                for (int i = 0; i < 8; ++i) o[i] = bs[i];
#pragma unroll
                for (int j = 0; j < 4; ++j) { const u32x4 x = rw[3 + q - j]; const float x8[8] = {bflo(x.x), bfhi(x.x), bflo(x.y), bfhi(x.y), bflo(x.z), bfhi(x.z), bflo(x.w), bfhi(x.w)};
#pragma unroll
                    for (int i = 0; i < 8; ++i) o[i] += wt[j][i] * x8[i]; }
#pragma unroll
                for (int i = 0; i < 8; ++i) { o[i] = o[i] * fsigmoid(o[i]); if (!isk) o[i] *= 0.08838834764831845f; }
                u32x4 w; w.x = cvt_pk_bf16(o[0], o[1]); w.y = cvt_pk_bf16(o[2], o[3]); w.z = cvt_pk_bf16(o[4], o[5]); w.w = cvt_pk_bf16(o[6], o[7]);
                if (!isk) *(LAS u32x4*)(Qs + t * 136 + c8) = w;
                else { *(LAS u32x4*)(Ks + t * 136 + c8) = w;
#pragma unroll
                    for (int i = 0; i < 8; ++i) KT[TRI(c8 + i, t)] = f2bf(o[i]); }
            }
#pragma unroll
            for (int rep = 0; rep < 2; ++rep) {
                const int v = tid + rep * 512, t = v >> 4, v8 = (v & 15) * 8;
                const u32x4 x = vx[rep]; const float wl = gwl[t];
                const float x8[8] = {bflo(x.x), bfhi(x.x), bflo(x.y), bfhi(x.y), bflo(x.z), bfhi(x.z), bflo(x.w), bfhi(x.w)};
#pragma unroll
                for (int i = 0; i < 8; ++i) { VT[TRI(v8 + i, t)] = f2bf(x8[i]); VwT[TRI(v8 + i, t)] = f2bf(x8[i] * wl); }
            }
            if (c < 63) ML_PF_QKV(c + 1);
        }
        WG_BAR();
        const int st = wave & 3;
        bf16x8 qf[4];
#pragma unroll
        for (int ks = 0; ks < 4; ++ks) qf[ks] = *(const LAS bf16x8*)(Qs + (st * 16 + fr) * 136 + ks * 32 + fq * 8);
        {
            const int s = st * 16 + fr; const float gas = ga[s]; float dsum = 0.f;
#pragma unroll
            for (int q = 0; q < 2; ++q) {
                const int rt = (wave >> 2) * 2 + q; f32x4 a = (f32x4){0.f, 0.f, 0.f, 0.f};
#pragma unroll
                for (int ks = 0; ks < 4; ++ks) { const bf16x8 kf = *(const LAS bf16x8*)(Ks + (rt * 16 + fr) * 136 + ks * 32 + fq * 8); a = __builtin_amdgcn_mfma_f32_16x16x32_bf16(kf, qf[ks], a, 0, 0, 0); }
                const int r0 = rt * 16 + fq * 4; float p[4];
#pragma unroll
                for (int j = 0; j < 4; ++j) { p[j] = (r0 + j <= s) ? __expf(gas + gu[r0 + j]) * a[j] : 0.f; dsum += p[j]; }
                u32x2 w; w.x = cvt_pk_bf16(p[0], p[1]); w.y = cvt_pk_bf16(p[2], p[3]); *(LAS u32x2*)(Pp + s * 72 + r0) = w;
            }
            dsum += __shfl_xor(dsum, 16); dsum += __shfl_xor(dsum, 32);
            if (fq == 0) __hip_atomic_fetch_add(dn + s, dsum, __ATOMIC_RELAXED, __HIP_MEMORY_SCOPE_WORKGROUP);
            const int s2 = tid >> 3, kq = tid & 7; float a = 0.f;
#pragma unroll
            for (int i = 0; i < 16; ++i) a += ns[kq * 16 + i] * bf2f(Qs[s2 * 136 + kq * 16 + i]);
            a = red8(a); if (kq == 0) nq[s2] = a;
        }
        WG_BAR();
        {
            const int s = st * 16 + fr, vh = wave >> 2; const float wi = gwi[s];
            const float den = dn[s] + wi * nq[s], dinv = 1.f / fmaxf(fabsf(den), gei[s]);
            bf16x8 pf[2];
#pragma unroll
            for (int ks = 0; ks < 2; ++ks) pf[ks] = *(const LAS bf16x8*)(Pp + s * 72 + ks * 32 + fq * 8);
            f32x4 hv[4]; float s1 = 0.f, s2 = 0.f;
#pragma unroll
            for (int q = 0; q < 4; ++q) {
                const int vt = vh * 4 + q; f32x4 a = (f32x4){0.f, 0.f, 0.f, 0.f};
#pragma unroll
                for (int ks = 0; ks < 4; ++ks) { const bf16x8 cf = *(const LAS bf16x8*)(Cb + (vt * 16 + fr) * 136 + ks * 32 + fq * 8); a = __builtin_amdgcn_mfma_f32_16x16x32_bf16(cf, qf[ks], a, 0, 0, 0); }
                a = a * wi;
#pragma unroll
                for (int ks = 0; ks < 2; ++ks) { const bf16x8 vf = *(const LAS bf16x8*)(VT + TRB(vt * 16 + fr, ks * 4 + fq)); a = __builtin_amdgcn_mfma_f32_16x16x32_bf16(vf, pf[ks], a, 0, 0, 0); }
                a = a * dinv; hv[q] = a;
#pragma unroll
                for (int j = 0; j < 4; ++j) { s1 += a[j]; s2 += a[j] * a[j]; }
            }
            s1 += __shfl_xor(s1, 16); s1 += __shfl_xor(s1, 32); s2 += __shfl_xor(s2, 16); s2 += __shfl_xor(s2, 32);
            if (fq == 0) { lnx[s * 4 + vh * 2] = s1; lnx[s * 4 + vh * 2 + 1] = s2; }
            WG_BAR();
            const f32x4 l4 = *(const LAS f32x4*)(lnx + s * 4);
            const float mean = (l4[0] + l4[2]) * (1.f / 128.f), var = fmaxf((l4[1] + l4[3]) * (1.f / 128.f) - mean * mean, 0.f), rstd = rsqrtf(var + 1e-6f);
            const size_t tok = tokc + s;
#pragma unroll
            for (int q = 0; q < 4; ++q) {
                const int v0 = (vh * 4 + q) * 16 + fq * 4;
                const u32x2 og = ogp[q]; const f32x4 g4 = *(const LAS f32x4*)(MLN + v0);
                const float o0 = (hv[q][0] - mean) * rstd * g4[0] * fsigmoid(bflo(og.x)), o1 = (hv[q][1] - mean) * rstd * g4[1] * fsigmoid(bfhi(og.x));
                const float o2 = (hv[q][2] - mean) * rstd * g4[2] * fsigmoid(bflo(og.y)), o3 = (hv[q][3] - mean) * rstd * g4[3] * fsigmoid(bfhi(og.y));
                u32x2 w; w.x = cvt_pk_bf16(o0, o1); w.y = cvt_pk_bf16(o2, o3);
                *(u32x2*)(Yb + tok * DM + 512 + h * 128 + v0) = w;
            }
            if (c < 63) ML_PF_OG(c + 1);
        }
        WG_BAR();
        {
            const float dec = sc[0];
            bf16x8 vf[2];
#pragma unroll
            for (int ks = 0; ks < 2; ++ks) vf[ks] = *(const LAS bf16x8*)(VwT + TRB(wave * 16 + fr, ks * 4 + fq));
#pragma unroll
            for (int kt = 0; kt < 8; ++kt) {
                f32x4 a = Cacc[kt] * dec;
#pragma unroll
                for (int ks = 0; ks < 2; ++ks) { const bf16x8 kf = *(const LAS bf16x8*)(KT + TRB(kt * 16 + fr, ks * 4 + fq)); a = __builtin_amdgcn_mfma_f32_16x16x32_bf16(kf, vf[ks], a, 0, 0, 0); }
                Cacc[kt] = a;
                u32x2 w; w.x = cvt_pk_bf16(a[0], a[1]); w.y = cvt_pk_bf16(a[2], a[3]);
                *(LAS u32x2*)(Cb + (wave * 16 + fr) * 136 + kt * 16 + fq * 4) = w;
            }
            if (tid < 128) { float a = ns[tid] * dec;
                for (int l = 0; l < 64; ++l) a += gwl[l] * bf2f(Ks[l * 136 + tid]);
                ns[tid] = a; }
            mprev = sc[1];
        }
        WG_BAR();
    }
#undef ML_PF_QKV
#undef ML_PF_IF
#undef ML_PF_OG
}

struct SchedKV {
    const char* memb; const char* wk; const char* wv; int j;
    __device__ __forceinline__ bool next(int i, Unit& u) const {
        if (i != 0 || j < 0 || j >= 64) return false;
        const size_t ts = (size_t)256 * 1024 * 2;
        if (j < 32) { u.pm = j >> 2; u.pn = j & 3; u.A = memb + u.pm * ts; u.B = wk + u.pn * ts; u.tag = 0; }
        else { const int q = j - 32; u.pm = q >> 3; u.pn = q & 7; u.A = wv + u.pm * ts; u.B = memb + u.pn * ts; u.tag = 1; }
        u.nt = 16; return true;
    }
};
struct SchedMerge {
    const char* xb; const char* yb; const char* wg; const char* wup; int c;
    __device__ __forceinline__ bool next(int i, Unit& u) const {
        if (i >= 8) return false;
        const int T = c + 256 * (i >> 2), pass = i & 3; u.pm = T >> 2; u.pn = T & 3; u.tag = pass;
        const size_t ts = (size_t)256 * 1024 * 2;
        if (pass == 0) { u.A = xb + u.pm * ts; u.B = wg + u.pn * ts; u.nt = 16; }
        else if (pass == 1) { u.A = yb + u.pm * ts; u.B = wup + u.pn * ts; u.nt = 8; }
        else if (pass == 2) { u.A = xb + u.pm * ts; u.B = wg + (size_t)(4 + u.pn) * ts; u.nt = 16; }
        else { u.A = yb + u.pm * ts + 1024; u.B = wup + u.pn * ts + 1024; u.nt = 8; }
        return true;
    }
};
struct SchedAttn {
    const char* xb; const char* wq; const char* q; const char* p; const char* kb; const char* vt; int c;
    __device__ __forceinline__ bool next(int i, Unit& u) const {
        if (i >= 6) return false;
        const int pr = c + 256 * (i & 1), b = pr >> 6, h = (pr >> 4) & 3, qt = pr & 15, st = i >> 1;
        u.pm = b * 16 + qt; u.pn = h;
        const size_t ao = ((size_t)u.pm * 256 * 1024 + h * 256) * 2;
        if (st == 0) { u.A = xb + (size_t)u.pm * 256 * 1024 * 2; u.B = wq + (size_t)h * 256 * 1024 * 2; u.nt = 16; u.tag = 2; }
        else if (st == 1) { u.A = q + ao; u.B = kb + ((size_t)b * 256 * 1024 + h * 256) * 2; u.nt = 4; u.tag = 0; }
        else { u.A = p + ao; u.B = vt + (size_t)(b >> 2) * 2097152 + ((size_t)h * 256 * 1024 + (b & 3) * 256) * 2; u.nt = 4; u.tag = 1; }
        return true;
    }
};

#define XB_TMO      128
#define XB_XCNT(j)  (256  + 64 * (j))
#define XB_XSUB(j)  (1280 + 64 * (j))
#define XB_XGEN(j)  (2304 + 64 * (j))
#define XB_TOP      3328
#define XB_TOPGEN   3392
#define XCD_BAR_WORDS 3456
#define XB_SPIN_CAP (1u << 18)
__device__ __forceinline__ unsigned xb_ld(unsigned* p)              { return __hip_atomic_load(p, __ATOMIC_RELAXED, __HIP_MEMORY_SCOPE_AGENT); }
__device__ __forceinline__ unsigned xb_add(unsigned* p, unsigned v) { return __hip_atomic_fetch_add(p, v, __ATOMIC_RELAXED, __HIP_MEMORY_SCOPE_AGENT); }
__device__ __forceinline__ unsigned xb_xcc_id() { return (unsigned)__builtin_amdgcn_s_getreg((3 << 11) | 20) & 0xFu; }
#define XB_SPIN(cond, bar) do { unsigned _sp = 0; while (cond) { __builtin_amdgcn_s_sleep(1); \
    if ((++_sp & 255u) == 0u) { if (xb_ld(&(bar)[XB_TMO])) break; if (_sp > XB_SPIN_CAP) { atomicAdd(&(bar)[XB_TMO], 1u); break; } } } } while (0)
struct XcdBarrier { unsigned* bar; unsigned x; volatile LAS unsigned* st; };
__device__ __forceinline__ XcdBarrier xcd_barrier_post(unsigned* bar, volatile LAS unsigned* st) {
    XcdBarrier b; b.bar = bar; b.x = xb_xcc_id(); b.st = st;
    if (threadIdx.x == 0) (void)xb_add(&bar[XB_XCNT(b.x)], 1u);
    return b;
}
__device__ __forceinline__ void xcd_barrier_complete(unsigned* bar, unsigned x, unsigned& nloc, unsigned& nx) {
    const unsigned G = gridDim.x * gridDim.y * gridDim.z;
    unsigned sum, cnt, mine, sp = 0u;
    for (;;) {
        sum = 0u; cnt = 0u; mine = 0u;
#pragma unroll
        for (unsigned j = 0; j < 16; ++j) { const unsigned c = xb_ld(&bar[XB_XCNT(j)]); sum += c; cnt += (c > 0u) ? 1u : 0u; mine = (j == x) ? c : mine; }
        if (sum == G) break;
        __builtin_amdgcn_s_sleep(1);
        if ((++sp & 255u) == 0u) { if (xb_ld(&bar[XB_TMO])) break; if (sp > XB_SPIN_CAP) { atomicAdd(&bar[XB_TMO], 1u); break; } }
    }
    nloc = mine > 0u ? mine : 1u; nx = cnt > 0u ? cnt : 1u;
}
__device__ __forceinline__ void xcd_barrier(const XcdBarrier& b) {
    asm volatile("s_waitcnt vmcnt(0)" ::: "memory");
    __syncthreads();
    if (threadIdx.x == 0) {
        unsigned* bar = b.bar;
        __builtin_amdgcn_s_waitcnt(0);
        unsigned nloc = b.st[0], nx = b.st[1];
        if (nloc == 0u) { xcd_barrier_complete(bar, b.x, nloc, nx); b.st[0] = nloc; b.st[1] = nx; }
        const unsigned old = xb_add(&bar[XB_XSUB(b.x)], 1u);
        const unsigned gen = old / nloc;
        if (old + 1u == (gen + 1u) * nloc) {
            __builtin_amdgcn_fence(__ATOMIC_RELEASE, "agent");
            asm volatile("s_waitcnt vmcnt(0)" ::: "memory");
            const unsigned og = xb_add(&bar[XB_TOP], 1u);
            const unsigned tg = og / nx;
            if (og + 1u == (tg + 1u) * nx) xb_add(&bar[XB_TOPGEN], 1u);
            else XB_SPIN(xb_ld(&bar[XB_TOPGEN]) == tg, bar);
            __builtin_amdgcn_fence(__ATOMIC_ACQUIRE, "agent");
            xb_add(&bar[XB_XGEN(b.x)], 1u);
            asm volatile("s_waitcnt vmcnt(0)" ::: "memory");
        } else {
            XB_SPIN(xb_ld(&bar[XB_XGEN(b.x)]) == gen, bar);
            __builtin_amdgcn_fence(__ATOMIC_ACQUIRE, "agent");
            asm volatile("s_waitcnt vmcnt(0)" ::: "memory");
        }
    }
    __syncthreads();
}

__global__ void __launch_bounds__(512, 2) mega(Params P) {
    extern __shared__ __attribute__((aligned(16))) unsigned char smem[];
    LAS unsigned char* lds = (LAS unsigned char*)smem;
    unsigned char* ws = P.ws;
    const int G = gridDim.x, c = blockIdx.x, lo = P.ph_lo, hi = P.ph_hi;
    float* ssq0 = (float*)(ws + OFF_SSQ0); float* ssq1 = (float*)(ws + OFF_SSQ1); float* ssq2 = (float*)(ws + OFF_SSQ2); float* ssq3 = (float*)(ws + OFF_SSQ3); float* ssq4 = (float*)(ws + OFF_SSQ4);
    bf16_t* XB = (bf16_t*)(ws + OFF_XB); bf16_t* U = (bf16_t*)(ws + OFF_U);
#ifdef ONLY_PHASE
#define IN(k) ((k) == ONLY_PHASE && lo <= (k) && (k) < hi)
#else
#define IN(k) (lo <= (k) && (k) < hi)
#endif
    volatile LAS unsigned* bst = (volatile LAS unsigned*)(lds + 163776);
    if (threadIdx.x < 2) bst[threadIdx.x] = 0u;
    __syncthreads();
    XcdBarrier xbar; xbar.bar = (unsigned*)(ws + OFF_BARW); xbar.x = 0; xbar.st = bst;
    if (P.coop) xbar = xcd_barrier_post((unsigned*)(ws + OFF_BARW), bst);
    if (P.ph_hi > NPHASE) cg::this_grid().sync();
#define SEAM(k) do { if (P.coop && IN(k) && IN((k) + 1)) xcd_barrier(xbar); } while (0)
    const size_t TS1 = (size_t)256 * 1024 * 2, TSF = (size_t)256 * DFF * 2;

    if (IN(0)) { phase_prep(P, lds); }
    SEAM(0);
    if (IN(1)) {
        SchedStatic S{(const char*)XB, (const char*)(ws + OFF_WGU1), TS1, 128, 22, 16, G, c}; EpiSwiglu E{U, ssq0};
        gemm_phase(lds, 1024, S, E);
    }
    SEAM(1);
    if (IN(2)) {
        SchedStatic S{(const char*)U, (const char*)(ws + OFF_WD1), TSF, 128, 4, 44, G, c}; EpiResid<true> E{P.in[0], P.out, XB, ssq1, 0.5f};
        gemm_phase(lds, DFF, S, E);
    }
    SEAM(2);
    if (IN(3)) {
        SchedStatic S{(const char*)XB, (const char*)(ws + OFF_WIN), TS1, 128, 16, 16, G, c}; EpiRowScale<0> E{(bf16_t*)(ws + OFF_Z), ssq1, (float*)(ws + OFF_IF)};
        gemm_phase(lds, 1024, S, E);
    }
    SEAM(3);
    if (IN(4)) {
        if (c < 128) rwkv_item(P, lds, c);
        else if (c < 160) mlstm_item(P, lds, c - 128);
        else {
            if (c < 224) { SchedKV S{(const char*)(ws + OFF_MEMB), (const char*)(ws + OFF_WK), (const char*)(ws + OFF_WV), c - 160}; EpiKV E{(bf16_t*)(ws + OFF_KB), (bf16_t*)(ws + OFF_VT), (const float*)(ws + OFF_SSQM)};
                gemm_phase(lds, 1024, S, E); }
            const int wv_ = threadIdx.x >> 6, ln_ = threadIdx.x & 63; LAS float* scr = (LAS float*)(lds + wv_ * 16384);
            for (int it = P.nearly + (c - 160) * 8 + wv_; it < P.nitems; it += 96 * 8) {
                int j = 0;
                while (j + 1 < P.njobs && it >= P.jobs[j + 1].item0) ++j;
                transpose_item(P.jobs[j], it - P.jobs[j].item0, scr, ln_);
            }
        }
    }
    SEAM(4);
    if (IN(5)) {
        SchedMerge S{(const char*)XB, (const char*)(ws + OFF_Y), (const char*)(ws + OFF_WG), (const char*)(ws + OFF_WUP), c};
        EpiMerge E{(u32x4*)(ws + OFF_SCRS) + (size_t)c * 8192, (f32x4*)(ws + OFF_SCRM) + (size_t)c * 16384, (bf16_t*)(ws + OFF_MG), ssq1};
        if (c < 256) gemm_phase(lds, 1024, S, E);
    }
    SEAM(5);
    if (IN(6)) {
        SchedStatic S{(const char*)(ws + OFF_MG), (const char*)(ws + OFF_WOUT), TS1, 128, 4, 16, G, c}; EpiResid<true> E{P.out, P.out, XB, ssq2, 1.0f};
        gemm_phase(lds, 1024, S, E);
    }
    SEAM(6);
    if (IN(8)) {
        SchedAttn S{(const char*)XB, (const char*)(ws + OFF_WQ), (const char*)(ws + OFF_Q), (const char*)(ws + OFF_P), (const char*)(ws + OFF_KB), (const char*)(ws + OFF_VT), c};
        EpiAttn E{(bf16_t*)(ws + OFF_P), (bf16_t*)(ws + OFF_O), (bf16_t*)(ws + OFF_Q), ssq2};
        if (c < 256) gemm_phase(lds, 1024, S, E);
    }
    SEAM(8);
    if (IN(9)) {
        SchedStatic S{(const char*)(ws + OFF_O), (const char*)(ws + OFF_WO), TS1, 128, 4, 16, G, c}; EpiResid<true> E{P.out, P.out, XB, ssq3, 1.0f};
        gemm_phase(lds, 1024, S, E);
    }
    SEAM(9);
    if (IN(10)) {
        SchedStatic S{(const char*)XB, (const char*)(ws + OFF_WGU2), TS1, 128, 22, 16, G, c}; EpiSwiglu E{U, ssq3};
        gemm_phase(lds, 1024, S, E);
    }
    SEAM(10);
    if (IN(11)) {
        SchedStatic S{(const char*)U, (const char*)(ws + OFF_WD2), TSF, 128, 4, 44, G, c}; EpiResid<false> E{P.out, P.out, nullptr, ssq4, 0.5f};
        gemm_phase(lds, DFF, S, E);
    }
    SEAM(11);
    if (IN(12)) {
        const int lane = threadIdx.x & 63, gw = c * 8 + (threadIdx.x >> 6), NGW = G * 8; const float* fn = P.in[36];
        f32x4 g4[4];
#pragma unroll
        for (int j = 0; j < 4; ++j) g4[j] = *((const f32x4*)fn + lane + 64 * j);
        for (int m = gw * 4; m < NTOK; m += NGW * 4) {
            f32x4 v[4][4]; float rs[4];
#pragma unroll
            for (int r = 0; r < 4; ++r) { rs[r] = rsqrtf(ssq4[m + r] * (1.f / 1024.f) + NORM_EPS);
#pragma unroll
                for (int j = 0; j < 4; ++j) v[r][j] = ((const f32x4*)(P.out + (size_t)(m + r) * DM) + lane)[64 * j]; }
#pragma unroll
            for (int r = 0; r < 4; ++r)
#pragma unroll
                for (int j = 0; j < 4; ++j) ((f32x4*)(P.out + (size_t)(m + r) * DM) + lane)[64 * j] = v[r][j] * rs[r] * g4[j];
        }
    }
#undef IN
#undef SEAM
}

#ifdef MK_DBG_DUMP
__global__ void dbg_dump(const bf16_t* src, int ld, int mode, float* out) {
    const size_t i = (size_t)blockIdx.x * 256 + threadIdx.x; const size_t r = i >> 10; const int c = (int)(i & 1023);
    float v = bf2f(src[r * ld + c]);
    if (mode == 1) v += 2.f * bf2f(src[r * ld + c + 1024]) + 3.f * bf2f(src[r * ld + c + 2048]) + 5.f * bf2f(src[r * ld + c + 2816]);
    if (mode == 4) v = ((const float*)src)[i & 262143];
    if (mode == 2 && c >= 512) v = 0.f;
    if (mode == 3 && c < 512) v = 0.f;
    out[i] = v;
}
#endif
static void add_job(Params& p, const float* src, const float* gain, size_t dst_off, int K, int ldsrc, int col0, int ncols, int dst_ld, int dst_row0, int dst_k0, int mode, float scale) {
    TJob& j = p.jobs[p.njobs++]; j.src = src; j.gain = gain; j.dst = (bf16_t*)(p.ws + dst_off); j.K = K; j.ldsrc = ldsrc; j.col0 = col0; j.ncols = ncols; j.dst_ld = dst_ld; j.dst_row0 = dst_row0; j.dst_k0 = dst_k0;
    j.mode = mode; j.scale = scale; j.item0 = p.nitems; p.nitems += (K / 64) * ((ncols + 31) / 32);
}
extern "C" void kernel_launch(void* const* d_in, const int* in_sizes, int n_in, void* d_out, int out_size, void* d_ws, size_t ws_size, hipStream_t stream) {
    static int ready = 0;
    if (ready == 0) {
        if (n_in != 37 || out_size != NTOK * DM || ws_size < WS_END) { fprintf(stderr, "kernel_launch: unexpected shapes: n_in %d out %d ws %zu (need %zu); nothing launched\n", n_in, out_size, ws_size, (size_t)WS_END); ready = -1; return; }
        if (hipFuncSetAttribute((const void*)mega, hipFuncAttributeMaxDynamicSharedMemorySize, LDS_BYTES) != hipSuccess) { fprintf(stderr, "kernel_launch: hipFuncSetAttribute failed\n"); ready = -1; return; }
        int per_cu = 0; (void)hipOccupancyMaxActiveBlocksPerMultiprocessor(&per_cu, (const void*)mega, 512, LDS_BYTES); (void)hipGetLastError();
        if (per_cu < 1) fprintf(stderr, "kernel_launch: note: occupancy query says %d blocks per CU\n", per_cu);
        ready = 1;
    }
    if (ready < 0) return;
    Params p; memset(&p, 0, sizeof(p));
    for (int i = 0; i < 37; ++i) p.in[i] = (const float*)d_in[i];
    p.out = (float*)d_out; p.ws = (unsigned char*)d_ws;
    const float* const* in = p.in;
    add_job(p, in[3], in[2], OFF_WGU1, 1024, DFF, 0, DFF, 1024, 0, 0, 1, 1.f);
    add_job(p, in[4], in[2], OFF_WGU1, 1024, DFF, 0, DFF, 1024, 128, 0, 1, 1.f);
    add_job(p, in[5], nullptr, OFF_WD1, DFF, 1024, 0, 1024, DFF, 0, 0, 0, 1.f);
    add_job(p, in[7], in[6], OFF_WIN, 1024, 5896, 0, 3848, 1024, 0, 0, 0, 1.f);
    add_job(p, in[30], in[28], OFF_WK, 1024, 2048, 0, 1024, 1024, 0, 0, 0, 1.f);
    add_job(p, in[30], in[28], OFF_WV, 1024, 2048, 1024, 1024, 1024, 0, 0, 0, 1.f);
    add_job(p, in[10], nullptr, OFF_W2T, 64, 512, 0, 512, 64, 0, 0, 0, 1.f);
    add_job(p, in[12], nullptr, OFF_A2T, 64, 512, 0, 512, 64, 0, 0, 0, 1.f);
    add_job(p, in[13], nullptr, OFF_G2T, 128, 512, 0, 512, 128, 0, 0, 0, 1.f);
    p.nearly = p.nitems;
    add_job(p, in[7], in[6], OFF_WG, 1024, 5896, 3848, 2048, 1024, 0, 0, 0, 1.f);
    add_job(p, in[24], nullptr, OFF_WUP, 512, 1024, 0, 1024, 1024, 0, 0, 0, 1.f);
    add_job(p, in[25], nullptr, OFF_WUP, 512, 1024, 0, 1024, 1024, 0, 512, 0, 1.f);
    add_job(p, in[26], nullptr, OFF_WOUT, 1024, 1024, 0, 1024, 1024, 0, 0, 0, 1.f);
    add_job(p, in[29], in[27], OFF_WQ, 1024, 1024, 0, 1024, 1024, 0, 0, 0, 0.0625f);
    add_job(p, in[31], nullptr, OFF_WO, 1024, 1024, 0, 1024, 1024, 0, 0, 0, 1.f);
    add_job(p, in[33], in[32], OFF_WGU2, 1024, DFF, 0, DFF, 1024, 0, 0, 1, 1.f);
    add_job(p, in[34], in[32], OFF_WGU2, 1024, DFF, 0, DFF, 1024, 128, 0, 1, 1.f);
    add_job(p, in[35], nullptr, OFF_WD2, DFF, 1024, 0, 1024, DFF, 0, 0, 0, 1.f);
    const int grid = 256;
#if MK_PER_PHASE
    p.coop = 0;
    for (int ph = 0; ph < MK_DBG_HI; ++ph) { p.ph_lo = ph; p.ph_hi = ph + 1; hipLaunchKernelGGL(mega, dim3(grid), dim3(512), LDS_BYTES, stream, p); }
#ifdef MK_DBG_DUMP
    hipLaunchKernelGGL(dbg_dump, dim3(NTOK * 4), dim3(256), 0, stream, (const bf16_t*)(p.ws + MK_DBG_DUMP), MK_DBG_LD, MK_DBG_MODE, p.out);
#endif
#else
    p.coop = 1; p.ph_lo = 0; p.ph_hi = NPHASE;
    if (hipMemsetAsync((char*)d_ws + OFF_BARW, 0, XCD_BAR_WORDS * 4, stream) != hipSuccess) { fprintf(stderr, "kernel_launch: hipMemsetAsync failed\n"); return; }
    void* args[] = {&p};
    hipError_t e = hipLaunchCooperativeKernel((const void*)mega, dim3(grid), dim3(512), args, LDS_BYTES, stream);
    if (e != hipSuccess) fprintf(stderr, "kernel_launch: cooperative launch failed: %s\n", hipGetErrorString(e));
#endif
}
```

```cpp
#include <hip/hip_runtime.h>
#include <hip/hip_cooperative_groups.h>
#include <cstdio>
#include <cstdint>
#include <cstring>
namespace cg = cooperative_groups;

#define LAS __attribute__((address_space(3)))
typedef unsigned short bf16_t;
typedef short bf16x8 __attribute__((ext_vector_type(8)));
typedef float f32x4 __attribute__((ext_vector_type(4)));
typedef float f32x2 __attribute__((ext_vector_type(2)));
typedef unsigned u32x4 __attribute__((ext_vector_type(4)));
typedef unsigned u32x2 __attribute__((ext_vector_type(2)));

#ifndef MK_DBG_HI
#define MK_DBG_HI 13
#endif
#ifndef MK_PER_PHASE
#define MK_PER_PHASE 0
#endif

constexpr int NTOK = 32768, DM = 1024, SEQ = 4096, NB = 8, DFF = 2816, MEMTOK = 2048;
constexpr int ZLD = 3840;
constexpr float NORM_EPS = 1e-5f;
constexpr int NPHASE = 13;
constexpr int LDS_BYTES = 160 * 1024;
constexpr int XCH_OFF = 131072;

constexpr size_t MiB = 1048576;
constexpr size_t OFF_SSQ0 = 0, OFF_SSQ1 = 131072, OFF_SSQ2 = 262144, OFF_SSQ3 = 393216, OFF_SSQ4 = 524288, OFF_SSQM = 655360;
constexpr size_t OFF_IF = 1 * MiB;
constexpr size_t OFF_GATES = 2 * MiB;
constexpr size_t OFF_BARW = 720896;
constexpr size_t OFF_STATS = 444 * MiB;
constexpr size_t OFF_W = 4 * MiB;
constexpr size_t SZ_WGU = (size_t)5632 * 1024 * 2, SZ_WD = (size_t)1024 * 2816 * 2, SZ_WIN = (size_t)4096 * 1024 * 2, SZ_WG = (size_t)2048 * 1024 * 2, SZ_SQ = (size_t)1024 * 1024 * 2;
constexpr size_t OFF_WGU1 = OFF_W, OFF_WD1 = OFF_WGU1 + SZ_WGU, OFF_WIN = OFF_WD1 + SZ_WD, OFF_WG = OFF_WIN + SZ_WIN, OFF_WUP = OFF_WG + SZ_WG, OFF_WOUT = OFF_WUP + SZ_SQ,
                 OFF_WQ = OFF_WOUT + SZ_SQ, OFF_WK = OFF_WQ + SZ_SQ, OFF_WV = OFF_WK + SZ_SQ, OFF_WO = OFF_WV + SZ_SQ, OFF_WGU2 = OFF_WO + SZ_SQ, OFF_WD2 = OFF_WGU2 + SZ_WGU,
                 OFF_W2T = OFF_WD2 + SZ_WD, OFF_A2T = OFF_W2T + 65536, OFF_G2T = OFF_A2T + 65536, OFF_WEND = OFF_G2T + 131072;
static_assert(OFF_WEND <= 64 * MiB, "weights");
constexpr size_t OFF_XB = 64 * MiB, OFF_Y = 128 * MiB, OFF_MEMB = 192 * MiB, OFF_KB = 196 * MiB, OFF_VT = 200 * MiB, OFF_BIG = 204 * MiB, WS_END = 460 * MiB;
constexpr size_t OFF_U = OFF_BIG, OFF_Z = OFF_BIG, OFF_SCRS = OFF_BIG, OFF_SCRM = OFF_BIG + 32 * MiB, OFF_MG = OFF_BIG + 96 * MiB, OFF_Q = OFF_BIG, OFF_P = OFF_BIG + 64 * MiB, OFF_O = OFF_BIG + 128 * MiB;

typedef __bf16 bf16x2_t __attribute__((ext_vector_type(2)));
__device__ __forceinline__ unsigned cvt_pk_bf16(float lo, float hi) { f32x2 v = {lo, hi}; bf16x2_t b = __builtin_convertvector(v, bf16x2_t); return __builtin_bit_cast(unsigned, b); }
__device__ __forceinline__ float bflo(unsigned u) { return __builtin_bit_cast(float, u << 16); }
__device__ __forceinline__ float bfhi(unsigned u) { return __builtin_bit_cast(float, u & 0xffff0000u); }
__device__ __forceinline__ float bf2f(bf16_t b) { return __builtin_bit_cast(float, (unsigned)b << 16); }
__device__ __forceinline__ bf16_t f2bf(float f) { return (bf16_t)(cvt_pk_bf16(f, 0.f) & 0xffffu); }
__device__ __forceinline__ float fsigmoid(float x) { return __builtin_amdgcn_rcpf(1.f + __expf(-x)); }
__device__ __forceinline__ float wave_sum(float v) {
#pragma unroll
    for (int o = 1; o < 64; o <<= 1) v += __shfl_xor(v, o);
    return v;
}
template <int CTRL> __device__ __forceinline__ float dpp_f(float x) { return __builtin_bit_cast(float, __builtin_amdgcn_update_dpp(0, __builtin_bit_cast(int, x), CTRL, 0xF, 0xF, true)); }
__device__ __forceinline__ float red8(float x) {
    x += dpp_f<0xB1>(x); x += dpp_f<0x4E>(x); x += dpp_f<0x141>(x); return x;
}
#define LDS_WAIT() asm volatile("s_waitcnt lgkmcnt(0)" ::: "memory")
#define WG_BAR() do { asm volatile("s_waitcnt lgkmcnt(0)" ::: "memory"); __builtin_amdgcn_s_barrier(); asm volatile("" ::: "memory"); } while (0)
#define WG_BAR_ALL() do { asm volatile("s_waitcnt vmcnt(0) lgkmcnt(0)" ::: "memory"); __builtin_amdgcn_s_barrier(); asm volatile("" ::: "memory"); } while (0)

constexpr int BM = 256, BK = 64, HALF = 128, HTB = HALF * BK * 2;
__host__ __device__ __forceinline__ int lds_byte(int r, int c) { const int st = (r >> 4) * 2 + (c >> 5), rr = r & 15, cc = c & 31, ob = rr * 64 + cc * 2; return st * 1024 + (ob ^ (((ob >> 9) & 1) << 5)); }
__host__ __device__ __forceinline__ void stage_rc(int b, int& R, int& C) { const int st = b / 1024, sb = b % 1024, swz = sb ^ (((sb >> 9) & 1) << 5); R = (st >> 1) * 16 + swz / 64; C = (st & 1) * 32 + (swz % 64) / 2; }
__host__ __device__ __forceinline__ int perm32(int rho) { const int n = rho >> 4, i = rho & 15; return 8 * (i >> 2) + 4 * n + (i & 3); }

struct Unit { const char* A; const char* B; int nt, pm, pn, tag; };

__device__ __forceinline__ void tile_of(int L, int nM, int nN, int& pm, int& pn) {
    const int nwg = nM * nN; int wgid = L;
    { const int q = nwg / 8, r = nwg % 8, xcd = wgid % 8, off = wgid / 8; wgid = (xcd < r ? xcd * (q + 1) : r * (q + 1) + (xcd - r) * q) + off; }
    const int nig = 8 * nN, gid = wgid / nig, fm = gid * 8, gsz = (nM - fm) < 8 ? (nM - fm) : 8;
    pm = fm + ((wgid % nig) % gsz); pn = (wgid % nig) / gsz;
}
struct SchedStatic {
    const char* A; const char* B; size_t tstep; int nM, nN, nt, G, c;
    __device__ __forceinline__ bool next(int i, Unit& u) const {
        const long L = (long)i * G + c; if (L >= (long)nM * nN) return false;
        int pm, pn; tile_of((int)L, nM, nN, pm, pn);
        u.A = A + (size_t)pm * tstep; u.B = B + (size_t)pn * tstep; u.nt = nt; u.pm = pm; u.pn = pn; u.tag = 0; return true;
    }
};

template <class Epi, class Sched>
__device__ __forceinline__ void gemm_phase(LAS unsigned char* lds, const int ld, const Sched& S, const Epi& E) {
    const int tid = threadIdx.x, wid = __builtin_amdgcn_readfirstlane(tid >> 6), lane = tid & 63, wr = wid >> 2, wc = wid & 3, fr = lane & 15, fq = lane >> 4;
    unsigned voffA[2], voffB[2];
#pragma unroll
    for (int i = 0; i < 2; ++i) { int R, C; stage_rc(tid * 16 + i * 8192, R, C); const int Rb = (R & ~31) + perm32(R & 31);
        voffA[i] = (unsigned)(R * ld + C) * 2u; voffB[i] = (unsigned)(Rb * ld + C) * 2u; }
    const size_t kstep = (size_t)(BK * 2);
    const size_t hstep = (size_t)HALF * ld * 2;
    const unsigned ldsw = (unsigned)wid * 1024u;
    const int aoff = lds_byte(wr * 64 + fr, fq * 8), boff = lds_byte(wc * 32 + fr, fq * 8);
#define PG8_SA(b, h) (((b) * 2 + (h)) * HTB)
#define PG8_SB(b, h) ((4 + (b) * 2 + (h)) * HTB)
#define PG8_STAGE(bufoff, gbase, voff) do { _Pragma("unroll") for (int _i = 0; _i < 2; ++_i) \
        __builtin_amdgcn_global_load_lds((const unsigned*)((const char*)(gbase) + (voff)[_i]), (LAS unsigned*)(lds + (bufoff) + ldsw + _i * 8192), 16, 0, 0); } while (0)
#define PG8_LDA(dst, b, h) do { _Pragma("unroll") for (int m = 0; m < 4; ++m) _Pragma("unroll") for (int k = 0; k < 2; ++k) dst[m][k] = *(const LAS bf16x8*)(lds + PG8_SA(b, h) + aoff + m * 2048 + k * 1024); } while (0)
#define PG8_LDB(dst, b, h) do { _Pragma("unroll") for (int n = 0; n < 2; ++n) _Pragma("unroll") for (int k = 0; k < 2; ++k) dst[n][k] = *(const LAS bf16x8*)(lds + PG8_SB(b, h) + boff + n * 2048 + k * 1024); } while (0)
#define PG8_MMA(ai, bj, At, Bt) do { __builtin_amdgcn_s_setprio(1); _Pragma("unroll") for (int m = 0; m < 4; ++m) _Pragma("unroll") for (int n = 0; n < 2; ++n) _Pragma("unroll") for (int k = 0; k < 2; ++k) \
        acc[ai][bj][m][n] = __builtin_amdgcn_mfma_f32_16x16x32_bf16(Bt[n][k], At[m][k], acc[ai][bj][m][n], 0, 0, 0); __builtin_amdgcn_s_setprio(0); } while (0)
#define PG8_WAIT_V(n) asm volatile("s_waitcnt vmcnt(" #n ")" ::: "memory")
#define PG8_WAIT_L(n) asm volatile("s_waitcnt lgkmcnt(" #n ")" ::: "memory")
#define PG8_BAR __builtin_amdgcn_s_barrier()
#define PG8_SCHED __builtin_amdgcn_sched_barrier(0)
    Unit cur, nxt; int ui = 0;
    if (!S.next(0, cur)) return;
    f32x4 acc[2][2][4][2];
#pragma unroll
    for (int a = 0; a < 2; ++a)
#pragma unroll
        for (int b = 0; b < 2; ++b)
#pragma unroll
            for (int m = 0; m < 4; ++m)
#pragma unroll
                for (int n = 0; n < 2; ++n) acc[a][b][m][n] = (f32x4){0.f, 0.f, 0.f, 0.f};
    bf16x8 At[4][2], B0[2][2], B1[2][2];
    const char* cA = cur.A; const char* cB = cur.B; int nt = cur.nt; asm volatile("" : "+s"(nt));
    PG8_STAGE(PG8_SB(0, 0), cB, voffB); PG8_STAGE(PG8_SB(0, 1), cB + hstep, voffB); PG8_STAGE(PG8_SA(0, 0), cA, voffA); PG8_STAGE(PG8_SA(0, 1), cA + hstep, voffA);
    if (wr == 1) PG8_BAR;
    PG8_WAIT_V(2); PG8_BAR;
    PG8_STAGE(PG8_SB(1, 0), cB + kstep, voffB); PG8_STAGE(PG8_SA(1, 0), cA + kstep, voffA); PG8_STAGE(PG8_SB(1, 1), cB + hstep + kstep, voffB);
    PG8_WAIT_V(6); PG8_BAR;
#pragma unroll 1
    for (;;) {
        asm volatile("" : "+s"(ui));
        const bool has_next = S.next(ui + 1, nxt);
        const char* nA = has_next ? nxt.A : cA; const char* nB = has_next ? nxt.B : cB;
#pragma unroll 1
        for (int t = 0; t < nt; t += 2) {
            const bool last = (t == nt - 2);
            const char* a1 = cA + (size_t)(t + 1) * kstep;
            const char* a2 = last ? nA : cA + (size_t)(t + 2) * kstep; const char* b2 = last ? nB : cB + (size_t)(t + 2) * kstep;
            const char* a3 = a2 + kstep; const char* b3 = b2 + kstep;
            PG8_LDB(B0, 0, 0); PG8_LDB(B1, 0, 1); PG8_SCHED; PG8_LDA(At, 0, 0); PG8_STAGE(PG8_SA(1, 1), a1 + hstep, voffA);
            PG8_WAIT_V(8); PG8_WAIT_L(0); PG8_BAR; PG8_MMA(0, 0, At, B0); PG8_MMA(0, 1, At, B1); PG8_BAR; PG8_SCHED;
            PG8_LDA(At, 0, 1); PG8_STAGE(PG8_SB(0, 0), b2, voffB); PG8_STAGE(PG8_SB(0, 1), b2 + hstep, voffB); PG8_STAGE(PG8_SA(0, 0), a2, voffA);
            PG8_WAIT_V(8); PG8_WAIT_L(0); PG8_BAR; PG8_MMA(1, 0, At, B0); PG8_MMA(1, 1, At, B1); PG8_BAR; PG8_SCHED;
            PG8_LDB(B0, 1, 0); PG8_LDB(B1, 1, 1); PG8_SCHED; PG8_LDA(At, 1, 0); PG8_STAGE(PG8_SA(0, 1), a2 + hstep, voffA);
            PG8_WAIT_V(8); PG8_WAIT_L(0); PG8_BAR; PG8_MMA(0, 0, At, B0); PG8_MMA(0, 1, At, B1); PG8_BAR; PG8_SCHED;
            PG8_LDA(At, 1, 1); PG8_STAGE(PG8_SB(1, 0), b3, voffB); PG8_STAGE(PG8_SB(1, 1), b3 + hstep, voffB); PG8_STAGE(PG8_SA(1, 0), a3, voffA);
            PG8_WAIT_V(8); PG8_WAIT_L(0); PG8_BAR; PG8_MMA(1, 0, At, B0); PG8_MMA(1, 1, At, B1); PG8_BAR; PG8_SCHED;
        }
        if (wr == 0) PG8_BAR;
        E(acc, cur, wr, wc, fr, fq, lds);
        if (!has_next) break;
#pragma unroll
        for (int a = 0; a < 2; ++a)
#pragma unroll
            for (int b = 0; b < 2; ++b)
#pragma unroll
                for (int m = 0; m < 4; ++m)
#pragma unroll
                    for (int n = 0; n < 2; ++n) acc[a][b][m][n] = (f32x4){0.f, 0.f, 0.f, 0.f};
        cur = nxt; cA = nA; cB = nB; nt = cur.nt; asm volatile("" : "+s"(nt)); ++ui;
        if (wr == 1) PG8_BAR;
    }
    PG8_WAIT_V(0);
    PG8_BAR;
#undef PG8_SA
#undef PG8_SB
#undef PG8_STAGE
#undef PG8_LDA
#undef PG8_LDB
#undef PG8_MMA
#undef PG8_WAIT_V
#undef PG8_WAIT_L
#undef PG8_BAR
#undef PG8_SCHED
}

typedef f32x4 (&AccRef)[2][2][4][2];
#define EPI_ROWS_BEGIN _Pragma("unroll") for (int ai = 0; ai < 2; ++ai) _Pragma("unroll") for (int m = 0; m < 4; ++m) { const int rl = ai * 128 + wr * 64 + m * 16 + fr;
#define EPI_ROWS_END }

struct EpiSwiglu {
    bf16_t* U; const float* ssq;
    __device__ __forceinline__ void operator()(AccRef acc, const Unit& u, int wr, int wc, int fr, int fq, LAS unsigned char*) const {
        EPI_ROWS_BEGIN
            const int row = u.pm * 256 + rl; const float rs = rsqrtf(ssq[row] * (1.f / 1024.f) + NORM_EPS);
            float o[8];
#pragma unroll
            for (int n = 0; n < 2; ++n)
#pragma unroll
                for (int j = 0; j < 4; ++j) { const float g = acc[ai][0][m][n][j] * rs, up = acc[ai][1][m][n][j] * rs; o[n * 4 + j] = g * fsigmoid(g) * up; }
            u32x4 w; w.x = cvt_pk_bf16(o[0], o[1]); w.y = cvt_pk_bf16(o[2], o[3]); w.z = cvt_pk_bf16(o[4], o[5]); w.w = cvt_pk_bf16(o[6], o[7]);
            *(u32x4*)(U + (size_t)row * DFF + u.pn * 128 + wc * 32 + fq * 8) = w;
        EPI_ROWS_END
    }
};
template <bool WB> struct EpiResid {
    const float* xin; float* xout; bf16_t* xb; float* ssq; float scale;
    __device__ __forceinline__ void operator()(AccRef acc, const Unit& u, int wr, int wc, int fr, int fq, LAS unsigned char*) const {
        EPI_ROWS_BEGIN
            const int row = u.pm * 256 + rl; float ss = 0.f;
#pragma unroll
            for (int bj = 0; bj < 2; ++bj) {
                const size_t o = (size_t)row * DM + u.pn * 256 + bj * 128 + wc * 32 + fq * 8;
                f32x4 v0 = *(const f32x4*)(xin + o), v1 = *(const f32x4*)(xin + o + 4);
                v0 = v0 + acc[ai][bj][m][0] * scale; v1 = v1 + acc[ai][bj][m][1] * scale;
                *(f32x4*)(xout + o) = v0; *(f32x4*)(xout + o + 4) = v1;
                ss += v0[0] * v0[0] + v0[1] * v0[1] + v0[2] * v0[2] + v0[3] * v0[3] + v1[0] * v1[0] + v1[1] * v1[1] + v1[2] * v1[2] + v1[3] * v1[3];
                if (WB) { u32x4 w; w.x = cvt_pk_bf16(v0[0], v0[1]); w.y = cvt_pk_bf16(v0[2], v0[3]); w.z = cvt_pk_bf16(v1[0], v1[1]); w.w = cvt_pk_bf16(v1[2], v1[3]); *(u32x4*)(xb + o) = w; }
            }
            ss += __shfl_xor(ss, 16); ss += __shfl_xor(ss, 32);
            if (fq == 0) atomicAdd(ssq + row, ss);
        EPI_ROWS_END
    }
};
template <int MODE> struct EpiResidX {
    static constexpr bool ALIGN = true;
    const float* xin; float* xout; bf16_t* xb; float* ssq; float scale;
    __device__ __forceinline__ void operator()(AccRef acc, const Unit& u, int wr, int wc, int fr, int fq, LAS unsigned char*) const {
        EPI_ROWS_BEGIN
            const int row = u.pm * 256 + rl; float ss = 0.f;
#pragma unroll
            for (int bj = 0; bj < 2; ++bj) {
                const size_t o = (size_t)row * DM + u.pn * 256 + bj * 128 + wc * 32 + fq * 8;
                f32x4 v0, v1;
                if (MODE == 1) { v0 = *(const f32x4*)(xin + o); v1 = *(const f32x4*)(xin + o + 4); }
                else { const u32x4 xr = *(const u32x4*)(xb + o); v0 = (f32x4){bflo(xr.x), bfhi(xr.x), bflo(xr.y), bfhi(xr.y)}; v1 = (f32x4){bflo(xr.z), bfhi(xr.z), bflo(xr.w), bfhi(xr.w)}; }
                v0 = v0 + acc[ai][bj][m][0] * scale; v1 = v1 + acc[ai][bj][m][1] * scale;
                if (MODE == 2) { *(f32x4*)(xout + o) = v0; *(f32x4*)(xout + o + 4) = v1; }
                ss += v0[0] * v0[0] + v0[1] * v0[1] + v0[2] * v0[2] + v0[3] * v0[3] + v1[0] * v1[0] + v1[1] * v1[1] + v1[2] * v1[2] + v1[3] * v1[3];
                u32x4 w; w.x = cvt_pk_bf16(v0[0], v0[1]); w.y = cvt_pk_bf16(v0[2], v0[3]); w.z = cvt_pk_bf16(v1[0], v1[1]); w.w = cvt_pk_bf16(v1[2], v1[3]); *(u32x4*)(xb + o) = w;
            }
            ss += __shfl_xor(ss, 16); ss += __shfl_xor(ss, 32);
            if (fq == 0) atomicAdd(ssq + row, ss);
        EPI_ROWS_END
    }
};
struct EpiGate {
    static constexpr bool ALIGN = true;
    bf16_t* SA; bf16_t* SB; const float* ssq;
    __device__ __forceinline__ void operator()(AccRef acc, const Unit& u, int wr, int wc, int fr, int fq, LAS unsigned char*) const {
        bf16_t* base = (u.pn < 4 ? SA : SB) + (u.pn & 3) * 256 + wc * 32 + fq * 8;
        EPI_ROWS_BEGIN
            const int row = u.pm * 256 + rl; const float rs = rsqrtf(ssq[row] * (1.f / 1024.f) + NORM_EPS);
#pragma unroll
            for (int bj = 0; bj < 2; ++bj) { const f32x4 a0 = acc[ai][bj][m][0], a1 = acc[ai][bj][m][1];
                u32x4 w; w.x = cvt_pk_bf16(fsigmoid(a0[0] * rs), fsigmoid(a0[1] * rs)); w.y = cvt_pk_bf16(fsigmoid(a0[2] * rs), fsigmoid(a0[3] * rs));
                w.z = cvt_pk_bf16(fsigmoid(a1[0] * rs), fsigmoid(a1[1] * rs)); w.w = cvt_pk_bf16(fsigmoid(a1[2] * rs), fsigmoid(a1[3] * rs));
                *(u32x4*)(base + (size_t)row * DM + bj * 128) = w; }
        EPI_ROWS_END
    }
};
struct EpiMerge2 {
    static constexpr bool ALIGN = true;
    u32x4* scrM; bf16_t* MG; const bf16_t* SA; const bf16_t* SB;
    __device__ __forceinline__ void operator()(AccRef acc, const Unit& u, int wr, int wc, int fr, int fq, LAS unsigned char*) const {
        char* sM = (char*)scrM + (threadIdx.x >> 6) * 16384u + (threadIdx.x & 63) * 16u; asm volatile("" : "+v"(sM));
        const bf16_t* G = (u.tag == 1 ? SA : SB);
        EPI_ROWS_BEGIN
            const int row = u.pm * 256 + rl;
#pragma unroll
            for (int bj = 0; bj < 2; ++bj) {
                const int i = (ai * 4 + m) * 2 + bj; const f32x4 a0 = acc[ai][bj][m][0], a1 = acc[ai][bj][m][1];
                const size_t o = (size_t)row * DM + u.pn * 256 + bj * 128 + wc * 32 + fq * 8;
                const u32x4 sg = *(const u32x4*)(G + o);
                f32x4 m0 = (f32x4){bflo(sg.x) * a0[0], bfhi(sg.x) * a0[1], bflo(sg.y) * a0[2], bfhi(sg.y) * a0[3]};
                f32x4 m1 = (f32x4){bflo(sg.z) * a1[0], bfhi(sg.z) * a1[1], bflo(sg.w) * a1[2], bfhi(sg.w) * a1[3]};
                if (u.tag == 3) { const u32x4 pm_ = *(const u32x4*)(sM + i * 1024);
                    m0 = m0 + (f32x4){bflo(pm_.x), bfhi(pm_.x), bflo(pm_.y), bfhi(pm_.y)}; m1 = m1 + (f32x4){bflo(pm_.z), bfhi(pm_.z), bflo(pm_.w), bfhi(pm_.w)}; }
                u32x4 w; w.x = cvt_pk_bf16(m0[0], m0[1]); w.y = cvt_pk_bf16(m0[2], m0[3]); w.z = cvt_pk_bf16(m1[0], m1[1]); w.w = cvt_pk_bf16(m1[2], m1[3]);
                if (u.tag == 1) *(u32x4*)(sM + i * 1024) = w; else *(u32x4*)(MG + o) = w;
            }
            asm volatile("" ::: "memory");
        EPI_ROWS_END
    }
};
template <int MODE> struct EpiRowScale {
    bf16_t* O; const float* ssq; float* IFb;
    __device__ __forceinline__ void operator()(AccRef acc, const Unit& u, int wr, int wc, int fr, int fq, LAS unsigned char*) const {
        constexpr int LDO = MODE == 0 ? ZLD : DM;
        EPI_ROWS_BEGIN
            const int row = u.pm * 256 + rl; const float rs = rsqrtf(ssq[row] * (1.f / 1024.f) + NORM_EPS);
            if (MODE == 0 && u.pn == 15) {
                if (wc == 0 && fq == 0) { *(f32x4*)(IFb + (size_t)row * 8) = acc[ai][0][m][0] * rs; *(f32x4*)(IFb + (size_t)row * 8 + 4) = acc[ai][0][m][1] * rs; }
            } else {
#pragma unroll
                for (int bj = 0; bj < 2; ++bj) { const f32x4 v0 = acc[ai][bj][m][0] * rs, v1 = acc[ai][bj][m][1] * rs;
                    u32x4 w; w.x = cvt_pk_bf16(v0[0], v0[1]); w.y = cvt_pk_bf16(v0[2], v0[3]); w.z = cvt_pk_bf16(v1[0], v1[1]); w.w = cvt_pk_bf16(v1[2], v1[3]);
                    *(u32x4*)(O + (size_t)row * LDO + u.pn * 256 + bj * 128 + wc * 32 + fq * 8) = w; }
            }
        EPI_ROWS_END
    }
};
struct EpiKV {
    bf16_t* Kb; bf16_t* VT; const float* ssqm;
    __device__ __forceinline__ void operator()(AccRef acc, const Unit& u, int wr, int wc, int fr, int fq, LAS unsigned char*) const {
        EPI_ROWS_BEGIN
            const int row = u.pm * 256 + rl;
#pragma unroll
            for (int bj = 0; bj < 2; ++bj) {
                const int cl = bj * 128 + wc * 32 + fq * 8; f32x4 v0 = acc[ai][bj][m][0], v1 = acc[ai][bj][m][1]; bf16_t* dst;
                if (u.tag == 0) { const float rs = rsqrtf(ssqm[row] * (1.f / 1024.f) + NORM_EPS); v0 = v0 * rs; v1 = v1 * rs; dst = Kb + (size_t)row * DM + u.pn * 256 + cl; }
                else { const int tok = u.pn * 256 + cl; const f32x4 s0 = *(const f32x4*)(ssqm + tok), s1 = *(const f32x4*)(ssqm + tok + 4);
#pragma unroll
                    for (int j = 0; j < 4; ++j) { v0[j] *= rsqrtf(s0[j] * (1.f / 1024.f) + NORM_EPS); v1[j] *= rsqrtf(s1[j] * (1.f / 1024.f) + NORM_EPS); }
                    dst = VT + (size_t)(u.pn >> 2) * 1048576 + (size_t)row * 1024 + (u.pn & 3) * 256 + cl; }
                u32x4 w; w.x = cvt_pk_bf16(v0[0], v0[1]); w.y = cvt_pk_bf16(v0[2], v0[3]); w.z = cvt_pk_bf16(v1[0], v1[1]); w.w = cvt_pk_bf16(v1[2], v1[3]);
                *(u32x4*)dst = w;
            }
        EPI_ROWS_END
    }
};
struct EpiMerge {
    u32x4* scrS; f32x4* scrM; bf16_t* MG; const float* ssq;
    __device__ __forceinline__ void operator()(AccRef acc, const Unit& u, int wr, int wc, int fr, int fq, LAS unsigned char*) const {
        char* sS = (char*)scrS + (threadIdx.x >> 6) * 16384u + (threadIdx.x & 63) * 16u; char* sM = (char*)scrM + (threadIdx.x >> 6) * 16384u + (threadIdx.x & 63) * 16u; asm volatile("" : "+v"(sS), "+v"(sM));
        if (u.tag == 0 || u.tag == 2) {
            EPI_ROWS_BEGIN
                const int row = u.pm * 256 + rl; const float rs = rsqrtf(ssq[row] * (1.f / 1024.f) + NORM_EPS);
#pragma unroll
                for (int bj = 0; bj < 2; ++bj) {
                    const int i = (ai * 4 + m) * 2 + bj; const f32x4 a0 = acc[ai][bj][m][0], a1 = acc[ai][bj][m][1];
                    u32x4 w; w.x = cvt_pk_bf16(fsigmoid(a0[0] * rs), fsigmoid(a0[1] * rs)); w.y = cvt_pk_bf16(fsigmoid(a0[2] * rs), fsigmoid(a0[3] * rs));
                    w.z = cvt_pk_bf16(fsigmoid(a1[0] * rs), fsigmoid(a1[1] * rs)); w.w = cvt_pk_bf16(fsigmoid(a1[2] * rs), fsigmoid(a1[3] * rs));
                    *(u32x4*)(sS + i * 1024) = w;
                }
            EPI_ROWS_END
        } else if (u.tag == 1) {
            EPI_ROWS_BEGIN
#pragma unroll
                for (int bj = 0; bj < 2; ++bj) {
                    const int i = (ai * 4 + m) * 2 + bj; const f32x4 a0 = acc[ai][bj][m][0], a1 = acc[ai][bj][m][1];
                    const u32x4 sg = *(const u32x4*)(sS + i * 1024);
                    u32x4 pm_; pm_.x = cvt_pk_bf16(bflo(sg.x) * a0[0], bfhi(sg.x) * a0[1]); pm_.y = cvt_pk_bf16(bflo(sg.y) * a0[2], bfhi(sg.y) * a0[3]);
                    pm_.z = cvt_pk_bf16(bflo(sg.z) * a1[0], bfhi(sg.z) * a1[1]); pm_.w = cvt_pk_bf16(bflo(sg.w) * a1[2], bfhi(sg.w) * a1[3]);
                    *(u32x4*)(sM + i * 1024) = pm_;
                }
                asm volatile("" ::: "memory");
            EPI_ROWS_END
        } else {
            EPI_ROWS_BEGIN
                const int row = u.pm * 256 + rl;
#pragma unroll
                for (int bj = 0; bj < 2; ++bj) {
                    const int i = (ai * 4 + m) * 2 + bj; const f32x4 a0 = acc[ai][bj][m][0], a1 = acc[ai][bj][m][1];
                    const u32x4 sg = *(const u32x4*)(sS + i * 1024);
                    const u32x4 pm_ = *(const u32x4*)(sM + i * 1024);
                    f32x4 m0 = (f32x4){bflo(pm_.x), bfhi(pm_.x), bflo(pm_.y), bfhi(pm_.y)}, m1 = (f32x4){bflo(pm_.z), bfhi(pm_.z), bflo(pm_.w), bfhi(pm_.w)};
                    m0 = m0 + (f32x4){bflo(sg.x) * a0[0], bfhi(sg.x) * a0[1], bflo(sg.y) * a0[2], bfhi(sg.y) * a0[3]};
                    m1 = m1 + (f32x4){bflo(sg.z) * a1[0], bfhi(sg.z) * a1[1], bflo(sg.w) * a1[2], bfhi(sg.w) * a1[3]};
                    u32x4 w; w.x = cvt_pk_bf16(m0[0], m0[1]); w.y = cvt_pk_bf16(m0[2], m0[3]); w.z = cvt_pk_bf16(m1[0], m1[1]); w.w = cvt_pk_bf16(m1[2], m1[3]);
                    *(u32x4*)(MG + (size_t)row * DM + u.pn * 256 + bj * 128 + wc * 32 + fq * 8) = w;
                }
                asm volatile("" ::: "memory");
            EPI_ROWS_END
        }
    }
};
struct EpiAttn {
    bf16_t* Pb; bf16_t* Ob; bf16_t* Qb; const float* ssq;
    __device__ __forceinline__ void operator()(AccRef acc, const Unit& u, int wr, int wc, int fr, int fq, LAS unsigned char* lds) const {
        LAS float* xm = (LAS float*)(lds + XCH_OFF); LAS float* xs = xm + 1024;
        if (u.tag == 2) {
            EPI_ROWS_BEGIN
                const int row = u.pm * 256 + rl; const float rs = rsqrtf(ssq[row] * (1.f / 1024.f) + NORM_EPS);
#pragma unroll
                for (int bj = 0; bj < 2; ++bj) { const f32x4 v0 = acc[ai][bj][m][0] * rs, v1 = acc[ai][bj][m][1] * rs;
                    u32x4 w; w.x = cvt_pk_bf16(v0[0], v0[1]); w.y = cvt_pk_bf16(v0[2], v0[3]); w.z = cvt_pk_bf16(v1[0], v1[1]); w.w = cvt_pk_bf16(v1[2], v1[3]);
                    *(u32x4*)(Qb + (size_t)row * DM + u.pn * 256 + bj * 128 + wc * 32 + fq * 8) = w; }
            EPI_ROWS_END
            return;
        }
        if (u.tag == 1) {
            EPI_ROWS_BEGIN
                const int row = u.pm * 256 + rl;
#pragma unroll
                for (int bj = 0; bj < 2; ++bj) { const f32x4 v0 = acc[ai][bj][m][0], v1 = acc[ai][bj][m][1];
                    u32x4 w; w.x = cvt_pk_bf16(v0[0], v0[1]); w.y = cvt_pk_bf16(v0[2], v0[3]); w.z = cvt_pk_bf16(v1[0], v1[1]); w.w = cvt_pk_bf16(v1[2], v1[3]);
                    *(u32x4*)(Ob + (size_t)row * DM + u.pn * 256 + bj * 128 + wc * 32 + fq * 8) = w; }
            EPI_ROWS_END
            return;
        }
        EPI_ROWS_BEGIN
            float v = -3.0e38f;
#pragma unroll
            for (int bj = 0; bj < 2; ++bj)
#pragma unroll
                for (int n = 0; n < 2; ++n)
#pragma unroll
                    for (int j = 0; j < 4; ++j) v = fmaxf(v, acc[ai][bj][m][n][j]);
            v = fmaxf(v, __shfl_xor(v, 16)); v = fmaxf(v, __shfl_xor(v, 32));
            if (fq == 0) xm[rl * 4 + wc] = v;
        EPI_ROWS_END
        WG_BAR();
        EPI_ROWS_BEGIN
            const f32x4 q = *(const LAS f32x4*)(xm + rl * 4); const float M = fmaxf(fmaxf(q[0], q[1]), fmaxf(q[2], q[3]));
            float sum = 0.f;
#pragma unroll
            for (int bj = 0; bj < 2; ++bj)
#pragma unroll
                for (int n = 0; n < 2; ++n)
#pragma unroll
                    for (int j = 0; j < 4; ++j) sum += __expf(acc[ai][bj][m][n][j] - M);
            sum += __shfl_xor(sum, 16); sum += __shfl_xor(sum, 32);
            if (fq == 0) xs[rl * 4 + wc] = sum;
        EPI_ROWS_END
        WG_BAR();
        EPI_ROWS_BEGIN
            const int row = u.pm * 256 + rl;
            const f32x4 q = *(const LAS f32x4*)(xm + rl * 4); const float M = fmaxf(fmaxf(q[0], q[1]), fmaxf(q[2], q[3]));
            const f32x4 qs = *(const LAS f32x4*)(xs + rl * 4); const float inv = __builtin_amdgcn_rcpf((qs[0] + qs[1]) + (qs[2] + qs[3]));
#pragma unroll
            for (int bj = 0; bj < 2; ++bj) { const f32x4 a0 = acc[ai][bj][m][0], a1 = acc[ai][bj][m][1];
                u32x4 w; w.x = cvt_pk_bf16(__expf(a0[0] - M) * inv, __expf(a0[1] - M) * inv); w.y = cvt_pk_bf16(__expf(a0[2] - M) * inv, __expf(a0[3] - M) * inv);
                w.z = cvt_pk_bf16(__expf(a1[0] - M) * inv, __expf(a1[1] - M) * inv); w.w = cvt_pk_bf16(__expf(a1[2] - M) * inv, __expf(a1[3] - M) * inv);
                *(u32x4*)(Pb + (size_t)row * DM + u.pn * 256 + bj * 128 + wc * 32 + fq * 8) = w; }
            asm volatile("" ::: "memory");
        EPI_ROWS_END
        WG_BAR();
    }
};

struct TJob { const float* src; const float* gain; bf16_t* dst; int K, ldsrc, col0, ncols, dst_ld, dst_row0, dst_k0, mode; float scale; int item0; };
struct Params { const float* in[37]; float* out; unsigned char* ws; TJob jobs[20]; int njobs, nitems, ph_lo, ph_hi, coop, nearly; };

__device__ __forceinline__ void transpose_item(const TJob& J, int item, LAS float* scr, int lane) {
    const int nblk = (J.ncols + 31) >> 5, kb = item / nblk, nb = item - kb * nblk, k0 = 64 * kb, n0 = 32 * nb;
    const bool nok = (n0 + (lane & 31)) < J.ncols;
#pragma unroll
    for (int i = 0; i < 32; ++i) { const int kk = 2 * i + (lane >> 5);
        float v = 0.f; if (nok) { v = J.src[(size_t)(k0 + kk) * J.ldsrc + J.col0 + n0 + (lane & 31)] * J.scale; if (J.gain) v *= J.gain[k0 + kk]; }
        scr[kk * 33 + (lane & 31)] = v; }
    LDS_WAIT();
    const int c = lane & 7;
#pragma unroll
    for (int j = 0; j < 4; ++j) { const int n = n0 + (lane >> 3) + 8 * j; const LAS float* s = scr + (8 * c) * 33 + (n - n0);
        if (n < J.ncols) { u32x4 o; o.x = cvt_pk_bf16(s[0], s[33]); o.y = cvt_pk_bf16(s[66], s[99]); o.z = cvt_pk_bf16(s[132], s[165]); o.w = cvt_pk_bf16(s[198], s[231]);
            const int dr = (J.mode ? ((n >> 7) * 256 + (n & 127)) : n) + J.dst_row0;
            *(u32x4*)(J.dst + (size_t)dr * J.dst_ld + J.dst_k0 + k0 + 8 * c) = o; } }
    LDS_WAIT();
}
__device__ __forceinline__ void row_to_bf16_ssq(const float* xrow, bf16_t* orow, float* ssq, int lane) {
    const f32x4* xr = (const f32x4*)xrow + lane; f32x4 v[4]; float s = 0.f;
#pragma unroll
    for (int j = 0; j < 4; ++j) { v[j] = xr[64 * j]; s += (v[j].x * v[j].x + v[j].y * v[j].y) + (v[j].z * v[j].z + v[j].w * v[j].w); }
    s = wave_sum(s); if (lane == 0) *ssq = s;
    u32x2* o8 = (u32x2*)orow + lane;
#pragma unroll
    for (int j = 0; j < 4; ++j) { u32x2 w; w.x = cvt_pk_bf16(v[j].x, v[j].y); w.y = cvt_pk_bf16(v[j].z, v[j].w); o8[64 * j] = w; }
}
__device__ __forceinline__ void rows4_to_bf16_ssq(const float* xrow, bf16_t* orow, float* ssq, int lane) {
    f32x4 v[4][4]; float s[4];
#pragma unroll
    for (int r = 0; r < 4; ++r)
#pragma unroll
        for (int j = 0; j < 4; ++j) v[r][j] = ((const f32x4*)(xrow + (size_t)r * DM) + lane)[64 * j];
#pragma unroll
    for (int r = 0; r < 4; ++r) { s[r] = 0.f;
#pragma unroll
        for (int j = 0; j < 4; ++j) s[r] += (v[r][j].x * v[r][j].x + v[r][j].y * v[r][j].y) + (v[r][j].z * v[r][j].z + v[r][j].w * v[r][j].w); }
#pragma unroll
    for (int o = 1; o < 64; o <<= 1) {
#pragma unroll
        for (int r = 0; r < 4; ++r) s[r] += __shfl_xor(s[r], o); }
    if (lane < 4) ssq[lane] = lane == 0 ? s[0] : (lane == 1 ? s[1] : (lane == 2 ? s[2] : s[3]));
#pragma unroll
    for (int r = 0; r < 4; ++r) { u32x2* o8 = (u32x2*)(orow + (size_t)r * DM) + lane;
#pragma unroll
        for (int j = 0; j < 4; ++j) { u32x2 w; w.x = cvt_pk_bf16(v[r][j].x, v[r][j].y); w.y = cvt_pk_bf16(v[r][j].z, v[r][j].w); o8[64 * j] = w; } }
}
__device__ __forceinline__ void phase_prep(const Params& P, LAS unsigned char* lds) {
    const int tid = threadIdx.x, lane = tid & 63, wave = tid >> 6; unsigned char* ws = P.ws;
    const int gw = blockIdx.x * 8 + wave, NGW = gridDim.x * 8;
    LAS float* scr = (LAS float*)(lds + wave * 16384);
    for (int it = gw; it < P.nearly; it += NGW) {
        int j = 0;
        while (j + 1 < P.njobs && it >= P.jobs[j + 1].item0) ++j;
        transpose_item(P.jobs[j], it - P.jobs[j].item0, scr, lane);
    }
    for (int m = gw * 4; m < NTOK; m += NGW * 4) rows4_to_bf16_ssq(P.in[0] + (size_t)m * DM, (bf16_t*)(ws + OFF_XB) + (size_t)m * DM, (float*)(ws + OFF_SSQ0) + m, lane);
    for (int m = gw * 4; m < MEMTOK; m += NGW * 4) rows4_to_bf16_ssq(P.in[1] + (size_t)m * DM, (bf16_t*)(ws + OFF_MEMB) + (size_t)m * DM, (float*)(ws + OFF_SSQM) + m, lane);
    const int gt = blockIdx.x * 512 + tid, NGT = gridDim.x * 512;
    for (int i = gt; i < 4 * NTOK; i += NGT) ((float*)(ws + OFF_SSQ1))[i] = 0.f;
    for (int i = gt; i < (int)(8 * MiB / 16); i += NGT) ((u32x4*)(ws + OFF_STATS))[i] = (u32x4){0u, 0u, 0u, 0u};
    for (int i = gt; i < 248 * 1024 / 8; i += NGT) ((u32x4*)(ws + OFF_WIN + (size_t)3848 * 2048))[i] = (u32x4){0u, 0u, 0u, 0u};
}

#define RLX_AGENT __ATOMIC_RELAXED, __HIP_MEMORY_SCOPE_AGENT
__device__ __forceinline__ float red16(float x) {
    x += dpp_f<0xB1>(x); x += dpp_f<0x4E>(x); x += dpp_f<0x141>(x); x += dpp_f<0x140>(x); return x;
}
#define RWA_COL(ty_, cv_, h_, rg_) ((ty_) == 0 ? 1664 + (cv_) * 8 : ((ty_) == 1 ? 1536 + (cv_) * 8 : ((ty_) == 2 ? 1600 + (cv_) * 8 : ((ty_) == 3 ? (h_) * 64 + (cv_) * 8 : ((ty_) == 4 ? 512 + (h_) * 64 + (cv_) * 8 : 1024 + (h_) * 64 + (rg_) * 32 + (cv_) * 8)))))
#define RWA_MAP(p_, lane_, h_, rg_) \
    int ty0, ty1, cv0, cv1, tq0, tq1; bool act0 = true, act1 = true; \
    if ((p_) == 0) { ty0 = 0; cv0 = (lane_) & 7; ty1 = 3; cv1 = (lane_) & 7; tq0 = tq1 = (lane_) >> 3; } \
    else if ((p_) == 1) { ty0 = 0; cv0 = 8 + ((lane_) & 7); ty1 = 4; cv1 = (lane_) & 7; tq0 = tq1 = (lane_) >> 3; } \
    else if ((p_) == 2) { ty0 = 1; cv0 = (lane_) & 7; ty1 = 2; cv1 = (lane_) & 7; tq0 = tq1 = (lane_) >> 3; } \
    else { ty0 = 5; cv0 = (lane_) & 3; tq0 = ((lane_) >> 2) & 7; act0 = (lane_) < 32; ty1 = 5; cv1 = 0; tq1 = 0; act1 = false; } \
    const int col0 = RWA_COL(ty0, cv0, h_, rg_), col1 = RWA_COL(ty1, cv1, h_, rg_);
__device__ __forceinline__ void rwkv_item(const Params& P, LAS unsigned char* lds, int item) {
    const int bh = item >> 1, rg = item & 1, b = bh >> 3, h = bh & 7; unsigned char* ws = P.ws;
    const bf16_t* Z = (const bf16_t*)(ws + OFF_Z); bf16_t* Yb = (bf16_t*)(ws + OFF_Y);
    unsigned long long* gran = (unsigned long long*)(ws + OFF_STATS);
    const float* mu = P.in[8]; const float* w0 = P.in[9]; const float* a0 = P.in[11]; const float* k_k = P.in[14]; const float* k_a = P.in[15]; const float* r_k = P.in[16];
    const float* gn_w = P.in[17]; const float* gn_b = P.in[18];
#define OPS_RR(s_) ((LAS float*)(lds + (s_) * 40960))
#define OPS_WW(s_) ((LAS float*)(lds + (s_) * 40960 + 8192))
#define OPS_BV(s_) ((LAS float*)(lds + (s_) * 40960 + 16384))
#define OPS_KM(s_) ((LAS float*)(lds + (s_) * 40960 + 24576))
#define OPS_KK(s_) ((LAS float*)(lds + (s_) * 40960 + 32768))
    LAS bf16_t* AW = (LAS bf16_t*)(lds + 81920); LAS bf16_t* AA = (LAS bf16_t*)(lds + 86528); LAS bf16_t* AG = (LAS bf16_t*)(lds + 91136);
    LAS float* KS = (LAS float*)(lds + 99840); LAS float* Aa = (LAS float*)(lds + 108032);
#define VV(s_) ((LAS float*)(lds + 116224 + (s_) * 4096))
#define YY(j_) ((LAS float*)(lds + 124416 + (j_) * 4096))
    LAS float* Gt = (LAS float*)(lds + 140800);
#define Q1B(j_) ((LAS bf16_t*)(lds + 144896 + (j_) * 2048))
#define Q2B(j_) ((LAS bf16_t*)(lds + 153088 + (j_) * 2048))
    LAS float* PRM = (LAS float*)(lds + 161280);
    LAS unsigned* GB = (LAS unsigned*)(lds + 162816);
    {
        const int tid = threadIdx.x;
        if (tid < 64) { PRM[tid] = k_k[h * 64 + tid]; PRM[64 + tid] = k_a[h * 64 + tid]; PRM[128 + tid] = r_k[h * 64 + tid]; PRM[192 + tid] = w0[h * 64 + tid]; PRM[256 + tid] = a0[h * 64 + tid]; }
        if (tid < 32) { PRM[320 + tid] = gn_w[h * 64 + rg * 32 + tid]; PRM[352 + tid] = gn_b[h * 64 + rg * 32 + tid]; }
        if (tid == 0) GB[0] = 0u;
    }
    bf16x8 bw[2][2], ba[2][2], bg[4];
    {
        const int lane = threadIdx.x & 63, fr = lane & 15, fq = lane >> 4, p = (threadIdx.x >> 6) & 3, kp = p >> 1;
#pragma unroll
        for (int q = 0; q < 2; ++q) { const int ch = h * 64 + (2 * kp + q) * 16 + fr;
#pragma unroll
            for (int ks = 0; ks < 2; ++ks) { bw[q][ks] = *(const bf16x8*)((const bf16_t*)(ws + OFF_W2T) + (size_t)ch * 64 + ks * 32 + fq * 8); ba[q][ks] = *(const bf16x8*)((const bf16_t*)(ws + OFF_A2T) + (size_t)ch * 64 + ks * 32 + fq * 8); } }
#pragma unroll
        for (int ks = 0; ks < 4; ++ks) bg[ks] = *(const bf16x8*)((const bf16_t*)(ws + OFF_G2T) + (size_t)(h * 64 + rg * 32 + kp * 16 + fr) * 128 + ks * 32 + fq * 8);
    }
    f32x2 S2[4] = {{0.f, 0.f}, {0.f, 0.f}, {0.f, 0.f}, {0.f, 0.f}};
    float muA[8], muB[8]; u32x4 pzA[4], pzB[4], ppA, ppB; unsigned gbgen = 0u; float ps1 = 0.f, ps2 = 0.f;
    {
        RWA_MAP(((int)(threadIdx.x >> 6)) & 3, (int)(threadIdx.x & 63), h, rg)
        (void)act0; (void)act1; (void)tq0; (void)tq1;
        const f32x4 m0 = *(const f32x4*)(mu + col0), m1 = *(const f32x4*)(mu + col0 + 4), n0 = *(const f32x4*)(mu + col1), n1 = *(const f32x4*)(mu + col1 + 4);
#pragma unroll
        for (int j = 0; j < 4; ++j) { muA[j] = m0[j]; muA[4 + j] = m1[j]; muB[j] = n0[j]; muB[4 + j] = n1[j]; }
    }
#define RW_PF1(cn, pz_, pp_, act_, tq_, col_) do { pp_ = (u32x4){0u, 0u, 0u, 0u}; _Pragma("unroll") for (int i_ = 0; i_ < 4; ++i_) pz_[i_] = pp_; \
        if (act_) { const size_t tok = (size_t)b * SEQ + (cn) * 32 + (tq_) * 4; if ((cn) * 32 + (tq_) * 4 > 0) pp_ = *(const u32x4*)(Z + (tok - 1) * ZLD + (col_)); \
            _Pragma("unroll") for (int i_ = 0; i_ < 4; ++i_) pz_[i_] = *(const u32x4*)(Z + (tok + i_) * ZLD + (col_)); } } while (0)
#define RW_PREFETCH(cn) do { RW_PF1(cn, pzA, ppA, act0, tq0, col0); RW_PF1(cn, pzB, ppB, act1, tq1, col1); } while (0)
#define GRP_BAR() do { asm volatile("s_waitcnt lgkmcnt(0)" ::: "memory"); gbgen += 1u; if (lane == 0) (void)__hip_atomic_fetch_add(GB, 1u, __ATOMIC_RELAXED, __HIP_MEMORY_SCOPE_WORKGROUP); \
        { unsigned sp_ = 0; while (__hip_atomic_load(GB, __ATOMIC_RELAXED, __HIP_MEMORY_SCOPE_WORKGROUP) < gbgen * 4u) { if (++sp_ > (1u << 24)) break; } } asm volatile("" ::: "memory"); } while (0)
    {
        RWA_MAP(((int)(threadIdx.x >> 6)) & 3, (int)(threadIdx.x & 63), h, rg)
        act0 = act0 && threadIdx.x >= 256; act1 = act1 && threadIdx.x >= 256;
        RW_PREFETCH(0);
    }
    WG_BAR();
#pragma unroll 1
    for (int it = 0; it < 131; ++it) {
        int tl_ = threadIdx.x; asm volatile("" : "+v"(tl_));
        const int tid = tl_, lane = tid & 63, wave = __builtin_amdgcn_readfirstlane(tid >> 6), fr = lane & 15, fq = lane >> 4;
        if (wave >= 4) {
            unsigned long long g0 = 0ull, g1 = 0ull;
            if (wave == 7 && it >= 3) {
                const unsigned long long* gb3 = gran + (((size_t)bh * 128 + (it - 3)) * 2) * 64 + (lane & 31) * 2 + (rg ^ 1) * 64;
                g0 = __hip_atomic_load(gb3, RLX_AGENT); g1 = __hip_atomic_load(gb3 + 1, RLX_AGENT);
            }
            if (it < 128) {
                const int c = it, os = c & 1, qj = c & 3;
                const int tidp = tid - 256, p = wave - 4, tt = p & 1, kp = p >> 1;
                RWA_MAP(p, lane, h, rg)
                LAS float* Rr = OPS_RR(os); LAS float* Ww = OPS_WW(os); LAS float* Bv = OPS_BV(os); LAS float* KM = OPS_KM(os); LAS float* KK = OPS_KK(os); LAS float* Vv = VV(os);
#define RWA_SEG(pz_, pp_, mu_, act_, ty_, cv_, tq_) do { if (act_) { _Pragma("unroll") for (int i = 0; i < 4; ++i) { \
                    const int t = (tq_) * 4 + i; const u32x4 zc = pz_[i], zp = (i == 0) ? pp_ : pz_[i > 0 ? i - 1 : 0]; \
                    float z[8]; const float c8[8] = {bflo(zc.x), bfhi(zc.x), bflo(zc.y), bfhi(zc.y), bflo(zc.z), bfhi(zc.z), bflo(zc.w), bfhi(zc.w)}; \
                    const float p8[8] = {bflo(zp.x), bfhi(zp.x), bflo(zp.y), bfhi(zp.y), bflo(zp.z), bfhi(zp.z), bflo(zp.w), bfhi(zp.w)}; \
                    _Pragma("unroll") for (int j = 0; j < 8; ++j) z[j] = c8[j] + (p8[j] - c8[j]) * mu_[j]; \
                    if ((ty_) >= 3) { LAS float* dst = (ty_) == 3 ? Rr + t * 64 + (cv_) * 8 : ((ty_) == 4 ? KS + t * 64 + (cv_) * 8 : Vv + t * 32 + (cv_) * 8); \
                        *(LAS f32x4*)dst = (f32x4){z[0], z[1], z[2], z[3]}; *(LAS f32x4*)(dst + 4) = (f32x4){z[4], z[5], z[6], z[7]}; } \
                    else { LAS bf16_t* dst; \
                        if ((ty_) == 1) { dst = AW + t * 72 + (cv_) * 8; _Pragma("unroll") for (int j = 0; j < 8; ++j) z[j] = 1.f - 2.f * __builtin_amdgcn_rcpf(__expf(2.f * z[j]) + 1.f); } \
                        else if ((ty_) == 2) dst = AA + t * 72 + (cv_) * 8; \
                        else { dst = AG + t * 136 + (cv_) * 8; _Pragma("unroll") for (int j = 0; j < 8; ++j) z[j] = fsigmoid(z[j]); } \
                        u32x4 w; w.x = cvt_pk_bf16(z[0], z[1]); w.y = cvt_pk_bf16(z[2], z[3]); w.z = cvt_pk_bf16(z[4], z[5]); w.w = cvt_pk_bf16(z[6], z[7]); \
                        *(LAS u32x4*)dst = w; } } } } while (0)
                RWA_SEG(pzA, ppA, muA, act0, ty0, cv0, tq0);
                RWA_SEG(pzB, ppB, muB, act1, ty1, cv1, tq1);
#undef RWA_SEG
                if (c < 127) RW_PREFETCH(c + 1);
                GRP_BAR();
                {
                    bf16x8 aw[2], aa[2];
#pragma unroll
                    for (int ks = 0; ks < 2; ++ks) { aw[ks] = *(const LAS bf16x8*)(AW + (tt * 16 + fr) * 72 + ks * 32 + fq * 8); aa[ks] = *(const LAS bf16x8*)(AA + (tt * 16 + fr) * 72 + ks * 32 + fq * 8); }
                    const int t = tt * 16 + fr;
#pragma unroll
                    for (int q = 0; q < 2; ++q) {
                        f32x4 cw = (f32x4){0.f, 0.f, 0.f, 0.f}, ca = cw;
#pragma unroll
                        for (int ks = 0; ks < 2; ++ks) { cw = __builtin_amdgcn_mfma_f32_16x16x32_bf16(bw[q][ks], aw[ks], cw, 0, 0, 0); ca = __builtin_amdgcn_mfma_f32_16x16x32_bf16(ba[q][ks], aa[ks], ca, 0, 0, 0); }
                        const int kl = (2 * kp + q) * 16 + fq * 4;
                        const f32x4 w0v = *(const LAS f32x4*)(PRM + 192 + kl), a0v = *(const LAS f32x4*)(PRM + 256 + kl);
                        f32x4 dw, av;
#pragma unroll
                        for (int j = 0; j < 4; ++j) { dw[j] = __expf(-0.6065306597f * fsigmoid(w0v[j] + cw[j])); av[j] = fsigmoid(a0v[j] + ca[j]); }
                        *(LAS f32x4*)(Ww + t * 64 + kl) = dw; *(LAS f32x4*)(Aa + t * 64 + kl) = av;
                    }
                    f32x4 cg_ = (f32x4){0.f, 0.f, 0.f, 0.f};
#pragma unroll
                    for (int ks = 0; ks < 4; ++ks) { const bf16x8 ag = *(const LAS bf16x8*)(AG + (tt * 16 + fr) * 136 + ks * 32 + fq * 8); cg_ = __builtin_amdgcn_mfma_f32_16x16x32_bf16(bg[ks], ag, cg_, 0, 0, 0); }
                    *(LAS f32x4*)(Gt + t * 32 + kp * 16 + fq * 4) = cg_;
                }
                GRP_BAR();
                {
                    const int t = tidp >> 3, k8 = tidp & 7, k0 = k8 * 8;
                    float ks8[8], a8[8], r8[8], kk8[8], km8[8], pk[8], pa[8], pr[8]; float n2 = 0.f, bon = 0.f;
#pragma unroll
                    for (int i = 0; i < 2; ++i) { const f32x4 x0 = *(const LAS f32x4*)(KS + t * 64 + k0 + 4 * i), x1 = *(const LAS f32x4*)(Aa + t * 64 + k0 + 4 * i), x2 = *(const LAS f32x4*)(Rr + t * 64 + k0 + 4 * i);
                        const f32x4 y0 = *(const LAS f32x4*)(PRM + k0 + 4 * i), y1 = *(const LAS f32x4*)(PRM + 64 + k0 + 4 * i), y2 = *(const LAS f32x4*)(PRM + 128 + k0 + 4 * i);
#pragma unroll
                        for (int j = 0; j < 4; ++j) { ks8[4 * i + j] = x0[j]; a8[4 * i + j] = x1[j]; r8[4 * i + j] = x2[j]; pk[4 * i + j] = y0[j]; pa[4 * i + j] = y1[j]; pr[4 * i + j] = y2[j]; } }
#pragma unroll
                    for (int i = 0; i < 8; ++i) { kk8[i] = ks8[i] * pk[i]; n2 += kk8[i] * kk8[i]; km8[i] = ks8[i] * (1.f + (a8[i] - 1.f) * pa[i]); bon += r8[i] * km8[i] * pr[i]; }
                    n2 = red8(n2); bon = red8(bon);
                    const float inv = 1.f / fmaxf(sqrtf(n2), 1e-12f);
                    f32x4 o0[2], o1[2], o2[2];
#pragma unroll
                    for (int i = 0; i < 8; ++i) { const float kn = kk8[i] * inv; o0[i >> 2][i & 3] = -kn; o1[i >> 2][i & 3] = km8[i]; o2[i >> 2][i & 3] = kn * a8[i]; }
#pragma unroll
                    for (int i = 0; i < 2; ++i) { *(LAS f32x4*)(KK + t * 64 + k0 + 4 * i) = o0[i]; *(LAS f32x4*)(KM + t * 64 + k0 + 4 * i) = o1[i]; *(LAS f32x4*)(Bv + t * 64 + k0 + 4 * i) = o2[i]; }
                    const int r4 = k8 * 4;
                    const f32x4 g4 = *(const LAS f32x4*)(Gt + t * 32 + r4), v4 = *(const LAS f32x4*)(Vv + t * 32 + r4), gw4 = *(const LAS f32x4*)(PRM + 320 + r4), gb4 = *(const LAS f32x4*)(PRM + 352 + r4);
                    u32x2 q1, q2;
                    q1.x = cvt_pk_bf16(g4[0] * gw4[0], g4[1] * gw4[1]); q1.y = cvt_pk_bf16(g4[2] * gw4[2], g4[3] * gw4[3]);
                    q2.x = cvt_pk_bf16(g4[0] * (gb4[0] + bon * v4[0]), g4[1] * (gb4[1] + bon * v4[1])); q2.y = cvt_pk_bf16(g4[2] * (gb4[2] + bon * v4[2]), g4[3] * (gb4[3] + bon * v4[3]));
                    *(LAS u32x2*)(Q1B(qj) + t * 32 + r4) = q1; *(LAS u32x2*)(Q2B(qj) + t * 32 + r4) = q2;
                }
            }
            if (wave == 7 && it >= 2) {
                const int t = lane & 31;
                float ns1 = 0.f, ns2 = 0.f;
                if (it <= 129) {
                    const int c = it - 2, yj = c & 3;
#pragma unroll
                    for (int i = 0; i < 8; ++i) { const f32x4 y = *(const LAS f32x4*)(YY(yj) + t * 32 + 4 * i); ns1 += (y[0] + y[1]) + (y[2] + y[3]); ns2 += (y[0] * y[0] + y[1] * y[1]) + (y[2] * y[2] + y[3] * y[3]); }
                    const unsigned long long ep = (unsigned long long)(unsigned)(c + 1) << 32;
                    unsigned long long* gbase = gran + (((size_t)bh * 128 + c) * 2) * 64 + t * 2;
                    if (lane < 32) { __hip_atomic_store(gbase + rg * 64, ep | __builtin_bit_cast(unsigned, ns1), RLX_AGENT); __hip_atomic_store(gbase + rg * 64 + 1, ep | __builtin_bit_cast(unsigned, ns2), RLX_AGENT); }
                }
                if (it >= 3) {
                    const int c = it - 3, yj = c & 3;
                    unsigned long long* gb3 = gran + (((size_t)bh * 128 + c) * 2) * 64 + t * 2 + (rg ^ 1) * 64;
                    unsigned spins = 0;
                    for (;;) {
                        const bool ok = ((g0 >> 32) == (unsigned long long)(unsigned)(c + 1)) && ((g1 >> 32) == (unsigned long long)(unsigned)(c + 1));
                        if (__all(ok)) break;
                        __builtin_amdgcn_s_sleep(2); if (++spins > (1u << 20)) break;
                        g0 = __hip_atomic_load(gb3, RLX_AGENT); g1 = __hip_atomic_load(gb3 + 1, RLX_AGENT);
                    }
                    const float s1 = ps1 + __builtin_bit_cast(float, (unsigned)g0), s2 = ps2 + __builtin_bit_cast(float, (unsigned)g1);
                    const float mean = s1 * (1.f / 64.f), var = fmaxf(s2 * (1.f / 64.f) - mean * mean, 0.f), rstd = rsqrtf(var + 64e-5f);
                    if (lane < 32) {
                        bf16_t* dst = Yb + ((size_t)b * SEQ + c * 32 + t) * DM + h * 64 + rg * 32;
#pragma unroll
                        for (int i = 0; i < 4; ++i) {
                            const f32x4 ya = *(const LAS f32x4*)(YY(yj) + t * 32 + 8 * i), yb = *(const LAS f32x4*)(YY(yj) + t * 32 + 8 * i + 4);
                            const u32x4 q1 = *(const LAS u32x4*)(Q1B(yj) + t * 32 + 8 * i), q2 = *(const LAS u32x4*)(Q2B(yj) + t * 32 + 8 * i);
                            u32x4 w;
                            w.x = cvt_pk_bf16((ya[0] - mean) * rstd * bflo(q1.x) + bflo(q2.x), (ya[1] - mean) * rstd * bfhi(q1.x) + bfhi(q2.x));
                            w.y = cvt_pk_bf16((ya[2] - mean) * rstd * bflo(q1.y) + bflo(q2.y), (ya[3] - mean) * rstd * bfhi(q1.y) + bfhi(q2.y));
                            w.z = cvt_pk_bf16((yb[0] - mean) * rstd * bflo(q1.z) + bflo(q2.z), (yb[1] - mean) * rstd * bfhi(q1.z) + bfhi(q2.z));
                            w.w = cvt_pk_bf16((yb[2] - mean) * rstd * bflo(q1.w) + bflo(q2.w), (yb[3] - mean) * rstd * bfhi(q1.w) + bfhi(q2.w));
                            *(u32x4*)(dst + 8 * i) = w;
                        }
                    }
                }
                ps1 = ns1; ps2 = ns2;
            }
        } else if (it >= 1 && it <= 128) {
            const int c = it - 1, os = c & 1, yj = c & 3, grp = tid >> 4, kq = tid & 15;
            LAS const unsigned char* ob = (LAS const unsigned char*)OPS_RR(os) + kq * 16;
            LAS const unsigned char* vp = (LAS const unsigned char*)VV(os) + grp * 8; LAS unsigned char* yp = (LAS unsigned char*)YY(yj) + grp * 8;
            f32x4 wA, bA, mA, kA, rA, wB, bB, mB, kB, rB; f32x2 vA, vB;
#define RW_LD(X, d) do { r##X = *(const LAS f32x4*)(ob + (d) * 256); w##X = *(const LAS f32x4*)(ob + (d) * 256 + 8192); b##X = *(const LAS f32x4*)(ob + (d) * 256 + 16384); m##X = *(const LAS f32x4*)(ob + (d) * 256 + 24576); \
                k##X = *(const LAS f32x4*)(ob + (d) * 256 + 32768); v##X = *(const LAS f32x2*)(vp + (d) * 128); } while (0)
#define RW_LVL(a_, b_, C) do { a_ += dpp_f<C>(a_); b_ += dpp_f<C>(b_); asm volatile("" : "+v"(a_), "+v"(b_)); } while (0)
#define RW_RED2(x) do { float a_ = x[0], b_ = x[1]; RW_LVL(a_, b_, 0xB1); RW_LVL(a_, b_, 0x4E); RW_LVL(a_, b_, 0x141); RW_LVL(a_, b_, 0x140); x = (f32x2){a_, b_}; } while (0)
#define RW_STEP(X, t) do { f32x2 sa = S2[0] * k##X[0]; sa = S2[1] * k##X[1] + sa; sa = S2[2] * k##X[2] + sa; sa = S2[3] * k##X[3] + sa; RW_RED2(sa); \
                _Pragma("unroll") for (int i = 0; i < 4; ++i) S2[i] = S2[i] * w##X[i] + (sa * b##X[i] + v##X * m##X[i]); \
                f32x2 y = S2[0] * r##X[0]; y = S2[1] * r##X[1] + y; y = S2[2] * r##X[2] + y; y = S2[3] * r##X[3] + y; RW_RED2(y); \
                if (kq == 0) *(LAS f32x2*)(yp + (t) * 128) = y; } while (0)
            RW_LD(A, 0);
#pragma unroll 1
            for (int t = 0; t < 32; t += 2) {
                RW_LD(B, 1); __builtin_amdgcn_sched_barrier(0);
                RW_STEP(A, 0); __builtin_amdgcn_sched_barrier(0);
                if (t == 30) { ob -= 30 * 256; vp -= 30 * 128; }
                RW_LD(A, 2); __builtin_amdgcn_sched_barrier(0);
                RW_STEP(B, 1); __builtin_amdgcn_sched_barrier(0);
                ob += 512; vp += 256; yp += 256;
            }
#undef RW_LD
#undef RW_STEP
#undef RW_RED2
#undef RW_LVL
        }
        WG_BAR();
    }
#undef RW_PREFETCH
#undef RW_PF1
#undef GRP_BAR
#undef OPS_RR
#undef OPS_WW
#undef OPS_BV
#undef OPS_KM
#undef OPS_KK
#undef VV
#undef YY
#undef Q1B
#undef Q2B
}

#define TRI(r, t) ((r) * 72 + (((((t) >> 3) ^ (((r) >> 3) & 7))) << 3) + ((t) & 7))
#define TRB(r, blk) ((r) * 72 + (((blk) ^ (((r) >> 3) & 7)) << 3))
__device__ __forceinline__ void mlstm_item(const Params& P, LAS unsigned char* lds, int bh) {
    const int tid = threadIdx.x, lane = tid & 63, wave = tid >> 6, fr = lane & 15, fq = lane >> 4;
    const int b = bh >> 2, h = bh & 3; unsigned char* ws = P.ws;
    const bf16_t* Z = (const bf16_t*)(ws + OFF_Z); bf16_t* Yb = (bf16_t*)(ws + OFF_Y); const float* IFb = (const float*)(ws + OFF_IF);
    const float* cw = P.in[19]; const float* cb = P.in[20]; const float ib = P.in[21][h], fb = P.in[22][h]; const float* mln = P.in[23];
    LAS bf16_t* Qs = (LAS bf16_t*)(lds); LAS bf16_t* Ks = (LAS bf16_t*)(lds + 17408); LAS bf16_t* KT = (LAS bf16_t*)(lds + 34816); LAS bf16_t* VT = (LAS bf16_t*)(lds + 53248);
    LAS bf16_t* VwT = (LAS bf16_t*)(lds + 71680); LAS bf16_t* Pp = (LAS bf16_t*)(lds + 90112); LAS bf16_t* Cb = (LAS bf16_t*)(lds + 99328);
    LAS float* F = (LAS float*)(lds + 134144);
    LAS float* ga = F, *gu = F + 64, *gwl = F + 128, *gwi = F + 192, *gei = F + 256, *dn = F + 320, *nq = F + 384, *lnx = F + 448  , *ns = F + 704  , *sc = F + 832;
    LAS float* CWL = (LAS float*)(lds + 138240);
    LAS float* CBL = CWL + 1024; LAS float* MLN = CWL + 1280;
    for (int i = tid; i < 1024; i += 512) { const int j = i >> 8, cc = i & 255; CWL[i] = cw[j * 1024 + (cc < 128 ? h * 128 + cc : 512 + h * 128 + cc - 128)]; }
    if (tid < 256) CBL[tid] = cb[tid < 128 ? h * 128 + tid : 512 + h * 128 + tid - 128];
    if (tid < 128) MLN[tid] = mln[h * 128 + tid];
    f32x4 Cacc[8];
#pragma unroll
    for (int i = 0; i < 8; ++i) Cacc[i] = (f32x4){0.f, 0.f, 0.f, 0.f};
    const int pcv = tid & 31, ptg = tid >> 5; const bool pisk = pcv >= 16; const int pc8 = (pcv & 15) * 8;
    const int pzcol = (pisk ? 2304 : 1792) + h * 128 + pc8;
    u32x4 rw[7], vx[2]; u32x2 ogp[4]; float pfb = 0.f, pfu = 0.f, pfp = 0.f, pfe = 0.f, pfm = 0.f;
#define ML_PF_QKV(cn) do { _Pragma("unroll") for (int d = 0; d < 7; ++d) { const int tl = (cn) * 64 + ptg * 4 - 3 + d; rw[d] = (u32x4){0u, 0u, 0u, 0u}; if (tl >= 0) rw[d] = *(const u32x4*)(Z + ((size_t)b * SEQ + tl) * ZLD + pzcol); } \
        _Pragma("unroll") for (int rep = 0; rep < 2; ++rep) { const int v = tid + rep * 512; vx[rep] = *(const u32x4*)(Z + ((size_t)b * SEQ + (cn) * 64 + (v >> 4)) * ZLD + 2816 + h * 128 + (v & 15) * 8); } } while (0)
#define ML_PF_IF(cn) do { if (wave == 0) { pfb = GS[(cn) * 64 + lane]; pfu = GS[4096 + (cn) * 64 + lane]; pfp = GS[8192 + (cn) * 64 + lane]; pfe = GS[12288 + (cn)]; pfm = GS[12352 + (cn)]; } } while (0)
#define ML_PF_OG(cn) do { _Pragma("unroll") for (int q = 0; q < 4; ++q) ogp[q] = *(const u32x2*)(Z + ((size_t)b * SEQ + (cn) * 64 + (wave & 3) * 16 + fr) * ZLD + 3328 + h * 128 + ((wave >> 2) * 4 + q) * 16 + fq * 4); } while (0)
    float* GS = (float*)(ws + OFF_GATES) + (size_t)bh * 12416;
    for (int cc = wave; cc < 64; cc += 8) {
        const size_t tk = (size_t)b * SEQ + cc * 64 + lane;
        const float ig = IFb[tk * 8 + h] + ib, fg = IFb[tk * 8 + 4 + h] + fb;
        const float lf = fminf(fg, 0.f) - __logf(1.f + __expf(-fabsf(fg)));
        float bc = lf;
#pragma unroll
        for (int o = 1; o < 64; o <<= 1) { const float t = __shfl_up(bc, o); if (lane >= o) bc += t; }
        const float bend = __shfl(bc, 63), u = ig - bc;
        float mc = bend + u;
#pragma unroll
        for (int o = 1; o < 64; o <<= 1) mc = fmaxf(mc, __shfl_xor(mc, o));
        float pm = u;
#pragma unroll
        for (int o = 1; o < 64; o <<= 1) { const float t = __shfl_up(pm, o); if (lane >= o) pm = fmaxf(pm, t); }
        GS[cc * 64 + lane] = bc; GS[4096 + cc * 64 + lane] = u; GS[8192 + cc * 64 + lane] = pm;
        if (lane == 0) { GS[12288 + cc] = bend; GS[12352 + cc] = mc; }
    }
    WG_BAR_ALL();
    ML_PF_IF(0); ML_PF_QKV(0); ML_PF_OG(0);
    for (int i = tid; i < 128 * 136 / 2; i += 512) ((LAS unsigned*)Cb)[i] = 0u;
    if (tid < 128) ns[tid] = 0.f;
    float mprev = 0.f;
    WG_BAR();
#pragma unroll 1
    for (int c = 0; c < 64; ++c) {
        int tl_ = threadIdx.x; asm volatile("" : "+v"(tl_));
        const int tid = tl_, lane = tid & 63, wave = tid >> 6, fr = lane & 15, fq = lane >> 4;
        const int pcv = tid & 31, ptg = tid >> 5; const bool pisk = pcv >= 16; const int pc8 = (pcv & 15) * 8;
        const int pzcol = (pisk ? 2304 : 1792) + h * 128 + pc8;
        const size_t tokc = (size_t)b * SEQ + c * 64;
        if (wave == 0) {
            const float bc = pfb, u = pfu, pm = pfp, bend = pfe, mc = pfm;
            ML_PF_IF((c + 1) & 63);
            const float lw = bend + u;
            const float mnew = fmaxf(bend + mprev, mc), dec = __expf(bend + mprev - mnew);
            const float linter = bc + mprev, mrow = fmaxf(linter, bc + pm);
            ga[lane] = bc - mrow; gu[lane] = u; gwl[lane] = __expf(lw - mnew); gwi[lane] = __expf(linter - mrow); gei[lane] = __expf(-mrow); dn[lane] = 0.f;
            if (lane == 0) { sc[0] = dec; sc[1] = mnew; }
        }
        WG_BAR();
        {
            const int tg = ptg; const bool isk = pisk; const int c8 = pc8, lch = (isk ? 128 : 0) + c8;
            float wt[4][8], bs[8];
#pragma unroll
            for (int j = 0; j < 4; ++j) { const f32x4 x0 = *(const LAS f32x4*)(CWL + j * 256 + lch), x1 = *(const LAS f32x4*)(CWL + j * 256 + lch + 4);
#pragma unroll
                for (int i = 0; i < 4; ++i) { wt[j][i] = x0[i]; wt[j][4 + i] = x1[i]; } }
            { const f32x4 x0 = *(const LAS f32x4*)(CBL + lch), x1 = *(const LAS f32x4*)(CBL + lch + 4);
#pragma unroll
              for (int i = 0; i < 4; ++i) { bs[i] = x0[i]; bs[4 + i] = x1[i]; } }
#pragma unroll
            for (int q = 0; q < 4; ++q) {
                const int t = tg * 4 + q; float o[8];
#pragma unroll
                for (int i = 0; i < 8; ++i) o[i] = bs[i];
#pragma unroll
                for (int j = 0; j < 4; ++j) { const u32x4 x = rw[3 + q - j]; const float x8[8] = {bflo(x.x), bfhi(x.x), bflo(x.y), bfhi(x.y), bflo(x.z), bfhi(x.z), bflo(x.w), bfhi(x.w)};
#pragma unroll
                    for (int i = 0; i < 8; ++i) o[i] += wt[j][i] * x8[i]; }
#pragma unroll
                for (int i = 0; i < 8; ++i) { o[i] = o[i] * fsigmoid(o[i]); if (!isk) o[i] *= 0.08838834764831845f; }
                u32x4 w; w.x = cvt_pk_bf16(o[0], o[1]); w.y = cvt_pk_bf16(o[2], o[3]); w.z = cvt_pk_bf16(o[4], o[5]); w.w = cvt_pk_bf16(o[6], o[7]);
                if (!isk) *(LAS u32x4*)(Qs + t * 136 + c8) = w;
                else { *(LAS u32x4*)(Ks + t * 136 + c8) = w;
#pragma unroll
                    for (int i = 0; i < 8; ++i) KT[TRI(c8 + i, t)] = f2bf(o[i]); }
            }
#pragma unroll
            for (int rep = 0; rep < 2; ++rep) {
                const int v = tid + rep * 512, t = v >> 4, v8 = (v & 15) * 8;
                const u32x4 x = vx[rep]; const float wl = gwl[t];
                const float x8[8] = {bflo(x.x), bfhi(x.x), bflo(x.y), bfhi(x.y), bflo(x.z), bfhi(x.z), bflo(x.w), bfhi(x.w)};
#pragma unroll
                for (int i = 0; i < 8; ++i) { VT[TRI(v8 + i, t)] = f2bf(x8[i]); VwT[TRI(v8 + i, t)] = f2bf(x8[i] * wl); }
            }
            if (c < 63) ML_PF_QKV(c + 1);
        }
        WG_BAR();
        const int st = wave & 3;
        bf16x8 qf[4];
#pragma unroll
        for (int ks = 0; ks < 4; ++ks) qf[ks] = *(const LAS bf16x8*)(Qs + (st * 16 + fr) * 136 + ks * 32 + fq * 8);
        {
            const int s = st * 16 + fr; const float gas = ga[s]; float dsum = 0.f;
#pragma unroll
            for (int q = 0; q < 2; ++q) {
                const int rt = (wave >> 2) * 2 + q; f32x4 a = (f32x4){0.f, 0.f, 0.f, 0.f};
#pragma unroll
                for (int ks = 0; ks < 4; ++ks) { const bf16x8 kf = *(const LAS bf16x8*)(Ks + (rt * 16 + fr) * 136 + ks * 32 + fq * 8); a = __builtin_amdgcn_mfma_f32_16x16x32_bf16(kf, qf[ks], a, 0, 0, 0); }
                const int r0 = rt * 16 + fq * 4; float p[4];
#pragma unroll
                for (int j = 0; j < 4; ++j) { p[j] = (r0 + j <= s) ? __expf(gas + gu[r0 + j]) * a[j] : 0.f; dsum += p[j]; }
                u32x2 w; w.x = cvt_pk_bf16(p[0], p[1]); w.y = cvt_pk_bf16(p[2], p[3]); *(LAS u32x2*)(Pp + s * 72 + r0) = w;
            }
            dsum += __shfl_xor(dsum, 16); dsum += __shfl_xor(dsum, 32);
            if (fq == 0) __hip_atomic_fetch_add(dn + s, dsum, __ATOMIC_RELAXED, __HIP_MEMORY_SCOPE_WORKGROUP);
            const int s2 = tid >> 3, kq = tid & 7; float a = 0.f;
#pragma unroll
            for (int i = 0; i < 16; ++i) a += ns[kq * 16 + i] * bf2f(Qs[s2 * 136 + kq * 16 + i]);
            a = red8(a); if (kq == 0) nq[s2] = a;
        }
        WG_BAR();
        {
            const int s = st * 16 + fr, vh = wave >> 2; const float wi = gwi[s];
            const float den = dn[s] + wi * nq[s], dinv = 1.f / fmaxf(fabsf(den), gei[s]);
            bf16x8 pf[2];
#pragma unroll
            for (int ks = 0; ks < 2; ++ks) pf[ks] = *(const LAS bf16x8*)(Pp + s * 72 + ks * 32 + fq * 8);
            f32x4 hv[4]; float s1 = 0.f, s2 = 0.f;
#pragma unroll
            for (int q = 0; q < 4; ++q) {
                const int vt = vh * 4 + q; f32x4 a = (f32x4){0.f, 0.f, 0.f, 0.f};
#pragma unroll
                for (int ks = 0; ks < 4; ++ks) { const bf16x8 cf = *(const LAS bf16x8*)(Cb + (vt * 16 + fr) * 136 + ks * 32 + fq * 8); a = __builtin_amdgcn_mfma_f32_16x16x32_bf16(cf, qf[ks], a, 0, 0, 0); }
                a = a * wi;
#pragma unroll
                for (int ks = 0; ks < 2; ++ks) { const bf16x8 vf = *(const LAS bf16x8*)(VT + TRB(vt * 16 + fr, ks * 4 + fq)); a = __builtin_amdgcn_mfma_f32_16x16x32_bf16(vf, pf[ks], a, 0, 0, 0); }
                a = a * dinv; hv[q] = a;
#pragma unroll
                for (int j = 0; j < 4; ++j) { s1 += a[j]; s2 += a[j] * a[j]; }
            }
            s1 += __shfl_xor(s1, 16); s1 += __shfl_xor(s1, 32); s2 += __shfl_xor(s2, 16); s2 += __shfl_xor(s2, 32);
            if (fq == 0) { lnx[s * 4 + vh * 2] = s1; lnx[s * 4 + vh * 2 + 1] = s2; }
            WG_BAR();
            const f32x4 l4 = *(const LAS f32x4*)(lnx + s * 4);
            const float mean = (l4[0] + l4[2]) * (1.f / 128.f), var = fmaxf((l4[1] + l4[3]) * (1.f / 128.f) - mean * mean, 0.f), rstd = rsqrtf(var + 1e-6f);
            const size_t tok = tokc + s;
#pragma unroll
            for (int q = 0; q < 4; ++q) {
                const int v0 = (vh * 4 + q) * 16 + fq * 4;
                const u32x2 og = ogp[q]; const f32x4 g4 = *(const LAS f32x4*)(MLN + v0);
                const float o0 = (hv[q][0] - mean) * rstd * g4[0] * fsigmoid(bflo(og.x)), o1 = (hv[q][1] - mean) * rstd * g4[1] * fsigmoid(bfhi(og.x));
                const float o2 = (hv[q][2] - mean) * rstd * g4[2] * fsigmoid(bflo(og.y)), o3 = (hv[q][3] - mean) * rstd * g4[3] * fsigmoid(bfhi(og.y));
                u32x2 w; w.x = cvt_pk_bf16(o0, o1); w.y = cvt_pk_bf16(o2, o3);
                *(u32x2*)(Yb + tok * DM + 512 + h * 128 + v0) = w;
            }
            if (c < 63) ML_PF_OG(c + 1);
        }
        WG_BAR();
        {
            const float dec = sc[0];
            bf16x8 vf[2];
#pragma unroll
            for (int ks = 0; ks < 2; ++ks) vf[ks] = *(const LAS bf16x8*)(VwT + TRB(wave * 16 + fr, ks * 4 + fq));
#pragma unroll
            for (int kt = 0; kt < 8; ++kt) {
                f32x4 a = Cacc[kt] * dec;
#pragma unroll
                for (int ks = 0; ks < 2; ++ks) { const bf16x8 kf = *(const LAS bf16x8*)(KT + TRB(kt * 16 + fr, ks * 4 + fq)); a = __builtin_amdgcn_mfma_f32_16x16x32_bf16(kf, vf[ks], a, 0, 0, 0); }
                Cacc[kt] = a;
                u32x2 w; w.x = cvt_pk_bf16(a[0], a[1]); w.y = cvt_pk_bf16(a[2], a[3]);
                *(LAS u32x2*)(Cb + (wave * 16 + fr) * 136 + kt * 16 + fq * 4) = w;
            }
            if (tid < 128) { float a = ns[tid] * dec;
                for (int l = 0; l < 64; ++l) a += gwl[l] * bf2f(Ks[l * 136 + tid]);
                ns[tid] = a; }
            mprev = sc[1];
        }
        WG_BAR();
    }
#undef ML_PF_QKV
#undef ML_PF_IF
#undef ML_PF_OG
}

struct SchedKV {
    const char* memb; const char* wk; const char* wv; int j;
    __device__ __forceinline__ bool next(int i, Unit& u) const {
        if (i != 0 || j < 0 || j >= 64) return false;
        const size_t ts = (size_t)256 * 1024 * 2;
        if (j < 32) { u.pm = j >> 2; u.pn = j & 3; u.A = memb + u.pm * ts; u.B = wk + u.pn * ts; u.tag = 0; }
        else { const int q = j - 32; u.pm = q >> 3; u.pn = q & 7; u.A = wv + u.pm * ts; u.B = memb + u.pn * ts; u.tag = 1; }
        u.nt = 16; return true;
    }
};
struct SchedMerge {
    const char* yb; const char* wup; int c;
    __device__ __forceinline__ bool next(int i, Unit& u) const {
        if (i >= 4) return false;
        const int T = c + 256 * (i >> 1), pass = i & 1; u.pm = T >> 2; u.pn = T & 3; u.tag = pass ? 3 : 1; u.nt = 8;
        const size_t ts = (size_t)256 * 1024 * 2;
        u.A = yb + u.pm * ts + pass * 1024; u.B = wup + u.pn * ts + pass * 1024;
        return true;
    }
};
struct SchedGate {
    const char* xb; const char* wg; int j0;
    __device__ __forceinline__ bool next(int i, Unit& u) const {
        const int j = j0 + 96 * i; if (j >= 1024) return false;
        u.pm = j >> 3; u.pn = j & 7; u.nt = 16; u.tag = 0;
        const size_t ts = (size_t)256 * 1024 * 2;
        u.A = xb + u.pm * ts; u.B = wg + u.pn * ts;
        return true;
    }
};
struct SchedAttn {
    const char* xb; const char* wq; const char* q; const char* p; const char* kb; const char* vt; int c;
    __device__ __forceinline__ bool next(int i, Unit& u) const {
        if (i >= 6) return false;
        const int pr = c + 256 * (i & 1), b = pr >> 6, h = (pr >> 4) & 3, qt = pr & 15, st = i >> 1;
        u.pm = b * 16 + qt; u.pn = h;
        const size_t ao = ((size_t)u.pm * 256 * 1024 + h * 256) * 2;
        if (st == 0) { u.A = xb + (size_t)u.pm * 256 * 1024 * 2; u.B = wq + (size_t)h * 256 * 1024 * 2; u.nt = 16; u.tag = 2; }
        else if (st == 1) { u.A = q + ao; u.B = kb + ((size_t)b * 256 * 1024 + h * 256) * 2; u.nt = 4; u.tag = 0; }
        else { u.A = p + ao; u.B = vt + (size_t)(b >> 2) * 2097152 + ((size_t)h * 256 * 1024 + (b & 3) * 256) * 2; u.nt = 4; u.tag = 1; }
        return true;
    }
};

#define XB_TMO      128
#define XB_XCNT(j)  (256  + 64 * (j))
#define XB_XSUB(j)  (1280 + 64 * (j))
#define XB_XGEN(j)  (2304 + 64 * (j))
#define XB_TOP      3328
#define XB_TOPGEN   3392
#define XCD_BAR_WORDS 3456
#define XB_SPIN_CAP (1u << 18)
__device__ __forceinline__ unsigned xb_ld(unsigned* p)              { return __hip_atomic_load(p, __ATOMIC_RELAXED, __HIP_MEMORY_SCOPE_AGENT); }
__device__ __forceinline__ unsigned xb_add(unsigned* p, unsigned v) { return __hip_atomic_fetch_add(p, v, __ATOMIC_RELAXED, __HIP_MEMORY_SCOPE_AGENT); }
__device__ __forceinline__ unsigned xb_xcc_id() { return (unsigned)__builtin_amdgcn_s_getreg((3 << 11) | 20) & 0xFu; }
#define XB_SPIN(cond, bar) do { unsigned _sp = 0; while (cond) { __builtin_amdgcn_s_sleep(1); \
    if ((++_sp & 255u) == 0u) { if (xb_ld(&(bar)[XB_TMO])) break; if (_sp > XB_SPIN_CAP) { atomicAdd(&(bar)[XB_TMO], 1u); break; } } } } while (0)
struct XcdBarrier { unsigned* bar; unsigned x; volatile LAS unsigned* st; };
__device__ __forceinline__ XcdBarrier xcd_barrier_post(unsigned* bar, volatile LAS unsigned* st) {
    XcdBarrier b; b.bar = bar; b.x = xb_xcc_id(); b.st = st;
    if (threadIdx.x == 0) (void)xb_add(&bar[XB_XCNT(b.x)], 1u);
    return b;
}
__device__ __forceinline__ void xcd_barrier_complete(unsigned* bar, unsigned x, unsigned& nloc, unsigned& nx) {
    const unsigned G = gridDim.x * gridDim.y * gridDim.z;
    unsigned sum, cnt, mine, sp = 0u;
    for (;;) {
        sum = 0u; cnt = 0u; mine = 0u;
#pragma unroll
        for (unsigned j = 0; j < 16; ++j) { const unsigned c = xb_ld(&bar[XB_XCNT(j)]); sum += c; cnt += (c > 0u) ? 1u : 0u; mine = (j == x) ? c : mine; }
        if (sum == G) break;
        __builtin_amdgcn_s_sleep(1);
        if ((++sp & 255u) == 0u) { if (xb_ld(&bar[XB_TMO])) break; if (sp > XB_SPIN_CAP) { atomicAdd(&bar[XB_TMO], 1u); break; } }
    }
    nloc = mine > 0u ? mine : 1u; nx = cnt > 0u ? cnt : 1u;
}
__device__ __forceinline__ void xcd_barrier(const XcdBarrier& b) {
    asm volatile("s_waitcnt vmcnt(0)" ::: "memory");
    __syncthreads();
    if (threadIdx.x == 0) {
        unsigned* bar = b.bar;
        __builtin_amdgcn_s_waitcnt(0);
        unsigned nloc = b.st[0], nx = b.st[1];
        if (nloc == 0u) { xcd_barrier_complete(bar, b.x, nloc, nx); b.st[0] = nloc; b.st[1] = nx; }
        const unsigned old = xb_add(&bar[XB_XSUB(b.x)], 1u);
        const unsigned gen = old / nloc;
        if (old + 1u == (gen + 1u) * nloc) {
            __builtin_amdgcn_fence(__ATOMIC_RELEASE, "agent");
            asm volatile("s_waitcnt vmcnt(0)" ::: "memory");
            const unsigned og = xb_add(&bar[XB_TOP], 1u);
            const unsigned tg = og / nx;
            if (og + 1u == (tg + 1u) * nx) xb_add(&bar[XB_TOPGEN], 1u);
            else XB_SPIN(xb_ld(&bar[XB_TOPGEN]) == tg, bar);
            __builtin_amdgcn_fence(__ATOMIC_ACQUIRE, "agent");
            xb_add(&bar[XB_XGEN(b.x)], 1u);
            asm volatile("s_waitcnt vmcnt(0)" ::: "memory");
        } else {
            XB_SPIN(xb_ld(&bar[XB_XGEN(b.x)]) == gen, bar);
            __builtin_amdgcn_fence(__ATOMIC_ACQUIRE, "agent");
            asm volatile("s_waitcnt vmcnt(0)" ::: "memory");
        }
    }
    __syncthreads();
}

__global__ void __launch_bounds__(512, 2) mega(Params P) {
    extern __shared__ __attribute__((aligned(16))) unsigned char smem[];
    LAS unsigned char* lds = (LAS unsigned char*)smem;
    unsigned char* ws = P.ws;
    const int G = gridDim.x, c = blockIdx.x, lo = P.ph_lo, hi = P.ph_hi;
    float* ssq0 = (float*)(ws + OFF_SSQ0); float* ssq1 = (float*)(ws + OFF_SSQ1); float* ssq2 = (float*)(ws + OFF_SSQ2); float* ssq3 = (float*)(ws + OFF_SSQ3); float* ssq4 = (float*)(ws + OFF_SSQ4);
    bf16_t* XB = (bf16_t*)(ws + OFF_XB); bf16_t* U = (bf16_t*)(ws + OFF_U);
#ifdef ONLY_PHASE
#define IN(k) ((k) == ONLY_PHASE && lo <= (k) && (k) < hi)
#else
#define IN(k) (lo <= (k) && (k) < hi)
#endif
    volatile LAS unsigned* bst = (volatile LAS unsigned*)(lds + 163776);
    if (threadIdx.x < 2) bst[threadIdx.x] = 0u;
    __syncthreads();
    XcdBarrier xbar; xbar.bar = (unsigned*)(ws + OFF_BARW); xbar.x = 0; xbar.st = bst;
    if (P.coop) xbar = xcd_barrier_post((unsigned*)(ws + OFF_BARW), bst);
    if (P.ph_hi > NPHASE) cg::this_grid().sync();
#define SEAM(k) do { if (P.coop && IN(k) && IN((k) + 1)) xcd_barrier(xbar); } while (0)
    const size_t TS1 = (size_t)256 * 1024 * 2, TSF = (size_t)256 * DFF * 2;

    if (IN(0)) { phase_prep(P, lds); }
    SEAM(0);
    if (IN(1)) {
        SchedStatic S{(const char*)XB, (const char*)(ws + OFF_WGU1), TS1, 128, 22, 16, G, c}; EpiSwiglu E{U, ssq0};
        gemm_phase(lds, 1024, S, E);
    }
    SEAM(1);
    if (IN(2)) {
        SchedStatic S{(const char*)U, (const char*)(ws + OFF_WD1), TSF, 128, 4, 44, G, c}; EpiResidX<1> E{P.in[0], nullptr, XB, ssq1, 0.5f};
        gemm_phase(lds, DFF, S, E);
    }
    SEAM(2);
    if (IN(3)) {
        SchedStatic S{(const char*)XB, (const char*)(ws + OFF_WIN), TS1, 128, 16, 16, G, c}; EpiRowScale<0> E{(bf16_t*)(ws + OFF_Z), ssq1, (float*)(ws + OFF_IF)};
        gemm_phase(lds, 1024, S, E);
    }
    SEAM(3);
    if (IN(4)) {
        if (c < 128) rwkv_item(P, lds, c);
        else if (c < 160) mlstm_item(P, lds, c - 128);
        else {
            if (c < 224) { SchedKV S{(const char*)(ws + OFF_MEMB), (const char*)(ws + OFF_WK), (const char*)(ws + OFF_WV), c - 160}; EpiKV E{(bf16_t*)(ws + OFF_KB), (bf16_t*)(ws + OFF_VT), (const float*)(ws + OFF_SSQM)};
                gemm_phase(lds, 1024, S, E); }
            {
                SchedGate S{(const char*)XB, (const char*)(ws + OFF_WG), c - 160}; EpiGate E{(bf16_t*)P.out, (bf16_t*)P.out + (size_t)NTOK * DM, ssq1};
                gemm_phase(lds, 1024, S, E); }
            const int wv_ = threadIdx.x >> 6, ln_ = threadIdx.x & 63; LAS float* scr = (LAS float*)(lds + wv_ * 16384);
            for (int it = P.nearly + (c - 160) * 8 + wv_; it < P.nitems; it += 96 * 8) {
                int j = 0;
                while (j + 1 < P.njobs && it >= P.jobs[j + 1].item0) ++j;
                transpose_item(P.jobs[j], it - P.jobs[j].item0, scr, ln_);
            }
        }
    }
    SEAM(4);
    if (IN(5)) {
        SchedMerge S{(const char*)(ws + OFF_Y), (const char*)(ws + OFF_WUP), c};
        EpiMerge2 E{(u32x4*)(ws + OFF_SCRS) + (size_t)c * 8192, (bf16_t*)(ws + OFF_MG), (const bf16_t*)P.out, (const bf16_t*)P.out + (size_t)NTOK * DM};
        if (c < 256) gemm_phase(lds, 1024, S, E);
    }
    SEAM(5);
    if (IN(6)) {
        SchedStatic S{(const char*)(ws + OFF_MG), (const char*)(ws + OFF_WOUT), TS1, 128, 4, 16, G, c}; EpiResidX<2> E{nullptr, P.out, XB, ssq2, 1.0f};
        gemm_phase(lds, 1024, S, E);
    }
    SEAM(6);
    if (IN(8)) {
        SchedAttn S{(const char*)XB, (const char*)(ws + OFF_WQ), (const char*)(ws + OFF_Q), (const char*)(ws + OFF_P), (const char*)(ws + OFF_KB), (const char*)(ws + OFF_VT), c};
        EpiAttn E{(bf16_t*)(ws + OFF_P), (bf16_t*)(ws + OFF_O), (bf16_t*)(ws + OFF_Q), ssq2};
        if (c < 256) gemm_phase(lds, 1024, S, E);
    }
    SEAM(8);
    if (IN(9)) {
        SchedStatic S{(const char*)(ws + OFF_O), (const char*)(ws + OFF_WO), TS1, 128, 4, 16, G, c}; EpiResid<true> E{P.out, P.out, XB, ssq3, 1.0f};
        gemm_phase(lds, 1024, S, E);
    }
    SEAM(9);
    if (IN(10)) {
        SchedStatic S{(const char*)XB, (const char*)(ws + OFF_WGU2), TS1, 128, 22, 16, G, c}; EpiSwiglu E{U, ssq3};
        gemm_phase(lds, 1024, S, E);
    }
    SEAM(10);
    if (IN(11)) {
        SchedStatic S{(const char*)U, (const char*)(ws + OFF_WD2), TSF, 128, 4, 44, G, c}; EpiResid<false> E{P.out, P.out, nullptr, ssq4, 0.5f};
        gemm_phase(lds, DFF, S, E);
    }
    SEAM(11);
    if (IN(12)) {
        const int lane = threadIdx.x & 63, gw = c * 8 + (threadIdx.x >> 6), NGW = G * 8; const float* fn = P.in[36];
        f32x4 g4[4];
#pragma unroll
        for (int j = 0; j < 4; ++j) g4[j] = *((const f32x4*)fn + lane + 64 * j);
        for (int m = gw * 4; m < NTOK; m += NGW * 4) {
            f32x4 v[4][4]; float rs[4];
#pragma unroll
            for (int r = 0; r < 4; ++r) { rs[r] = rsqrtf(ssq4[m + r] * (1.f / 1024.f) + NORM_EPS);
#pragma unroll
                for (int j = 0; j < 4; ++j) v[r][j] = ((const f32x4*)(P.out + (size_t)(m + r) * DM) + lane)[64 * j]; }
#pragma unroll
            for (int r = 0; r < 4; ++r)
#pragma unroll
                for (int j = 0; j < 4; ++j) ((f32x4*)(P.out + (size_t)(m + r) * DM) + lane)[64 * j] = v[r][j] * rs[r] * g4[j];
        }
    }
#undef IN
#undef SEAM
}

#ifdef MK_DBG_DUMP
__global__ void dbg_dump(const bf16_t* src, int ld, int mode, float* out) {
    const size_t i = (size_t)blockIdx.x * 256 + threadIdx.x; const size_t r = i >> 10; const int c = (int)(i & 1023);
    float v = bf2f(src[r * ld + c]);
    if (mode == 1) v += 2.f * bf2f(src[r * ld + c + 1024]) + 3.f * bf2f(src[r * ld + c + 2048]) + 5.f * bf2f(src[r * ld + c + 2816]);
    if (mode == 4) v = ((const float*)src)[i & 262143];
    if (mode == 2 && c >= 512) v = 0.f;
    if (mode == 3 && c < 512) v = 0.f;
    out[i] = v;
}
#endif
static void add_job(Params& p, const float* src, const float* gain, size_t dst_off, int K, int ldsrc, int col0, int ncols, int dst_ld, int dst_row0, int dst_k0, int mode, float scale) {
    TJob& j = p.jobs[p.njobs++]; j.src = src; j.gain = gain; j.dst = (bf16_t*)(p.ws + dst_off); j.K = K; j.ldsrc = ldsrc; j.col0 = col0; j.ncols = ncols; j.dst_ld = dst_ld; j.dst_row0 = dst_row0; j.dst_k0 = dst_k0;
    j.mode = mode; j.scale = scale; j.item0 = p.nitems; p.nitems += (K / 64) * ((ncols + 31) / 32);
}
extern "C" void kernel_launch(void* const* d_in, const int* in_sizes, int n_in, void* d_out, int out_size, void* d_ws, size_t ws_size, hipStream_t stream) {
    static int ready = 0;
    if (ready == 0) {
        if (n_in != 37 || out_size != NTOK * DM || ws_size < WS_END) { fprintf(stderr, "kernel_launch: unexpected shapes: n_in %d out %d ws %zu (need %zu); nothing launched\n", n_in, out_size, ws_size, (size_t)WS_END); ready = -1; return; }
        if (hipFuncSetAttribute((const void*)mega, hipFuncAttributeMaxDynamicSharedMemorySize, LDS_BYTES) != hipSuccess) { fprintf(stderr, "kernel_launch: hipFuncSetAttribute failed\n"); ready = -1; return; }
        int per_cu = 0; (void)hipOccupancyMaxActiveBlocksPerMultiprocessor(&per_cu, (const void*)mega, 512, LDS_BYTES); (void)hipGetLastError();
        if (per_cu < 1) fprintf(stderr, "kernel_launch: note: occupancy query says %d blocks per CU\n", per_cu);
        ready = 1;
    }
    if (ready < 0) return;
    Params p; memset(&p, 0, sizeof(p));
    for (int i = 0; i < 37; ++i) p.in[i] = (const float*)d_in[i];
    p.out = (float*)d_out; p.ws = (unsigned char*)d_ws;
    const float* const* in = p.in;
    add_job(p, in[3], in[2], OFF_WGU1, 1024, DFF, 0, DFF, 1024, 0, 0, 1, 1.f);
    add_job(p, in[4], in[2], OFF_WGU1, 1024, DFF, 0, DFF, 1024, 128, 0, 1, 1.f);
    add_job(p, in[5], nullptr, OFF_WD1, DFF, 1024, 0, 1024, DFF, 0, 0, 0, 1.f);
    add_job(p, in[7], in[6], OFF_WIN, 1024, 5896, 0, 3848, 1024, 0, 0, 0, 1.f);
    add_job(p, in[30], in[28], OFF_WK, 1024, 2048, 0, 1024, 1024, 0, 0, 0, 1.f);
    add_job(p, in[30], in[28], OFF_WV, 1024, 2048, 1024, 1024, 1024, 0, 0, 0, 1.f);
    add_job(p, in[10], nullptr, OFF_W2T, 64, 512, 0, 512, 64, 0, 0, 0, 1.f);
    add_job(p, in[12], nullptr, OFF_A2T, 64, 512, 0, 512, 64, 0, 0, 0, 1.f);
    add_job(p, in[13], nullptr, OFF_G2T, 128, 512, 0, 512, 128, 0, 0, 0, 1.f);
    add_job(p, in[7], in[6], OFF_WG, 1024, 5896, 3848, 2048, 1024, 0, 0, 0, 1.f);
    p.nearly = p.nitems;
    add_job(p, in[24], nullptr, OFF_WUP, 512, 1024, 0, 1024, 1024, 0, 0, 0, 1.f);
    add_job(p, in[25], nullptr, OFF_WUP, 512, 1024, 0, 1024, 1024, 0, 512, 0, 1.f);
    add_job(p, in[26], nullptr, OFF_WOUT, 1024, 1024, 0, 1024, 1024, 0, 0, 0, 1.f);
    add_job(p, in[29], in[27], OFF_WQ, 1024, 1024, 0, 1024, 1024, 0, 0, 0, 0.0625f);
    add_job(p, in[31], nullptr, OFF_WO, 1024, 1024, 0, 1024, 1024, 0, 0, 0, 1.f);
    add_job(p, in[33], in[32], OFF_WGU2, 1024, DFF, 0, DFF, 1024, 0, 0, 1, 1.f);
    add_job(p, in[34], in[32], OFF_WGU2, 1024, DFF, 0, DFF, 1024, 128, 0, 1, 1.f);
    add_job(p, in[35], nullptr, OFF_WD2, DFF, 1024, 0, 1024, DFF, 0, 0, 0, 1.f);
    const int grid = 256;
#if MK_PER_PHASE
    p.coop = 0;
    for (int ph = 0; ph < MK_DBG_HI; ++ph) { p.ph_lo = ph; p.ph_hi = ph + 1; hipLaunchKernelGGL(mega, dim3(grid), dim3(512), LDS_BYTES, stream, p); }
#ifdef MK_DBG_DUMP
    hipLaunchKernelGGL(dbg_dump, dim3(NTOK * 4), dim3(256), 0, stream, (const bf16_t*)(p.ws + MK_DBG_DUMP), MK_DBG_LD, MK_DBG_MODE, p.out);
#endif
#else
    p.coop = 1; p.ph_lo = 0; p.ph_hi = NPHASE;
    if (hipMemsetAsync((char*)d_ws + OFF_BARW, 0, XCD_BAR_WORDS * 4, stream) != hipSuccess) { fprintf(stderr, "kernel_launch: hipMemsetAsync failed\n"); return; }
    void* args[] = {&p};
    hipError_t e = hipLaunchCooperativeKernel((const void*)mega, dim3(grid), dim3(512), args, LDS_BYTES, stream);
    if (e != hipSuccess) fprintf(stderr, "kernel_launch: cooperative launch failed: %s\n", hipGetErrorString(e));
#endif
}
```

```cpp
#include <hip/hip_runtime.h>
#include <hip/hip_cooperative_groups.h>
#include <cstdio>
#include <cstdint>
#include <cstring>
namespace cg = cooperative_groups;

#define LAS __attribute__((address_space(3)))
typedef unsigned short bf16_t;
typedef short bf16x8 __attribute__((ext_vector_type(8)));
typedef float f32x4 __attribute__((ext_vector_type(4)));
typedef float f32x2 __attribute__((ext_vector_type(2)));
typedef unsigned u32x4 __attribute__((ext_vector_type(4)));
typedef unsigned u32x2 __attribute__((ext_vector_type(2)));

#ifndef MK_DBG_HI
#define MK_DBG_HI 13
#endif
#ifndef MK_PER_PHASE
#define MK_PER_PHASE 0
#endif

constexpr int NTOK = 32768, DM = 1024, SEQ = 4096, NB = 8, DFF = 2816, MEMTOK = 2048;
constexpr int ZLD = 3840;
constexpr float NORM_EPS = 1e-5f;
constexpr int NPHASE = 13;
constexpr int LDS_BYTES = 160 * 1024;
constexpr int XCH_OFF = 131072;

constexpr size_t MiB = 1048576;
constexpr size_t OFF_SSQ0 = 0, OFF_SSQ1 = 131072, OFF_SSQ2 = 262144, OFF_SSQ3 = 393216, OFF_SSQ4 = 524288, OFF_SSQM = 655360;
constexpr size_t OFF_IF = 1 * MiB;
constexpr size_t OFF_GATES = 2 * MiB;
constexpr size_t OFF_BARW = 720896;
constexpr size_t OFF_STATS = 444 * MiB;
constexpr size_t OFF_W = 4 * MiB;
constexpr size_t SZ_WGU = (size_t)5632 * 1024 * 2, SZ_WD = (size_t)1024 * 2816 * 2, SZ_WIN = (size_t)4096 * 1024 * 2, SZ_WG = (size_t)2048 * 1024 * 2, SZ_SQ = (size_t)1024 * 1024 * 2;
constexpr size_t OFF_WGU1 = OFF_W, OFF_WD1 = OFF_WGU1 + SZ_WGU, OFF_WIN = OFF_WD1 + SZ_WD, OFF_WG = OFF_WIN + SZ_WIN, OFF_WUP = OFF_WG + SZ_WG, OFF_WOUT = OFF_WUP + SZ_SQ,
                 OFF_WQ = OFF_WOUT + SZ_SQ, OFF_WK = OFF_WQ + SZ_SQ, OFF_WV = OFF_WK + SZ_SQ, OFF_WO = OFF_WV + SZ_SQ, OFF_WGU2 = OFF_WO + SZ_SQ, OFF_WD2 = OFF_WGU2 + SZ_WGU,
                 OFF_W2T = OFF_WD2 + SZ_WD, OFF_A2T = OFF_W2T + 65536, OFF_G2T = OFF_A2T + 65536, OFF_WEND = OFF_G2T + 131072;
static_assert(OFF_WEND <= 64 * MiB, "weights");
constexpr size_t OFF_XB = 64 * MiB, OFF_Y = 128 * MiB, OFF_MEMB = 192 * MiB, OFF_KB = 196 * MiB, OFF_VT = 200 * MiB, OFF_BIG = 204 * MiB, WS_END = 460 * MiB;
constexpr size_t OFF_U = OFF_BIG, OFF_Z = OFF_BIG, OFF_SCRS = OFF_BIG, OFF_SCRM = OFF_BIG + 32 * MiB, OFF_MG = OFF_BIG + 96 * MiB, OFF_Q = OFF_BIG, OFF_P = OFF_BIG + 64 * MiB, OFF_O = OFF_BIG + 128 * MiB;

typedef __bf16 bf16x2_t __attribute__((ext_vector_type(2)));
__device__ __forceinline__ unsigned cvt_pk_bf16(float lo, float hi) { f32x2 v = {lo, hi}; bf16x2_t b = __builtin_convertvector(v, bf16x2_t); return __builtin_bit_cast(unsigned, b); }
__device__ __forceinline__ float bflo(unsigned u) { return __builtin_bit_cast(float, u << 16); }
__device__ __forceinline__ float bfhi(unsigned u) { return __builtin_bit_cast(float, u & 0xffff0000u); }
__device__ __forceinline__ float bf2f(bf16_t b) { return __builtin_bit_cast(float, (unsigned)b << 16); }
__device__ __forceinline__ bf16_t f2bf(float f) { return (bf16_t)(cvt_pk_bf16(f, 0.f) & 0xffffu); }
__device__ __forceinline__ float fsigmoid(float x) { return __builtin_amdgcn_rcpf(1.f + __expf(-x)); }
__device__ __forceinline__ float wave_sum(float v) {
#pragma unroll
    for (int o = 1; o < 64; o <<= 1) v += __shfl_xor(v, o);
    return v;
}
template <int CTRL> __device__ __forceinline__ float dpp_f(float x) { return __builtin_bit_cast(float, __builtin_amdgcn_update_dpp(0, __builtin_bit_cast(int, x), CTRL, 0xF, 0xF, true)); }
__device__ __forceinline__ float red8(float x) {
    x += dpp_f<0xB1>(x); x += dpp_f<0x4E>(x); x += dpp_f<0x141>(x); return x;
}
#define LDS_WAIT() asm volatile("s_waitcnt lgkmcnt(0)" ::: "memory")
#define WG_BAR() do { asm volatile("s_waitcnt lgkmcnt(0)" ::: "memory"); __builtin_amdgcn_s_barrier(); asm volatile("" ::: "memory"); } while (0)
#define WG_BAR_ALL() do { asm volatile("s_waitcnt vmcnt(0) lgkmcnt(0)" ::: "memory"); __builtin_amdgcn_s_barrier(); asm volatile("" ::: "memory"); } while (0)

constexpr int BM = 256, BK = 64, HALF = 128, HTB = HALF * BK * 2;
__host__ __device__ __forceinline__ int lds_byte(int r, int c) { const int st = (r >> 4) * 2 + (c >> 5), rr = r & 15, cc = c & 31, ob = rr * 64 + cc * 2; return st * 1024 + (ob ^ (((ob >> 9) & 1) << 5)); }
__host__ __device__ __forceinline__ void stage_rc(int b, int& R, int& C) { const int st = b / 1024, sb = b % 1024, swz = sb ^ (((sb >> 9) & 1) << 5); R = (st >> 1) * 16 + swz / 64; C = (st & 1) * 32 + (swz % 64) / 2; }
__host__ __device__ __forceinline__ int perm32(int rho) { const int n = rho >> 4, i = rho & 15; return 8 * (i >> 2) + 4 * n + (i & 3); }

struct Unit { const char* A; const char* B; int nt, pm, pn, tag; };

__device__ __forceinline__ void tile_of(int L, int nM, int nN, int& pm, int& pn) {
    const int nwg = nM * nN; int wgid = L;
    { const int q = nwg / 8, r = nwg % 8, xcd = wgid % 8, off = wgid / 8; wgid = (xcd < r ? xcd * (q + 1) : r * (q + 1) + (xcd - r) * q) + off; }
    const int nig = 8 * nN, gid = wgid / nig, fm = gid * 8, gsz = (nM - fm) < 8 ? (nM - fm) : 8;
    pm = fm + ((wgid % nig) % gsz); pn = (wgid % nig) / gsz;
}
struct SchedStatic {
    const char* A; const char* B; size_t tstep; int nM, nN, nt, G, c;
    __device__ __forceinline__ bool next(int i, Unit& u) const {
        const long L = (long)i * G + c; if (L >= (long)nM * nN) return false;
        int pm, pn; tile_of((int)L, nM, nN, pm, pn);
        u.A = A + (size_t)pm * tstep; u.B = B + (size_t)pn * tstep; u.nt = nt; u.pm = pm; u.pn = pn; u.tag = 0; return true;
    }
};

template <class Epi, class Sched>
__device__ __forceinline__ void gemm_phase(LAS unsigned char* lds, const int ld, const Sched& S, const Epi& E) {
    const int tid = threadIdx.x, wid = __builtin_amdgcn_readfirstlane(tid >> 6), lane = tid & 63, wr = wid >> 2, wc = wid & 3, fr = lane & 15, fq = lane >> 4;
    unsigned voffA[2], voffB[2];
#pragma unroll
    for (int i = 0; i < 2; ++i) { int R, C; stage_rc(tid * 16 + i * 8192, R, C); const int Rb = (R & ~31) + perm32(R & 31);
        voffA[i] = (unsigned)(R * ld + C) * 2u; voffB[i] = (unsigned)(Rb * ld + C) * 2u; }
    const size_t kstep = (size_t)(BK * 2);
    const size_t hstep = (size_t)HALF * ld * 2;
    const unsigned ldsw = (unsigned)wid * 1024u;
    const int aoff = lds_byte(wr * 64 + fr, fq * 8), boff = lds_byte(wc * 32 + fr, fq * 8);
#define PG8_SA(b, h) (((b) * 2 + (h)) * HTB)
#define PG8_SB(b, h) ((4 + (b) * 2 + (h)) * HTB)
#define PG8_STAGE(bufoff, gbase, voff) do { _Pragma("unroll") for (int _i = 0; _i < 2; ++_i) \
        __builtin_amdgcn_global_load_lds((const unsigned*)((const char*)(gbase) + (voff)[_i]), (LAS unsigned*)(lds + (bufoff) + ldsw + _i * 8192), 16, 0, 0); } while (0)
#define PG8_LDA(dst, b, h) do { _Pragma("unroll") for (int m = 0; m < 4; ++m) _Pragma("unroll") for (int k = 0; k < 2; ++k) dst[m][k] = *(const LAS bf16x8*)(lds + PG8_SA(b, h) + aoff + m * 2048 + k * 1024); } while (0)
#define PG8_LDB(dst, b, h) do { _Pragma("unroll") for (int n = 0; n < 2; ++n) _Pragma("unroll") for (int k = 0; k < 2; ++k) dst[n][k] = *(const LAS bf16x8*)(lds + PG8_SB(b, h) + boff + n * 2048 + k * 1024); } while (0)
#define PG8_MMA(ai, bj, At, Bt) do { __builtin_amdgcn_s_setprio(1); _Pragma("unroll") for (int m = 0; m < 4; ++m) _Pragma("unroll") for (int n = 0; n < 2; ++n) _Pragma("unroll") for (int k = 0; k < 2; ++k) \
        acc[ai][bj][m][n] = __builtin_amdgcn_mfma_f32_16x16x32_bf16(Bt[n][k], At[m][k], acc[ai][bj][m][n], 0, 0, 0); __builtin_amdgcn_s_setprio(0); } while (0)
#define PG8_WAIT_V(n) asm volatile("s_waitcnt vmcnt(" #n ")" ::: "memory")
#define PG8_WAIT_L(n) asm volatile("s_waitcnt lgkmcnt(" #n ")" ::: "memory")
#define PG8_BAR __builtin_amdgcn_s_barrier()
#define PG8_SCHED __builtin_amdgcn_sched_barrier(0)
    Unit cur, nxt; int ui = 0;
    if (!S.next(0, cur)) return;
    f32x4 acc[2][2][4][2];
#pragma unroll
    for (int a = 0; a < 2; ++a)
#pragma unroll
        for (int b = 0; b < 2; ++b)
#pragma unroll
            for (int m = 0; m < 4; ++m)
#pragma unroll
                for (int n = 0; n < 2; ++n) acc[a][b][m][n] = (f32x4){0.f, 0.f, 0.f, 0.f};
    bf16x8 At[4][2], B0[2][2], B1[2][2];
    const char* cA = cur.A; const char* cB = cur.B; int nt = cur.nt; asm volatile("" : "+s"(nt));
    PG8_STAGE(PG8_SB(0, 0), cB, voffB); PG8_STAGE(PG8_SB(0, 1), cB + hstep, voffB); PG8_STAGE(PG8_SA(0, 0), cA, voffA); PG8_STAGE(PG8_SA(0, 1), cA + hstep, voffA);
    if (wr == 1) PG8_BAR;
    PG8_WAIT_V(2); PG8_BAR;
    PG8_STAGE(PG8_SB(1, 0), cB + kstep, voffB); PG8_STAGE(PG8_SA(1, 0), cA + kstep, voffA); PG8_STAGE(PG8_SB(1, 1), cB + hstep + kstep, voffB);
    PG8_WAIT_V(6); PG8_BAR;
#pragma unroll 1
    for (;;) {
        asm volatile("" : "+s"(ui));
        const bool has_next = S.next(ui + 1, nxt);
        const char* nA = has_next ? nxt.A : cA; const char* nB = has_next ? nxt.B : cB;
#pragma unroll 1
        for (int t = 0; t < nt; t += 2) {
            const bool last = (t == nt - 2);
            const char* a1 = cA + (size_t)(t + 1) * kstep;
            const char* a2 = last ? nA : cA + (size_t)(t + 2) * kstep; const char* b2 = last ? nB : cB + (size_t)(t + 2) * kstep;
            const char* a3 = a2 + kstep; const char* b3 = b2 + kstep;
            PG8_LDB(B0, 0, 0); PG8_LDB(B1, 0, 1); PG8_SCHED; PG8_LDA(At, 0, 0); PG8_STAGE(PG8_SA(1, 1), a1 + hstep, voffA);
            PG8_WAIT_V(8); PG8_WAIT_L(0); PG8_BAR; PG8_MMA(0, 0, At, B0); PG8_MMA(0, 1, At, B1); PG8_BAR; PG8_SCHED;
            PG8_LDA(At, 0, 1); PG8_STAGE(PG8_SB(0, 0), b2, voffB); PG8_STAGE(PG8_SB(0, 1), b2 + hstep, voffB); PG8_STAGE(PG8_SA(0, 0), a2, voffA);
            PG8_WAIT_V(8); PG8_WAIT_L(0); PG8_BAR; PG8_MMA(1, 0, At, B0); PG8_MMA(1, 1, At, B1); PG8_BAR; PG8_SCHED;
            PG8_LDB(B0, 1, 0); PG8_LDB(B1, 1, 1); PG8_SCHED; PG8_LDA(At, 1, 0); PG8_STAGE(PG8_SA(0, 1), a2 + hstep, voffA);
            PG8_WAIT_V(8); PG8_WAIT_L(0); PG8_BAR; PG8_MMA(0, 0, At, B0); PG8_MMA(0, 1, At, B1); PG8_BAR; PG8_SCHED;
            PG8_LDA(At, 1, 1); PG8_STAGE(PG8_SB(1, 0), b3, voffB); PG8_STAGE(PG8_SB(1, 1), b3 + hstep, voffB); PG8_STAGE(PG8_SA(1, 0), a3, voffA);
            PG8_WAIT_V(8); PG8_WAIT_L(0); PG8_BAR; PG8_MMA(1, 0, At, B0); PG8_MMA(1, 1, At, B1); PG8_BAR; PG8_SCHED;
        }
        if (wr == 0) PG8_BAR;
        E(acc, cur, wr, wc, fr, fq, lds);
        if (!has_next) break;
#pragma unroll
        for (int a = 0; a < 2; ++a)
#pragma unroll
            for (int b = 0; b < 2; ++b)
#pragma unroll
                for (int m = 0; m < 4; ++m)
#pragma unroll
                    for (int n = 0; n < 2; ++n) acc[a][b][m][n] = (f32x4){0.f, 0.f, 0.f, 0.f};
        cur = nxt; cA = nA; cB = nB; nt = cur.nt; asm volatile("" : "+s"(nt)); ++ui;
        if (wr == 1) PG8_BAR;
    }
    PG8_WAIT_V(0);
    PG8_BAR;
#undef PG8_SA
#undef PG8_SB
#undef PG8_STAGE
#undef PG8_LDA
#undef PG8_LDB
#undef PG8_MMA
#undef PG8_WAIT_V
#undef PG8_WAIT_L
#undef PG8_BAR
#undef PG8_SCHED
}

typedef f32x4 (&AccRef)[2][2][4][2];
#define EPI_ROWS_BEGIN _Pragma("unroll") for (int ai = 0; ai < 2; ++ai) _Pragma("unroll") for (int m = 0; m < 4; ++m) { const int rl = ai * 128 + wr * 64 + m * 16 + fr;
#define EPI_ROWS_END }

struct EpiSwiglu {
    bf16_t* U; const float* ssq;
    __device__ __forceinline__ void operator()(AccRef acc, const Unit& u, int wr, int wc, int fr, int fq, LAS unsigned char*) const {
        EPI_ROWS_BEGIN
            const int row = u.pm * 256 + rl; const float rs = rsqrtf(ssq[row] * (1.f / 1024.f) + NORM_EPS);
            float o[8];
#pragma unroll
            for (int n = 0; n < 2; ++n)
#pragma unroll
                for (int j = 0; j < 4; ++j) { const float g = acc[ai][0][m][n][j] * rs, up = acc[ai][1][m][n][j] * rs; o[n * 4 + j] = g * fsigmoid(g) * up; }
            u32x4 w; w.x = cvt_pk_bf16(o[0], o[1]); w.y = cvt_pk_bf16(o[2], o[3]); w.z = cvt_pk_bf16(o[4], o[5]); w.w = cvt_pk_bf16(o[6], o[7]);
            *(u32x4*)(U + (size_t)row * DFF + u.pn * 128 + wc * 32 + fq * 8) = w;
        EPI_ROWS_END
    }
};
template <bool WB> struct EpiResid {
    const float* xin; float* xout; bf16_t* xb; float* ssq; float scale;
    __device__ __forceinline__ void operator()(AccRef acc, const Unit& u, int wr, int wc, int fr, int fq, LAS unsigned char*) const {
        EPI_ROWS_BEGIN
            const int row = u.pm * 256 + rl; float ss = 0.f;
#pragma unroll
            for (int bj = 0; bj < 2; ++bj) {
                const size_t o = (size_t)row * DM + u.pn * 256 + bj * 128 + wc * 32 + fq * 8;
                f32x4 v0 = *(const f32x4*)(xin + o), v1 = *(const f32x4*)(xin + o + 4);
                v0 = v0 + acc[ai][bj][m][0] * scale; v1 = v1 + acc[ai][bj][m][1] * scale;
                *(f32x4*)(xout + o) = v0; *(f32x4*)(xout + o + 4) = v1;
                ss += v0[0] * v0[0] + v0[1] * v0[1] + v0[2] * v0[2] + v0[3] * v0[3] + v1[0] * v1[0] + v1[1] * v1[1] + v1[2] * v1[2] + v1[3] * v1[3];
                if (WB) { u32x4 w; w.x = cvt_pk_bf16(v0[0], v0[1]); w.y = cvt_pk_bf16(v0[2], v0[3]); w.z = cvt_pk_bf16(v1[0], v1[1]); w.w = cvt_pk_bf16(v1[2], v1[3]); *(u32x4*)(xb + o) = w; }
            }
            ss += __shfl_xor(ss, 16); ss += __shfl_xor(ss, 32);
            if (fq == 0) atomicAdd(ssq + row, ss);
        EPI_ROWS_END
    }
};
template <int MODE> struct EpiResidX {
    static constexpr bool ALIGN = true;
    const float* xin; float* xout; bf16_t* xb; float* ssq; float scale;
    __device__ __forceinline__ void operator()(AccRef acc, const Unit& u, int wr, int wc, int fr, int fq, LAS unsigned char*) const {
        EPI_ROWS_BEGIN
            const int row = u.pm * 256 + rl; float ss = 0.f;
#pragma unroll
            for (int bj = 0; bj < 2; ++bj) {
                const size_t o = (size_t)row * DM + u.pn * 256 + bj * 128 + wc * 32 + fq * 8;
                f32x4 v0, v1;
                if (MODE == 1) { v0 = *(const f32x4*)(xin + o); v1 = *(const f32x4*)(xin + o + 4); }
                else { const u32x4 xr = *(const u32x4*)(xb + o); v0 = (f32x4){bflo(xr.x), bfhi(xr.x), bflo(xr.y), bfhi(xr.y)}; v1 = (f32x4){bflo(xr.z), bfhi(xr.z), bflo(xr.w), bfhi(xr.w)}; }
                v0 = v0 + acc[ai][bj][m][0] * scale; v1 = v1 + acc[ai][bj][m][1] * scale;
                if (MODE == 2) { *(f32x4*)(xout + o) = v0; *(f32x4*)(xout + o + 4) = v1; }
                ss += v0[0] * v0[0] + v0[1] * v0[1] + v0[2] * v0[2] + v0[3] * v0[3] + v1[0] * v1[0] + v1[1] * v1[1] + v1[2] * v1[2] + v1[3] * v1[3];
                u32x4 w; w.x = cvt_pk_bf16(v0[0], v0[1]); w.y = cvt_pk_bf16(v0[2], v0[3]); w.z = cvt_pk_bf16(v1[0], v1[1]); w.w = cvt_pk_bf16(v1[2], v1[3]); *(u32x4*)(xb + o) = w;
            }
            ss += __shfl_xor(ss, 16); ss += __shfl_xor(ss, 32);
            if (fq == 0) atomicAdd(ssq + row, ss);
        EPI_ROWS_END
    }
};
struct EpiGate {
    static constexpr bool ALIGN = true;
    bf16_t* SA; bf16_t* SB; const float* ssq;
    __device__ __forceinline__ void operator()(AccRef acc, const Unit& u, int wr, int wc, int fr, int fq, LAS unsigned char*) const {
        bf16_t* base = (u.pn < 4 ? SA : SB) + (u.pn & 3) * 256 + wc * 32 + fq * 8;
        EPI_ROWS_BEGIN
            const int row = u.pm * 256 + rl; const float rs = rsqrtf(ssq[row] * (1.f / 1024.f) + NORM_EPS);
#pragma unroll
            for (int bj = 0; bj < 2; ++bj) { const f32x4 a0 = acc[ai][bj][m][0], a1 = acc[ai][bj][m][1];
                u32x4 w; w.x = cvt_pk_bf16(a0[0] * rs, a0[1] * rs); w.y = cvt_pk_bf16(a0[2] * rs, a0[3] * rs);
                w.z = cvt_pk_bf16(a1[0] * rs, a1[1] * rs); w.w = cvt_pk_bf16(a1[2] * rs, a1[3] * rs);
                *(u32x4*)(base + (size_t)row * DM + bj * 128) = w; }
        EPI_ROWS_END
    }
};
struct EpiMerge2 {
    static constexpr bool ALIGN = true;
    u32x4* scrM; bf16_t* MG; const bf16_t* SA; const bf16_t* SB;
    __device__ __forceinline__ void operator()(AccRef acc, const Unit& u, int wr, int wc, int fr, int fq, LAS unsigned char*) const {
        char* sM = (char*)scrM + (threadIdx.x >> 6) * 16384u + (threadIdx.x & 63) * 16u; asm volatile("" : "+v"(sM));
        const bf16_t* G = (u.tag == 1 ? SA : SB);
        EPI_ROWS_BEGIN
            const int row = u.pm * 256 + rl;
#pragma unroll
            for (int bj = 0; bj < 2; ++bj) {
                const int i = (ai * 4 + m) * 2 + bj; const f32x4 a0 = acc[ai][bj][m][0], a1 = acc[ai][bj][m][1];
                const size_t o = (size_t)row * DM + u.pn * 256 + bj * 128 + wc * 32 + fq * 8;
                const u32x4 sg = *(const u32x4*)(G + o);
                f32x4 m0 = (f32x4){fsigmoid(bflo(sg.x)) * a0[0], fsigmoid(bfhi(sg.x)) * a0[1], fsigmoid(bflo(sg.y)) * a0[2], fsigmoid(bfhi(sg.y)) * a0[3]};
                f32x4 m1 = (f32x4){fsigmoid(bflo(sg.z)) * a1[0], fsigmoid(bfhi(sg.z)) * a1[1], fsigmoid(bflo(sg.w)) * a1[2], fsigmoid(bfhi(sg.w)) * a1[3]};
                if (u.tag == 3) { const u32x4 pm_ = *(const u32x4*)(sM + i * 1024);
                    m0 = m0 + (f32x4){bflo(pm_.x), bfhi(pm_.x), bflo(pm_.y), bfhi(pm_.y)}; m1 = m1 + (f32x4){bflo(pm_.z), bfhi(pm_.z), bflo(pm_.w), bfhi(pm_.w)}; }
                u32x4 w; w.x = cvt_pk_bf16(m0[0], m0[1]); w.y = cvt_pk_bf16(m0[2], m0[3]); w.z = cvt_pk_bf16(m1[0], m1[1]); w.w = cvt_pk_bf16(m1[2], m1[3]);
                if (u.tag == 1) *(u32x4*)(sM + i * 1024) = w; else *(u32x4*)(MG + o) = w;
            }
            asm volatile("" ::: "memory");
        EPI_ROWS_END
    }
};
template <int MODE> struct EpiRowScale {
    bf16_t* O; const float* ssq; float* IFb;
    __device__ __forceinline__ void operator()(AccRef acc, const Unit& u, int wr, int wc, int fr, int fq, LAS unsigned char*) const {
        constexpr int LDO = MODE == 0 ? ZLD : DM;
        EPI_ROWS_BEGIN
            const int row = u.pm * 256 + rl; const float rs = rsqrtf(ssq[row] * (1.f / 1024.f) + NORM_EPS);
            if (MODE == 0 && u.pn == 15) {
                if (wc == 0 && fq == 0) { *(f32x4*)(IFb + (size_t)row * 8) = acc[ai][0][m][0] * rs; *(f32x4*)(IFb + (size_t)row * 8 + 4) = acc[ai][0][m][1] * rs; }
            } else {
#pragma unroll
                for (int bj = 0; bj < 2; ++bj) { const f32x4 v0 = acc[ai][bj][m][0] * rs, v1 = acc[ai][bj][m][1] * rs;
                    u32x4 w; w.x = cvt_pk_bf16(v0[0], v0[1]); w.y = cvt_pk_bf16(v0[2], v0[3]); w.z = cvt_pk_bf16(v1[0], v1[1]); w.w = cvt_pk_bf16(v1[2], v1[3]);
                    *(u32x4*)(O + (size_t)row * LDO + u.pn * 256 + bj * 128 + wc * 32 + fq * 8) = w; }
            }
        EPI_ROWS_END
    }
};
struct EpiKV {
    bf16_t* Kb; bf16_t* VT; const float* ssqm;
    __device__ __forceinline__ void operator()(AccRef acc, const Unit& u, int wr, int wc, int fr, int fq, LAS unsigned char*) const {
        EPI_ROWS_BEGIN
            const int row = u.pm * 256 + rl;
#pragma unroll
            for (int bj = 0; bj < 2; ++bj) {
                const int cl = bj * 128 + wc * 32 + fq * 8; f32x4 v0 = acc[ai][bj][m][0], v1 = acc[ai][bj][m][1]; bf16_t* dst;
                if (u.tag == 0) { const float rs = rsqrtf(ssqm[row] * (1.f / 1024.f) + NORM_EPS); v0 = v0 * rs; v1 = v1 * rs; dst = Kb + (size_t)row * DM + u.pn * 256 + cl; }
                else { const int tok = u.pn * 256 + cl; const f32x4 s0 = *(const f32x4*)(ssqm + tok), s1 = *(const f32x4*)(ssqm + tok + 4);
#pragma unroll
                    for (int j = 0; j < 4; ++j) { v0[j] *= rsqrtf(s0[j] * (1.f / 1024.f) + NORM_EPS); v1[j] *= rsqrtf(s1[j] * (1.f / 1024.f) + NORM_EPS); }
                    dst = VT + (size_t)(u.pn >> 2) * 1048576 + (size_t)row * 1024 + (u.pn & 3) * 256 + cl; }
                u32x4 w; w.x = cvt_pk_bf16(v0[0], v0[1]); w.y = cvt_pk_bf16(v0[2], v0[3]); w.z = cvt_pk_bf16(v1[0], v1[1]); w.w = cvt_pk_bf16(v1[2], v1[3]);
                *(u32x4*)dst = w;
            }
        EPI_ROWS_END
    }
};
struct EpiMerge {
    u32x4* scrS; f32x4* scrM; bf16_t* MG; const float* ssq;
    __device__ __forceinline__ void operator()(AccRef acc, const Unit& u, int wr, int wc, int fr, int fq, LAS unsigned char*) const {
        char* sS = (char*)scrS + (threadIdx.x >> 6) * 16384u + (threadIdx.x & 63) * 16u; char* sM = (char*)scrM + (threadIdx.x >> 6) * 16384u + (threadIdx.x & 63) * 16u; asm volatile("" : "+v"(sS), "+v"(sM));
        if (u.tag == 0 || u.tag == 2) {
            EPI_ROWS_BEGIN
                const int row = u.pm * 256 + rl; const float rs = rsqrtf(ssq[row] * (1.f / 1024.f) + NORM_EPS);
#pragma unroll
                for (int bj = 0; bj < 2; ++bj) {
                    const int i = (ai * 4 + m) * 2 + bj; const f32x4 a0 = acc[ai][bj][m][0], a1 = acc[ai][bj][m][1];
                    u32x4 w; w.x = cvt_pk_bf16(fsigmoid(a0[0] * rs), fsigmoid(a0[1] * rs)); w.y = cvt_pk_bf16(fsigmoid(a0[2] * rs), fsigmoid(a0[3] * rs));
                    w.z = cvt_pk_bf16(fsigmoid(a1[0] * rs), fsigmoid(a1[1] * rs)); w.w = cvt_pk_bf16(fsigmoid(a1[2] * rs), fsigmoid(a1[3] * rs));
                    *(u32x4*)(sS + i * 1024) = w;
                }
            EPI_ROWS_END
        } else if (u.tag == 1) {
            EPI_ROWS_BEGIN
#pragma unroll
                for (int bj = 0; bj < 2; ++bj) {
                    const int i = (ai * 4 + m) * 2 + bj; const f32x4 a0 = acc[ai][bj][m][0], a1 = acc[ai][bj][m][1];
                    const u32x4 sg = *(const u32x4*)(sS + i * 1024);
                    u32x4 pm_; pm_.x = cvt_pk_bf16(bflo(sg.x) * a0[0], bfhi(sg.x) * a0[1]); pm_.y = cvt_pk_bf16(bflo(sg.y) * a0[2], bfhi(sg.y) * a0[3]);
                    pm_.z = cvt_pk_bf16(bflo(sg.z) * a1[0], bfhi(sg.z) * a1[1]); pm_.w = cvt_pk_bf16(bflo(sg.w) * a1[2], bfhi(sg.w) * a1[3]);
                    *(u32x4*)(sM + i * 1024) = pm_;
                }
                asm volatile("" ::: "memory");
            EPI_ROWS_END
        } else {
            EPI_ROWS_BEGIN
                const int row = u.pm * 256 + rl;
#pragma unroll
                for (int bj = 0; bj < 2; ++bj) {
                    const int i = (ai * 4 + m) * 2 + bj; const f32x4 a0 = acc[ai][bj][m][0], a1 = acc[ai][bj][m][1];
                    const u32x4 sg = *(const u32x4*)(sS + i * 1024);
                    const u32x4 pm_ = *(const u32x4*)(sM + i * 1024);
                    f32x4 m0 = (f32x4){bflo(pm_.x), bfhi(pm_.x), bflo(pm_.y), bfhi(pm_.y)}, m1 = (f32x4){bflo(pm_.z), bfhi(pm_.z), bflo(pm_.w), bfhi(pm_.w)};
                    m0 = m0 + (f32x4){bflo(sg.x) * a0[0], bfhi(sg.x) * a0[1], bflo(sg.y) * a0[2], bfhi(sg.y) * a0[3]};
                    m1 = m1 + (f32x4){bflo(sg.z) * a1[0], bfhi(sg.z) * a1[1], bflo(sg.w) * a1[2], bfhi(sg.w) * a1[3]};
                    u32x4 w; w.x = cvt_pk_bf16(m0[0], m0[1]); w.y = cvt_pk_bf16(m0[2], m0[3]); w.z = cvt_pk_bf16(m1[0], m1[1]); w.w = cvt_pk_bf16(m1[2], m1[3]);
                    *(u32x4*)(MG + (size_t)row * DM + u.pn * 256 + bj * 128 + wc * 32 + fq * 8) = w;
                }
                asm volatile("" ::: "memory");
            EPI_ROWS_END
        }
    }
};
struct EpiAttn {
    bf16_t* Pb; bf16_t* Ob; bf16_t* Qb; const float* ssq;
    __device__ __forceinline__ void operator()(AccRef acc, const Unit& u, int wr, int wc, int fr, int fq, LAS unsigned char* lds) const {
        LAS float* xm = (LAS float*)(lds + XCH_OFF); LAS float* xs = xm + 1024;
        if (u.tag == 2) {
            EPI_ROWS_BEGIN
                const int row = u.pm * 256 + rl; const float rs = rsqrtf(ssq[row] * (1.f / 1024.f) + NORM_EPS);
#pragma unroll
                for (int bj = 0; bj < 2; ++bj) { const f32x4 v0 = acc[ai][bj][m][0] * rs, v1 = acc[ai][bj][m][1] * rs;
                    u32x4 w; w.x = cvt_pk_bf16(v0[0], v0[1]); w.y = cvt_pk_bf16(v0[2], v0[3]); w.z = cvt_pk_bf16(v1[0], v1[1]); w.w = cvt_pk_bf16(v1[2], v1[3]);
                    *(u32x4*)(Qb + (size_t)row * DM + u.pn * 256 + bj * 128 + wc * 32 + fq * 8) = w; }
            EPI_ROWS_END
            return;
        }
        if (u.tag == 1) {
            EPI_ROWS_BEGIN
                const int row = u.pm * 256 + rl;
#pragma unroll
                for (int bj = 0; bj < 2; ++bj) { const f32x4 v0 = acc[ai][bj][m][0], v1 = acc[ai][bj][m][1];
                    u32x4 w; w.x = cvt_pk_bf16(v0[0], v0[1]); w.y = cvt_pk_bf16(v0[2], v0[3]); w.z = cvt_pk_bf16(v1[0], v1[1]); w.w = cvt_pk_bf16(v1[2], v1[3]);
                    *(u32x4*)(Ob + (size_t)row * DM + u.pn * 256 + bj * 128 + wc * 32 + fq * 8) = w; }
            EPI_ROWS_END
            return;
        }
        EPI_ROWS_BEGIN
            float v = -3.0e38f;
#pragma unroll
            for (int bj = 0; bj < 2; ++bj)
#pragma unroll
                for (int n = 0; n < 2; ++n)
#pragma unroll
                    for (int j = 0; j < 4; ++j) v = fmaxf(v, acc[ai][bj][m][n][j]);
            v = fmaxf(v, __shfl_xor(v, 16)); v = fmaxf(v, __shfl_xor(v, 32));
            if (fq == 0) xm[rl * 4 + wc] = v;
        EPI_ROWS_END
        WG_BAR();
        EPI_ROWS_BEGIN
            const f32x4 q = *(const LAS f32x4*)(xm + rl * 4); const float M = fmaxf(fmaxf(q[0], q[1]), fmaxf(q[2], q[3]));
            float sum = 0.f;
#pragma unroll
            for (int bj = 0; bj < 2; ++bj)
#pragma unroll
                for (int n = 0; n < 2; ++n)
#pragma unroll
                    for (int j = 0; j < 4; ++j) sum += __expf(acc[ai][bj][m][n][j] - M);
            sum += __shfl_xor(sum, 16); sum += __shfl_xor(sum, 32);
            if (fq == 0) xs[rl * 4 + wc] = sum;
        EPI_ROWS_END
        WG_BAR();
        EPI_ROWS_BEGIN
            const int row = u.pm * 256 + rl;
            const f32x4 q = *(const LAS f32x4*)(xm + rl * 4); const float M = fmaxf(fmaxf(q[0], q[1]), fmaxf(q[2], q[3]));
            const f32x4 qs = *(const LAS f32x4*)(xs + rl * 4); const float inv = __builtin_amdgcn_rcpf((qs[0] + qs[1]) + (qs[2] + qs[3]));
#pragma unroll
            for (int bj = 0; bj < 2; ++bj) { const f32x4 a0 = acc[ai][bj][m][0], a1 = acc[ai][bj][m][1];
                u32x4 w; w.x = cvt_pk_bf16(__expf(a0[0] - M) * inv, __expf(a0[1] - M) * inv); w.y = cvt_pk_bf16(__expf(a0[2] - M) * inv, __expf(a0[3] - M) * inv);
                w.z = cvt_pk_bf16(__expf(a1[0] - M) * inv, __expf(a1[1] - M) * inv); w.w = cvt_pk_bf16(__expf(a1[2] - M) * inv, __expf(a1[3] - M) * inv);
                *(u32x4*)(Pb + (size_t)row * DM + u.pn * 256 + bj * 128 + wc * 32 + fq * 8) = w; }
            asm volatile("" ::: "memory");
        EPI_ROWS_END
        WG_BAR();
    }
};

struct TJob { const float* src; const float* gain; bf16_t* dst; int K, ldsrc, col0, ncols, dst_ld, dst_row0, dst_k0, mode; float scale; int item0; };
struct Params { const float* in[37]; float* out; unsigned char* ws; TJob jobs[20]; int njobs, nitems, ph_lo, ph_hi, coop, nearly; };

__device__ __forceinline__ void transpose_item(const TJob& J, int item, LAS float* scr, int lane) {
    const int nblk = (J.ncols + 31) >> 5, kb = item / nblk, nb = item - kb * nblk, k0 = 64 * kb, n0 = 32 * nb;
    const bool nok = (n0 + (lane & 31)) < J.ncols;
#pragma unroll
    for (int i = 0; i < 32; ++i) { const int kk = 2 * i + (lane >> 5);
        float v = 0.f; if (nok) { v = J.src[(size_t)(k0 + kk) * J.ldsrc + J.col0 + n0 + (lane & 31)] * J.scale; if (J.gain) v *= J.gain[k0 + kk]; }
        scr[kk * 33 + (lane & 31)] = v; }
    LDS_WAIT();
    const int c = lane & 7;
#pragma unroll
    for (int j = 0; j < 4; ++j) { const int n = n0 + (lane >> 3) + 8 * j; const LAS float* s = scr + (8 * c) * 33 + (n - n0);
        if (n < J.ncols) { u32x4 o; o.x = cvt_pk_bf16(s[0], s[33]); o.y = cvt_pk_bf16(s[66], s[99]); o.z = cvt_pk_bf16(s[132], s[165]); o.w = cvt_pk_bf16(s[198], s[231]);
            const int dr = (J.mode ? ((n >> 7) * 256 + (n & 127)) : n) + J.dst_row0;
            *(u32x4*)(J.dst + (size_t)dr * J.dst_ld + J.dst_k0 + k0 + 8 * c) = o; } }
    LDS_WAIT();
}
__device__ __forceinline__ void row_to_bf16_ssq(const float* xrow, bf16_t* orow, float* ssq, int lane) {
    const f32x4* xr = (const f32x4*)xrow + lane; f32x4 v[4]; float s = 0.f;
#pragma unroll
    for (int j = 0; j < 4; ++j) { v[j] = xr[64 * j]; s += (v[j].x * v[j].x + v[j].y * v[j].y) + (v[j].z * v[j].z + v[j].w * v[j].w); }
    s = wave_sum(s); if (lane == 0) *ssq = s;
    u32x2* o8 = (u32x2*)orow + lane;
#pragma unroll
    for (int j = 0; j < 4; ++j) { u32x2 w; w.x = cvt_pk_bf16(v[j].x, v[j].y); w.y = cvt_pk_bf16(v[j].z, v[j].w); o8[64 * j] = w; }
}
__device__ __forceinline__ void rows4_to_bf16_ssq(const float* xrow, bf16_t* orow, float* ssq, int lane) {
    f32x4 v[4][4]; float s[4];
#pragma unroll
    for (int r = 0; r < 4; ++r)
#pragma unroll
        for (int j = 0; j < 4; ++j) v[r][j] = ((const f32x4*)(xrow + (size_t)r * DM) + lane)[64 * j];
#pragma unroll
    for (int r = 0; r < 4; ++r) { s[r] = 0.f;
#pragma unroll
        for (int j = 0; j < 4; ++j) s[r] += (v[r][j].x * v[r][j].x + v[r][j].y * v[r][j].y) + (v[r][j].z * v[r][j].z + v[r][j].w * v[r][j].w); }
#pragma unroll
    for (int o = 1; o < 64; o <<= 1) {
#pragma unroll
        for (int r = 0; r < 4; ++r) s[r] += __shfl_xor(s[r], o); }
    if (lane < 4) ssq[lane] = lane == 0 ? s[0] : (lane == 1 ? s[1] : (lane == 2 ? s[2] : s[3]));
#pragma unroll
    for (int r = 0; r < 4; ++r) { u32x2* o8 = (u32x2*)(orow + (size_t)r * DM) + lane;
#pragma unroll
        for (int j = 0; j < 4; ++j) { u32x2 w; w.x = cvt_pk_bf16(v[r][j].x, v[r][j].y); w.y = cvt_pk_bf16(v[r][j].z, v[r][j].w); o8[64 * j] = w; } }
}
__device__ __forceinline__ void phase_prep(const Params& P, LAS unsigned char* lds) {
    const int tid = threadIdx.x, lane = tid & 63, wave = tid >> 6; unsigned char* ws = P.ws;
    const int gw = blockIdx.x * 8 + wave, NGW = gridDim.x * 8;
    LAS float* scr = (LAS float*)(lds + wave * 16384);
    for (int it = gw; it < P.nearly; it += NGW) {
        int j = 0;
        while (j + 1 < P.njobs && it >= P.jobs[j + 1].item0) ++j;
        transpose_item(P.jobs[j], it - P.jobs[j].item0, scr, lane);
    }
    for (int m = gw * 4; m < NTOK; m += NGW * 4) rows4_to_bf16_ssq(P.in[0] + (size_t)m * DM, (bf16_t*)(ws + OFF_XB) + (size_t)m * DM, (float*)(ws + OFF_SSQ0) + m, lane);
    for (int m = gw * 4; m < MEMTOK; m += NGW * 4) rows4_to_bf16_ssq(P.in[1] + (size_t)m * DM, (bf16_t*)(ws + OFF_MEMB) + (size_t)m * DM, (float*)(ws + OFF_SSQM) + m, lane);
    const int gt = blockIdx.x * 512 + tid, NGT = gridDim.x * 512;
    for (int i = gt; i < 4 * NTOK; i += NGT) ((float*)(ws + OFF_SSQ1))[i] = 0.f;
    for (int i = gt; i < (int)(8 * MiB / 16); i += NGT) ((u32x4*)(ws + OFF_STATS))[i] = (u32x4){0u, 0u, 0u, 0u};
    for (int i = gt; i < 248 * 1024 / 8; i += NGT) ((u32x4*)(ws + OFF_WIN + (size_t)3848 * 2048))[i] = (u32x4){0u, 0u, 0u, 0u};
}

#define RLX_AGENT __ATOMIC_RELAXED, __HIP_MEMORY_SCOPE_AGENT
__device__ __forceinline__ float red16(float x) {
    x += dpp_f<0xB1>(x); x += dpp_f<0x4E>(x); x += dpp_f<0x141>(x); x += dpp_f<0x140>(x); return x;
}
#define RWA_COL(ty_, cv_, h_, rg_) ((ty_) == 0 ? 1664 + (cv_) * 8 : ((ty_) == 1 ? 1536 + (cv_) * 8 : ((ty_) == 2 ? 1600 + (cv_) * 8 : ((ty_) == 3 ? (h_) * 64 + (cv_) * 8 : ((ty_) == 4 ? 512 + (h_) * 64 + (cv_) * 8 : 1024 + (h_) * 64 + (rg_) * 32 + (cv_) * 8)))))
#define RWA_MAP(p_, lane_, h_, rg_) \
    int ty0, ty1, cv0, cv1, tq0, tq1; bool act0 = true, act1 = true; \
    if ((p_) == 0) { ty0 = 0; cv0 = (lane_) & 7; ty1 = 3; cv1 = (lane_) & 7; tq0 = tq1 = (lane_) >> 3; } \
    else if ((p_) == 1) { ty0 = 0; cv0 = 8 + ((lane_) & 7); ty1 = 4; cv1 = (lane_) & 7; tq0 = tq1 = (lane_) >> 3; } \
    else if ((p_) == 2) { ty0 = 1; cv0 = (lane_) & 7; ty1 = 2; cv1 = (lane_) & 7; tq0 = tq1 = (lane_) >> 3; } \
    else { ty0 = 5; cv0 = (lane_) & 3; tq0 = ((lane_) >> 2) & 7; act0 = (lane_) < 32; ty1 = 5; cv1 = 0; tq1 = 0; act1 = false; } \
    const int col0 = RWA_COL(ty0, cv0, h_, rg_), col1 = RWA_COL(ty1, cv1, h_, rg_);
__device__ __forceinline__ void rwkv_item(const Params& P, LAS unsigned char* lds, int item) {
    const int bh = item >> 1, rg = item & 1, b = bh >> 3, h = bh & 7; unsigned char* ws = P.ws;
    const bf16_t* Z = (const bf16_t*)(ws + OFF_Z); bf16_t* Yb = (bf16_t*)(ws + OFF_Y);
    unsigned long long* gran = (unsigned long long*)(ws + OFF_STATS);
    const float* mu = P.in[8]; const float* w0 = P.in[9]; const float* a0 = P.in[11]; const float* k_k = P.in[14]; const float* k_a = P.in[15]; const float* r_k = P.in[16];
    const float* gn_w = P.in[17]; const float* gn_b = P.in[18];
#define OPS_RR(s_) ((LAS float*)(lds + (s_) * 40960))
#define OPS_WW(s_) ((LAS float*)(lds + (s_) * 40960 + 8192))
#define OPS_BV(s_) ((LAS float*)(lds + (s_) * 40960 + 16384))
#define OPS_KM(s_) ((LAS float*)(lds + (s_) * 40960 + 24576))
#define OPS_KK(s_) ((LAS float*)(lds + (s_) * 40960 + 32768))
    LAS bf16_t* AW = (LAS bf16_t*)(lds + 81920); LAS bf16_t* AA = (LAS bf16_t*)(lds + 86528); LAS bf16_t* AG = (LAS bf16_t*)(lds + 91136);
    LAS float* KS = (LAS float*)(lds + 99840); LAS float* Aa = (LAS float*)(lds + 108032);
#define VV(s_) ((LAS float*)(lds + 116224 + (s_) * 4096))
#define YY(j_) ((LAS float*)(lds + 124416 + (j_) * 4096))
    LAS float* Gt = (LAS float*)(lds + 140800);
#define Q1B(j_) ((LAS bf16_t*)(lds + 144896 + (j_) * 2048))
#define Q2B(j_) ((LAS bf16_t*)(lds + 153088 + (j_) * 2048))
    LAS float* PRM = (LAS float*)(lds + 161280);
    LAS unsigned* GB = (LAS unsigned*)(lds + 162816);
    {
        const int tid = threadIdx.x;
        if (tid < 64) { PRM[tid] = k_k[h * 64 + tid]; PRM[64 + tid] = k_a[h * 64 + tid]; PRM[128 + tid] = r_k[h * 64 + tid]; PRM[192 + tid] = w0[h * 64 + tid]; PRM[256 + tid] = a0[h * 64 + tid]; }
        if (tid < 32) { PRM[320 + tid] = gn_w[h * 64 + rg * 32 + tid]; PRM[352 + tid] = gn_b[h * 64 + rg * 32 + tid]; }
        if (tid == 0) GB[0] = 0u;
    }
    bf16x8 bw[2][2], ba[2][2], bg[4];
    {
        const int lane = threadIdx.x & 63, fr = lane & 15, fq = lane >> 4, p = (threadIdx.x >> 6) & 3, kp = p >> 1;
#pragma unroll
        for (int q = 0; q < 2; ++q) { const int ch = h * 64 + (2 * kp + q) * 16 + fr;
#pragma unroll
            for (int ks = 0; ks < 2; ++ks) { bw[q][ks] = *(const bf16x8*)((const bf16_t*)(ws + OFF_W2T) + (size_t)ch * 64 + ks * 32 + fq * 8); ba[q][ks] = *(const bf16x8*)((const bf16_t*)(ws + OFF_A2T) + (size_t)ch * 64 + ks * 32 + fq * 8); } }
#pragma unroll
        for (int ks = 0; ks < 4; ++ks) bg[ks] = *(const bf16x8*)((const bf16_t*)(ws + OFF_G2T) + (size_t)(h * 64 + rg * 32 + kp * 16 + fr) * 128 + ks * 32 + fq * 8);
    }
    f32x2 S2[4] = {{0.f, 0.f}, {0.f, 0.f}, {0.f, 0.f}, {0.f, 0.f}};
    float muA[8], muB[8]; u32x4 pzA[4], pzB[4], ppA, ppB; unsigned gbgen = 0u; float ps1 = 0.f, ps2 = 0.f;
    {
        RWA_MAP(((int)(threadIdx.x >> 6)) & 3, (int)(threadIdx.x & 63), h, rg)
        (void)act0; (void)act1; (void)tq0; (void)tq1;
        const f32x4 m0 = *(const f32x4*)(mu + col0), m1 = *(const f32x4*)(mu + col0 + 4), n0 = *(const f32x4*)(mu + col1), n1 = *(const f32x4*)(mu + col1 + 4);
#pragma unroll
        for (int j = 0; j < 4; ++j) { muA[j] = m0[j]; muA[4 + j] = m1[j]; muB[j] = n0[j]; muB[4 + j] = n1[j]; }
    }
#define RW_PF1(cn, pz_, pp_, act_, tq_, col_) do { pp_ = (u32x4){0u, 0u, 0u, 0u}; _Pragma("unroll") for (int i_ = 0; i_ < 4; ++i_) pz_[i_] = pp_; \
        if (act_) { const size_t tok = (size_t)b * SEQ + (cn) * 32 + (tq_) * 4; if ((cn) * 32 + (tq_) * 4 > 0) pp_ = *(const u32x4*)(Z + (tok - 1) * ZLD + (col_)); \
            _Pragma("unroll") for (int i_ = 0; i_ < 4; ++i_) pz_[i_] = *(const u32x4*)(Z + (tok + i_) * ZLD + (col_)); } } while (0)
#define RW_PREFETCH(cn) do { RW_PF1(cn, pzA, ppA, act0, tq0, col0); RW_PF1(cn, pzB, ppB, act1, tq1, col1); } while (0)
#define GRP_BAR() do { asm volatile("s_waitcnt lgkmcnt(0)" ::: "memory"); gbgen += 1u; if (lane == 0) (void)__hip_atomic_fetch_add(GB, 1u, __ATOMIC_RELAXED, __HIP_MEMORY_SCOPE_WORKGROUP); \
        { unsigned sp_ = 0; while (__hip_atomic_load(GB, __ATOMIC_RELAXED, __HIP_MEMORY_SCOPE_WORKGROUP) < gbgen * 4u) { if (++sp_ > (1u << 24)) break; } } asm volatile("" ::: "memory"); } while (0)
    {
        RWA_MAP(((int)(threadIdx.x >> 6)) & 3, (int)(threadIdx.x & 63), h, rg)
        act0 = act0 && threadIdx.x >= 256; act1 = act1 && threadIdx.x >= 256;
        RW_PREFETCH(0);
    }
    WG_BAR();
#pragma unroll 1
    for (int it = 0; it < 131; ++it) {
        int tl_ = threadIdx.x; asm volatile("" : "+v"(tl_));
        const int tid = tl_, lane = tid & 63, wave = __builtin_amdgcn_readfirstlane(tid >> 6), fr = lane & 15, fq = lane >> 4;
        if (wave >= 4) {
            unsigned long long g0 = 0ull, g1 = 0ull;
            if (wave == 7 && it >= 3) {
                const unsigned long long* gb3 = gran + (((size_t)bh * 128 + (it - 3)) * 2) * 64 + (lane & 31) * 2 + (rg ^ 1) * 64;
                g0 = __hip_atomic_load(gb3, RLX_AGENT); g1 = __hip_atomic_load(gb3 + 1, RLX_AGENT);
            }
            if (it < 128) {
                const int c = it, os = c & 1, qj = c & 3;
                const int tidp = tid - 256, p = wave - 4, tt = p & 1, kp = p >> 1;
                RWA_MAP(p, lane, h, rg)
                LAS float* Rr = OPS_RR(os); LAS float* Ww = OPS_WW(os); LAS float* Bv = OPS_BV(os); LAS float* KM = OPS_KM(os); LAS float* KK = OPS_KK(os); LAS float* Vv = VV(os);
#define RWA_SEG(pz_, pp_, mu_, act_, ty_, cv_, tq_) do { if (act_) { _Pragma("unroll") for (int i = 0; i < 4; ++i) { \
                    const int t = (tq_) * 4 + i; const u32x4 zc = pz_[i], zp = (i == 0) ? pp_ : pz_[i > 0 ? i - 1 : 0]; \
                    float z[8]; const float c8[8] = {bflo(zc.x), bfhi(zc.x), bflo(zc.y), bfhi(zc.y), bflo(zc.z), bfhi(zc.z), bflo(zc.w), bfhi(zc.w)}; \
                    const float p8[8] = {bflo(zp.x), bfhi(zp.x), bflo(zp.y), bfhi(zp.y), bflo(zp.z), bfhi(zp.z), bflo(zp.w), bfhi(zp.w)}; \
                    _Pragma("unroll") for (int j = 0; j < 8; ++j) z[j] = c8[j] + (p8[j] - c8[j]) * mu_[j]; \
                    if ((ty_) >= 3) { LAS float* dst = (ty_) == 3 ? Rr + t * 64 + (cv_) * 8 : ((ty_) == 4 ? KS + t * 64 + (cv_) * 8 : Vv + t * 32 + (cv_) * 8); \
                        *(LAS f32x4*)dst = (f32x4){z[0], z[1], z[2], z[3]}; *(LAS f32x4*)(dst + 4) = (f32x4){z[4], z[5], z[6], z[7]}; } \
                    else { LAS bf16_t* dst; \
                        if ((ty_) == 1) { dst = AW + t * 72 + (cv_) * 8; _Pragma("unroll") for (int j = 0; j < 8; ++j) z[j] = 1.f - 2.f * __builtin_amdgcn_rcpf(__expf(2.f * z[j]) + 1.f); } \
                        else if ((ty_) == 2) dst = AA + t * 72 + (cv_) * 8; \
                        else { dst = AG + t * 136 + (cv_) * 8; _Pragma("unroll") for (int j = 0; j < 8; ++j) z[j] = fsigmoid(z[j]); } \
                        u32x4 w; w.x = cvt_pk_bf16(z[0], z[1]); w.y = cvt_pk_bf16(z[2], z[3]); w.z = cvt_pk_bf16(z[4], z[5]); w.w = cvt_pk_bf16(z[6], z[7]); \
                        *(LAS u32x4*)dst = w; } } } } while (0)
                RWA_SEG(pzA, ppA, muA, act0, ty0, cv0, tq0);
                RWA_SEG(pzB, ppB, muB, act1, ty1, cv1, tq1);
#undef RWA_SEG
                if (c < 127) RW_PREFETCH(c + 1);
                GRP_BAR();
                {
                    bf16x8 aw[2], aa[2];
#pragma unroll
                    for (int ks = 0; ks < 2; ++ks) { aw[ks] = *(const LAS bf16x8*)(AW + (tt * 16 + fr) * 72 + ks * 32 + fq * 8); aa[ks] = *(const LAS bf16x8*)(AA + (tt * 16 + fr) * 72 + ks * 32 + fq * 8); }
                    const int t = tt * 16 + fr;
#pragma unroll
                    for (int q = 0; q < 2; ++q) {
                        f32x4 cw = (f32x4){0.f, 0.f, 0.f, 0.f}, ca = cw;
#pragma unroll
                        for (int ks = 0; ks < 2; ++ks) { cw = __builtin_amdgcn_mfma_f32_16x16x32_bf16(bw[q][ks], aw[ks], cw, 0, 0, 0); ca = __builtin_amdgcn_mfma_f32_16x16x32_bf16(ba[q][ks], aa[ks], ca, 0, 0, 0); }
                        const int kl = (2 * kp + q) * 16 + fq * 4;
                        const f32x4 w0v = *(const LAS f32x4*)(PRM + 192 + kl), a0v = *(const LAS f32x4*)(PRM + 256 + kl);
                        f32x4 dw, av;
#pragma unroll
                        for (int j = 0; j < 4; ++j) { dw[j] = __expf(-0.6065306597f * fsigmoid(w0v[j] + cw[j])); av[j] = fsigmoid(a0v[j] + ca[j]); }
                        *(LAS f32x4*)(Ww + t * 64 + kl) = dw; *(LAS f32x4*)(Aa + t * 64 + kl) = av;
                    }
                    f32x4 cg_ = (f32x4){0.f, 0.f, 0.f, 0.f};
#pragma unroll
                    for (int ks = 0; ks < 4; ++ks) { const bf16x8 ag = *(const LAS bf16x8*)(AG + (tt * 16 + fr) * 136 + ks * 32 + fq * 8); cg_ = __builtin_amdgcn_mfma_f32_16x16x32_bf16(bg[ks], ag, cg_, 0, 0, 0); }
                    *(LAS f32x4*)(Gt + t * 32 + kp * 16 + fq * 4) = cg_;
                }
                GRP_BAR();
                {
                    const int t = tidp >> 3, k8 = tidp & 7, k0 = k8 * 8;
                    float ks8[8], a8[8], r8[8], kk8[8], km8[8], pk[8], pa[8], pr[8]; float n2 = 0.f, bon = 0.f;
#pragma unroll
                    for (int i = 0; i < 2; ++i) { const f32x4 x0 = *(const LAS f32x4*)(KS + t * 64 + k0 + 4 * i), x1 = *(const LAS f32x4*)(Aa + t * 64 + k0 + 4 * i), x2 = *(const LAS f32x4*)(Rr + t * 64 + k0 + 4 * i);
                        const f32x4 y0 = *(const LAS f32x4*)(PRM + k0 + 4 * i), y1 = *(const LAS f32x4*)(PRM + 64 + k0 + 4 * i), y2 = *(const LAS f32x4*)(PRM + 128 + k0 + 4 * i);
#pragma unroll
                        for (int j = 0; j < 4; ++j) { ks8[4 * i + j] = x0[j]; a8[4 * i + j] = x1[j]; r8[4 * i + j] = x2[j]; pk[4 * i + j] = y0[j]; pa[4 * i + j] = y1[j]; pr[4 * i + j] = y2[j]; } }
#pragma unroll
                    for (int i = 0; i < 8; ++i) { kk8[i] = ks8[i] * pk[i]; n2 += kk8[i] * kk8[i]; km8[i] = ks8[i] * (1.f + (a8[i] - 1.f) * pa[i]); bon += r8[i] * km8[i] * pr[i]; }
                    n2 = red8(n2); bon = red8(bon);
                    const float inv = 1.f / fmaxf(sqrtf(n2), 1e-12f);
                    f32x4 o0[2], o1[2], o2[2];
#pragma unroll
                    for (int i = 0; i < 8; ++i) { const float kn = kk8[i] * inv; o0[i >> 2][i & 3] = -kn; o1[i >> 2][i & 3] = km8[i]; o2[i >> 2][i & 3] = kn * a8[i]; }
#pragma unroll
                    for (int i = 0; i < 2; ++i) { *(LAS f32x4*)(KK + t * 64 + k0 + 4 * i) = o0[i]; *(LAS f32x4*)(KM + t * 64 + k0 + 4 * i) = o1[i]; *(LAS f32x4*)(Bv + t * 64 + k0 + 4 * i) = o2[i]; }
                    const int r4 = k8 * 4;
                    const f32x4 g4 = *(const LAS f32x4*)(Gt + t * 32 + r4), v4 = *(const LAS f32x4*)(Vv + t * 32 + r4), gw4 = *(const LAS f32x4*)(PRM + 320 + r4), gb4 = *(const LAS f32x4*)(PRM + 352 + r4);
                    u32x2 q1, q2;
                    q1.x = cvt_pk_bf16(g4[0] * gw4[0], g4[1] * gw4[1]); q1.y = cvt_pk_bf16(g4[2] * gw4[2], g4[3] * gw4[3]);
                    q2.x = cvt_pk_bf16(g4[0] * (gb4[0] + bon * v4[0]), g4[1] * (gb4[1] + bon * v4[1])); q2.y = cvt_pk_bf16(g4[2] * (gb4[2] + bon * v4[2]), g4[3] * (gb4[3] + bon * v4[3]));
                    *(LAS u32x2*)(Q1B(qj) + t * 32 + r4) = q1; *(LAS u32x2*)(Q2B(qj) + t * 32 + r4) = q2;
                }
            }
            if (wave == 7 && it >= 2) {
                const int t = lane & 31;
                float ns1 = 0.f, ns2 = 0.f;
                if (it <= 129) {
                    const int c = it - 2, yj = c & 3;
#pragma unroll
                    for (int i = 0; i < 8; ++i) { const f32x4 y = *(const LAS f32x4*)(YY(yj) + t * 32 + 4 * i); ns1 += (y[0] + y[1]) + (y[2] + y[3]); ns2 += (y[0] * y[0] + y[1] * y[1]) + (y[2] * y[2] + y[3] * y[3]); }
                    const unsigned long long ep = (unsigned long long)(unsigned)(c + 1) << 32;
                    unsigned long long* gbase = gran + (((size_t)bh * 128 + c) * 2) * 64 + t * 2;
                    if (lane < 32) { __hip_atomic_store(gbase + rg * 64, ep | __builtin_bit_cast(unsigned, ns1), RLX_AGENT); __hip_atomic_store(gbase + rg * 64 + 1, ep | __builtin_bit_cast(unsigned, ns2), RLX_AGENT); }
                }
                if (it >= 3) {
                    const int c = it - 3, yj = c & 3;
                    unsigned long long* gb3 = gran + (((size_t)bh * 128 + c) * 2) * 64 + t * 2 + (rg ^ 1) * 64;
                    unsigned spins = 0;
                    for (;;) {
                        const bool ok = ((g0 >> 32) == (unsigned long long)(unsigned)(c + 1)) && ((g1 >> 32) == (unsigned long long)(unsigned)(c + 1));
                        if (__all(ok)) break;
                        __builtin_amdgcn_s_sleep(2); if (++spins > (1u << 20)) break;
                        g0 = __hip_atomic_load(gb3, RLX_AGENT); g1 = __hip_atomic_load(gb3 + 1, RLX_AGENT);
                    }
                    const float s1 = ps1 + __builtin_bit_cast(float, (unsigned)g0), s2 = ps2 + __builtin_bit_cast(float, (unsigned)g1);
                    const float mean = s1 * (1.f / 64.f), var = fmaxf(s2 * (1.f / 64.f) - mean * mean, 0.f), rstd = rsqrtf(var + 64e-5f);
                    if (lane < 32) {
                        bf16_t* dst = Yb + ((size_t)b * SEQ + c * 32 + t) * DM + h * 64 + rg * 32;
#pragma unroll
                        for (int i = 0; i < 4; ++i) {
                            const f32x4 ya = *(const LAS f32x4*)(YY(yj) + t * 32 + 8 * i), yb = *(const LAS f32x4*)(YY(yj) + t * 32 + 8 * i + 4);
                            const u32x4 q1 = *(const LAS u32x4*)(Q1B(yj) + t * 32 + 8 * i), q2 = *(const LAS u32x4*)(Q2B(yj) + t * 32 + 8 * i);
                            u32x4 w;
                            w.x = cvt_pk_bf16((ya[0] - mean) * rstd * bflo(q1.x) + bflo(q2.x), (ya[1] - mean) * rstd * bfhi(q1.x) + bfhi(q2.x));
                            w.y = cvt_pk_bf16((ya[2] - mean) * rstd * bflo(q1.y) + bflo(q2.y), (ya[3] - mean) * rstd * bfhi(q1.y) + bfhi(q2.y));
                            w.z = cvt_pk_bf16((yb[0] - mean) * rstd * bflo(q1.z) + bflo(q2.z), (yb[1] - mean) * rstd * bfhi(q1.z) + bfhi(q2.z));
                            w.w = cvt_pk_bf16((yb[2] - mean) * rstd * bflo(q1.w) + bflo(q2.w), (yb[3] - mean) * rstd * bfhi(q1.w) + bfhi(q2.w));
                            *(u32x4*)(dst + 8 * i) = w;
                        }
                    }
                }
                ps1 = ns1; ps2 = ns2;
            }
        } else if (it >= 1 && it <= 128) {
            const int c = it - 1, os = c & 1, yj = c & 3, grp = tid >> 4, kq = tid & 15;
            LAS const unsigned char* ob = (LAS const unsigned char*)OPS_RR(os) + kq * 16;
            LAS const unsigned char* vp = (LAS const unsigned char*)VV(os) + grp * 8; LAS unsigned char* yp = (LAS unsigned char*)YY(yj) + grp * 8;
            f32x4 wA, bA, mA, kA, rA, wB, bB, mB, kB, rB; f32x2 vA, vB;
#define RW_LD(X, d) do { r##X = *(const LAS f32x4*)(ob + (d) * 256); w##X = *(const LAS f32x4*)(ob + (d) * 256 + 8192); b##X = *(const LAS f32x4*)(ob + (d) * 256 + 16384); m##X = *(const LAS f32x4*)(ob + (d) * 256 + 24576); \
                k##X = *(const LAS f32x4*)(ob + (d) * 256 + 32768); v##X = *(const LAS f32x2*)(vp + (d) * 128); } while (0)
#define RW_LVL(a_, b_, C) do { a_ += dpp_f<C>(a_); b_ += dpp_f<C>(b_); asm volatile("" : "+v"(a_), "+v"(b_)); } while (0)
#define RW_RED2(x) do { float a_ = x[0], b_ = x[1]; RW_LVL(a_, b_, 0xB1); RW_LVL(a_, b_, 0x4E); RW_LVL(a_, b_, 0x141); RW_LVL(a_, b_, 0x140); x = (f32x2){a_, b_}; } while (0)
#define RW_STEP(X, t) do { f32x2 sa = S2[0] * k##X[0]; sa = S2[1] * k##X[1] + sa; sa = S2[2] * k##X[2] + sa; sa = S2[3] * k##X[3] + sa; RW_RED2(sa); \
                _Pragma("unroll") for (int i = 0; i < 4; ++i) S2[i] = S2[i] * w##X[i] + (sa * b##X[i] + v##X * m##X[i]); \
                f32x2 y = S2[0] * r##X[0]; y = S2[1] * r##X[1] + y; y = S2[2] * r##X[2] + y; y = S2[3] * r##X[3] + y; RW_RED2(y); \
                if (kq == 0) *(LAS f32x2*)(yp + (t) * 128) = y; } while (0)
            RW_LD(A, 0);
#pragma unroll 1
            for (int t = 0; t < 32; t += 2) {
                RW_LD(B, 1); __builtin_amdgcn_sched_barrier(0);
                RW_STEP(A, 0); __builtin_amdgcn_sched_barrier(0);
                if (t == 30) { ob -= 30 * 256; vp -= 30 * 128; }
                RW_LD(A, 2); __builtin_amdgcn_sched_barrier(0);
                RW_STEP(B, 1); __builtin_amdgcn_sched_barrier(0);
                ob += 512; vp += 256; yp += 256;
            }
#undef RW_LD
#undef RW_STEP
#undef RW_RED2
#undef RW_LVL
        }
        WG_BAR();
    }
#undef RW_PREFETCH
#undef RW_PF1
#undef GRP_BAR
#undef OPS_RR
#undef OPS_WW
#undef OPS_BV
#undef OPS_KM
#undef OPS_KK
#undef VV
#undef YY
#undef Q1B
#undef Q2B
}

#define TRI(r, t) ((r) * 72 + (((((t) >> 3) ^ (((r) >> 3) & 7))) << 3) + ((t) & 7))
#define TRB(r, blk) ((r) * 72 + (((blk) ^ (((r) >> 3) & 7)) << 3))
__device__ __forceinline__ void mlstm_item(const Params& P, LAS unsigned char* lds, int bh) {
    const int tid = threadIdx.x, lane = tid & 63, wave = tid >> 6, fr = lane & 15, fq = lane >> 4;
    const int b = bh >> 2, h = bh & 3; unsigned char* ws = P.ws;
    const bf16_t* Z = (const bf16_t*)(ws + OFF_Z); bf16_t* Yb = (bf16_t*)(ws + OFF_Y); const float* IFb = (const float*)(ws + OFF_IF);
    const float* cw = P.in[19]; const float* cb = P.in[20]; const float ib = P.in[21][h], fb = P.in[22][h]; const float* mln = P.in[23];
    LAS bf16_t* Qs = (LAS bf16_t*)(lds); LAS bf16_t* Ks = (LAS bf16_t*)(lds + 17408); LAS bf16_t* KT = (LAS bf16_t*)(lds + 34816); LAS bf16_t* VT = (LAS bf16_t*)(lds + 53248);
    LAS bf16_t* VwT = (LAS bf16_t*)(lds + 71680); LAS bf16_t* Pp = (LAS bf16_t*)(lds + 90112); LAS bf16_t* Cb = (LAS bf16_t*)(lds + 99328);
    LAS float* F = (LAS float*)(lds + 134144);
    LAS float* ga = F, *gu = F + 64, *gwl = F + 128, *gwi = F + 192, *gei = F + 256, *dn = F + 320, *nq = F + 384, *lnx = F + 448  , *ns = F + 704  , *sc = F + 832;
    LAS float* CWL = (LAS float*)(lds + 138240);
    LAS float* CBL = CWL + 1024; LAS float* MLN = CWL + 1280;
    for (int i = tid; i < 1024; i += 512) { const int j = i >> 8, cc = i & 255; CWL[i] = cw[j * 1024 + (cc < 128 ? h * 128 + cc : 512 + h * 128 + cc - 128)]; }
    if (tid < 256) CBL[tid] = cb[tid < 128 ? h * 128 + tid : 512 + h * 128 + tid - 128];
    if (tid < 128) MLN[tid] = mln[h * 128 + tid];
    f32x4 Cacc[8];
#pragma unroll
    for (int i = 0; i < 8; ++i) Cacc[i] = (f32x4){0.f, 0.f, 0.f, 0.f};
    const int pcv = tid & 31, ptg = tid >> 5; const bool pisk = pcv >= 16; const int pc8 = (pcv & 15) * 8;
    const int pzcol = (pisk ? 2304 : 1792) + h * 128 + pc8;
    u32x4 rw[7], vx[2]; u32x2 ogp[4]; float pfb = 0.f, pfu = 0.f, pfp = 0.f, pfe = 0.f, pfm = 0.f;
#define ML_PF_QKV(cn) do { _Pragma("unroll") for (int d = 0; d < 7; ++d) { const int tl = (cn) * 64 + ptg * 4 - 3 + d; rw[d] = (u32x4){0u, 0u, 0u, 0u}; if (tl >= 0) rw[d] = *(const u32x4*)(Z + ((size_t)b * SEQ + tl) * ZLD + pzcol); } \
        _Pragma("unroll") for (int rep = 0; rep < 2; ++rep) { const int v = tid + rep * 512; vx[rep] = *(const u32x4*)(Z + ((size_t)b * SEQ + (cn) * 64 + (v >> 4)) * ZLD + 2816 + h * 128 + (v & 15) * 8); } } while (0)
#define ML_PF_IF(cn) do { if (wave == 0) { pfb = GS[(cn) * 64 + lane]; pfu = GS[4096 + (cn) * 64 + lane]; pfp = GS[8192 + (cn) * 64 + lane]; pfe = GS[12288 + (cn)]; pfm = GS[12352 + (cn)]; } } while (0)
#define ML_PF_OG(cn) do { _Pragma("unroll") for (int q = 0; q < 4; ++q) ogp[q] = *(const u32x2*)(Z + ((size_t)b * SEQ + (cn) * 64 + (wave & 3) * 16 + fr) * ZLD + 3328 + h * 128 + ((wave >> 2) * 4 + q) * 16 + fq * 4); } while (0)
    float* GS = (float*)(ws + OFF_GATES) + (size_t)bh * 12416;
    for (int cc = wave; cc < 64; cc += 8) {
        const size_t tk = (size_t)b * SEQ + cc * 64 + lane;
        const float ig = IFb[tk * 8 + h] + ib, fg = IFb[tk * 8 + 4 + h] + fb;
        const float lf = fminf(fg, 0.f) - __logf(1.f + __expf(-fabsf(fg)));
        float bc = lf;
#pragma unroll
        for (int o = 1; o < 64; o <<= 1) { const float t = __shfl_up(bc, o); if (lane >= o) bc += t; }
        const float bend = __shfl(bc, 63), u = ig - bc;
        float mc = bend + u;
#pragma unroll
        for (int o = 1; o < 64; o <<= 1) mc = fmaxf(mc, __shfl_xor(mc, o));
        float pm = u;
#pragma unroll
        for (int o = 1; o < 64; o <<= 1) { const float t = __shfl_up(pm, o); if (lane >= o) pm = fmaxf(pm, t); }
        GS[cc * 64 + lane] = bc; GS[4096 + cc * 64 + lane] = u; GS[8192 + cc * 64 + lane] = pm;
        if (lane == 0) { GS[12288 + cc] = bend; GS[12352 + cc] = mc; }
    }
    WG_BAR_ALL();
    ML_PF_IF(0); ML_PF_QKV(0); ML_PF_OG(0);
    for (int i = tid; i < 128 * 136 / 2; i += 512) ((LAS unsigned*)Cb)[i] = 0u;
    if (tid < 128) ns[tid] = 0.f;
    float mprev = 0.f;
    WG_BAR();
#pragma unroll 1
    for (int c = 0; c < 64; ++c) {
        int tl_ = threadIdx.x; asm volatile("" : "+v"(tl_));
        const int tid = tl_, lane = tid & 63, wave = tid >> 6, fr = lane & 15, fq = lane >> 4;
        const int pcv = tid & 31, ptg = tid >> 5; const bool pisk = pcv >= 16; const int pc8 = (pcv & 15) * 8;
        const int pzcol = (pisk ? 2304 : 1792) + h * 128 + pc8;
        const size_t tokc = (size_t)b * SEQ + c * 64;
        if (wave == 0) {
            const float bc = pfb, u = pfu, pm = pfp, bend = pfe, mc = pfm;
            ML_PF_IF((c + 1) & 63);
            const float lw = bend + u;
            const float mnew = fmaxf(bend + mprev, mc), dec = __expf(bend + mprev - mnew);
            const float linter = bc + mprev, mrow = fmaxf(linter, bc + pm);
            ga[lane] = bc - mrow; gu[lane] = u; gwl[lane] = __expf(lw - mnew); gwi[lane] = __expf(linter - mrow); gei[lane] = __expf(-mrow); dn[lane] = 0.f;
            if (lane == 0) { sc[0] = dec; sc[1] = mnew; }
        }
        WG_BAR();
        {
            const int tg = ptg; const bool isk = pisk; const int c8 = pc8, lch = (isk ? 128 : 0) + c8;
            float wt[4][8], bs[8];
#pragma unroll
            for (int j = 0; j < 4; ++j) { const f32x4 x0 = *(const LAS f32x4*)(CWL + j * 256 + lch), x1 = *(const LAS f32x4*)(CWL + j * 256 + lch + 4);
#pragma unroll
                for (int i = 0; i < 4; ++i) { wt[j][i] = x0[i]; wt[j][4 + i] = x1[i]; } }
            { const f32x4 x0 = *(const LAS f32x4*)(CBL + lch), x1 = *(const LAS f32x4*)(CBL + lch + 4);
#pragma unroll
              for (int i = 0; i < 4; ++i) { bs[i] = x0[i]; bs[4 + i] = x1[i]; } }
#pragma unroll
            for (int q = 0; q < 4; ++q) {
                const int t = tg * 4 + q; float o[8];
#pragma unroll
                for (int i = 0; i < 8; ++i) o[i] = bs[i];
#pragma unroll
                for (int j = 0; j < 4; ++j) { const u32x4 x = rw[3 + q - j]; const float x8[8] = {bflo(x.x), bfhi(x.x), bflo(x.y), bfhi(x.y), bflo(x.z), bfhi(x.z), bflo(x.w), bfhi(x.w)};
#pragma unroll
                    for (int i = 0; i < 8; ++i) o[i] += wt[j][i] * x8[i]; }
#pragma unroll
                for (int i = 0; i < 8; ++i) { o[i] = o[i] * fsigmoid(o[i]); if (!isk) o[i] *= 0.08838834764831845f; }
                u32x4 w; w.x = cvt_pk_bf16(o[0], o[1]); w.y = cvt_pk_bf16(o[2], o[3]); w.z = cvt_pk_bf16(o[4], o[5]); w.w = cvt_pk_bf16(o[6], o[7]);
                if (!isk) *(LAS u32x4*)(Qs + t * 136 + c8) = w;
                else { *(LAS u32x4*)(Ks + t * 136 + c8) = w;
#pragma unroll
                    for (int i = 0; i < 8; ++i) KT[TRI(c8 + i, t)] = f2bf(o[i]); }
            }
#pragma unroll
            for (int rep = 0; rep < 2; ++rep) {
                const int v = tid + rep * 512, t = v >> 4, v8 = (v & 15) * 8;
                const u32x4 x = vx[rep]; const float wl = gwl[t];
                const float x8[8] = {bflo(x.x), bfhi(x.x), bflo(x.y), bfhi(x.y), bflo(x.z), bfhi(x.z), bflo(x.w), bfhi(x.w)};
#pragma unroll
                for (int i = 0; i < 8; ++i) { VT[TRI(v8 + i, t)] = f2bf(x8[i]); VwT[TRI(v8 + i, t)] = f2bf(x8[i] * wl); }
            }
            if (c < 63) ML_PF_QKV(c + 1);
        }
        WG_BAR();
        const int st = wave & 3;
        bf16x8 qf[4];
#pragma unroll
        for (int ks = 0; ks < 4; ++ks) qf[ks] = *(const LAS bf16x8*)(Qs + (st * 16 + fr) * 136 + ks * 32 + fq * 8);
        {
            const int s = st * 16 + fr; const float gas = ga[s]; float dsum = 0.f;
#pragma unroll
            for (int q = 0; q < 2; ++q) {
                const int rt = (wave >> 2) * 2 + q; f32x4 a = (f32x4){0.f, 0.f, 0.f, 0.f};
#pragma unroll
                for (int ks = 0; ks < 4; ++ks) { const bf16x8 kf = *(const LAS bf16x8*)(Ks + (rt * 16 + fr) * 136 + ks * 32 + fq * 8); a = __builtin_amdgcn_mfma_f32_16x16x32_bf16(kf, qf[ks], a, 0, 0, 0); }
                const int r0 = rt * 16 + fq * 4; float p[4];
#pragma unroll
                for (int j = 0; j < 4; ++j) { p[j] = (r0 + j <= s) ? __expf(gas + gu[r0 + j]) * a[j] : 0.f; dsum += p[j]; }
                u32x2 w; w.x = cvt_pk_bf16(p[0], p[1]); w.y = cvt_pk_bf16(p[2], p[3]); *(LAS u32x2*)(Pp + s * 72 + r0) = w;
            }
            dsum += __shfl_xor(dsum, 16); dsum += __shfl_xor(dsum, 32);
            if (fq == 0) __hip_atomic_fetch_add(dn + s, dsum, __ATOMIC_RELAXED, __HIP_MEMORY_SCOPE_WORKGROUP);
            const int s2 = tid >> 3, kq = tid & 7; float a = 0.f;
#pragma unroll
            for (int i = 0; i < 16; ++i) a += ns[kq * 16 + i] * bf2f(Qs[s2 * 136 + kq * 16 + i]);
            a = red8(a); if (kq == 0) nq[s2] = a;
        }
        WG_BAR();
        {
            const int s = st * 16 + fr, vh = wave >> 2; const float wi = gwi[s];
            const float den = dn[s] + wi * nq[s], dinv = 1.f / fmaxf(fabsf(den), gei[s]);
            bf16x8 pf[2];
#pragma unroll
            for (int ks = 0; ks < 2; ++ks) pf[ks] = *(const LAS bf16x8*)(Pp + s * 72 + ks * 32 + fq * 8);
            f32x4 hv[4]; float s1 = 0.f, s2 = 0.f;
#pragma unroll
            for (int q = 0; q < 4; ++q) {
                const int vt = vh * 4 + q; f32x4 a = (f32x4){0.f, 0.f, 0.f, 0.f};
#pragma unroll
                for (int ks = 0; ks < 4; ++ks) { const bf16x8 cf = *(const LAS bf16x8*)(Cb + (vt * 16 + fr) * 136 + ks * 32 + fq * 8); a = __builtin_amdgcn_mfma_f32_16x16x32_bf16(cf, qf[ks], a, 0, 0, 0); }
                a = a * wi;
#pragma unroll
                for (int ks = 0; ks < 2; ++ks) { const bf16x8 vf = *(const LAS bf16x8*)(VT + TRB(vt * 16 + fr, ks * 4 + fq)); a = __builtin_amdgcn_mfma_f32_16x16x32_bf16(vf, pf[ks], a, 0, 0, 0); }
                a = a * dinv; hv[q] = a;
#pragma unroll
                for (int j = 0; j < 4; ++j) { s1 += a[j]; s2 += a[j] * a[j]; }
            }
            s1 += __shfl_xor(s1, 16); s1 += __shfl_xor(s1, 32); s2 += __shfl_xor(s2, 16); s2 += __shfl_xor(s2, 32);
            if (fq == 0) { lnx[s * 4 + vh * 2] = s1; lnx[s * 4 + vh * 2 + 1] = s2; }
            WG_BAR();
            const f32x4 l4 = *(const LAS f32x4*)(lnx + s * 4);
            const float mean = (l4[0] + l4[2]) * (1.f / 128.f), var = fmaxf((l4[1] + l4[3]) * (1.f / 128.f) - mean * mean, 0.f), rstd = rsqrtf(var + 1e-6f);
            const size_t tok = tokc + s;
#pragma unroll
            for (int q = 0; q < 4; ++q) {
                const int v0 = (vh * 4 + q) * 16 + fq * 4;
                const u32x2 og = ogp[q]; const f32x4 g4 = *(const LAS f32x4*)(MLN + v0);
                const float o0 = (hv[q][0] - mean) * rstd * g4[0] * fsigmoid(bflo(og.x)), o1 = (hv[q][1] - mean) * rstd * g4[1] * fsigmoid(bfhi(og.x));
                const float o2 = (hv[q][2] - mean) * rstd * g4[2] * fsigmoid(bflo(og.y)), o3 = (hv[q][3] - mean) * rstd * g4[3] * fsigmoid(bfhi(og.y));
                u32x2 w; w.x = cvt_pk_bf16(o0, o1); w.y = cvt_pk_bf16(o2, o3);
                *(u32x2*)(Yb + tok * DM + 512 + h * 128 + v0) = w;
            }
            if (c < 63) ML_PF_OG(c + 1);
        }
        WG_BAR();
        {
            const float dec = sc[0];
            bf16x8 vf[2];
#pragma unroll
            for (int ks = 0; ks < 2; ++ks) vf[ks] = *(const LAS bf16x8*)(VwT + TRB(wave * 16 + fr, ks * 4 + fq));
#pragma unroll
            for (int kt = 0; kt < 8; ++kt) {
                f32x4 a = Cacc[kt] * dec;
#pragma unroll
                for (int ks = 0; ks < 2; ++ks) { const bf16x8 kf = *(const LAS bf16x8*)(KT + TRB(kt * 16 + fr, ks * 4 + fq)); a = __builtin_amdgcn_mfma_f32_16x16x32_bf16(kf, vf[ks], a, 0, 0, 0); }
                Cacc[kt] = a;
                u32x2 w; w.x = cvt_pk_bf16(a[0], a[1]); w.y = cvt_pk_bf16(a[2], a[3]);
                *(LAS u32x2*)(Cb + (wave * 16 + fr) * 136 + kt * 16 + fq * 4) = w;
            }
            if (tid < 128) { float a = ns[tid] * dec;
                for (int l = 0; l < 64; ++l) a += gwl[l] * bf2f(Ks[l * 136 + tid]);
                ns[tid] = a; }
            mprev = sc[1];
        }
        WG_BAR();
    }
#undef ML_PF_QKV
#undef ML_PF_IF
#undef ML_PF_OG
}

struct SchedKV {
    const char* memb; const char* wk; const char* wv; int j;
    __device__ __forceinline__ bool next(int i, Unit& u) const {
        if (i != 0 || j < 0 || j >= 64) return false;
        const size_t ts = (size_t)256 * 1024 * 2;
        if (j < 32) { u.pm = j >> 2; u.pn = j & 3; u.A = memb + u.pm * ts; u.B = wk + u.pn * ts; u.tag = 0; }
        else { const int q = j - 32; u.pm = q >> 3; u.pn = q & 7; u.A = wv + u.pm * ts; u.B = memb + u.pn * ts; u.tag = 1; }
        u.nt = 16; return true;
    }
};
struct SchedMerge {
    const char* yb; const char* wup; int c;
    __device__ __forceinline__ bool next(int i, Unit& u) const {
        if (i >= 4) return false;
        const int T = c + 256 * (i >> 1), pass = i & 1; u.pm = T >> 2; u.pn = T & 3; u.tag = pass ? 3 : 1; u.nt = 8;
        const size_t ts = (size_t)256 * 1024 * 2;
        u.A = yb + u.pm * ts + pass * 1024; u.B = wup + u.pn * ts + pass * 1024;
        return true;
    }
};
struct SchedGate {
    const char* xb; const char* wg; int j0;
    __device__ __forceinline__ bool next(int i, Unit& u) const {
        const int j = j0 + 96 * i; if (j >= 1024) return false;
        u.pm = j >> 3; u.pn = j & 7; u.nt = 16; u.tag = 0;
        const size_t ts = (size_t)256 * 1024 * 2;
        u.A = xb + u.pm * ts; u.B = wg + u.pn * ts;
        return true;
    }
};
struct SchedAttn {
    const char* xb; const char* wq; const char* q; const char* p; const char* kb; const char* vt; int c;
    __device__ __forceinline__ bool next(int i, Unit& u) const {
        if (i >= 6) return false;
        const int pr = c + 256 * (i & 1), b = pr >> 6, h = (pr >> 4) & 3, qt = pr & 15, st = i >> 1;
        u.pm = b * 16 + qt; u.pn = h;
        const size_t ao = ((size_t)u.pm * 256 * 1024 + h * 256) * 2;
        if (st == 0) { u.A = xb + (size_t)u.pm * 256 * 1024 * 2; u.B = wq + (size_t)h * 256 * 1024 * 2; u.nt = 16; u.tag = 2; }
        else if (st == 1) { u.A = q + ao; u.B = kb + ((size_t)b * 256 * 1024 + h * 256) * 2; u.nt = 4; u.tag = 0; }
        else { u.A = p + ao; u.B = vt + (size_t)(b >> 2) * 2097152 + ((size_t)h * 256 * 1024 + (b & 3) * 256) * 2; u.nt = 4; u.tag = 1; }
        return true;
    }
};

#define XB_TMO      128
#define XB_XCNT(j)  (256  + 64 * (j))
#define XB_XSUB(j)  (1280 + 64 * (j))
#define XB_XGEN(j)  (2304 + 64 * (j))
#define XB_TOP      3328
#define XB_TOPGEN   3392
#define XCD_BAR_WORDS 3456
#define XB_SPIN_CAP (1u << 18)
__device__ __forceinline__ unsigned xb_ld(unsigned* p)              { return __hip_atomic_load(p, __ATOMIC_RELAXED, __HIP_MEMORY_SCOPE_AGENT); }
__device__ __forceinline__ unsigned xb_add(unsigned* p, unsigned v) { return __hip_atomic_fetch_add(p, v, __ATOMIC_RELAXED, __HIP_MEMORY_SCOPE_AGENT); }
__device__ __forceinline__ unsigned xb_xcc_id() { return (unsigned)__builtin_amdgcn_s_getreg((3 << 11) | 20) & 0xFu; }
#define XB_SPIN(cond, bar) do { unsigned _sp = 0; while (cond) { __builtin_amdgcn_s_sleep(1); \
    if ((++_sp & 255u) == 0u) { if (xb_ld(&(bar)[XB_TMO])) break; if (_sp > XB_SPIN_CAP) { atomicAdd(&(bar)[XB_TMO], 1u); break; } } } } while (0)
struct XcdBarrier { unsigned* bar; unsigned x; volatile LAS unsigned* st; };
__device__ __forceinline__ XcdBarrier xcd_barrier_post(unsigned* bar, volatile LAS unsigned* st) {
    XcdBarrier b; b.bar = bar; b.x = xb_xcc_id(); b.st = st;
    if (threadIdx.x == 0) (void)xb_add(&bar[XB_XCNT(b.x)], 1u);
    return b;
}
__device__ __forceinline__ void xcd_barrier_complete(unsigned* bar, unsigned x, unsigned& nloc, unsigned& nx) {
    const unsigned G = gridDim.x * gridDim.y * gridDim.z;
    unsigned sum, cnt, mine, sp = 0u;
    for (;;) {
        sum = 0u; cnt = 0u; mine = 0u;
#pragma unroll
        for (unsigned j = 0; j < 16; ++j) { const unsigned c = xb_ld(&bar[XB_XCNT(j)]); sum += c; cnt += (c > 0u) ? 1u : 0u; mine = (j == x) ? c : mine; }
        if (sum == G) break;
        __builtin_amdgcn_s_sleep(1);
        if ((++sp & 255u) == 0u) { if (xb_ld(&bar[XB_TMO])) break; if (sp > XB_SPIN_CAP) { atomicAdd(&bar[XB_TMO], 1u); break; } }
    }
    nloc = mine > 0u ? mine : 1u; nx = cnt > 0u ? cnt : 1u;
}
__device__ __forceinline__ void xcd_barrier(const XcdBarrier& b) {
    asm volatile("s_waitcnt vmcnt(0)" ::: "memory");
    __syncthreads();
    if (threadIdx.x == 0) {
        unsigned* bar = b.bar;
        __builtin_amdgcn_s_waitcnt(0);
        unsigned nloc = b.st[0], nx = b.st[1];
        if (nloc == 0u) { xcd_barrier_complete(bar, b.x, nloc, nx); b.st[0] = nloc; b.st[1] = nx; }
        const unsigned old = xb_add(&bar[XB_XSUB(b.x)], 1u);
        const unsigned gen = old / nloc;
        if (old + 1u == (gen + 1u) * nloc) {
            __builtin_amdgcn_fence(__ATOMIC_RELEASE, "agent");
            asm volatile("s_waitcnt vmcnt(0)" ::: "memory");
            const unsigned og = xb_add(&bar[XB_TOP], 1u);
            const unsigned tg = og / nx;
            if (og + 1u == (tg + 1u) * nx) xb_add(&bar[XB_TOPGEN], 1u);
            else XB_SPIN(xb_ld(&bar[XB_TOPGEN]) == tg, bar);
            __builtin_amdgcn_fence(__ATOMIC_ACQUIRE, "agent");
            xb_add(&bar[XB_XGEN(b.x)], 1u);
            asm volatile("s_waitcnt vmcnt(0)" ::: "memory");
        } else {
            XB_SPIN(xb_ld(&bar[XB_XGEN(b.x)]) == gen, bar);
            __builtin_amdgcn_fence(__ATOMIC_ACQUIRE, "agent");
            asm volatile("s_waitcnt vmcnt(0)" ::: "memory");
        }
    }
    __syncthreads();
}

__global__ void __launch_bounds__(512, 2) mega(Params P) {
    extern __shared__ __attribute__((aligned(16))) unsigned char smem[];
    LAS unsigned char* lds = (LAS unsigned char*)smem;
    unsigned char* ws = P.ws;
    const int G = gridDim.x, c = blockIdx.x, lo = P.ph_lo, hi = P.ph_hi;
    float* ssq0 = (float*)(ws + OFF_SSQ0); float* ssq1 = (float*)(ws + OFF_SSQ1); float* ssq2 = (float*)(ws + OFF_SSQ2); float* ssq3 = (float*)(ws + OFF_SSQ3); float* ssq4 = (float*)(ws + OFF_SSQ4);
    bf16_t* XB = (bf16_t*)(ws + OFF_XB); bf16_t* U = (bf16_t*)(ws + OFF_U);
#ifdef ONLY_PHASE
#define IN(k) ((k) == ONLY_PHASE && lo <= (k) && (k) < hi)
#else
#define IN(k) (lo <= (k) && (k) < hi)
#endif
    volatile LAS unsigned* bst = (volatile LAS unsigned*)(lds + 163776);
    if (threadIdx.x < 2) bst[threadIdx.x] = 0u;
    __syncthreads();
    XcdBarrier xbar; xbar.bar = (unsigned*)(ws + OFF_BARW); xbar.x = 0; xbar.st = bst;
    if (P.coop) xbar = xcd_barrier_post((unsigned*)(ws + OFF_BARW), bst);
    if (P.ph_hi > NPHASE) cg::this_grid().sync();
#define SEAM(k) do { if (P.coop && IN(k) && IN((k) + 1)) xcd_barrier(xbar); } while (0)
    const size_t TS1 = (size_t)256 * 1024 * 2, TSF = (size_t)256 * DFF * 2;

    if (IN(0)) { phase_prep(P, lds); }
    SEAM(0);
    if (IN(1)) {
        SchedStatic S{(const char*)XB, (const char*)(ws + OFF_WGU1), TS1, 128, 22, 16, G, c}; EpiSwiglu E{U, ssq0};
        gemm_phase(lds, 1024, S, E);
    }
    SEAM(1);
    if (IN(2)) {
        SchedStatic S{(const char*)U, (const char*)(ws + OFF_WD1), TSF, 128, 4, 44, G, c}; EpiResidX<1> E{P.in[0], nullptr, XB, ssq1, 0.5f};
        gemm_phase(lds, DFF, S, E);
    }
    SEAM(2);
    if (IN(3)) {
        SchedStatic S{(const char*)XB, (const char*)(ws + OFF_WIN), TS1, 128, 16, 16, G, c}; EpiRowScale<0> E{(bf16_t*)(ws + OFF_Z), ssq1, (float*)(ws + OFF_IF)};
        gemm_phase(lds, 1024, S, E);
    }
    SEAM(3);
    if (IN(4)) {
        if (c < 128) rwkv_item(P, lds, c);
        else if (c < 160) mlstm_item(P, lds, c - 128);
        else {
            if (c < 224) { SchedKV S{(const char*)(ws + OFF_MEMB), (const char*)(ws + OFF_WK), (const char*)(ws + OFF_WV), c - 160}; EpiKV E{(bf16_t*)(ws + OFF_KB), (bf16_t*)(ws + OFF_VT), (const float*)(ws + OFF_SSQM)};
                gemm_phase(lds, 1024, S, E); }
            {
                SchedGate S{(const char*)XB, (const char*)(ws + OFF_WG), c >= 224 ? c - 224 : c - 128}; EpiGate E{(bf16_t*)P.out, (bf16_t*)P.out + (size_t)NTOK * DM, ssq1};
                gemm_phase(lds, 1024, S, E); }
            const int wv_ = threadIdx.x >> 6, ln_ = threadIdx.x & 63; LAS float* scr = (LAS float*)(lds + wv_ * 16384);
            for (int it = P.nearly + (c - 160) * 8 + wv_; it < P.nitems; it += 96 * 8) {
                int j = 0;
                while (j + 1 < P.njobs && it >= P.jobs[j + 1].item0) ++j;
                transpose_item(P.jobs[j], it - P.jobs[j].item0, scr, ln_);
            }
        }
    }
    SEAM(4);
    if (IN(5)) {
        SchedMerge S{(const char*)(ws + OFF_Y), (const char*)(ws + OFF_WUP), c};
        EpiMerge2 E{(u32x4*)(ws + OFF_SCRS) + (size_t)c * 8192, (bf16_t*)(ws + OFF_MG), (const bf16_t*)P.out, (const bf16_t*)P.out + (size_t)NTOK * DM};
        if (c < 256) gemm_phase(lds, 1024, S, E);
    }
    SEAM(5);
    if (IN(6)) {
        SchedStatic S{(const char*)(ws + OFF_MG), (const char*)(ws + OFF_WOUT), TS1, 128, 4, 16, G, c}; EpiResidX<2> E{nullptr, P.out, XB, ssq2, 1.0f};
        gemm_phase(lds, 1024, S, E);
    }
    SEAM(6);
    if (IN(8)) {
        SchedAttn S{(const char*)XB, (const char*)(ws + OFF_WQ), (const char*)(ws + OFF_Q), (const char*)(ws + OFF_P), (const char*)(ws + OFF_KB), (const char*)(ws + OFF_VT), c};
        EpiAttn E{(bf16_t*)(ws + OFF_P), (bf16_t*)(ws + OFF_O), (bf16_t*)(ws + OFF_Q), ssq2};
        if (c < 256) gemm_phase(lds, 1024, S, E);
    }
    SEAM(8);
    if (IN(9)) {
        SchedStatic S{(const char*)(ws + OFF_O), (const char*)(ws + OFF_WO), TS1, 128, 4, 16, G, c}; EpiResid<true> E{P.out, P.out, XB, ssq3, 1.0f};
        gemm_phase(lds, 1024, S, E);
    }
    SEAM(9);
    if (IN(10)) {
        SchedStatic S{(const char*)XB, (const char*)(ws + OFF_WGU2), TS1, 128, 22, 16, G, c}; EpiSwiglu E{U, ssq3};
        gemm_phase(lds, 1024, S, E);
    }
    SEAM(10);
    if (IN(11)) {
        SchedStatic S{(const char*)U, (const char*)(ws + OFF_WD2), TSF, 128, 4, 44, G, c}; EpiResid<false> E{P.out, P.out, nullptr, ssq4, 0.5f};
        gemm_phase(lds, DFF, S, E);
    }
    SEAM(11);
    if (IN(12)) {
        const int lane = threadIdx.x & 63, gw = c * 8 + (threadIdx.x >> 6), NGW = G * 8; const float* fn = P.in[36];
        f32x4 g4[4];
#pragma unroll
        for (int j = 0; j < 4; ++j) g4[j] = *((const f32x4*)fn + lane + 64 * j);
        for (int m = gw * 4; m < NTOK; m += NGW * 4) {
            f32x4 v[4][4]; float rs[4];
#pragma unroll
            for (int r = 0; r < 4; ++r) { rs[r] = rsqrtf(ssq4[m + r] * (1.f / 1024.f) + NORM_EPS);
#pragma unroll
                for (int j = 0; j < 4; ++j) v[r][j] = ((const f32x4*)(P.out + (size_t)(m + r) * DM) + lane)[64 * j]; }
#pragma unroll
            for (int r = 0; r < 4; ++r)
#pragma unroll
                for (int j = 0; j < 4; ++j) ((f32x4*)(P.out + (size_t)(m + r) * DM) + lane)[64 * j] = v[r][j] * rs[r] * g4[j];
        }
    }
#undef IN
#undef SEAM
}

#ifdef MK_DBG_DUMP
__global__ void dbg_dump(const bf16_t* src, int ld, int mode, float* out) {
    const size_t i = (size_t)blockIdx.x * 256 + threadIdx.x; const size_t r = i >> 10; const int c = (int)(i & 1023);
    float v = bf2f(src[r * ld + c]);
    if (mode == 1) v += 2.f * bf2f(src[r * ld + c + 1024]) + 3.f * bf2f(src[r * ld + c + 2048]) + 5.f * bf2f(src[r * ld + c + 2816]);
    if (mode == 4) v = ((const float*)src)[i & 262143];
    if (mode == 2 && c >= 512) v = 0.f;
    if (mode == 3 && c < 512) v = 0.f;
    out[i] = v;
}
#endif
static void add_job(Params& p, const float* src, const float* gain, size_t dst_off, int K, int ldsrc, int col0, int ncols, int dst_ld, int dst_row0, int dst_k0, int mode, float scale) {
    TJob& j = p.jobs[p.njobs++]; j.src = src; j.gain = gain; j.dst = (bf16_t*)(p.ws + dst_off); j.K = K; j.ldsrc = ldsrc; j.col0 = col0; j.ncols = ncols; j.dst_ld = dst_ld; j.dst_row0 = dst_row0; j.dst_k0 = dst_k0;
    j.mode = mode; j.scale = scale; j.item0 = p.nitems; p.nitems += (K / 64) * ((ncols + 31) / 32);
}
extern "C" void kernel_launch(void* const* d_in, const int* in_sizes, int n_in, void* d_out, int out_size, void* d_ws, size_t ws_size, hipStream_t stream) {
    static int ready = 0;
    if (ready == 0) {
        if (n_in != 37 || out_size != NTOK * DM || ws_size < WS_END) { fprintf(stderr, "kernel_launch: unexpected shapes: n_in %d out %d ws %zu (need %zu); nothing launched\n", n_in, out_size, ws_size, (size_t)WS_END); ready = -1; return; }
        if (hipFuncSetAttribute((const void*)mega, hipFuncAttributeMaxDynamicSharedMemorySize, LDS_BYTES) != hipSuccess) { fprintf(stderr, "kernel_launch: hipFuncSetAttribute failed\n"); ready = -1; return; }
        int per_cu = 0; (void)hipOccupancyMaxActiveBlocksPerMultiprocessor(&per_cu, (const void*)mega, 512, LDS_BYTES); (void)hipGetLastError();
        if (per_cu < 1) fprintf(stderr, "kernel_launch: note: occupancy query says %d blocks per CU\n", per_cu);
        ready = 1;
    }
    if (ready < 0) return;
    Params p; memset(&p, 0, sizeof(p));
    for (int i = 0; i < 37; ++i) p.in[i] = (const float*)d_in[i];
    p.out = (float*)d_out; p.ws = (unsigned char*)d_ws;
    const float* const* in = p.in;
    add_job(p, in[3], in[2], OFF_WGU1, 1024, DFF, 0, DFF, 1024, 0, 0, 1, 1.f);
    add_job(p, in[4], in[2], OFF_WGU1, 1024, DFF, 0, DFF, 1024, 128, 0, 1, 1.f);
    add_job(p, in[5], nullptr, OFF_WD1, DFF, 1024, 0, 1024, DFF, 0, 0, 0, 1.f);
    add_job(p, in[7], in[6], OFF_WIN, 1024, 5896, 0, 3848, 1024, 0, 0, 0, 1.f);
    add_job(p, in[30], in[28], OFF_WK, 1024, 2048, 0, 1024, 1024, 0, 0, 0, 1.f);
    add_job(p, in[30], in[28], OFF_WV, 1024, 2048, 1024, 1024, 1024, 0, 0, 0, 1.f);
    add_job(p, in[10], nullptr, OFF_W2T, 64, 512, 0, 512, 64, 0, 0, 0, 1.f);
    add_job(p, in[12], nullptr, OFF_A2T, 64, 512, 0, 512, 64, 0, 0, 0, 1.f);
    add_job(p, in[13], nullptr, OFF_G2T, 128, 512, 0, 512, 128, 0, 0, 0, 1.f);
    add_job(p, in[7], in[6], OFF_WG, 1024, 5896, 3848, 2048, 1024, 0, 0, 0, 1.f);
    p.nearly = p.nitems;
    add_job(p, in[24], nullptr, OFF_WUP, 512, 1024, 0, 1024, 1024, 0, 0, 0, 1.f);
    add_job(p, in[25], nullptr, OFF_WUP, 512, 1024, 0, 1024, 1024, 0, 512, 0, 1.f);
    add_job(p, in[26], nullptr, OFF_WOUT, 1024, 1024, 0, 1024, 1024, 0, 0, 0, 1.f);
    add_job(p, in[29], in[27], OFF_WQ, 1024, 1024, 0, 1024, 1024, 0, 0, 0, 0.0625f);
    add_job(p, in[31], nullptr, OFF_WO, 1024, 1024, 0, 1024, 1024, 0, 0, 0, 1.f);
    add_job(p, in[33], in[32], OFF_WGU2, 1024, DFF, 0, DFF, 1024, 0, 0, 1, 1.f);
    add_job(p, in[34], in[32], OFF_WGU2, 1024, DFF, 0, DFF, 1024, 128, 0, 1, 1.f);
    add_job(p, in[35], nullptr, OFF_WD2, DFF, 1024, 0, 1024, DFF, 0, 0, 0, 1.f);
    const int grid = 256;
#if MK_PER_PHASE
    p.coop = 0;
    for (int ph = 0; ph < MK_DBG_HI; ++ph) { p.ph_lo = ph; p.ph_hi = ph + 1; hipLaunchKernelGGL(mega, dim3(grid), dim3(512), LDS_BYTES, stream, p); }
#ifdef MK_DBG_DUMP
    hipLaunchKernelGGL(dbg_dump, dim3(NTOK * 4), dim3(256), 0, stream, (const bf16_t*)(p.ws + MK_DBG_DUMP), MK_DBG_LD, MK_DBG_MODE, p.out);
#endif
#else
    p.coop = 1; p.ph_lo = 0; p.ph_hi = NPHASE;
    if (hipMemsetAsync((char*)d_ws + OFF_BARW, 0, XCD_BAR_WORDS * 4, stream) != hipSuccess) { fprintf(stderr, "kernel_launch: hipMemsetAsync failed\n"); return; }
    void* args[] = {&p};
    hipError_t e = hipLaunchCooperativeKernel((const void*)mega, dim3(grid), dim3(512), args, LDS_BYTES, stream);
    if (e != hipSuccess) fprintf(stderr, "kernel_launch: cooperative launch failed: %s\n", hipGetErrorString(e));
#endif
}
```

```cpp
#include <hip/hip_runtime.h>
#include <hip/hip_cooperative_groups.h>
#include <cstdio>
#include <cstdint>
#include <cstring>
namespace cg = cooperative_groups;

#define LAS __attribute__((address_space(3)))
typedef unsigned short bf16_t;
typedef short bf16x8 __attribute__((ext_vector_type(8)));
typedef float f32x4 __attribute__((ext_vector_type(4)));
typedef float f32x2 __attribute__((ext_vector_type(2)));
typedef unsigned u32x4 __attribute__((ext_vector_type(4)));
typedef unsigned u32x2 __attribute__((ext_vector_type(2)));

#ifndef MK_DBG_HI
#define MK_DBG_HI 13
#endif
#ifndef MK_PER_PHASE
#define MK_PER_PHASE 0
#endif

constexpr int NTOK = 32768, DM = 1024, SEQ = 4096, NB = 8, DFF = 2816, MEMTOK = 2048;
constexpr int ZLD = 3840;
constexpr float NORM_EPS = 1e-5f;
constexpr int NPHASE = 13;
constexpr int LDS_BYTES = 160 * 1024;
constexpr int XCH_OFF = 131072;

constexpr size_t MiB = 1048576;
constexpr size_t OFF_SSQ0 = 0, OFF_SSQ1 = 131072, OFF_SSQ2 = 262144, OFF_SSQ3 = 393216, OFF_SSQ4 = 524288, OFF_SSQM = 655360;
constexpr size_t OFF_IF = 1 * MiB;
constexpr size_t OFF_GATES = 2 * MiB;
constexpr size_t OFF_BARW = 720896;
constexpr size_t OFF_STATS = 444 * MiB;
constexpr size_t OFF_W = 4 * MiB;
constexpr size_t SZ_WGU = (size_t)5632 * 1024 * 2, SZ_WD = (size_t)1024 * 2816 * 2, SZ_WIN = (size_t)4096 * 1024 * 2, SZ_WG = (size_t)2048 * 1024 * 2, SZ_SQ = (size_t)1024 * 1024 * 2;
constexpr size_t OFF_WGU1 = OFF_W, OFF_WD1 = OFF_WGU1 + SZ_WGU, OFF_WIN = OFF_WD1 + SZ_WD, OFF_WG = OFF_WIN + SZ_WIN, OFF_WUP = OFF_WG + SZ_WG, OFF_WOUT = OFF_WUP + SZ_SQ,
                 OFF_WQ = OFF_WOUT + SZ_SQ, OFF_WK = OFF_WQ + SZ_SQ, OFF_WV = OFF_WK + SZ_SQ, OFF_WO = OFF_WV + SZ_SQ, OFF_WGU2 = OFF_WO + SZ_SQ, OFF_WD2 = OFF_WGU2 + SZ_WGU,
                 OFF_W2T = OFF_WD2 + SZ_WD, OFF_A2T = OFF_W2T + 65536, OFF_G2T = OFF_A2T + 65536, OFF_WEND = OFF_G2T + 131072;
static_assert(OFF_WEND <= 64 * MiB, "weights");
constexpr size_t OFF_XB = 64 * MiB, OFF_Y = 128 * MiB, OFF_MEMB = 192 * MiB, OFF_KB = 196 * MiB, OFF_VT = 200 * MiB, OFF_BIG = 204 * MiB, WS_END = 460 * MiB;
constexpr size_t OFF_U = OFF_BIG, OFF_Z = OFF_BIG, OFF_SCRS = OFF_BIG, OFF_SCRM = OFF_BIG + 32 * MiB, OFF_MG = OFF_BIG + 96 * MiB, OFF_Q = OFF_BIG, OFF_P = OFF_BIG + 64 * MiB, OFF_O = OFF_BIG + 128 * MiB;

typedef __bf16 bf16x2_t __attribute__((ext_vector_type(2)));
__device__ __forceinline__ unsigned cvt_pk_bf16(float lo, float hi) { f32x2 v = {lo, hi}; bf16x2_t b = __builtin_convertvector(v, bf16x2_t); return __builtin_bit_cast(unsigned, b); }
__device__ __forceinline__ float bflo(unsigned u) { return __builtin_bit_cast(float, u << 16); }
__device__ __forceinline__ float bfhi(unsigned u) { return __builtin_bit_cast(float, u & 0xffff0000u); }
__device__ __forceinline__ float bf2f(bf16_t b) { return __builtin_bit_cast(float, (unsigned)b << 16); }
__device__ __forceinline__ bf16_t f2bf(float f) { return (bf16_t)(cvt_pk_bf16(f, 0.f) & 0xffffu); }
__device__ __forceinline__ float fsigmoid(float x) { return __builtin_amdgcn_rcpf(1.f + __expf(-x)); }
__device__ __forceinline__ float wave_sum(float v) {
#pragma unroll
    for (int o = 1; o < 64; o <<= 1) v += __shfl_xor(v, o);
    return v;
}
template <int CTRL> __device__ __forceinline__ float dpp_f(float x) { return __builtin_bit_cast(float, __builtin_amdgcn_update_dpp(0, __builtin_bit_cast(int, x), CTRL, 0xF, 0xF, true)); }
__device__ __forceinline__ float red8(float x) {
    x += dpp_f<0xB1>(x); x += dpp_f<0x4E>(x); x += dpp_f<0x141>(x); return x;
}
#define LDS_WAIT() asm volatile("s_waitcnt lgkmcnt(0)" ::: "memory")
#define WG_BAR() do { asm volatile("s_waitcnt lgkmcnt(0)" ::: "memory"); __builtin_amdgcn_s_barrier(); asm volatile("" ::: "memory"); } while (0)
#define WG_BAR_ALL() do { asm volatile("s_waitcnt vmcnt(0) lgkmcnt(0)" ::: "memory"); __builtin_amdgcn_s_barrier(); asm volatile("" ::: "memory"); } while (0)

constexpr int BM = 256, BK = 64, HALF = 128, HTB = HALF * BK * 2;
__host__ __device__ __forceinline__ int lds_byte(int r, int c) { const int st = (r >> 4) * 2 + (c >> 5), rr = r & 15, cc = c & 31, ob = rr * 64 + cc * 2; return st * 1024 + (ob ^ (((ob >> 9) & 1) << 5)); }
__host__ __device__ __forceinline__ void stage_rc(int b, int& R, int& C) { const int st = b / 1024, sb = b % 1024, swz = sb ^ (((sb >> 9) & 1) << 5); R = (st >> 1) * 16 + swz / 64; C = (st & 1) * 32 + (swz % 64) / 2; }
__host__ __device__ __forceinline__ int perm32(int rho) { const int n = rho >> 4, i = rho & 15; return 8 * (i >> 2) + 4 * n + (i & 3); }

struct Unit { const char* A; const char* B; int nt, pm, pn, tag; };

__device__ __forceinline__ void tile_of(int L, int nM, int nN, int& pm, int& pn) {
    const int nwg = nM * nN; int wgid = L;
    { const int q = nwg / 8, r = nwg % 8, xcd = wgid % 8, off = wgid / 8; wgid = (xcd < r ? xcd * (q + 1) : r * (q + 1) + (xcd - r) * q) + off; }
    const int nig = 8 * nN, gid = wgid / nig, fm = gid * 8, gsz = (nM - fm) < 8 ? (nM - fm) : 8;
    pm = fm + ((wgid % nig) % gsz); pn = (wgid % nig) / gsz;
}
struct SchedStatic {
    const char* A; const char* B; size_t tstep; int nM, nN, nt, G, c;
    __device__ __forceinline__ bool next(int i, Unit& u) const {
        const long L = (long)i * G + c; if (L >= (long)nM * nN) return false;
        int pm, pn; tile_of((int)L, nM, nN, pm, pn);
        u.A = A + (size_t)pm * tstep; u.B = B + (size_t)pn * tstep; u.nt = nt; u.pm = pm; u.pn = pn; u.tag = 0; return true;
    }
};

template <class Epi, class Sched>
__device__ __forceinline__ void gemm_phase(LAS unsigned char* lds, const int ld, const Sched& S, const Epi& E) {
    const int tid = threadIdx.x, wid = __builtin_amdgcn_readfirstlane(tid >> 6), lane = tid & 63, wr = wid >> 2, wc = wid & 3, fr = lane & 15, fq = lane >> 4;
    unsigned voffA[2], voffB[2];
#pragma unroll
    for (int i = 0; i < 2; ++i) { int R, C; stage_rc(tid * 16 + i * 8192, R, C); const int Rb = (R & ~31) + perm32(R & 31);
        voffA[i] = (unsigned)(R * ld + C) * 2u; voffB[i] = (unsigned)(Rb * ld + C) * 2u; }
    const size_t kstep = (size_t)(BK * 2);
    const size_t hstep = (size_t)HALF * ld * 2;
    const unsigned ldsw = (unsigned)wid * 1024u;
    const int aoff = lds_byte(wr * 64 + fr, fq * 8), boff = lds_byte(wc * 32 + fr, fq * 8);
#define PG8_SA(b, h) (((b) * 2 + (h)) * HTB)
#define PG8_SB(b, h) ((4 + (b) * 2 + (h)) * HTB)
#define PG8_STAGE(bufoff, gbase, voff) do { _Pragma("unroll") for (int _i = 0; _i < 2; ++_i) \
        __builtin_amdgcn_global_load_lds((const unsigned*)((const char*)(gbase) + (voff)[_i]), (LAS unsigned*)(lds + (bufoff) + ldsw + _i * 8192), 16, 0, 0); } while (0)
#define PG8_LDA(dst, b, h) do { _Pragma("unroll") for (int m = 0; m < 4; ++m) _Pragma("unroll") for (int k = 0; k < 2; ++k) dst[m][k] = *(const LAS bf16x8*)(lds + PG8_SA(b, h) + aoff + m * 2048 + k * 1024); } while (0)
#define PG8_LDB(dst, b, h) do { _Pragma("unroll") for (int n = 0; n < 2; ++n) _Pragma("unroll") for (int k = 0; k < 2; ++k) dst[n][k] = *(const LAS bf16x8*)(lds + PG8_SB(b, h) + boff + n * 2048 + k * 1024); } while (0)
#define PG8_MMA(ai, bj, At, Bt) do { __builtin_amdgcn_s_setprio(1); _Pragma("unroll") for (int m = 0; m < 4; ++m) _Pragma("unroll") for (int n = 0; n < 2; ++n) _Pragma("unroll") for (int k = 0; k < 2; ++k) \
        acc[ai][bj][m][n] = __builtin_amdgcn_mfma_f32_16x16x32_bf16(Bt[n][k], At[m][k], acc[ai][bj][m][n], 0, 0, 0); __builtin_amdgcn_s_setprio(0); } while (0)
#define PG8_WAIT_V(n) asm volatile("s_waitcnt vmcnt(" #n ")" ::: "memory")
#define PG8_WAIT_L(n) asm volatile("s_waitcnt lgkmcnt(" #n ")" ::: "memory")
#define PG8_BAR __builtin_amdgcn_s_barrier()
#define PG8_SCHED __builtin_amdgcn_sched_barrier(0)
    Unit cur, nxt; int ui = 0;
    if (!S.next(0, cur)) return;
    f32x4 acc[2][2][4][2];
#pragma unroll
    for (int a = 0; a < 2; ++a)
#pragma unroll
        for (int b = 0; b < 2; ++b)
#pragma unroll
            for (int m = 0; m < 4; ++m)
#pragma unroll
                for (int n = 0; n < 2; ++n) acc[a][b][m][n] = (f32x4){0.f, 0.f, 0.f, 0.f};
    bf16x8 At[4][2], B0[2][2], B1[2][2];
    const char* cA = cur.A; const char* cB = cur.B; int nt = cur.nt; asm volatile("" : "+s"(nt));
    PG8_STAGE(PG8_SB(0, 0), cB, voffB); PG8_STAGE(PG8_SB(0, 1), cB + hstep, voffB); PG8_STAGE(PG8_SA(0, 0), cA, voffA); PG8_STAGE(PG8_SA(0, 1), cA + hstep, voffA);
    if (wr == 1) PG8_BAR;
    PG8_WAIT_V(2); PG8_BAR;
    PG8_STAGE(PG8_SB(1, 0), cB + kstep, voffB); PG8_STAGE(PG8_SA(1, 0), cA + kstep, voffA); PG8_STAGE(PG8_SB(1, 1), cB + hstep + kstep, voffB);
    PG8_WAIT_V(6); PG8_BAR;
#pragma unroll 1
    for (;;) {
        asm volatile("" : "+s"(ui));
        const bool has_next = S.next(ui + 1, nxt);
        const char* nA = has_next ? nxt.A : cA; const char* nB = has_next ? nxt.B : cB;
#pragma unroll 1
        for (int t = 0; t < nt; t += 2) {
            const bool last = (t == nt - 2);
            const char* a1 = cA + (size_t)(t + 1) * kstep;
            const char* a2 = last ? nA : cA + (size_t)(t + 2) * kstep; const char* b2 = last ? nB : cB + (size_t)(t + 2) * kstep;
            const char* a3 = a2 + kstep; const char* b3 = b2 + kstep;
            PG8_LDB(B0, 0, 0); PG8_LDB(B1, 0, 1); PG8_SCHED; PG8_LDA(At, 0, 0); PG8_STAGE(PG8_SA(1, 1), a1 + hstep, voffA);
            PG8_WAIT_V(8); PG8_WAIT_L(0); PG8_BAR; PG8_MMA(0, 0, At, B0); PG8_MMA(0, 1, At, B1); PG8_BAR; PG8_SCHED;
            PG8_LDA(At, 0, 1); PG8_STAGE(PG8_SB(0, 0), b2, voffB); PG8_STAGE(PG8_SB(0, 1), b2 + hstep, voffB); PG8_STAGE(PG8_SA(0, 0), a2, voffA);
            PG8_WAIT_V(8); PG8_WAIT_L(0); PG8_BAR; PG8_MMA(1, 0, At, B0); PG8_MMA(1, 1, At, B1); PG8_BAR; PG8_SCHED;
            PG8_LDB(B0, 1, 0); PG8_LDB(B1, 1, 1); PG8_SCHED; PG8_LDA(At, 1, 0); PG8_STAGE(PG8_SA(0, 1), a2 + hstep, voffA);
            PG8_WAIT_V(8); PG8_WAIT_L(0); PG8_BAR; PG8_MMA(0, 0, At, B0); PG8_MMA(0, 1, At, B1); PG8_BAR; PG8_SCHED;
            PG8_LDA(At, 1, 1); PG8_STAGE(PG8_SB(1, 0), b3, voffB); PG8_STAGE(PG8_SB(1, 1), b3 + hstep, voffB); PG8_STAGE(PG8_SA(1, 0), a3, voffA);
            PG8_WAIT_V(8); PG8_WAIT_L(0); PG8_BAR; PG8_MMA(1, 0, At, B0); PG8_MMA(1, 1, At, B1); PG8_BAR; PG8_SCHED;
        }
        if (wr == 0) PG8_BAR;
        E(acc, cur, wr, wc, fr, fq, lds);
        if (!has_next) break;
#pragma unroll
        for (int a = 0; a < 2; ++a)
#pragma unroll
            for (int b = 0; b < 2; ++b)
#pragma unroll
                for (int m = 0; m < 4; ++m)
#pragma unroll
                    for (int n = 0; n < 2; ++n) acc[a][b][m][n] = (f32x4){0.f, 0.f, 0.f, 0.f};
        cur = nxt; cA = nA; cB = nB; nt = cur.nt; asm volatile("" : "+s"(nt)); ++ui;
        if (wr == 1) PG8_BAR;
    }
    PG8_WAIT_V(0);
    PG8_BAR;
#undef PG8_SA
#undef PG8_SB
#undef PG8_STAGE
#undef PG8_LDA
#undef PG8_LDB
#undef PG8_MMA
#undef PG8_WAIT_V
#undef PG8_WAIT_L
#undef PG8_BAR
#undef PG8_SCHED
}

typedef f32x4 (&AccRef)[2][2][4][2];
#define EPI_ROWS_BEGIN _Pragma("unroll") for (int ai = 0; ai < 2; ++ai) _Pragma("unroll") for (int m = 0; m < 4; ++m) { const int rl = ai * 128 + wr * 64 + m * 16 + fr;
#define EPI_ROWS_END }

struct EpiSwiglu {
    bf16_t* U; const float* ssq;
    __device__ __forceinline__ void operator()(AccRef acc, const Unit& u, int wr, int wc, int fr, int fq, LAS unsigned char*) const {
        EPI_ROWS_BEGIN
            const int row = u.pm * 256 + rl; const float rs = rsqrtf(ssq[row] * (1.f / 1024.f) + NORM_EPS);
            float o[8];
#pragma unroll
            for (int n = 0; n < 2; ++n)
#pragma unroll
                for (int j = 0; j < 4; ++j) { const float g = acc[ai][0][m][n][j] * rs, up = acc[ai][1][m][n][j] * rs; o[n * 4 + j] = g * fsigmoid(g) * up; }
            u32x4 w; w.x = cvt_pk_bf16(o[0], o[1]); w.y = cvt_pk_bf16(o[2], o[3]); w.z = cvt_pk_bf16(o[4], o[5]); w.w = cvt_pk_bf16(o[6], o[7]);
            *(u32x4*)(U + (size_t)row * DFF + u.pn * 128 + wc * 32 + fq * 8) = w;
        EPI_ROWS_END
    }
};
template <bool WB> struct EpiResid {
    const float* xin; float* xout; bf16_t* xb; float* ssq; float scale;
    __device__ __forceinline__ void operator()(AccRef acc, const Unit& u, int wr, int wc, int fr, int fq, LAS unsigned char*) const {
        EPI_ROWS_BEGIN
            const int row = u.pm * 256 + rl; float ss = 0.f;
#pragma unroll
            for (int bj = 0; bj < 2; ++bj) {
                const size_t o = (size_t)row * DM + u.pn * 256 + bj * 128 + wc * 32 + fq * 8;
                f32x4 v0 = *(const f32x4*)(xin + o), v1 = *(const f32x4*)(xin + o + 4);
                v0 = v0 + acc[ai][bj][m][0] * scale; v1 = v1 + acc[ai][bj][m][1] * scale;
                *(f32x4*)(xout + o) = v0; *(f32x4*)(xout + o + 4) = v1;
                ss += v0[0] * v0[0] + v0[1] * v0[1] + v0[2] * v0[2] + v0[3] * v0[3] + v1[0] * v1[0] + v1[1] * v1[1] + v1[2] * v1[2] + v1[3] * v1[3];
                if (WB) { u32x4 w; w.x = cvt_pk_bf16(v0[0], v0[1]); w.y = cvt_pk_bf16(v0[2], v0[3]); w.z = cvt_pk_bf16(v1[0], v1[1]); w.w = cvt_pk_bf16(v1[2], v1[3]); *(u32x4*)(xb + o) = w; }
            }
            ss += __shfl_xor(ss, 16); ss += __shfl_xor(ss, 32);
            if (fq == 0) atomicAdd(ssq + row, ss);
        EPI_ROWS_END
    }
};
template <int MODE> struct EpiResidX {
    static constexpr bool ALIGN = true;
    const float* xin; float* xout; bf16_t* xb; float* ssq; float scale;
    __device__ __forceinline__ void operator()(AccRef acc, const Unit& u, int wr, int wc, int fr, int fq, LAS unsigned char*) const {
        EPI_ROWS_BEGIN
            const int row = u.pm * 256 + rl; float ss = 0.f;
#pragma unroll
            for (int bj = 0; bj < 2; ++bj) {
                const size_t o = (size_t)row * DM + u.pn * 256 + bj * 128 + wc * 32 + fq * 8;
                f32x4 v0, v1;
                if (MODE == 1) { v0 = *(const f32x4*)(xin + o); v1 = *(const f32x4*)(xin + o + 4); }
                else { const u32x4 xr = *(const u32x4*)(xb + o); v0 = (f32x4){bflo(xr.x), bfhi(xr.x), bflo(xr.y), bfhi(xr.y)}; v1 = (f32x4){bflo(xr.z), bfhi(xr.z), bflo(xr.w), bfhi(xr.w)}; }
                v0 = v0 + acc[ai][bj][m][0] * scale; v1 = v1 + acc[ai][bj][m][1] * scale;
                if (MODE == 2) { *(f32x4*)(xout + o) = v0; *(f32x4*)(xout + o + 4) = v1; }
                ss += v0[0] * v0[0] + v0[1] * v0[1] + v0[2] * v0[2] + v0[3] * v0[3] + v1[0] * v1[0] + v1[1] * v1[1] + v1[2] * v1[2] + v1[3] * v1[3];
                u32x4 w; w.x = cvt_pk_bf16(v0[0], v0[1]); w.y = cvt_pk_bf16(v0[2], v0[3]); w.z = cvt_pk_bf16(v1[0], v1[1]); w.w = cvt_pk_bf16(v1[2], v1[3]); *(u32x4*)(xb + o) = w;
            }
            ss += __shfl_xor(ss, 16); ss += __shfl_xor(ss, 32);
            if (fq == 0) atomicAdd(ssq + row, ss);
        EPI_ROWS_END
    }
};
struct EpiGate {
    static constexpr bool ALIGN = true;
    bf16_t* SA; bf16_t* SB; const float* ssq;
    __device__ __forceinline__ void operator()(AccRef acc, const Unit& u, int wr, int wc, int fr, int fq, LAS unsigned char*) const {
        bf16_t* base = (u.pn < 4 ? SA : SB) + (u.pn & 3) * 256 + wc * 32 + fq * 8;
        EPI_ROWS_BEGIN
            const int row = u.pm * 256 + rl; const float rs = rsqrtf(ssq[row] * (1.f / 1024.f) + NORM_EPS);
#pragma unroll
            for (int bj = 0; bj < 2; ++bj) { const f32x4 a0 = acc[ai][bj][m][0], a1 = acc[ai][bj][m][1];
                u32x4 w; w.x = cvt_pk_bf16(a0[0] * rs, a0[1] * rs); w.y = cvt_pk_bf16(a0[2] * rs, a0[3] * rs);
                w.z = cvt_pk_bf16(a1[0] * rs, a1[1] * rs); w.w = cvt_pk_bf16(a1[2] * rs, a1[3] * rs);
                *(u32x4*)(base + (size_t)row * DM + bj * 128) = w; }
        EPI_ROWS_END
    }
};
struct EpiMerge2 {
    static constexpr bool ALIGN = true;
    u32x4* scrM; bf16_t* MG; const bf16_t* SA; const bf16_t* SB;
    __device__ __forceinline__ void operator()(AccRef acc, const Unit& u, int wr, int wc, int fr, int fq, LAS unsigned char*) const {
        char* sM = (char*)scrM + (threadIdx.x >> 6) * 16384u + (threadIdx.x & 63) * 16u; asm volatile("" : "+v"(sM));
        const bf16_t* G = (u.tag == 1 ? SA : SB);
        EPI_ROWS_BEGIN
            const int row = u.pm * 256 + rl;
#pragma unroll
            for (int bj = 0; bj < 2; ++bj) {
                const int i = (ai * 4 + m) * 2 + bj; const f32x4 a0 = acc[ai][bj][m][0], a1 = acc[ai][bj][m][1];
                const size_t o = (size_t)row * DM + u.pn * 256 + bj * 128 + wc * 32 + fq * 8;
                const u32x4 sg = *(const u32x4*)(G + o);
                f32x4 m0 = (f32x4){fsigmoid(bflo(sg.x)) * a0[0], fsigmoid(bfhi(sg.x)) * a0[1], fsigmoid(bflo(sg.y)) * a0[2], fsigmoid(bfhi(sg.y)) * a0[3]};
                f32x4 m1 = (f32x4){fsigmoid(bflo(sg.z)) * a1[0], fsigmoid(bfhi(sg.z)) * a1[1], fsigmoid(bflo(sg.w)) * a1[2], fsigmoid(bfhi(sg.w)) * a1[3]};
                if (u.tag == 3) { const u32x4 pm_ = *(const u32x4*)(sM + i * 1024);
                    m0 = m0 + (f32x4){bflo(pm_.x), bfhi(pm_.x), bflo(pm_.y), bfhi(pm_.y)}; m1 = m1 + (f32x4){bflo(pm_.z), bfhi(pm_.z), bflo(pm_.w), bfhi(pm_.w)}; }
                u32x4 w; w.x = cvt_pk_bf16(m0[0], m0[1]); w.y = cvt_pk_bf16(m0[2], m0[3]); w.z = cvt_pk_bf16(m1[0], m1[1]); w.w = cvt_pk_bf16(m1[2], m1[3]);
                if (u.tag == 1) *(u32x4*)(sM + i * 1024) = w; else *(u32x4*)(MG + o) = w;
            }
            asm volatile("" ::: "memory");
        EPI_ROWS_END
    }
};
template <int MODE> struct EpiRowScale {
    bf16_t* O; const float* ssq; float* IFb;
    __device__ __forceinline__ void operator()(AccRef acc, const Unit& u, int wr, int wc, int fr, int fq, LAS unsigned char*) const {
        constexpr int LDO = MODE == 0 ? ZLD : DM;
        EPI_ROWS_BEGIN
            const int row = u.pm * 256 + rl; const float rs = rsqrtf(ssq[row] * (1.f / 1024.f) + NORM_EPS);
            if (MODE == 0 && u.pn == 15) {
                if (wc == 0 && fq == 0) { *(f32x4*)(IFb + (size_t)row * 8) = acc[ai][0][m][0] * rs; *(f32x4*)(IFb + (size_t)row * 8 + 4) = acc[ai][0][m][1] * rs; }
            } else {
#pragma unroll
                for (int bj = 0; bj < 2; ++bj) { const f32x4 v0 = acc[ai][bj][m][0] * rs, v1 = acc[ai][bj][m][1] * rs;
                    u32x4 w; w.x = cvt_pk_bf16(v0[0], v0[1]); w.y = cvt_pk_bf16(v0[2], v0[3]); w.z = cvt_pk_bf16(v1[0], v1[1]); w.w = cvt_pk_bf16(v1[2], v1[3]);
                    *(u32x4*)(O + (size_t)row * LDO + u.pn * 256 + bj * 128 + wc * 32 + fq * 8) = w; }
            }
        EPI_ROWS_END
    }
};
struct EpiKV {
    bf16_t* Kb; bf16_t* VT; const float* ssqm;
    __device__ __forceinline__ void operator()(AccRef acc, const Unit& u, int wr, int wc, int fr, int fq, LAS unsigned char*) const {
        EPI_ROWS_BEGIN
            const int row = u.pm * 256 + rl;
#pragma unroll
            for (int bj = 0; bj < 2; ++bj) {
                const int cl = bj * 128 + wc * 32 + fq * 8; f32x4 v0 = acc[ai][bj][m][0], v1 = acc[ai][bj][m][1]; bf16_t* dst;
                if (u.tag == 0) { const float rs = rsqrtf(ssqm[row] * (1.f / 1024.f) + NORM_EPS); v0 = v0 * rs; v1 = v1 * rs; dst = Kb + (size_t)row * DM + u.pn * 256 + cl; }
                else { const int tok = u.pn * 256 + cl; const f32x4 s0 = *(const f32x4*)(ssqm + tok), s1 = *(const f32x4*)(ssqm + tok + 4);
#pragma unroll
                    for (int j = 0; j < 4; ++j) { v0[j] *= rsqrtf(s0[j] * (1.f / 1024.f) + NORM_EPS); v1[j] *= rsqrtf(s1[j] * (1.f / 1024.f) + NORM_EPS); }
                    dst = VT + (size_t)(u.pn >> 2) * 1048576 + (size_t)row * 1024 + (u.pn & 3) * 256 + cl; }
                u32x4 w; w.x = cvt_pk_bf16(v0[0], v0[1]); w.y = cvt_pk_bf16(v0[2], v0[3]); w.z = cvt_pk_bf16(v1[0], v1[1]); w.w = cvt_pk_bf16(v1[2], v1[3]);
                *(u32x4*)dst = w;
            }
        EPI_ROWS_END
    }
};
struct EpiMerge {
    u32x4* scrS; f32x4* scrM; bf16_t* MG; const float* ssq;
    __device__ __forceinline__ void operator()(AccRef acc, const Unit& u, int wr, int wc, int fr, int fq, LAS unsigned char*) const {
        char* sS = (char*)scrS + (threadIdx.x >> 6) * 16384u + (threadIdx.x & 63) * 16u; char* sM = (char*)scrM + (threadIdx.x >> 6) * 16384u + (threadIdx.x & 63) * 16u; asm volatile("" : "+v"(sS), "+v"(sM));
        if (u.tag == 0 || u.tag == 2) {
            EPI_ROWS_BEGIN
                const int row = u.pm * 256 + rl; const float rs = rsqrtf(ssq[row] * (1.f / 1024.f) + NORM_EPS);
#pragma unroll
                for (int bj = 0; bj < 2; ++bj) {
                    const int i = (ai * 4 + m) * 2 + bj; const f32x4 a0 = acc[ai][bj][m][0], a1 = acc[ai][bj][m][1];
                    u32x4 w; w.x = cvt_pk_bf16(fsigmoid(a0[0] * rs), fsigmoid(a0[1] * rs)); w.y = cvt_pk_bf16(fsigmoid(a0[2] * rs), fsigmoid(a0[3] * rs));
                    w.z = cvt_pk_bf16(fsigmoid(a1[0] * rs), fsigmoid(a1[1] * rs)); w.w = cvt_pk_bf16(fsigmoid(a1[2] * rs), fsigmoid(a1[3] * rs));
                    *(u32x4*)(sS + i * 1024) = w;
                }
            EPI_ROWS_END
        } else if (u.tag == 1) {
            EPI_ROWS_BEGIN
#pragma unroll
                for (int bj = 0; bj < 2; ++bj) {
                    const int i = (ai * 4 + m) * 2 + bj; const f32x4 a0 = acc[ai][bj][m][0], a1 = acc[ai][bj][m][1];
                    const u32x4 sg = *(const u32x4*)(sS + i * 1024);
                    u32x4 pm_; pm_.x = cvt_pk_bf16(bflo(sg.x) * a0[0], bfhi(sg.x) * a0[1]); pm_.y = cvt_pk_bf16(bflo(sg.y) * a0[2], bfhi(sg.y) * a0[3]);
                    pm_.z = cvt_pk_bf16(bflo(sg.z) * a1[0], bfhi(sg.z) * a1[1]); pm_.w = cvt_pk_bf16(bflo(sg.w) * a1[2], bfhi(sg.w) * a1[3]);
                    *(u32x4*)(sM + i * 1024) = pm_;
                }
                asm volatile("" ::: "memory");
            EPI_ROWS_END
        } else {
            EPI_ROWS_BEGIN
                const int row = u.pm * 256 + rl;
#pragma unroll
                for (int bj = 0; bj < 2; ++bj) {
                    const int i = (ai * 4 + m) * 2 + bj; const f32x4 a0 = acc[ai][bj][m][0], a1 = acc[ai][bj][m][1];
                    const u32x4 sg = *(const u32x4*)(sS + i * 1024);
                    const u32x4 pm_ = *(const u32x4*)(sM + i * 1024);
                    f32x4 m0 = (f32x4){bflo(pm_.x), bfhi(pm_.x), bflo(pm_.y), bfhi(pm_.y)}, m1 = (f32x4){bflo(pm_.z), bfhi(pm_.z), bflo(pm_.w), bfhi(pm_.w)};
                    m0 = m0 + (f32x4){bflo(sg.x) * a0[0], bfhi(sg.x) * a0[1], bflo(sg.y) * a0[2], bfhi(sg.y) * a0[3]};
                    m1 = m1 + (f32x4){bflo(sg.z) * a1[0], bfhi(sg.z) * a1[1], bflo(sg.w) * a1[2], bfhi(sg.w) * a1[3]};
                    u32x4 w; w.x = cvt_pk_bf16(m0[0], m0[1]); w.y = cvt_pk_bf16(m0[2], m0[3]); w.z = cvt_pk_bf16(m1[0], m1[1]); w.w = cvt_pk_bf16(m1[2], m1[3]);
                    *(u32x4*)(MG + (size_t)row * DM + u.pn * 256 + bj * 128 + wc * 32 + fq * 8) = w;
                }
                asm volatile("" ::: "memory");
            EPI_ROWS_END
        }
    }
};
struct EpiAttn {
    bf16_t* Pb; bf16_t* Ob; bf16_t* Qb; const float* ssq;
    __device__ __forceinline__ void operator()(AccRef acc, const Unit& u, int wr, int wc, int fr, int fq, LAS unsigned char* lds) const {
        LAS float* xm = (LAS float*)(lds + XCH_OFF); LAS float* xs = xm + 1024;
        if (u.tag == 2) {
            EPI_ROWS_BEGIN
                const int row = u.pm * 256 + rl; const float rs = rsqrtf(ssq[row] * (1.f / 1024.f) + NORM_EPS);
#pragma unroll
                for (int bj = 0; bj < 2; ++bj) { const f32x4 v0 = acc[ai][bj][m][0] * rs, v1 = acc[ai][bj][m][1] * rs;
                    u32x4 w; w.x = cvt_pk_bf16(v0[0], v0[1]); w.y = cvt_pk_bf16(v0[2], v0[3]); w.z = cvt_pk_bf16(v1[0], v1[1]); w.w = cvt_pk_bf16(v1[2], v1[3]);
                    *(u32x4*)(Qb + (size_t)row * DM + u.pn * 256 + bj * 128 + wc * 32 + fq * 8) = w; }
            EPI_ROWS_END
            return;
        }
        if (u.tag == 1) {
            EPI_ROWS_BEGIN
                const int row = u.pm * 256 + rl;
#pragma unroll
                for (int bj = 0; bj < 2; ++bj) { const f32x4 v0 = acc[ai][bj][m][0], v1 = acc[ai][bj][m][1];
                    u32x4 w; w.x = cvt_pk_bf16(v0[0], v0[1]); w.y = cvt_pk_bf16(v0[2], v0[3]); w.z = cvt_pk_bf16(v1[0], v1[1]); w.w = cvt_pk_bf16(v1[2], v1[3]);
                    *(u32x4*)(Ob + (size_t)row * DM + u.pn * 256 + bj * 128 + wc * 32 + fq * 8) = w; }
            EPI_ROWS_END
            return;
        }
        EPI_ROWS_BEGIN
            float v = -3.0e38f;
#pragma unroll
            for (int bj = 0; bj < 2; ++bj)
#pragma unroll
                for (int n = 0; n < 2; ++n)
#pragma unroll
                    for (int j = 0; j < 4; ++j) v = fmaxf(v, acc[ai][bj][m][n][j]);
            v = fmaxf(v, __shfl_xor(v, 16)); v = fmaxf(v, __shfl_xor(v, 32));
            if (fq == 0) xm[rl * 4 + wc] = v;
        EPI_ROWS_END
        WG_BAR();
        EPI_ROWS_BEGIN
            const f32x4 q = *(const LAS f32x4*)(xm + rl * 4); const float M = fmaxf(fmaxf(q[0], q[1]), fmaxf(q[2], q[3]));
            float sum = 0.f;
#pragma unroll
            for (int bj = 0; bj < 2; ++bj)
#pragma unroll
                for (int n = 0; n < 2; ++n)
#pragma unroll
                    for (int j = 0; j < 4; ++j) sum += __expf(acc[ai][bj][m][n][j] - M);
            sum += __shfl_xor(sum, 16); sum += __shfl_xor(sum, 32);
            if (fq == 0) xs[rl * 4 + wc] = sum;
        EPI_ROWS_END
        WG_BAR();
        EPI_ROWS_BEGIN
            const int row = u.pm * 256 + rl;
            const f32x4 q = *(const LAS f32x4*)(xm + rl * 4); const float M = fmaxf(fmaxf(q[0], q[1]), fmaxf(q[2], q[3]));
            const f32x4 qs = *(const LAS f32x4*)(xs + rl * 4); const float inv = __builtin_amdgcn_rcpf((qs[0] + qs[1]) + (qs[2] + qs[3]));
#pragma unroll
            for (int bj = 0; bj < 2; ++bj) { const f32x4 a0 = acc[ai][bj][m][0], a1 = acc[ai][bj][m][1];
                u32x4 w; w.x = cvt_pk_bf16(__expf(a0[0] - M) * inv, __expf(a0[1] - M) * inv); w.y = cvt_pk_bf16(__expf(a0[2] - M) * inv, __expf(a0[3] - M) * inv);
                w.z = cvt_pk_bf16(__expf(a1[0] - M) * inv, __expf(a1[1] - M) * inv); w.w = cvt_pk_bf16(__expf(a1[2] - M) * inv, __expf(a1[3] - M) * inv);
                *(u32x4*)(Pb + (size_t)row * DM + u.pn * 256 + bj * 128 + wc * 32 + fq * 8) = w; }
            asm volatile("" ::: "memory");
        EPI_ROWS_END
        WG_BAR();
    }
};

struct TJob { const float* src; const float* gain; bf16_t* dst; int K, ldsrc, col0, ncols, dst_ld, dst_row0, dst_k0, mode; float scale; int item0; };
struct Params { const float* in[37]; float* out; unsigned char* ws; TJob jobs[20]; int njobs, nitems, ph_lo, ph_hi, coop, nearly; };

__device__ __forceinline__ void transpose_item(const TJob& J, int item, LAS float* scr, int lane) {
    const int nblk = (J.ncols + 63) >> 6, kb = item / nblk, nb = item - kb * nblk, k0 = 64 * kb, n0 = 64 * nb;
    const int nq = (lane & 15) * 4; const bool nok = (n0 + nq) < J.ncols;
#pragma unroll
    for (int i = 0; i < 16; ++i) { const int kk = 4 * i + (lane >> 4);
        f32x4 v = (f32x4){0.f, 0.f, 0.f, 0.f};
        if (nok) { v = *(const f32x4*)(J.src + (size_t)(k0 + kk) * J.ldsrc + J.col0 + n0 + nq); float sc = J.scale; if (J.gain) sc *= J.gain[k0 + kk]; v = v * sc; }
        *(LAS f32x4*)(scr + kk * 64 + (nq ^ ((kk >> 3) << 3))) = v; }
    LDS_WAIT();
    const int c = lane & 7;
#pragma unroll
    for (int j = 0; j < 8; ++j) { const int nl = (lane >> 3) + 8 * j, n = n0 + nl; const LAS float* sp = scr + (8 * c) * 64 + (nl ^ (c << 3));
        if (n < J.ncols) { u32x4 o; o.x = cvt_pk_bf16(sp[0], sp[64]); o.y = cvt_pk_bf16(sp[128], sp[192]); o.z = cvt_pk_bf16(sp[256], sp[320]); o.w = cvt_pk_bf16(sp[384], sp[448]);
            const int dr = (J.mode ? ((n >> 7) * 256 + (n & 127)) : n) + J.dst_row0;
            *(u32x4*)(J.dst + (size_t)dr * J.dst_ld + J.dst_k0 + k0 + 8 * c) = o; } }
    LDS_WAIT();
}
__device__ __forceinline__ void row_to_bf16_ssq(const float* xrow, bf16_t* orow, float* ssq, int lane) {
    const f32x4* xr = (const f32x4*)xrow + lane; f32x4 v[4]; float s = 0.f;
#pragma unroll
    for (int j = 0; j < 4; ++j) { v[j] = xr[64 * j]; s += (v[j].x * v[j].x + v[j].y * v[j].y) + (v[j].z * v[j].z + v[j].w * v[j].w); }
    s = wave_sum(s); if (lane == 0) *ssq = s;
    u32x2* o8 = (u32x2*)orow + lane;
#pragma unroll
    for (int j = 0; j < 4; ++j) { u32x2 w; w.x = cvt_pk_bf16(v[j].x, v[j].y); w.y = cvt_pk_bf16(v[j].z, v[j].w); o8[64 * j] = w; }
}
__device__ __forceinline__ void rows4_to_bf16_ssq(const float* xrow, bf16_t* orow, float* ssq, int lane) {
    f32x4 v[4][4]; float s[4];
#pragma unroll
    for (int r = 0; r < 4; ++r)
#pragma unroll
        for (int j = 0; j < 4; ++j) v[r][j] = ((const f32x4*)(xrow + (size_t)r * DM) + lane)[64 * j];
#pragma unroll
    for (int r = 0; r < 4; ++r) { s[r] = 0.f;
#pragma unroll
        for (int j = 0; j < 4; ++j) s[r] += (v[r][j].x * v[r][j].x + v[r][j].y * v[r][j].y) + (v[r][j].z * v[r][j].z + v[r][j].w * v[r][j].w); }
#pragma unroll
    for (int o = 1; o < 64; o <<= 1) {
#pragma unroll
        for (int r = 0; r < 4; ++r) s[r] += __shfl_xor(s[r], o); }
    if (lane < 4) ssq[lane] = lane == 0 ? s[0] : (lane == 1 ? s[1] : (lane == 2 ? s[2] : s[3]));
#pragma unroll
    for (int r = 0; r < 4; ++r) { u32x2* o8 = (u32x2*)(orow + (size_t)r * DM) + lane;
#pragma unroll
        for (int j = 0; j < 4; ++j) { u32x2 w; w.x = cvt_pk_bf16(v[r][j].x, v[r][j].y); w.y = cvt_pk_bf16(v[r][j].z, v[r][j].w); o8[64 * j] = w; } }
}
__device__ __forceinline__ void phase_prep(const Params& P, LAS unsigned char* lds) {
    const int tid = threadIdx.x, lane = tid & 63, wave = tid >> 6; unsigned char* ws = P.ws;
    const int gw = blockIdx.x * 8 + wave, NGW = gridDim.x * 8;
    LAS float* scr = (LAS float*)(lds + wave * 16384);
    for (int it = gw; it < P.nearly; it += NGW) {
        int j = 0;
        while (j + 1 < P.njobs && it >= P.jobs[j + 1].item0) ++j;
        transpose_item(P.jobs[j], it - P.jobs[j].item0, scr, lane);
    }
    for (int m = gw * 4; m < NTOK; m += NGW * 4) rows4_to_bf16_ssq(P.in[0] + (size_t)m * DM, (bf16_t*)(ws + OFF_XB) + (size_t)m * DM, (float*)(ws + OFF_SSQ0) + m, lane);
    for (int m = gw * 4; m < MEMTOK; m += NGW * 4) rows4_to_bf16_ssq(P.in[1] + (size_t)m * DM, (bf16_t*)(ws + OFF_MEMB) + (size_t)m * DM, (float*)(ws + OFF_SSQM) + m, lane);
    const int gt = blockIdx.x * 512 + tid, NGT = gridDim.x * 512;
    for (int i = gt; i < 4 * NTOK; i += NGT) ((float*)(ws + OFF_SSQ1))[i] = 0.f;
    for (int i = gt; i < (int)(8 * MiB / 16); i += NGT) ((u32x4*)(ws + OFF_STATS))[i] = (u32x4){0u, 0u, 0u, 0u};
    for (int i = gt; i < 248 * 1024 / 8; i += NGT) ((u32x4*)(ws + OFF_WIN + (size_t)3848 * 2048))[i] = (u32x4){0u, 0u, 0u, 0u};
}

#define RLX_AGENT __ATOMIC_RELAXED, __HIP_MEMORY_SCOPE_AGENT
__device__ __forceinline__ float red16(float x) {
    x += dpp_f<0xB1>(x); x += dpp_f<0x4E>(x); x += dpp_f<0x141>(x); x += dpp_f<0x140>(x); return x;
}
#define RWA_COL(ty_, cv_, h_, rg_) ((ty_) == 0 ? 1664 + (cv_) * 8 : ((ty_) == 1 ? 1536 + (cv_) * 8 : ((ty_) == 2 ? 1600 + (cv_) * 8 : ((ty_) == 3 ? (h_) * 64 + (cv_) * 8 : ((ty_) == 4 ? 512 + (h_) * 64 + (cv_) * 8 : 1024 + (h_) * 64 + (rg_) * 32 + (cv_) * 8)))))
#define RWA_MAP(p_, lane_, h_, rg_) \
    int ty0, ty1, cv0, cv1, tq0, tq1; bool act0 = true, act1 = true; \
    if ((p_) == 0) { ty0 = 0; cv0 = (lane_) & 7; ty1 = 3; cv1 = (lane_) & 7; tq0 = tq1 = (lane_) >> 3; } \
    else if ((p_) == 1) { ty0 = 0; cv0 = 8 + ((lane_) & 7); ty1 = 4; cv1 = (lane_) & 7; tq0 = tq1 = (lane_) >> 3; } \
    else if ((p_) == 2) { ty0 = 1; cv0 = (lane_) & 7; ty1 = 2; cv1 = (lane_) & 7; tq0 = tq1 = (lane_) >> 3; } \
    else { ty0 = 5; cv0 = (lane_) & 3; tq0 = ((lane_) >> 2) & 7; act0 = (lane_) < 32; ty1 = 5; cv1 = 0; tq1 = 0; act1 = false; } \
    const int col0 = RWA_COL(ty0, cv0, h_, rg_), col1 = RWA_COL(ty1, cv1, h_, rg_);
__device__ __forceinline__ void rwkv_item(const Params& P, LAS unsigned char* lds, int item) {
    const int bh = item >> 1, rg = item & 1, b = bh >> 3, h = bh & 7; unsigned char* ws = P.ws;
    const bf16_t* Z = (const bf16_t*)(ws + OFF_Z); bf16_t* Yb = (bf16_t*)(ws + OFF_Y);
    unsigned long long* gran = (unsigned long long*)(ws + OFF_STATS);
    const float* mu = P.in[8]; const float* w0 = P.in[9]; const float* a0 = P.in[11]; const float* k_k = P.in[14]; const float* k_a = P.in[15]; const float* r_k = P.in[16];
    const float* gn_w = P.in[17]; const float* gn_b = P.in[18];
#define OPS_RR(s_) ((LAS float*)(lds + (s_) * 40960))
#define OPS_WW(s_) ((LAS float*)(lds + (s_) * 40960 + 8192))
#define OPS_BV(s_) ((LAS float*)(lds + (s_) * 40960 + 16384))
#define OPS_KM(s_) ((LAS float*)(lds + (s_) * 40960 + 24576))
#define OPS_KK(s_) ((LAS float*)(lds + (s_) * 40960 + 32768))
    LAS bf16_t* AW = (LAS bf16_t*)(lds + 81920); LAS bf16_t* AA = (LAS bf16_t*)(lds + 86528); LAS bf16_t* AG = (LAS bf16_t*)(lds + 91136);
    LAS float* KS = (LAS float*)(lds + 99840); LAS float* Aa = (LAS float*)(lds + 108032);
#define VV(s_) ((LAS float*)(lds + 116224 + (s_) * 4096))
#define YY(j_) ((LAS float*)(lds + 124416 + (j_) * 4096))
    LAS float* Gt = (LAS float*)(lds + 140800);
#define Q1B(j_) ((LAS bf16_t*)(lds + 144896 + (j_) * 2048))
#define Q2B(j_) ((LAS bf16_t*)(lds + 153088 + (j_) * 2048))
    LAS float* PRM = (LAS float*)(lds + 161280);
    LAS unsigned* GB = (LAS unsigned*)(lds + 162816);
    {
        const int tid = threadIdx.x;
        if (tid < 64) { PRM[tid] = k_k[h * 64 + tid]; PRM[64 + tid] = k_a[h * 64 + tid]; PRM[128 + tid] = r_k[h * 64 + tid]; PRM[192 + tid] = w0[h * 64 + tid]; PRM[256 + tid] = a0[h * 64 + tid]; }
        if (tid < 32) { PRM[320 + tid] = gn_w[h * 64 + rg * 32 + tid]; PRM[352 + tid] = gn_b[h * 64 + rg * 32 + tid]; }
        if (tid == 0) GB[0] = 0u;
    }
    bf16x8 bw[2][2], ba[2][2], bg[4];
    {
        const int lane = threadIdx.x & 63, fr = lane & 15, fq = lane >> 4, p = (threadIdx.x >> 6) & 3, kp = p >> 1;
#pragma unroll
        for (int q = 0; q < 2; ++q) { const int ch = h * 64 + (2 * kp + q) * 16 + fr;
#pragma unroll
            for (int ks = 0; ks < 2; ++ks) { bw[q][ks] = *(const bf16x8*)((const bf16_t*)(ws + OFF_W2T) + (size_t)ch * 64 + ks * 32 + fq * 8); ba[q][ks] = *(const bf16x8*)((const bf16_t*)(ws + OFF_A2T) + (size_t)ch * 64 + ks * 32 + fq * 8); } }
#pragma unroll
        for (int ks = 0; ks < 4; ++ks) bg[ks] = *(const bf16x8*)((const bf16_t*)(ws + OFF_G2T) + (size_t)(h * 64 + rg * 32 + kp * 16 + fr) * 128 + ks * 32 + fq * 8);
    }
    f32x2 S2[4] = {{0.f, 0.f}, {0.f, 0.f}, {0.f, 0.f}, {0.f, 0.f}};
    float muA[8], muB[8]; u32x4 pzA[4], pzB[4], ppA, ppB; unsigned gbgen = 0u; float ps1 = 0.f, ps2 = 0.f;
    {
        RWA_MAP(((int)(threadIdx.x >> 6)) & 3, (int)(threadIdx.x & 63), h, rg)
        (void)act0; (void)act1; (void)tq0; (void)tq1;
        const f32x4 m0 = *(const f32x4*)(mu + col0), m1 = *(const f32x4*)(mu + col0 + 4), n0 = *(const f32x4*)(mu + col1), n1 = *(const f32x4*)(mu + col1 + 4);
#pragma unroll
        for (int j = 0; j < 4; ++j) { muA[j] = m0[j]; muA[4 + j] = m1[j]; muB[j] = n0[j]; muB[4 + j] = n1[j]; }
    }
#define RW_PF1(cn, pz_, pp_, act_, tq_, col_) do { pp_ = (u32x4){0u, 0u, 0u, 0u}; _Pragma("unroll") for (int i_ = 0; i_ < 4; ++i_) pz_[i_] = pp_; \
        if (act_) { const size_t tok = (size_t)b * SEQ + (cn) * 32 + (tq_) * 4; if ((cn) * 32 + (tq_) * 4 > 0) pp_ = *(const u32x4*)(Z + (tok - 1) * ZLD + (col_)); \
            _Pragma("unroll") for (int i_ = 0; i_ < 4; ++i_) pz_[i_] = *(const u32x4*)(Z + (tok + i_) * ZLD + (col_)); } } while (0)
#define RW_PREFETCH(cn) do { RW_PF1(cn, pzA, ppA, act0, tq0, col0); RW_PF1(cn, pzB, ppB, act1, tq1, col1); } while (0)
#define GRP_BAR() do { asm volatile("s_waitcnt lgkmcnt(0)" ::: "memory"); gbgen += 1u; if (lane == 0) (void)__hip_atomic_fetch_add(GB, 1u, __ATOMIC_RELAXED, __HIP_MEMORY_SCOPE_WORKGROUP); \
        { unsigned sp_ = 0; while (__hip_atomic_load(GB, __ATOMIC_RELAXED, __HIP_MEMORY_SCOPE_WORKGROUP) < gbgen * 4u) { if (++sp_ > (1u << 24)) break; } } asm volatile("" ::: "memory"); } while (0)
    {
        RWA_MAP(((int)(threadIdx.x >> 6)) & 3, (int)(threadIdx.x & 63), h, rg)
        act0 = act0 && threadIdx.x >= 256; act1 = act1 && threadIdx.x >= 256;
        RW_PREFETCH(0);
    }
    WG_BAR();
#pragma unroll 1
    for (int it = 0; it < 131; ++it) {
        int tl_ = threadIdx.x; asm volatile("" : "+v"(tl_));
        const int tid = tl_, lane = tid & 63, wave = __builtin_amdgcn_readfirstlane(tid >> 6), fr = lane & 15, fq = lane >> 4;
        if (wave >= 4) {
            unsigned long long g0 = 0ull, g1 = 0ull;
            if (wave == 7 && it >= 3) {
                const unsigned long long* gb3 = gran + (((size_t)bh * 128 + (it - 3)) * 2) * 64 + (lane & 31) * 2 + (rg ^ 1) * 64;
                g0 = __hip_atomic_load(gb3, RLX_AGENT); g1 = __hip_atomic_load(gb3 + 1, RLX_AGENT);
            }
            if (it < 128) {
                const int c = it, os = c & 1, qj = c & 3;
                const int tidp = tid - 256, p = wave - 4, tt = p & 1, kp = p >> 1;
                RWA_MAP(p, lane, h, rg)
                LAS float* Rr = OPS_RR(os); LAS float* Ww = OPS_WW(os); LAS float* Bv = OPS_BV(os); LAS float* KM = OPS_KM(os); LAS float* KK = OPS_KK(os); LAS float* Vv = VV(os);
#define RWA_SEG(pz_, pp_, mu_, act_, ty_, cv_, tq_) do { if (act_) { _Pragma("unroll") for (int i = 0; i < 4; ++i) { \
                    const int t = (tq_) * 4 + i; const u32x4 zc = pz_[i], zp = (i == 0) ? pp_ : pz_[i > 0 ? i - 1 : 0]; \
                    float z[8]; const float c8[8] = {bflo(zc.x), bfhi(zc.x), bflo(zc.y), bfhi(zc.y), bflo(zc.z), bfhi(zc.z), bflo(zc.w), bfhi(zc.w)}; \
                    const float p8[8] = {bflo(zp.x), bfhi(zp.x), bflo(zp.y), bfhi(zp.y), bflo(zp.z), bfhi(zp.z), bflo(zp.w), bfhi(zp.w)}; \
                    _Pragma("unroll") for (int j = 0; j < 8; ++j) z[j] = c8[j] + (p8[j] - c8[j]) * mu_[j]; \
                    if ((ty_) >= 3) { LAS float* dst = (ty_) == 3 ? Rr + t * 64 + (cv_) * 8 : ((ty_) == 4 ? KS + t * 64 + (cv_) * 8 : Vv + t * 32 + (cv_) * 8); \
                        *(LAS f32x4*)dst = (f32x4){z[0], z[1], z[2], z[3]}; *(LAS f32x4*)(dst + 4) = (f32x4){z[4], z[5], z[6], z[7]}; } \
                    else { LAS bf16_t* dst; \
                        if ((ty_) == 1) { dst = AW + t * 72 + (cv_) * 8; _Pragma("unroll") for (int j = 0; j < 8; ++j) z[j] = 1.f - 2.f * __builtin_amdgcn_rcpf(__expf(2.f * z[j]) + 1.f); } \
                        else if ((ty_) == 2) dst = AA + t * 72 + (cv_) * 8; \
                        else { dst = AG + t * 136 + (cv_) * 8; _Pragma("unroll") for (int j = 0; j < 8; ++j) z[j] = fsigmoid(z[j]); } \
                        u32x4 w; w.x = cvt_pk_bf16(z[0], z[1]); w.y = cvt_pk_bf16(z[2], z[3]); w.z = cvt_pk_bf16(z[4], z[5]); w.w = cvt_pk_bf16(z[6], z[7]); \
                        *(LAS u32x4*)dst = w; } } } } while (0)
                RWA_SEG(pzA, ppA, muA, act0, ty0, cv0, tq0);
                RWA_SEG(pzB, ppB, muB, act1, ty1, cv1, tq1);
#undef RWA_SEG
                if (c < 127) RW_PREFETCH(c + 1);
                GRP_BAR();
                {
                    bf16x8 aw[2], aa[2];
#pragma unroll
                    for (int ks = 0; ks < 2; ++ks) { aw[ks] = *(const LAS bf16x8*)(AW + (tt * 16 + fr) * 72 + ks * 32 + fq * 8); aa[ks] = *(const LAS bf16x8*)(AA + (tt * 16 + fr) * 72 + ks * 32 + fq * 8); }
                    const int t = tt * 16 + fr;
#pragma unroll
                    for (int q = 0; q < 2; ++q) {
                        f32x4 cw = (f32x4){0.f, 0.f, 0.f, 0.f}, ca = cw;
#pragma unroll
                        for (int ks = 0; ks < 2; ++ks) { cw = __builtin_amdgcn_mfma_f32_16x16x32_bf16(bw[q][ks], aw[ks], cw, 0, 0, 0); ca = __builtin_amdgcn_mfma_f32_16x16x32_bf16(ba[q][ks], aa[ks], ca, 0, 0, 0); }
                        const int kl = (2 * kp + q) * 16 + fq * 4;
                        const f32x4 w0v = *(const LAS f32x4*)(PRM + 192 + kl), a0v = *(const LAS f32x4*)(PRM + 256 + kl);
                        f32x4 dw, av;
#pragma unroll
                        for (int j = 0; j < 4; ++j) { dw[j] = __expf(-0.6065306597f * fsigmoid(w0v[j] + cw[j])); av[j] = fsigmoid(a0v[j] + ca[j]); }
                        *(LAS f32x4*)(Ww + t * 64 + kl) = dw; *(LAS f32x4*)(Aa + t * 64 + kl) = av;
                    }
                    f32x4 cg_ = (f32x4){0.f, 0.f, 0.f, 0.f};
#pragma unroll
                    for (int ks = 0; ks < 4; ++ks) { const bf16x8 ag = *(const LAS bf16x8*)(AG + (tt * 16 + fr) * 136 + ks * 32 + fq * 8); cg_ = __builtin_amdgcn_mfma_f32_16x16x32_bf16(bg[ks], ag, cg_, 0, 0, 0); }
                    *(LAS f32x4*)(Gt + t * 32 + kp * 16 + fq * 4) = cg_;
                }
                GRP_BAR();
                {
                    const int t = tidp >> 3, k8 = tidp & 7, k0 = k8 * 8;
                    float ks8[8], a8[8], r8[8], kk8[8], km8[8], pk[8], pa[8], pr[8]; float n2 = 0.f, bon = 0.f;
#pragma unroll
                    for (int i = 0; i < 2; ++i) { const f32x4 x0 = *(const LAS f32x4*)(KS + t * 64 + k0 + 4 * i), x1 = *(const LAS f32x4*)(Aa + t * 64 + k0 + 4 * i), x2 = *(const LAS f32x4*)(Rr + t * 64 + k0 + 4 * i);
                        const f32x4 y0 = *(const LAS f32x4*)(PRM + k0 + 4 * i), y1 = *(const LAS f32x4*)(PRM + 64 + k0 + 4 * i), y2 = *(const LAS f32x4*)(PRM + 128 + k0 + 4 * i);
#pragma unroll
                        for (int j = 0; j < 4; ++j) { ks8[4 * i + j] = x0[j]; a8[4 * i + j] = x1[j]; r8[4 * i + j] = x2[j]; pk[4 * i + j] = y0[j]; pa[4 * i + j] = y1[j]; pr[4 * i + j] = y2[j]; } }
#pragma unroll
                    for (int i = 0; i < 8; ++i) { kk8[i] = ks8[i] * pk[i]; n2 += kk8[i] * kk8[i]; km8[i] = ks8[i] * (1.f + (a8[i] - 1.f) * pa[i]); bon += r8[i] * km8[i] * pr[i]; }
                    n2 = red8(n2); bon = red8(bon);
                    const float inv = 1.f / fmaxf(sqrtf(n2), 1e-12f);
                    f32x4 o0[2], o1[2], o2[2];
#pragma unroll
                    for (int i = 0; i < 8; ++i) { const float kn = kk8[i] * inv; o0[i >> 2][i & 3] = -kn; o1[i >> 2][i & 3] = km8[i]; o2[i >> 2][i & 3] = kn * a8[i]; }
#pragma unroll
                    for (int i = 0; i < 2; ++i) { *(LAS f32x4*)(KK + t * 64 + k0 + 4 * i) = o0[i]; *(LAS f32x4*)(KM + t * 64 + k0 + 4 * i) = o1[i]; *(LAS f32x4*)(Bv + t * 64 + k0 + 4 * i) = o2[i]; }
                    const int r4 = k8 * 4;
                    const f32x4 g4 = *(const LAS f32x4*)(Gt + t * 32 + r4), v4 = *(const LAS f32x4*)(Vv + t * 32 + r4), gw4 = *(const LAS f32x4*)(PRM + 320 + r4), gb4 = *(const LAS f32x4*)(PRM + 352 + r4);
                    u32x2 q1, q2;
                    q1.x = cvt_pk_bf16(g4[0] * gw4[0], g4[1] * gw4[1]); q1.y = cvt_pk_bf16(g4[2] * gw4[2], g4[3] * gw4[3]);
                    q2.x = cvt_pk_bf16(g4[0] * (gb4[0] + bon * v4[0]), g4[1] * (gb4[1] + bon * v4[1])); q2.y = cvt_pk_bf16(g4[2] * (gb4[2] + bon * v4[2]), g4[3] * (gb4[3] + bon * v4[3]));
                    *(LAS u32x2*)(Q1B(qj) + t * 32 + r4) = q1; *(LAS u32x2*)(Q2B(qj) + t * 32 + r4) = q2;
                }
            }
            if (wave == 7 && it >= 2) {
                const int t = lane & 31;
                float ns1 = 0.f, ns2 = 0.f;
                if (it <= 129) {
                    const int c = it - 2, yj = c & 3;
#pragma unroll
                    for (int i = 0; i < 8; ++i) { const f32x4 y = *(const LAS f32x4*)(YY(yj) + t * 32 + 4 * i); ns1 += (y[0] + y[1]) + (y[2] + y[3]); ns2 += (y[0] * y[0] + y[1] * y[1]) + (y[2] * y[2] + y[3] * y[3]); }
                    const unsigned long long ep = (unsigned long long)(unsigned)(c + 1) << 32;
                    unsigned long long* gbase = gran + (((size_t)bh * 128 + c) * 2) * 64 + t * 2;
                    if (lane < 32) { __hip_atomic_store(gbase + rg * 64, ep | __builtin_bit_cast(unsigned, ns1), RLX_AGENT); __hip_atomic_store(gbase + rg * 64 + 1, ep | __builtin_bit_cast(unsigned, ns2), RLX_AGENT); }
                }
                if (it >= 3) {
                    const int c = it - 3, yj = c & 3;
                    unsigned long long* gb3 = gran + (((size_t)bh * 128 + c) * 2) * 64 + t * 2 + (rg ^ 1) * 64;
                    unsigned spins = 0;
                    for (;;) {
                        const bool ok = ((g0 >> 32) == (unsigned long long)(unsigned)(c + 1)) && ((g1 >> 32) == (unsigned long long)(unsigned)(c + 1));
                        if (__all(ok)) break;
                        __builtin_amdgcn_s_sleep(2); if (++spins > (1u << 20)) break;
                        g0 = __hip_atomic_load(gb3, RLX_AGENT); g1 = __hip_atomic_load(gb3 + 1, RLX_AGENT);
                    }
                    const float s1 = ps1 + __builtin_bit_cast(float, (unsigned)g0), s2 = ps2 + __builtin_bit_cast(float, (unsigned)g1);
                    const float mean = s1 * (1.f / 64.f), var = fmaxf(s2 * (1.f / 64.f) - mean * mean, 0.f), rstd = rsqrtf(var + 64e-5f);
                    if (lane < 32) {
                        bf16_t* dst = Yb + ((size_t)b * SEQ + c * 32 + t) * DM + h * 64 + rg * 32;
#pragma unroll
                        for (int i = 0; i < 4; ++i) {
                            const f32x4 ya = *(const LAS f32x4*)(YY(yj) + t * 32 + 8 * i), yb = *(const LAS f32x4*)(YY(yj) + t * 32 + 8 * i + 4);
                            const u32x4 q1 = *(const LAS u32x4*)(Q1B(yj) + t * 32 + 8 * i), q2 = *(const LAS u32x4*)(Q2B(yj) + t * 32 + 8 * i);
                            u32x4 w;
                            w.x = cvt_pk_bf16((ya[0] - mean) * rstd * bflo(q1.x) + bflo(q2.x), (ya[1] - mean) * rstd * bfhi(q1.x) + bfhi(q2.x));
                            w.y = cvt_pk_bf16((ya[2] - mean) * rstd * bflo(q1.y) + bflo(q2.y), (ya[3] - mean) * rstd * bfhi(q1.y) + bfhi(q2.y));
                            w.z = cvt_pk_bf16((yb[0] - mean) * rstd * bflo(q1.z) + bflo(q2.z), (yb[1] - mean) * rstd * bfhi(q1.z) + bfhi(q2.z));
                            w.w = cvt_pk_bf16((yb[2] - mean) * rstd * bflo(q1.w) + bflo(q2.w), (yb[3] - mean) * rstd * bfhi(q1.w) + bfhi(q2.w));
                            *(u32x4*)(dst + 8 * i) = w;
                        }
                    }
                }
                ps1 = ns1; ps2 = ns2;
            }
        } else if (it >= 1 && it <= 128) {
            const int c = it - 1, os = c & 1, yj = c & 3, grp = tid >> 4, kq = tid & 15;
            LAS const unsigned char* ob = (LAS const unsigned char*)OPS_RR(os) + kq * 16;
            LAS const unsigned char* vp = (LAS const unsigned char*)VV(os) + grp * 8; LAS unsigned char* yp = (LAS unsigned char*)YY(yj) + grp * 8;
            f32x4 wA, bA, mA, kA, rA, wB, bB, mB, kB, rB; f32x2 vA, vB;
#define RW_LD(X, d) do { r##X = *(const LAS f32x4*)(ob + (d) * 256); w##X = *(const LAS f32x4*)(ob + (d) * 256 + 8192); b##X = *(const LAS f32x4*)(ob + (d) * 256 + 16384); m##X = *(const LAS f32x4*)(ob + (d) * 256 + 24576); \
                k##X = *(const LAS f32x4*)(ob + (d) * 256 + 32768); v##X = *(const LAS f32x2*)(vp + (d) * 128); } while (0)
#define RW_LVL(a_, b_, C) do { a_ += dpp_f<C>(a_); b_ += dpp_f<C>(b_); asm volatile("" : "+v"(a_), "+v"(b_)); } while (0)
#define RW_RED2(x) do { float a_ = x[0], b_ = x[1]; RW_LVL(a_, b_, 0xB1); RW_LVL(a_, b_, 0x4E); RW_LVL(a_, b_, 0x141); RW_LVL(a_, b_, 0x140); x = (f32x2){a_, b_}; } while (0)
#define RW_STEP(X, t) do { f32x2 sa = S2[0] * k##X[0]; sa = S2[1] * k##X[1] + sa; sa = S2[2] * k##X[2] + sa; sa = S2[3] * k##X[3] + sa; RW_RED2(sa); \
                _Pragma("unroll") for (int i = 0; i < 4; ++i) S2[i] = S2[i] * w##X[i] + (sa * b##X[i] + v##X * m##X[i]); \
                f32x2 y = S2[0] * r##X[0]; y = S2[1] * r##X[1] + y; y = S2[2] * r##X[2] + y; y = S2[3] * r##X[3] + y; RW_RED2(y); \
                if (kq == 0) *(LAS f32x2*)(yp + (t) * 128) = y; } while (0)
            RW_LD(A, 0);
#pragma unroll 1
            for (int t = 0; t < 32; t += 2) {
                RW_LD(B, 1); __builtin_amdgcn_sched_barrier(0);
                RW_STEP(A, 0); __builtin_amdgcn_sched_barrier(0);
                if (t == 30) { ob -= 30 * 256; vp -= 30 * 128; }
                RW_LD(A, 2); __builtin_amdgcn_sched_barrier(0);
                RW_STEP(B, 1); __builtin_amdgcn_sched_barrier(0);
                ob += 512; vp += 256; yp += 256;
            }
#undef RW_LD
#undef RW_STEP
#undef RW_RED2
#undef RW_LVL
        }
        WG_BAR();
    }
#undef RW_PREFETCH
#undef RW_PF1
#undef GRP_BAR
#undef OPS_RR
#undef OPS_WW
#undef OPS_BV
#undef OPS_KM
#undef OPS_KK
#undef VV
#undef YY
#undef Q1B
#undef Q2B
}

#define TRI(r, t) ((r) * 72 + (((((t) >> 3) ^ (((r) >> 3) & 7))) << 3) + ((t) & 7))
#define TRB(r, blk) ((r) * 72 + (((blk) ^ (((r) >> 3) & 7)) << 3))
__device__ __forceinline__ void mlstm_item(const Params& P, LAS unsigned char* lds, int bh) {
    const int tid = threadIdx.x, lane = tid & 63, wave = tid >> 6, fr = lane & 15, fq = lane >> 4;
    const int b = bh >> 2, h = bh & 3; unsigned char* ws = P.ws;
    const bf16_t* Z = (const bf16_t*)(ws + OFF_Z); bf16_t* Yb = (bf16_t*)(ws + OFF_Y); const float* IFb = (const float*)(ws + OFF_IF);
    const float* cw = P.in[19]; const float* cb = P.in[20]; const float ib = P.in[21][h], fb = P.in[22][h]; const float* mln = P.in[23];
    LAS bf16_t* Qs = (LAS bf16_t*)(lds); LAS bf16_t* Ks = (LAS bf16_t*)(lds + 17408); LAS bf16_t* KT = (LAS bf16_t*)(lds + 34816); LAS bf16_t* VT = (LAS bf16_t*)(lds + 53248);
    LAS bf16_t* VwT = (LAS bf16_t*)(lds + 71680); LAS bf16_t* Pp = (LAS bf16_t*)(lds + 90112); LAS bf16_t* Cb = (LAS bf16_t*)(lds + 99328);
    LAS float* F = (LAS float*)(lds + 134144);
    LAS float* ga = F, *gu = F + 64, *gwl = F + 128, *gwi = F + 192, *gei = F + 256, *dn = F + 320, *nq = F + 384, *lnx = F + 448  , *ns = F + 704  , *sc = F + 832;
    LAS float* CWL = (LAS float*)(lds + 138240);
    LAS float* CBL = CWL + 1024; LAS float* MLN = CWL + 1280;
    for (int i = tid; i < 1024; i += 512) { const int j = i >> 8, cc = i & 255; CWL[i] = cw[j * 1024 + (cc < 128 ? h * 128 + cc : 512 + h * 128 + cc - 128)]; }
    if (tid < 256) CBL[tid] = cb[tid < 128 ? h * 128 + tid : 512 + h * 128 + tid - 128];
    if (tid < 128) MLN[tid] = mln[h * 128 + tid];
    f32x4 Cacc[8];
#pragma unroll
    for (int i = 0; i < 8; ++i) Cacc[i] = (f32x4){0.f, 0.f, 0.f, 0.f};
    const int pcv = tid & 31, ptg = tid >> 5; const bool pisk = pcv >= 16; const int pc8 = (pcv & 15) * 8;
    const int pzcol = (pisk ? 2304 : 1792) + h * 128 + pc8;
    u32x4 rw[7], vx[2]; u32x2 ogp[4]; float pfb = 0.f, pfu = 0.f, pfp = 0.f, pfe = 0.f, pfm = 0.f;
#define ML_PF_QKV(cn) do { _Pragma("unroll") for (int d = 0; d < 7; ++d) { const int tl = (cn) * 64 + ptg * 4 - 3 + d; rw[d] = (u32x4){0u, 0u, 0u, 0u}; if (tl >= 0) rw[d] = *(const u32x4*)(Z + ((size_t)b * SEQ + tl) * ZLD + pzcol); } \
        _Pragma("unroll") for (int rep = 0; rep < 2; ++rep) { const int v = tid + rep * 512; vx[rep] = *(const u32x4*)(Z + ((size_t)b * SEQ + (cn) * 64 + (v >> 4)) * ZLD + 2816 + h * 128 + (v & 15) * 8); } } while (0)
#define ML_PF_IF(cn) do { if (wave == 0) { pfb = GS[(cn) * 64 + lane]; pfu = GS[4096 + (cn) * 64 + lane]; pfp = GS[8192 + (cn) * 64 + lane]; pfe = GS[12288 + (cn)]; pfm = GS[12352 + (cn)]; } } while (0)
#define ML_PF_OG(cn) do { _Pragma("unroll") for (int q = 0; q < 4; ++q) ogp[q] = *(const u32x2*)(Z + ((size_t)b * SEQ + (cn) * 64 + (wave & 3) * 16 + fr) * ZLD + 3328 + h * 128 + ((wave >> 2) * 4 + q) * 16 + fq * 4); } while (0)
    float* GS = (float*)(ws + OFF_GATES) + (size_t)bh * 12416;
    for (int cc = wave; cc < 64; cc += 8) {
        const size_t tk = (size_t)b * SEQ + cc * 64 + lane;
        const float ig = IFb[tk * 8 + h] + ib, fg = IFb[tk * 8 + 4 + h] + fb;
        const float lf = fminf(fg, 0.f) - __logf(1.f + __expf(-fabsf(fg)));
        float bc = lf;
#pragma unroll
        for (int o = 1; o < 64; o <<= 1) { const float t = __shfl_up(bc, o); if (lane >= o) bc += t; }
        const float bend = __shfl(bc, 63), u = ig - bc;
        float mc = bend + u;
#pragma unroll
        for (int o = 1; o < 64; o <<= 1) mc = fmaxf(mc, __shfl_xor(mc, o));
        float pm = u;
#pragma unroll
        for (int o = 1; o < 64; o <<= 1) { const float t = __shfl_up(pm, o); if (lane >= o) pm = fmaxf(pm, t); }
        GS[cc * 64 + lane] = bc; GS[4096 + cc * 64 + lane] = u; GS[8192 + cc * 64 + lane] = pm;
        if (lane == 0) { GS[12288 + cc] = bend; GS[12352 + cc] = mc; }
    }
    WG_BAR_ALL();
    ML_PF_IF(0); ML_PF_QKV(0); ML_PF_OG(0);
    for (int i = tid; i < 128 * 136 / 2; i += 512) ((LAS unsigned*)Cb)[i] = 0u;
    if (tid < 128) ns[tid] = 0.f;
    float mprev = 0.f;
    WG_BAR();
#pragma unroll 1
    for (int c = 0; c < 64; ++c) {
        int tl_ = threadIdx.x; asm volatile("" : "+v"(tl_));
        const int tid = tl_, lane = tid & 63, wave = tid >> 6, fr = lane & 15, fq = lane >> 4;
        const int pcv = tid & 31, ptg = tid >> 5; const bool pisk = pcv >= 16; const int pc8 = (pcv & 15) * 8;
        const int pzcol = (pisk ? 2304 : 1792) + h * 128 + pc8;
        const size_t tokc = (size_t)b * SEQ + c * 64;
        if (wave == 0) {
            const float bc = pfb, u = pfu, pm = pfp, bend = pfe, mc = pfm;
            ML_PF_IF((c + 1) & 63);
            const float lw = bend + u;
            const float mnew = fmaxf(bend + mprev, mc), dec = __expf(bend + mprev - mnew);
            const float linter = bc + mprev, mrow = fmaxf(linter, bc + pm);
            ga[lane] = bc - mrow; gu[lane] = u; gwl[lane] = __expf(lw - mnew); gwi[lane] = __expf(linter - mrow); gei[lane] = __expf(-mrow); dn[lane] = 0.f;
            if (lane == 0) { sc[0] = dec; sc[1] = mnew; }
        }
        WG_BAR();
        {
            const int tg = ptg; const bool isk = pisk; const int c8 = pc8, lch = (isk ? 128 : 0) + c8;
            float wt[4][8], bs[8];
#pragma unroll
            for (int j = 0; j < 4; ++j) { const f32x4 x0 = *(const LAS f32x4*)(CWL + j * 256 + lch), x1 = *(const LAS f32x4*)(CWL + j * 256 + lch + 4);
#pragma unroll
                for (int i = 0; i < 4; ++i) { wt[j][i] = x0[i]; wt[j][4 + i] = x1[i]; } }
            { const f32x4 x0 = *(const LAS f32x4*)(CBL + lch), x1 = *(const LAS f32x4*)(CBL + lch + 4);
#pragma unroll
              for (int i = 0; i < 4; ++i) { bs[i] = x0[i]; bs[4 + i] = x1[i]; } }
#pragma unroll
            for (int q = 0; q < 4; ++q) {
                const int t = tg * 4 + q; float o[8];
#pragma unroll
                for (int i = 0; i < 8; ++i) o[i] = bs[i];
#pragma unroll
                for (int j = 0; j < 4; ++j) { const u32x4 x = rw[3 + q - j]; const float x8[8] = {bflo(x.x), bfhi(x.x), bflo(x.y), bfhi(x.y), bflo(x.z), bfhi(x.z), bflo(x.w), bfhi(x.w)};
#pragma unroll
                    for (int i = 0; i < 8; ++i) o[i] += wt[j][i] * x8[i]; }
#pragma unroll
                for (int i = 0; i < 8; ++i) { o[i] = o[i] * fsigmoid(o[i]); if (!isk) o[i] *= 0.08838834764831845f; }
                u32x4 w; w.x = cvt_pk_bf16(o[0], o[1]); w.y = cvt_pk_bf16(o[2], o[3]); w.z = cvt_pk_bf16(o[4], o[5]); w.w = cvt_pk_bf16(o[6], o[7]);
                if (!isk) *(LAS u32x4*)(Qs + t * 136 + c8) = w;
                else { *(LAS u32x4*)(Ks + t * 136 + c8) = w;
#pragma unroll
                    for (int i = 0; i < 8; ++i) KT[TRI(c8 + i, t)] = f2bf(o[i]); }
            }
#pragma unroll
            for (int rep = 0; rep < 2; ++rep) {
                const int v = tid + rep * 512, t = v >> 4, v8 = (v & 15) * 8;
                const u32x4 x = vx[rep]; const float wl = gwl[t];
                const float x8[8] = {bflo(x.x), bfhi(x.x), bflo(x.y), bfhi(x.y), bflo(x.z), bfhi(x.z), bflo(x.w), bfhi(x.w)};
#pragma unroll
                for (int i = 0; i < 8; ++i) { VT[TRI(v8 + i, t)] = f2bf(x8[i]); VwT[TRI(v8 + i, t)] = f2bf(x8[i] * wl); }
            }
            if (c < 63) ML_PF_QKV(c + 1);
        }
        WG_BAR();
        const int st = wave & 3;
        bf16x8 qf[4];
#pragma unroll
        for (int ks = 0; ks < 4; ++ks) qf[ks] = *(const LAS bf16x8*)(Qs + (st * 16 + fr) * 136 + ks * 32 + fq * 8);
        {
            const int s = st * 16 + fr; const float gas = ga[s]; float dsum = 0.f;
#pragma unroll
            for (int q = 0; q < 2; ++q) {
                const int rt = (wave >> 2) * 2 + q; f32x4 a = (f32x4){0.f, 0.f, 0.f, 0.f};
#pragma unroll
                for (int ks = 0; ks < 4; ++ks) { const bf16x8 kf = *(const LAS bf16x8*)(Ks + (rt * 16 + fr) * 136 + ks * 32 + fq * 8); a = __builtin_amdgcn_mfma_f32_16x16x32_bf16(kf, qf[ks], a, 0, 0, 0); }
                const int r0 = rt * 16 + fq * 4; float p[4];
#pragma unroll
                for (int j = 0; j < 4; ++j) { p[j] = (r0 + j <= s) ? __expf(gas + gu[r0 + j]) * a[j] : 0.f; dsum += p[j]; }
                u32x2 w; w.x = cvt_pk_bf16(p[0], p[1]); w.y = cvt_pk_bf16(p[2], p[3]); *(LAS u32x2*)(Pp + s * 72 + r0) = w;
            }
            dsum += __shfl_xor(dsum, 16); dsum += __shfl_xor(dsum, 32);
            if (fq == 0) __hip_atomic_fetch_add(dn + s, dsum, __ATOMIC_RELAXED, __HIP_MEMORY_SCOPE_WORKGROUP);
            const int s2 = tid >> 3, kq = tid & 7; float a = 0.f;
#pragma unroll
            for (int i = 0; i < 16; ++i) a += ns[kq * 16 + i] * bf2f(Qs[s2 * 136 + kq * 16 + i]);
            a = red8(a); if (kq == 0) nq[s2] = a;
        }
        WG_BAR();
        {
            const int s = st * 16 + fr, vh = wave >> 2; const float wi = gwi[s];
            const float den = dn[s] + wi * nq[s], dinv = 1.f / fmaxf(fabsf(den), gei[s]);
            bf16x8 pf[2];
#pragma unroll
            for (int ks = 0; ks < 2; ++ks) pf[ks] = *(const LAS bf16x8*)(Pp + s * 72 + ks * 32 + fq * 8);
            f32x4 hv[4]; float s1 = 0.f, s2 = 0.f;
#pragma unroll
            for (int q = 0; q < 4; ++q) {
                const int vt = vh * 4 + q; f32x4 a = (f32x4){0.f, 0.f, 0.f, 0.f};
#pragma unroll
                for (int ks = 0; ks < 4; ++ks) { const bf16x8 cf = *(const LAS bf16x8*)(Cb + (vt * 16 + fr) * 136 + ks * 32 + fq * 8); a = __builtin_amdgcn_mfma_f32_16x16x32_bf16(cf, qf[ks], a, 0, 0, 0); }
                a = a * wi;
#pragma unroll
                for (int ks = 0; ks < 2; ++ks) { const bf16x8 vf = *(const LAS bf16x8*)(VT + TRB(vt * 16 + fr, ks * 4 + fq)); a = __builtin_amdgcn_mfma_f32_16x16x32_bf16(vf, pf[ks], a, 0, 0, 0); }
                a = a * dinv; hv[q] = a;
#pragma unroll
                for (int j = 0; j < 4; ++j) { s1 += a[j]; s2 += a[j] * a[j]; }
            }
            s1 += __shfl_xor(s1, 16); s1 += __shfl_xor(s1, 32); s2 += __shfl_xor(s2, 16); s2 += __shfl_xor(s2, 32);
            if (fq == 0) { lnx[s * 4 + vh * 2] = s1; lnx[s * 4 + vh * 2 + 1] = s2; }
            WG_BAR();
            const f32x4 l4 = *(const LAS f32x4*)(lnx + s * 4);
            const float mean = (l4[0] + l4[2]) * (1.f / 128.f), var = fmaxf((l4[1] + l4[3]) * (1.f / 128.f) - mean * mean, 0.f), rstd = rsqrtf(var + 1e-6f);
            const size_t tok = tokc + s;
#pragma unroll
            for (int q = 0; q < 4; ++q) {
                const int v0 = (vh * 4 + q) * 16 + fq * 4;
                const u32x2 og = ogp[q]; const f32x4 g4 = *(const LAS f32x4*)(MLN + v0);
                const float o0 = (hv[q][0] - mean) * rstd * g4[0] * fsigmoid(bflo(og.x)), o1 = (hv[q][1] - mean) * rstd * g4[1] * fsigmoid(bfhi(og.x));
                const float o2 = (hv[q][2] - mean) * rstd * g4[2] * fsigmoid(bflo(og.y)), o3 = (hv[q][3] - mean) * rstd * g4[3] * fsigmoid(bfhi(og.y));
                u32x2 w; w.x = cvt_pk_bf16(o0, o1); w.y = cvt_pk_bf16(o2, o3);
                *(u32x2*)(Yb + tok * DM + 512 + h * 128 + v0) = w;
            }
            if (c < 63) ML_PF_OG(c + 1);
        }
        WG_BAR();
        {
            const float dec = sc[0];
            bf16x8 vf[2];
#pragma unroll
            for (int ks = 0; ks < 2; ++ks) vf[ks] = *(const LAS bf16x8*)(VwT + TRB(wave * 16 + fr, ks * 4 + fq));
#pragma unroll
            for (int kt = 0; kt < 8; ++kt) {
                f32x4 a = Cacc[kt] * dec;
#pragma unroll
                for (int ks = 0; ks < 2; ++ks) { const bf16x8 kf = *(const LAS bf16x8*)(KT + TRB(kt * 16 + fr, ks * 4 + fq)); a = __builtin_amdgcn_mfma_f32_16x16x32_bf16(kf, vf[ks], a, 0, 0, 0); }
                Cacc[kt] = a;
                u32x2 w; w.x = cvt_pk_bf16(a[0], a[1]); w.y = cvt_pk_bf16(a[2], a[3]);
                *(LAS u32x2*)(Cb + (wave * 16 + fr) * 136 + kt * 16 + fq * 4) = w;
            }
            if (tid < 128) { float a = ns[tid] * dec;
                for (int l = 0; l < 64; ++l) a += gwl[l] * bf2f(Ks[l * 136 + tid]);
                ns[tid] = a; }
            mprev = sc[1];
        }
        WG_BAR();
    }
#undef ML_PF_QKV
#undef ML_PF_IF
#undef ML_PF_OG
}

struct SchedKV {
    const char* memb; const char* wk; const char* wv; int j;
    __device__ __forceinline__ bool next(int i, Unit& u) const {
        if (i != 0 || j < 0 || j >= 64) return false;
        const size_t ts = (size_t)256 * 1024 * 2;
        if (j < 32) { u.pm = j >> 2; u.pn = j & 3; u.A = memb + u.pm * ts; u.B = wk + u.pn * ts; u.tag = 0; }
        else { const int q = j - 32; u.pm = q >> 3; u.pn = q & 7; u.A = wv + u.pm * ts; u.B = memb + u.pn * ts; u.tag = 1; }
        u.nt = 16; return true;
    }
};
struct SchedMerge {
    const char* yb; const char* wup; int c;
    __device__ __forceinline__ bool next(int i, Unit& u) const {
        if (i >= 4) return false;
        const int T = c + 256 * (i >> 1), pass = i & 1; u.pm = T >> 2; u.pn = T & 3; u.tag = pass ? 3 : 1; u.nt = 8;
        const size_t ts = (size_t)256 * 1024 * 2;
        u.A = yb + u.pm * ts + pass * 1024; u.B = wup + u.pn * ts + pass * 1024;
        return true;
    }
};
struct SchedGate {
    const char* xb; const char* wg; int j0;
    __device__ __forceinline__ bool next(int i, Unit& u) const {
        const int j = j0 + 96 * i; if (j >= 1024) return false;
        u.pm = j >> 3; u.pn = j & 7; u.nt = 16; u.tag = 0;
        const size_t ts = (size_t)256 * 1024 * 2;
        u.A = xb + u.pm * ts; u.B = wg + u.pn * ts;
        return true;
    }
};
struct SchedAttn {
    const char* xb; const char* wq; const char* q; const char* p; const char* kb; const char* vt; int c;
    __device__ __forceinline__ bool next(int i, Unit& u) const {
        if (i >= 6) return false;
        const int pr = c + 256 * (i & 1), b = pr >> 6, h = (pr >> 4) & 3, qt = pr & 15, st = i >> 1;
        u.pm = b * 16 + qt; u.pn = h;
        const size_t ao = ((size_t)u.pm * 256 * 1024 + h * 256) * 2;
        if (st == 0) { u.A = xb + (size_t)u.pm * 256 * 1024 * 2; u.B = wq + (size_t)h * 256 * 1024 * 2; u.nt = 16; u.tag = 2; }
        else if (st == 1) { u.A = q + ao; u.B = kb + ((size_t)b * 256 * 1024 + h * 256) * 2; u.nt = 4; u.tag = 0; }
        else { u.A = p + ao; u.B = vt + (size_t)(b >> 2) * 2097152 + ((size_t)h * 256 * 1024 + (b & 3) * 256) * 2; u.nt = 4; u.tag = 1; }
        return true;
    }
};

#define XB_TMO      128
#define XB_XCNT(j)  (256  + 64 * (j))
#define XB_XSUB(j)  (1280 + 64 * (j))
#define XB_XGEN(j)  (2304 + 64 * (j))
#define XB_TOP      3328
#define XB_TOPGEN   3392
#define XCD_BAR_WORDS 3456
#define XB_SPIN_CAP (1u << 18)
__device__ __forceinline__ unsigned xb_ld(unsigned* p)              { return __hip_atomic_load(p, __ATOMIC_RELAXED, __HIP_MEMORY_SCOPE_AGENT); }
__device__ __forceinline__ unsigned xb_add(unsigned* p, unsigned v) { return __hip_atomic_fetch_add(p, v, __ATOMIC_RELAXED, __HIP_MEMORY_SCOPE_AGENT); }
__device__ __forceinline__ unsigned xb_xcc_id() { return (unsigned)__builtin_amdgcn_s_getreg((3 << 11) | 20) & 0xFu; }
#define XB_SPIN(cond, bar) do { unsigned _sp = 0; while (cond) { __builtin_amdgcn_s_sleep(1); \
    if ((++_sp & 255u) == 0u) { if (xb_ld(&(bar)[XB_TMO])) break; if (_sp > XB_SPIN_CAP) { atomicAdd(&(bar)[XB_TMO], 1u); break; } } } } while (0)
struct XcdBarrier { unsigned* bar; unsigned x; volatile LAS unsigned* st; };
__device__ __forceinline__ XcdBarrier xcd_barrier_post(unsigned* bar, volatile LAS unsigned* st) {
    XcdBarrier b; b.bar = bar; b.x = xb_xcc_id(); b.st = st;
    if (threadIdx.x == 0) (void)xb_add(&bar[XB_XCNT(b.x)], 1u);
    return b;
}
__device__ __forceinline__ void xcd_barrier_complete(unsigned* bar, unsigned x, unsigned& nloc, unsigned& nx) {
    const unsigned G = gridDim.x * gridDim.y * gridDim.z;
    unsigned sum, cnt, mine, sp = 0u;
    for (;;) {
        sum = 0u; cnt = 0u; mine = 0u;
#pragma unroll
        for (unsigned j = 0; j < 16; ++j) { const unsigned c = xb_ld(&bar[XB_XCNT(j)]); sum += c; cnt += (c > 0u) ? 1u : 0u; mine = (j == x) ? c : mine; }
        if (sum == G) break;
        __builtin_amdgcn_s_sleep(1);
        if ((++sp & 255u) == 0u) { if (xb_ld(&bar[XB_TMO])) break; if (sp > XB_SPIN_CAP) { atomicAdd(&bar[XB_TMO], 1u); break; } }
    }
    nloc = mine > 0u ? mine : 1u; nx = cnt > 0u ? cnt : 1u;
}
__device__ __forceinline__ void xcd_barrier(const XcdBarrier& b) {
    asm volatile("s_waitcnt vmcnt(0)" ::: "memory");
    __syncthreads();
    if (threadIdx.x == 0) {
        unsigned* bar = b.bar;
        __builtin_amdgcn_s_waitcnt(0);
        unsigned nloc = b.st[0], nx = b.st[1];
        if (nloc == 0u) { xcd_barrier_complete(bar, b.x, nloc, nx); b.st[0] = nloc; b.st[1] = nx; }
        const unsigned old = xb_add(&bar[XB_XSUB(b.x)], 1u);
        const unsigned gen = old / nloc;
        if (old + 1u == (gen + 1u) * nloc) {
            __builtin_amdgcn_fence(__ATOMIC_RELEASE, "agent");
            asm volatile("s_waitcnt vmcnt(0)" ::: "memory");
            const unsigned og = xb_add(&bar[XB_TOP], 1u);
            const unsigned tg = og / nx;
            if (og + 1u == (tg + 1u) * nx) xb_add(&bar[XB_TOPGEN], 1u);
            else XB_SPIN(xb_ld(&bar[XB_TOPGEN]) == tg, bar);
            __builtin_amdgcn_fence(__ATOMIC_ACQUIRE, "agent");
            xb_add(&bar[XB_XGEN(b.x)], 1u);
            asm volatile("s_waitcnt vmcnt(0)" ::: "memory");
        } else {
            XB_SPIN(xb_ld(&bar[XB_XGEN(b.x)]) == gen, bar);
            __builtin_amdgcn_fence(__ATOMIC_ACQUIRE, "agent");
            asm volatile("s_waitcnt vmcnt(0)" ::: "memory");
        }
    }
    __syncthreads();
}

__global__ void __launch_bounds__(512, 2) mega(Params P) {
    extern __shared__ __attribute__((aligned(16))) unsigned char smem[];
    LAS unsigned char* lds = (LAS unsigned char*)smem;
    unsigned char* ws = P.ws;
    const int G = gridDim.x, c = blockIdx.x, lo = P.ph_lo, hi = P.ph_hi;
    float* ssq0 = (float*)(ws + OFF_SSQ0); float* ssq1 = (float*)(ws + OFF_SSQ1); float* ssq2 = (float*)(ws + OFF_SSQ2); float* ssq3 = (float*)(ws + OFF_SSQ3); float* ssq4 = (float*)(ws + OFF_SSQ4);
    bf16_t* XB = (bf16_t*)(ws + OFF_XB); bf16_t* U = (bf16_t*)(ws + OFF_U);
#ifdef ONLY_PHASE
#define IN(k) ((k) == ONLY_PHASE && lo <= (k) && (k) < hi)
#else
#define IN(k) (lo <= (k) && (k) < hi)
#endif
    volatile LAS unsigned* bst = (volatile LAS unsigned*)(lds + 163776);
    if (threadIdx.x < 2) bst[threadIdx.x] = 0u;
    __syncthreads();
    XcdBarrier xbar; xbar.bar = (unsigned*)(ws + OFF_BARW); xbar.x = 0; xbar.st = bst;
    if (P.coop) xbar = xcd_barrier_post((unsigned*)(ws + OFF_BARW), bst);
    if (P.ph_hi > NPHASE) cg::this_grid().sync();
#define SEAM(k) do { if (P.coop && IN(k) && IN((k) + 1)) xcd_barrier(xbar); } while (0)
    const size_t TS1 = (size_t)256 * 1024 * 2, TSF = (size_t)256 * DFF * 2;

    if (IN(0)) { phase_prep(P, lds); }
    SEAM(0);
    if (IN(1)) {
        SchedStatic S{(const char*)XB, (const char*)(ws + OFF_WGU1), TS1, 128, 22, 16, G, c}; EpiSwiglu E{U, ssq0};
        gemm_phase(lds, 1024, S, E);
    }
    SEAM(1);
    if (IN(2)) {
        SchedStatic S{(const char*)U, (const char*)(ws + OFF_WD1), TSF, 128, 4, 44, G, c}; EpiResidX<1> E{P.in[0], nullptr, XB, ssq1, 0.5f};
        gemm_phase(lds, DFF, S, E);
    }
    SEAM(2);
    if (IN(3)) {
        SchedStatic S{(const char*)XB, (const char*)(ws + OFF_WIN), TS1, 128, 16, 16, G, c}; EpiRowScale<0> E{(bf16_t*)(ws + OFF_Z), ssq1, (float*)(ws + OFF_IF)};
        gemm_phase(lds, 1024, S, E);
    }
    SEAM(3);
    if (IN(4)) {
        if (c < 128) rwkv_item(P, lds, c);
        else if (c < 160) mlstm_item(P, lds, c - 128);
        else {
            if (c < 224) { SchedKV S{(const char*)(ws + OFF_MEMB), (const char*)(ws + OFF_WK), (const char*)(ws + OFF_WV), c - 160}; EpiKV E{(bf16_t*)(ws + OFF_KB), (bf16_t*)(ws + OFF_VT), (const float*)(ws + OFF_SSQM)};
                gemm_phase(lds, 1024, S, E); }
            {
                SchedGate S{(const char*)XB, (const char*)(ws + OFF_WG), c >= 224 ? c - 224 : c - 128}; EpiGate E{(bf16_t*)P.out, (bf16_t*)P.out + (size_t)NTOK * DM, ssq1};
                gemm_phase(lds, 1024, S, E); }
            const int wv_ = threadIdx.x >> 6, ln_ = threadIdx.x & 63; LAS float* scr = (LAS float*)(lds + wv_ * 16384);
            for (int it = P.nearly + (c - 160) * 8 + wv_; it < P.nitems; it += 96 * 8) {
                int j = 0;
                while (j + 1 < P.njobs && it >= P.jobs[j + 1].item0) ++j;
                transpose_item(P.jobs[j], it - P.jobs[j].item0, scr, ln_);
            }
        }
    }
    SEAM(4);
    if (IN(5)) {
        SchedMerge S{(const char*)(ws + OFF_Y), (const char*)(ws + OFF_WUP), c};
        EpiMerge2 E{(u32x4*)(ws + OFF_SCRS) + (size_t)c * 8192, (bf16_t*)(ws + OFF_MG), (const bf16_t*)P.out, (const bf16_t*)P.out + (size_t)NTOK * DM};
        if (c < 256) gemm_phase(lds, 1024, S, E);
    }
    SEAM(5);
    if (IN(6)) {
        SchedStatic S{(const char*)(ws + OFF_MG), (const char*)(ws + OFF_WOUT), TS1, 128, 4, 16, G, c}; EpiResidX<2> E{nullptr, P.out, XB, ssq2, 1.0f};
        gemm_phase(lds, 1024, S, E);
    }
    SEAM(6);
    if (IN(8)) {
        SchedAttn S{(const char*)XB, (const char*)(ws + OFF_WQ), (const char*)(ws + OFF_Q), (const char*)(ws + OFF_P), (const char*)(ws + OFF_KB), (const char*)(ws + OFF_VT), c};
        EpiAttn E{(bf16_t*)(ws + OFF_P), (bf16_t*)(ws + OFF_O), (bf16_t*)(ws + OFF_Q), ssq2};
        if (c < 256) gemm_phase(lds, 1024, S, E);
    }
    SEAM(8);
    if (IN(9)) {
        SchedStatic S{(const char*)(ws + OFF_O), (const char*)(ws + OFF_WO), TS1, 128, 4, 16, G, c}; EpiResid<true> E{P.out, P.out, XB, ssq3, 1.0f};
        gemm_phase(lds, 1024, S, E);
    }
    SEAM(9);
    if (IN(10)) {
        SchedStatic S{(const char*)XB, (const char*)(ws + OFF_WGU2), TS1, 128, 22, 16, G, c}; EpiSwiglu E{U, ssq3};
        gemm_phase(lds, 1024, S, E);
    }
    SEAM(10);
    if (IN(11)) {
        SchedStatic S{(const char*)U, (const char*)(ws + OFF_WD2), TSF, 128, 4, 44, G, c}; EpiResid<false> E{P.out, P.out, nullptr, ssq4, 0.5f};
        gemm_phase(lds, DFF, S, E);
    }
    SEAM(11);
    if (IN(12)) {
        const int lane = threadIdx.x & 63, gw = c * 8 + (threadIdx.x >> 6), NGW = G * 8; const float* fn = P.in[36];
        f32x4 g4[4];
#pragma unroll
        for (int j = 0; j < 4; ++j) g4[j] = *((const f32x4*)fn + lane + 64 * j);
        for (int m = gw * 4; m < NTOK; m += NGW * 4) {
            f32x4 v[4][4]; float rs[4];
#pragma unroll
            for (int r = 0; r < 4; ++r) { rs[r] = rsqrtf(ssq4[m + r] * (1.f / 1024.f) + NORM_EPS);
#pragma unroll
                for (int j = 0; j < 4; ++j) v[r][j] = ((const f32x4*)(P.out + (size_t)(m + r) * DM) + lane)[64 * j]; }
#pragma unroll
            for (int r = 0; r < 4; ++r)
#pragma unroll
                for (int j = 0; j < 4; ++j) ((f32x4*)(P.out + (size_t)(m + r) * DM) + lane)[64 * j] = v[r][j] * rs[r] * g4[j];
        }
    }
#undef IN
#undef SEAM
}

#ifdef MK_DBG_DUMP
__global__ void dbg_dump(const bf16_t* src, int ld, int mode, float* out) {
    const size_t i = (size_t)blockIdx.x * 256 + threadIdx.x; const size_t r = i >> 10; const int c = (int)(i & 1023);
    float v = bf2f(src[r * ld + c]);
    if (mode == 1) v += 2.f * bf2f(src[r * ld + c + 1024]) + 3.f * bf2f(src[r * ld + c + 2048]) + 5.f * bf2f(src[r * ld + c + 2816]);
    if (mode == 4) v = ((const float*)src)[i & 262143];
    if (mode == 2 && c >= 512) v = 0.f;
    if (mode == 3 && c < 512) v = 0.f;
    out[i] = v;
}
#endif
static void add_job(Params& p, const float* src, const float* gain, size_t dst_off, int K, int ldsrc, int col0, int ncols, int dst_ld, int dst_row0, int dst_k0, int mode, float scale) {
    TJob& j = p.jobs[p.njobs++]; j.src = src; j.gain = gain; j.dst = (bf16_t*)(p.ws + dst_off); j.K = K; j.ldsrc = ldsrc; j.col0 = col0; j.ncols = ncols; j.dst_ld = dst_ld; j.dst_row0 = dst_row0; j.dst_k0 = dst_k0;
    j.mode = mode; j.scale = scale; j.item0 = p.nitems; p.nitems += (K / 64) * ((ncols + 63) / 64);
}
extern "C" void kernel_launch(void* const* d_in, const int* in_sizes, int n_in, void* d_out, int out_size, void* d_ws, size_t ws_size, hipStream_t stream) {
    static int ready = 0;
    if (ready == 0) {
        if (n_in != 37 || out_size != NTOK * DM || ws_size < WS_END) { fprintf(stderr, "kernel_launch: unexpected shapes: n_in %d out %d ws %zu (need %zu); nothing launched\n", n_in, out_size, ws_size, (size_t)WS_END); ready = -1; return; }
        if (hipFuncSetAttribute((const void*)mega, hipFuncAttributeMaxDynamicSharedMemorySize, LDS_BYTES) != hipSuccess) { fprintf(stderr, "kernel_launch: hipFuncSetAttribute failed\n"); ready = -1; return; }
        int per_cu = 0; (void)hipOccupancyMaxActiveBlocksPerMultiprocessor(&per_cu, (const void*)mega, 512, LDS_BYTES); (void)hipGetLastError();
        if (per_cu < 1) fprintf(stderr, "kernel_launch: note: occupancy query says %d blocks per CU\n", per_cu);
        ready = 1;
    }
    if (ready < 0) return;
    Params p; memset(&p, 0, sizeof(p));
    for (int i = 0; i < 37; ++i) p.in[i] = (const float*)d_in[i];
    p.out = (float*)d_out; p.ws = (unsigned char*)d_ws;
    const float* const* in = p.in;
    add_job(p, in[3], in[2], OFF_WGU1, 1024, DFF, 0, DFF, 1024, 0, 0, 1, 1.f);
    add_job(p, in[4], in[2], OFF_WGU1, 1024, DFF, 0, DFF, 1024, 128, 0, 1, 1.f);
    add_job(p, in[5], nullptr, OFF_WD1, DFF, 1024, 0, 1024, DFF, 0, 0, 0, 1.f);
    add_job(p, in[7], in[6], OFF_WIN, 1024, 5896, 0, 3848, 1024, 0, 0, 0, 1.f);
    add_job(p, in[30], in[28], OFF_WK, 1024, 2048, 0, 1024, 1024, 0, 0, 0, 1.f);
    add_job(p, in[30], in[28], OFF_WV, 1024, 2048, 1024, 1024, 1024, 0, 0, 0, 1.f);
    add_job(p, in[10], nullptr, OFF_W2T, 64, 512, 0, 512, 64, 0, 0, 0, 1.f);
    add_job(p, in[12], nullptr, OFF_A2T, 64, 512, 0, 512, 64, 0, 0, 0, 1.f);
    add_job(p, in[13], nullptr, OFF_G2T, 128, 512, 0, 512, 128, 0, 0, 0, 1.f);
    add_job(p, in[7], in[6], OFF_WG, 1024, 5896, 3848, 2048, 1024, 0, 0, 0, 1.f);
    p.nearly = p.nitems;
    add_job(p, in[24], nullptr, OFF_WUP, 512, 1024, 0, 1024, 1024, 0, 0, 0, 1.f);
    add_job(p, in[25], nullptr, OFF_WUP, 512, 1024, 0, 1024, 1024, 0, 512, 0, 1.f);
    add_job(p, in[26], nullptr, OFF_WOUT, 1024, 1024, 0, 1024, 1024, 0, 0, 0, 1.f);
    add_job(p, in[29], in[27], OFF_WQ, 1024, 1024, 0, 1024, 1024, 0, 0, 0, 0.0625f);
    add_job(p, in[31], nullptr, OFF_WO, 1024, 1024, 0, 1024, 1024, 0, 0, 0, 1.f);
    add_job(p, in[33], in[32], OFF_WGU2, 1024, DFF, 0, DFF, 1024, 0, 0, 1, 1.f);
    add_job(p, in[34], in[32], OFF_WGU2, 1024, DFF, 0, DFF, 1024, 128, 0, 1, 1.f);
    add_job(p, in[35], nullptr, OFF_WD2, DFF, 1024, 0, 1024, DFF, 0, 0, 0, 1.f);
    const int grid = 256;
#if MK_PER_PHASE
    p.coop = 0;
    for (int ph = 0; ph < MK_DBG_HI; ++ph) { p.ph_lo = ph; p.ph_hi = ph + 1; hipLaunchKernelGGL(mega, dim3(grid), dim3(512), LDS_BYTES, stream, p); }
#ifdef MK_DBG_DUMP
    hipLaunchKernelGGL(dbg_dump, dim3(NTOK * 4), dim3(256), 0, stream, (const bf16_t*)(p.ws + MK_DBG_DUMP), MK_DBG_LD, MK_DBG_MODE, p.out);
#endif
#else
    p.coop = 1; p.ph_lo = 0; p.ph_hi = NPHASE;
    if (hipMemsetAsync((char*)d_ws + OFF_BARW, 0, XCD_BAR_WORDS * 4, stream) != hipSuccess) { fprintf(stderr, "kernel_launch: hipMemsetAsync failed\n"); return; }
    void* args[] = {&p};
    hipError_t e = hipLaunchCooperativeKernel((const void*)mega, dim3(grid), dim3(512), args, LDS_BYTES, stream);
    if (e != hipSuccess) fprintf(stderr, "kernel_launch: cooperative launch failed: %s\n", hipGetErrorString(e));
#endif
}
```

```cpp
#include <hip/hip_runtime.h>
#include <hip/hip_cooperative_groups.h>
#include <cstdio>
#include <cstdint>
#include <cstring>
namespace cg = cooperative_groups;

#define LAS __attribute__((address_space(3)))
typedef unsigned short bf16_t;
typedef short bf16x8 __attribute__((ext_vector_type(8)));
typedef float f32x4 __attribute__((ext_vector_type(4)));
typedef float f32x2 __attribute__((ext_vector_type(2)));
typedef unsigned u32x4 __attribute__((ext_vector_type(4)));
typedef unsigned u32x2 __attribute__((ext_vector_type(2)));

#ifndef MK_DBG_HI
#define MK_DBG_HI 13
#endif
#ifndef MK_PER_PHASE
#define MK_PER_PHASE 0
#endif

constexpr int NTOK = 32768, DM = 1024, SEQ = 4096, NB = 8, DFF = 2816, MEMTOK = 2048;
constexpr int ZLD = 3840;
constexpr float NORM_EPS = 1e-5f;
constexpr int NPHASE = 13;
constexpr int LDS_BYTES = 160 * 1024;
constexpr int XCH_OFF = 131072;

constexpr size_t MiB = 1048576;
constexpr size_t OFF_SSQ0 = 0, OFF_SSQ1 = 131072, OFF_SSQ2 = 262144, OFF_SSQ3 = 393216, OFF_SSQ4 = 524288, OFF_SSQM = 655360;
constexpr size_t OFF_IF = 1 * MiB;
constexpr size_t OFF_FNG = 452 * MiB;
constexpr size_t OFF_GATES = 2 * MiB;
constexpr size_t OFF_BARW = 720896;
constexpr size_t OFF_STATS = 444 * MiB;
constexpr size_t OFF_W = 4 * MiB;
constexpr size_t SZ_WGU = (size_t)5632 * 1024 * 2, SZ_WD = (size_t)1024 * 2816 * 2, SZ_WIN = (size_t)4096 * 1024 * 2, SZ_WG = (size_t)2048 * 1024 * 2, SZ_SQ = (size_t)1024 * 1024 * 2;
constexpr size_t OFF_WGU1 = OFF_W, OFF_WD1 = OFF_WGU1 + SZ_WGU, OFF_WIN = OFF_WD1 + SZ_WD, OFF_WG = OFF_WIN + SZ_WIN, OFF_WUP = OFF_WG + SZ_WG, OFF_WOUT = OFF_WUP + SZ_SQ,
                 OFF_WQ = OFF_WOUT + SZ_SQ, OFF_WK = OFF_WQ + SZ_SQ, OFF_WV = OFF_WK + SZ_SQ, OFF_WO = OFF_WV + SZ_SQ, OFF_WGU2 = OFF_WO + SZ_SQ, OFF_WD2 = OFF_WGU2 + SZ_WGU,
                 OFF_W2T = OFF_WD2 + SZ_WD, OFF_A2T = OFF_W2T + 65536, OFF_G2T = OFF_A2T + 65536, OFF_WEND = OFF_G2T + 131072;
static_assert(OFF_WEND <= 64 * MiB, "weights");
constexpr size_t OFF_XB = 64 * MiB, OFF_Y = 128 * MiB, OFF_MEMB = 192 * MiB, OFF_KB = 196 * MiB, OFF_VT = 200 * MiB, OFF_BIG = 204 * MiB, WS_END = 460 * MiB;
constexpr size_t OFF_U = OFF_BIG, OFF_Z = OFF_BIG, OFF_SCRS = OFF_BIG, OFF_SCRM = OFF_BIG + 32 * MiB, OFF_MG = OFF_BIG + 96 * MiB, OFF_Q = OFF_BIG, OFF_P = OFF_BIG + 64 * MiB, OFF_O = OFF_BIG + 128 * MiB;

typedef __bf16 bf16x2_t __attribute__((ext_vector_type(2)));
__device__ __forceinline__ unsigned cvt_pk_bf16(float lo, float hi) { f32x2 v = {lo, hi}; bf16x2_t b = __builtin_convertvector(v, bf16x2_t); return __builtin_bit_cast(unsigned, b); }
__device__ __forceinline__ float bflo(unsigned u) { return __builtin_bit_cast(float, u << 16); }
__device__ __forceinline__ float bfhi(unsigned u) { return __builtin_bit_cast(float, u & 0xffff0000u); }
__device__ __forceinline__ float bf2f(bf16_t b) { return __builtin_bit_cast(float, (unsigned)b << 16); }
__device__ __forceinline__ bf16_t f2bf(float f) { return (bf16_t)(cvt_pk_bf16(f, 0.f) & 0xffffu); }
__device__ __forceinline__ float fsigmoid(float x) { return __builtin_amdgcn_rcpf(1.f + __expf(-x)); }
__device__ __forceinline__ float wave_sum(float v) {
#pragma unroll
    for (int o = 1; o < 64; o <<= 1) v += __shfl_xor(v, o);
    return v;
}
template <int CTRL> __device__ __forceinline__ float dpp_f(float x) { return __builtin_bit_cast(float, __builtin_amdgcn_update_dpp(0, __builtin_bit_cast(int, x), CTRL, 0xF, 0xF, true)); }
__device__ __forceinline__ float red8(float x) {
    x += dpp_f<0xB1>(x); x += dpp_f<0x4E>(x); x += dpp_f<0x141>(x); return x;
}
#define LDS_WAIT() asm volatile("s_waitcnt lgkmcnt(0)" ::: "memory")
#define WG_BAR() do { asm volatile("s_waitcnt lgkmcnt(0)" ::: "memory"); __builtin_amdgcn_s_barrier(); asm volatile("" ::: "memory"); } while (0)
#define WG_BAR_ALL() do { asm volatile("s_waitcnt vmcnt(0) lgkmcnt(0)" ::: "memory"); __builtin_amdgcn_s_barrier(); asm volatile("" ::: "memory"); } while (0)

constexpr int BM = 256, BK = 64, HALF = 128, HTB = HALF * BK * 2;
__host__ __device__ __forceinline__ int lds_byte(int r, int c) { const int st = (r >> 4) * 2 + (c >> 5), rr = r & 15, cc = c & 31, ob = rr * 64 + cc * 2; return st * 1024 + (ob ^ (((ob >> 9) & 1) << 5)); }
__host__ __device__ __forceinline__ void stage_rc(int b, int& R, int& C) { const int st = b / 1024, sb = b % 1024, swz = sb ^ (((sb >> 9) & 1) << 5); R = (st >> 1) * 16 + swz / 64; C = (st & 1) * 32 + (swz % 64) / 2; }
__host__ __device__ __forceinline__ int perm32(int rho) { const int n = rho >> 4, i = rho & 15; return 8 * (i >> 2) + 4 * n + (i & 3); }

struct Unit { const char* A; const char* B; int nt, pm, pn, tag; };

__device__ __forceinline__ void tile_of(int L, int nM, int nN, int& pm, int& pn) {
    const int nwg = nM * nN; int wgid = L;
    { const int q = nwg / 8, r = nwg % 8, xcd = wgid % 8, off = wgid / 8; wgid = (xcd < r ? xcd * (q + 1) : r * (q + 1) + (xcd - r) * q) + off; }
    const int nig = 8 * nN, gid = wgid / nig, fm = gid * 8, gsz = (nM - fm) < 8 ? (nM - fm) : 8;
    pm = fm + ((wgid % nig) % gsz); pn = (wgid % nig) / gsz;
}
struct SchedStatic {
    const char* A; const char* B; size_t tstep; int nM, nN, nt, G, c;
    __device__ __forceinline__ bool next(int i, Unit& u) const {
        const long L = (long)i * G + c; if (L >= (long)nM * nN) return false;
        int pm, pn; tile_of((int)L, nM, nN, pm, pn);
        u.A = A + (size_t)pm * tstep; u.B = B + (size_t)pn * tstep; u.nt = nt; u.pm = pm; u.pn = pn; u.tag = 0; return true;
    }
};

template <class Epi, class Sched>
__device__ __forceinline__ void gemm_phase(LAS unsigned char* lds, const int ld, const Sched& S, const Epi& E) {
    const int tid = threadIdx.x, wid = __builtin_amdgcn_readfirstlane(tid >> 6), lane = tid & 63, wr = wid >> 2, wc = wid & 3, fr = lane & 15, fq = lane >> 4;
    unsigned voffA[2], voffB[2];
#pragma unroll
    for (int i = 0; i < 2; ++i) { int R, C; stage_rc(tid * 16 + i * 8192, R, C); const int Rb = (R & ~31) + perm32(R & 31);
        voffA[i] = (unsigned)(R * ld + C) * 2u; voffB[i] = (unsigned)(Rb * ld + C) * 2u; }
    const size_t kstep = (size_t)(BK * 2);
    const size_t hstep = (size_t)HALF * ld * 2;
    const unsigned ldsw = (unsigned)wid * 1024u;
    const int aoff = lds_byte(wr * 64 + fr, fq * 8), boff = lds_byte(wc * 32 + fr, fq * 8);
#define PG8_SA(b, h) (((b) * 2 + (h)) * HTB)
#define PG8_SB(b, h) ((4 + (b) * 2 + (h)) * HTB)
#define PG8_STAGE(bufoff, gbase, voff) do { _Pragma("unroll") for (int _i = 0; _i < 2; ++_i) \
        __builtin_amdgcn_global_load_lds((const unsigned*)((const char*)(gbase) + (voff)[_i]), (LAS unsigned*)(lds + (bufoff) + ldsw + _i * 8192), 16, 0, 0); } while (0)
#define PG8_LDA(dst, b, h) do { _Pragma("unroll") for (int m = 0; m < 4; ++m) _Pragma("unroll") for (int k = 0; k < 2; ++k) dst[m][k] = *(const LAS bf16x8*)(lds + PG8_SA(b, h) + aoff + m * 2048 + k * 1024); } while (0)
#define PG8_LDB(dst, b, h) do { _Pragma("unroll") for (int n = 0; n < 2; ++n) _Pragma("unroll") for (int k = 0; k < 2; ++k) dst[n][k] = *(const LAS bf16x8*)(lds + PG8_SB(b, h) + boff + n * 2048 + k * 1024); } while (0)
#define PG8_MMA(ai, bj, At, Bt) do { __builtin_amdgcn_s_setprio(1); _Pragma("unroll") for (int m = 0; m < 4; ++m) _Pragma("unroll") for (int n = 0; n < 2; ++n) _Pragma("unroll") for (int k = 0; k < 2; ++k) \
        acc[ai][bj][m][n] = __builtin_amdgcn_mfma_f32_16x16x32_bf16(Bt[n][k], At[m][k], acc[ai][bj][m][n], 0, 0, 0); __builtin_amdgcn_s_setprio(0); } while (0)
#define PG8_WAIT_V(n) asm volatile("s_waitcnt vmcnt(" #n ")" ::: "memory")
#define PG8_WAIT_L(n) asm volatile("s_waitcnt lgkmcnt(" #n ")" ::: "memory")
#define PG8_BAR __builtin_amdgcn_s_barrier()
#define PG8_SCHED __builtin_amdgcn_sched_barrier(0)
    Unit cur, nxt; int ui = 0;
    if (!S.next(0, cur)) return;
    f32x4 acc[2][2][4][2];
#pragma unroll
    for (int a = 0; a < 2; ++a)
#pragma unroll
        for (int b = 0; b < 2; ++b)
#pragma unroll
            for (int m = 0; m < 4; ++m)
#pragma unroll
                for (int n = 0; n < 2; ++n) acc[a][b][m][n] = (f32x4){0.f, 0.f, 0.f, 0.f};
    bf16x8 At[4][2], B0[2][2], B1[2][2];
    const char* cA = cur.A; const char* cB = cur.B; int nt = cur.nt; asm volatile("" : "+s"(nt));
    PG8_STAGE(PG8_SB(0, 0), cB, voffB); PG8_STAGE(PG8_SB(0, 1), cB + hstep, voffB); PG8_STAGE(PG8_SA(0, 0), cA, voffA); PG8_STAGE(PG8_SA(0, 1), cA + hstep, voffA);
    if (wr == 1) PG8_BAR;
    PG8_WAIT_V(2); PG8_BAR;
    PG8_STAGE(PG8_SB(1, 0), cB + kstep, voffB); PG8_STAGE(PG8_SA(1, 0), cA + kstep, voffA); PG8_STAGE(PG8_SB(1, 1), cB + hstep + kstep, voffB);
    PG8_WAIT_V(6); PG8_BAR;
#pragma unroll 1
    for (;;) {
        asm volatile("" : "+s"(ui));
        const bool has_next = S.next(ui + 1, nxt);
        const char* nA = has_next ? nxt.A : cA; const char* nB = has_next ? nxt.B : cB;
#pragma unroll 1
        for (int t = 0; t < nt; t += 2) {
            const bool last = (t == nt - 2);
            const char* a1 = cA + (size_t)(t + 1) * kstep;
            const char* a2 = last ? nA : cA + (size_t)(t + 2) * kstep; const char* b2 = last ? nB : cB + (size_t)(t + 2) * kstep;
            const char* a3 = a2 + kstep; const char* b3 = b2 + kstep;
            PG8_LDB(B0, 0, 0); PG8_LDB(B1, 0, 1); PG8_SCHED; PG8_LDA(At, 0, 0); PG8_STAGE(PG8_SA(1, 1), a1 + hstep, voffA);
            PG8_WAIT_V(8); PG8_WAIT_L(0); PG8_BAR; PG8_MMA(0, 0, At, B0); PG8_MMA(0, 1, At, B1); PG8_BAR; PG8_SCHED;
            PG8_LDA(At, 0, 1); PG8_STAGE(PG8_SB(0, 0), b2, voffB); PG8_STAGE(PG8_SB(0, 1), b2 + hstep, voffB); PG8_STAGE(PG8_SA(0, 0), a2, voffA);
            PG8_WAIT_V(8); PG8_WAIT_L(0); PG8_BAR; PG8_MMA(1, 0, At, B0); PG8_MMA(1, 1, At, B1); PG8_BAR; PG8_SCHED;
            PG8_LDB(B0, 1, 0); PG8_LDB(B1, 1, 1); PG8_SCHED; PG8_LDA(At, 1, 0); PG8_STAGE(PG8_SA(0, 1), a2 + hstep, voffA);
            PG8_WAIT_V(8); PG8_WAIT_L(0); PG8_BAR; PG8_MMA(0, 0, At, B0); PG8_MMA(0, 1, At, B1); PG8_BAR; PG8_SCHED;
            PG8_LDA(At, 1, 1); PG8_STAGE(PG8_SB(1, 0), b3, voffB); PG8_STAGE(PG8_SB(1, 1), b3 + hstep, voffB); PG8_STAGE(PG8_SA(1, 0), a3, voffA);
            PG8_WAIT_V(8); PG8_WAIT_L(0); PG8_BAR; PG8_MMA(1, 0, At, B0); PG8_MMA(1, 1, At, B1); PG8_BAR; PG8_SCHED;
        }
        if (wr == 0) PG8_BAR;
        E(acc, cur, wr, wc, fr, fq, lds);
        if (!has_next) break;
#pragma unroll
        for (int a = 0; a < 2; ++a)
#pragma unroll
            for (int b = 0; b < 2; ++b)
#pragma unroll
                for (int m = 0; m < 4; ++m)
#pragma unroll
                    for (int n = 0; n < 2; ++n) acc[a][b][m][n] = (f32x4){0.f, 0.f, 0.f, 0.f};
        cur = nxt; cA = nA; cB = nB; nt = cur.nt; asm volatile("" : "+s"(nt)); ++ui;
        if (wr == 1) PG8_BAR;
    }
    PG8_WAIT_V(0);
    PG8_BAR;
#undef PG8_SA
#undef PG8_SB
#undef PG8_STAGE
#undef PG8_LDA
#undef PG8_LDB
#undef PG8_MMA
#undef PG8_WAIT_V
#undef PG8_WAIT_L
#undef PG8_BAR
#undef PG8_SCHED
}

typedef f32x4 (&AccRef)[2][2][4][2];
#define EPI_ROWS_BEGIN _Pragma("unroll") for (int ai = 0; ai < 2; ++ai) _Pragma("unroll") for (int m = 0; m < 4; ++m) { const int rl = ai * 128 + wr * 64 + m * 16 + fr;
#define EPI_ROWS_END }

struct EpiSwiglu {
    bf16_t* U; const float* ssq;
    __device__ __forceinline__ void operator()(AccRef acc, const Unit& u, int wr, int wc, int fr, int fq, LAS unsigned char*) const {
        EPI_ROWS_BEGIN
            const int row = u.pm * 256 + rl; const float rs = rsqrtf(ssq[row] * (1.f / 1024.f) + NORM_EPS);
            float o[8];
#pragma unroll
            for (int n = 0; n < 2; ++n)
#pragma unroll
                for (int j = 0; j < 4; ++j) { const float g = acc[ai][0][m][n][j] * rs, up = acc[ai][1][m][n][j] * rs; o[n * 4 + j] = g * fsigmoid(g) * up; }
            u32x4 w; w.x = cvt_pk_bf16(o[0], o[1]); w.y = cvt_pk_bf16(o[2], o[3]); w.z = cvt_pk_bf16(o[4], o[5]); w.w = cvt_pk_bf16(o[6], o[7]);
            *(u32x4*)(U + (size_t)row * DFF + u.pn * 128 + wc * 32 + fq * 8) = w;
        EPI_ROWS_END
    }
};
template <bool WB> struct EpiResid {
    const float* xin; float* xout; bf16_t* xb; float* ssq; float scale;
    __device__ __forceinline__ void operator()(AccRef acc, const Unit& u, int wr, int wc, int fr, int fq, LAS unsigned char*) const {
        EPI_ROWS_BEGIN
            const int row = u.pm * 256 + rl; float ss = 0.f;
#pragma unroll
            for (int bj = 0; bj < 2; ++bj) {
                const size_t o = (size_t)row * DM + u.pn * 256 + bj * 128 + wc * 32 + fq * 8;
                f32x4 v0 = *(const f32x4*)(xin + o), v1 = *(const f32x4*)(xin + o + 4);
                v0 = v0 + acc[ai][bj][m][0] * scale; v1 = v1 + acc[ai][bj][m][1] * scale;
                *(f32x4*)(xout + o) = v0; *(f32x4*)(xout + o + 4) = v1;
                ss += v0[0] * v0[0] + v0[1] * v0[1] + v0[2] * v0[2] + v0[3] * v0[3] + v1[0] * v1[0] + v1[1] * v1[1] + v1[2] * v1[2] + v1[3] * v1[3];
                if (WB) { u32x4 w; w.x = cvt_pk_bf16(v0[0], v0[1]); w.y = cvt_pk_bf16(v0[2], v0[3]); w.z = cvt_pk_bf16(v1[0], v1[1]); w.w = cvt_pk_bf16(v1[2], v1[3]); *(u32x4*)(xb + o) = w; }
            }
            ss += __shfl_xor(ss, 16); ss += __shfl_xor(ss, 32);
            if (fq == 0) atomicAdd(ssq + row, ss);
        EPI_ROWS_END
    }
};
template <int MODE> struct EpiResidX {
    static constexpr bool ALIGN = true;
    const float* xin; float* xout; bf16_t* xb; float* ssq; float scale;
    __device__ __forceinline__ void operator()(AccRef acc, const Unit& u, int wr, int wc, int fr, int fq, LAS unsigned char*) const {
        EPI_ROWS_BEGIN
            const int row = u.pm * 256 + rl; float ss = 0.f;
#pragma unroll
            for (int bj = 0; bj < 2; ++bj) {
                const size_t o = (size_t)row * DM + u.pn * 256 + bj * 128 + wc * 32 + fq * 8;
                f32x4 v0, v1;
                if (MODE == 1) { v0 = *(const f32x4*)(xin + o); v1 = *(const f32x4*)(xin + o + 4); }
                else { const u32x4 xr = *(const u32x4*)(xb + o); v0 = (f32x4){bflo(xr.x), bfhi(xr.x), bflo(xr.y), bfhi(xr.y)}; v1 = (f32x4){bflo(xr.z), bfhi(xr.z), bflo(xr.w), bfhi(xr.w)}; }
                v0 = v0 + acc[ai][bj][m][0] * scale; v1 = v1 + acc[ai][bj][m][1] * scale;
                if (MODE == 2) { *(f32x4*)(xout + o) = v0; *(f32x4*)(xout + o + 4) = v1; }
                ss += v0[0] * v0[0] + v0[1] * v0[1] + v0[2] * v0[2] + v0[3] * v0[3] + v1[0] * v1[0] + v1[1] * v1[1] + v1[2] * v1[2] + v1[3] * v1[3];
                u32x4 w; w.x = cvt_pk_bf16(v0[0], v0[1]); w.y = cvt_pk_bf16(v0[2], v0[3]); w.z = cvt_pk_bf16(v1[0], v1[1]); w.w = cvt_pk_bf16(v1[2], v1[3]); *(u32x4*)(xb + o) = w;
            }
            ss += __shfl_xor(ss, 16); ss += __shfl_xor(ss, 32);
            if (fq == 0) atomicAdd(ssq + row, ss);
        EPI_ROWS_END
    }
};
struct EpiGate {
    static constexpr bool ALIGN = true;
    bf16_t* SA; bf16_t* SB; const float* ssq;
    __device__ __forceinline__ void operator()(AccRef acc, const Unit& u, int wr, int wc, int fr, int fq, LAS unsigned char*) const {
        bf16_t* base = (u.pn < 4 ? SA : SB) + (u.pn & 3) * 256 + wc * 32 + fq * 8;
        EPI_ROWS_BEGIN
            const int row = u.pm * 256 + rl; const float rs = rsqrtf(ssq[row] * (1.f / 1024.f) + NORM_EPS);
#pragma unroll
            for (int bj = 0; bj < 2; ++bj) { const f32x4 a0 = acc[ai][bj][m][0], a1 = acc[ai][bj][m][1];
                u32x4 w; w.x = cvt_pk_bf16(a0[0] * rs, a0[1] * rs); w.y = cvt_pk_bf16(a0[2] * rs, a0[3] * rs);
                w.z = cvt_pk_bf16(a1[0] * rs, a1[1] * rs); w.w = cvt_pk_bf16(a1[2] * rs, a1[3] * rs);
                *(u32x4*)(base + (size_t)row * DM + bj * 128) = w; }
        EPI_ROWS_END
    }
};
struct EpiMerge2 {
    static constexpr bool ALIGN = true;
    u32x4* scrM; bf16_t* MG; const bf16_t* SA; const bf16_t* SB;
    __device__ __forceinline__ void operator()(AccRef acc, const Unit& u, int wr, int wc, int fr, int fq, LAS unsigned char*) const {
        char* sM = (char*)scrM + (threadIdx.x >> 6) * 16384u + (threadIdx.x & 63) * 16u; asm volatile("" : "+v"(sM));
        const bf16_t* G = (u.tag == 1 ? SA : SB);
        EPI_ROWS_BEGIN
            const int row = u.pm * 256 + rl;
#pragma unroll
            for (int bj = 0; bj < 2; ++bj) {
                const int i = (ai * 4 + m) * 2 + bj; const f32x4 a0 = acc[ai][bj][m][0], a1 = acc[ai][bj][m][1];
                const size_t o = (size_t)row * DM + u.pn * 256 + bj * 128 + wc * 32 + fq * 8;
                const u32x4 sg = *(const u32x4*)(G + o);
                f32x4 m0 = (f32x4){fsigmoid(bflo(sg.x)) * a0[0], fsigmoid(bfhi(sg.x)) * a0[1], fsigmoid(bflo(sg.y)) * a0[2], fsigmoid(bfhi(sg.y)) * a0[3]};
                f32x4 m1 = (f32x4){fsigmoid(bflo(sg.z)) * a1[0], fsigmoid(bfhi(sg.z)) * a1[1], fsigmoid(bflo(sg.w)) * a1[2], fsigmoid(bfhi(sg.w)) * a1[3]};
                if (u.tag == 3) { const u32x4 pm_ = *(const u32x4*)(sM + i * 1024);
                    m0 = m0 + (f32x4){bflo(pm_.x), bfhi(pm_.x), bflo(pm_.y), bfhi(pm_.y)}; m1 = m1 + (f32x4){bflo(pm_.z), bfhi(pm_.z), bflo(pm_.w), bfhi(pm_.w)}; }
                u32x4 w; w.x = cvt_pk_bf16(m0[0], m0[1]); w.y = cvt_pk_bf16(m0[2], m0[3]); w.z = cvt_pk_bf16(m1[0], m1[1]); w.w = cvt_pk_bf16(m1[2], m1[3]);
                if (u.tag == 1) *(u32x4*)(sM + i * 1024) = w; else *(u32x4*)(MG + o) = w;
            }
            asm volatile("" ::: "memory");
        EPI_ROWS_END
    }
};
struct EpiResidFin {
    static constexpr bool ALIGN = true;
    float* x; float scale;
    __device__ __forceinline__ void operator()(AccRef acc, const Unit& u, int wr, int wc, int fr, int fq, LAS unsigned char* lds) const {
        LAS float* rowss = (LAS float*)(lds + XCH_OFF);
        EPI_ROWS_BEGIN
            const int row = u.pm * 256 + rl; float ss = 0.f;
#pragma unroll
            for (int bj = 0; bj < 2; ++bj) {
                const size_t o = (size_t)row * DM + u.pn * 256 + bj * 128 + wc * 32 + fq * 8;
                f32x4 v0 = *(const f32x4*)(x + o), v1 = *(const f32x4*)(x + o + 4);
                v0 = v0 + acc[ai][bj][m][0] * scale; v1 = v1 + acc[ai][bj][m][1] * scale;
                *(f32x4*)(x + o) = v0; *(f32x4*)(x + o + 4) = v1;
                ss += v0[0] * v0[0] + v0[1] * v0[1] + v0[2] * v0[2] + v0[3] * v0[3] + v1[0] * v1[0] + v1[1] * v1[1] + v1[2] * v1[2] + v1[3] * v1[3];
            }
            ss += __shfl_xor(ss, 16); ss += __shfl_xor(ss, 32);
            if (fq == 0) (void)__hip_atomic_fetch_add(rowss + rl, ss, __ATOMIC_RELAXED, __HIP_MEMORY_SCOPE_WORKGROUP);
        EPI_ROWS_END
    }
};
template <int MODE> struct EpiRowScale {
    bf16_t* O; const float* ssq; float* IFb;
    __device__ __forceinline__ void operator()(AccRef acc, const Unit& u, int wr, int wc, int fr, int fq, LAS unsigned char*) const {
        constexpr int LDO = MODE == 0 ? ZLD : DM;
        EPI_ROWS_BEGIN
            const int row = u.pm * 256 + rl; const float rs = rsqrtf(ssq[row] * (1.f / 1024.f) + NORM_EPS);
            if (MODE == 0 && u.pn == 15) {
                if (wc == 0 && fq == 0) { *(f32x4*)(IFb + (size_t)row * 8) = acc[ai][0][m][0] * rs; *(f32x4*)(IFb + (size_t)row * 8 + 4) = acc[ai][0][m][1] * rs; }
            } else {
#pragma unroll
                for (int bj = 0; bj < 2; ++bj) { const f32x4 v0 = acc[ai][bj][m][0] * rs, v1 = acc[ai][bj][m][1] * rs;
                    u32x4 w; w.x = cvt_pk_bf16(v0[0], v0[1]); w.y = cvt_pk_bf16(v0[2], v0[3]); w.z = cvt_pk_bf16(v1[0], v1[1]); w.w = cvt_pk_bf16(v1[2], v1[3]);
                    *(u32x4*)(O + (size_t)row * LDO + u.pn * 256 + bj * 128 + wc * 32 + fq * 8) = w; }
            }
        EPI_ROWS_END
    }
};
struct EpiKV {
    bf16_t* Kb; bf16_t* VT; const float* ssqm;
    __device__ __forceinline__ void operator()(AccRef acc, const Unit& u, int wr, int wc, int fr, int fq, LAS unsigned char*) const {
        EPI_ROWS_BEGIN
            const int row = u.pm * 256 + rl;
#pragma unroll
            for (int bj = 0; bj < 2; ++bj) {
                const int cl = bj * 128 + wc * 32 + fq * 8; f32x4 v0 = acc[ai][bj][m][0], v1 = acc[ai][bj][m][1]; bf16_t* dst;
                if (u.tag == 0) { const float rs = rsqrtf(ssqm[row] * (1.f / 1024.f) + NORM_EPS); v0 = v0 * rs; v1 = v1 * rs; dst = Kb + (size_t)row * DM + u.pn * 256 + cl; }
                else { const int tok = u.pn * 256 + cl; const f32x4 s0 = *(const f32x4*)(ssqm + tok), s1 = *(const f32x4*)(ssqm + tok + 4);
#pragma unroll
                    for (int j = 0; j < 4; ++j) { v0[j] *= rsqrtf(s0[j] * (1.f / 1024.f) + NORM_EPS); v1[j] *= rsqrtf(s1[j] * (1.f / 1024.f) + NORM_EPS); }
                    dst = VT + (size_t)(u.pn >> 2) * 1048576 + (size_t)row * 1024 + (u.pn & 3) * 256 + cl; }
                u32x4 w; w.x = cvt_pk_bf16(v0[0], v0[1]); w.y = cvt_pk_bf16(v0[2], v0[3]); w.z = cvt_pk_bf16(v1[0], v1[1]); w.w = cvt_pk_bf16(v1[2], v1[3]);
                *(u32x4*)dst = w;
            }
        EPI_ROWS_END
    }
};
struct EpiMerge {
    u32x4* scrS; f32x4* scrM; bf16_t* MG; const float* ssq;
    __device__ __forceinline__ void operator()(AccRef acc, const Unit& u, int wr, int wc, int fr, int fq, LAS unsigned char*) const {
        char* sS = (char*)scrS + (threadIdx.x >> 6) * 16384u + (threadIdx.x & 63) * 16u; char* sM = (char*)scrM + (threadIdx.x >> 6) * 16384u + (threadIdx.x & 63) * 16u; asm volatile("" : "+v"(sS), "+v"(sM));
        if (u.tag == 0 || u.tag == 2) {
            EPI_ROWS_BEGIN
                const int row = u.pm * 256 + rl; const float rs = rsqrtf(ssq[row] * (1.f / 1024.f) + NORM_EPS);
#pragma unroll
                for (int bj = 0; bj < 2; ++bj) {
                    const int i = (ai * 4 + m) * 2 + bj; const f32x4 a0 = acc[ai][bj][m][0], a1 = acc[ai][bj][m][1];
                    u32x4 w; w.x = cvt_pk_bf16(fsigmoid(a0[0] * rs), fsigmoid(a0[1] * rs)); w.y = cvt_pk_bf16(fsigmoid(a0[2] * rs), fsigmoid(a0[3] * rs));
                    w.z = cvt_pk_bf16(fsigmoid(a1[0] * rs), fsigmoid(a1[1] * rs)); w.w = cvt_pk_bf16(fsigmoid(a1[2] * rs), fsigmoid(a1[3] * rs));
                    *(u32x4*)(sS + i * 1024) = w;
                }
            EPI_ROWS_END
        } else if (u.tag == 1) {
            EPI_ROWS_BEGIN
#pragma unroll
                for (int bj = 0; bj < 2; ++bj) {
                    const int i = (ai * 4 + m) * 2 + bj; const f32x4 a0 = acc[ai][bj][m][0], a1 = acc[ai][bj][m][1];
                    const u32x4 sg = *(const u32x4*)(sS + i * 1024);
                    u32x4 pm_; pm_.x = cvt_pk_bf16(bflo(sg.x) * a0[0], bfhi(sg.x) * a0[1]); pm_.y = cvt_pk_bf16(bflo(sg.y) * a0[2], bfhi(sg.y) * a0[3]);
                    pm_.z = cvt_pk_bf16(bflo(sg.z) * a1[0], bfhi(sg.z) * a1[1]); pm_.w = cvt_pk_bf16(bflo(sg.w) * a1[2], bfhi(sg.w) * a1[3]);
                    *(u32x4*)(sM + i * 1024) = pm_;
                }
                asm volatile("" ::: "memory");
            EPI_ROWS_END
        } else {
            EPI_ROWS_BEGIN
                const int row = u.pm * 256 + rl;
#pragma unroll
                for (int bj = 0; bj < 2; ++bj) {
                    const int i = (ai * 4 + m) * 2 + bj; const f32x4 a0 = acc[ai][bj][m][0], a1 = acc[ai][bj][m][1];
                    const u32x4 sg = *(const u32x4*)(sS + i * 1024);
                    const u32x4 pm_ = *(const u32x4*)(sM + i * 1024);
                    f32x4 m0 = (f32x4){bflo(pm_.x), bfhi(pm_.x), bflo(pm_.y), bfhi(pm_.y)}, m1 = (f32x4){bflo(pm_.z), bfhi(pm_.z), bflo(pm_.w), bfhi(pm_.w)};
                    m0 = m0 + (f32x4){bflo(sg.x) * a0[0], bfhi(sg.x) * a0[1], bflo(sg.y) * a0[2], bfhi(sg.y) * a0[3]};
                    m1 = m1 + (f32x4){bflo(sg.z) * a1[0], bfhi(sg.z) * a1[1], bflo(sg.w) * a1[2], bfhi(sg.w) * a1[3]};
                    u32x4 w; w.x = cvt_pk_bf16(m0[0], m0[1]); w.y = cvt_pk_bf16(m0[2], m0[3]); w.z = cvt_pk_bf16(m1[0], m1[1]); w.w = cvt_pk_bf16(m1[2], m1[3]);
                    *(u32x4*)(MG + (size_t)row * DM + u.pn * 256 + bj * 128 + wc * 32 + fq * 8) = w;
                }
                asm volatile("" ::: "memory");
            EPI_ROWS_END
        }
    }
};
struct EpiAttn {
    bf16_t* Pb; bf16_t* Ob; bf16_t* Qb; const float* ssq;
    __device__ __forceinline__ void operator()(AccRef acc, const Unit& u, int wr, int wc, int fr, int fq, LAS unsigned char* lds) const {
        LAS float* xm = (LAS float*)(lds + XCH_OFF); LAS float* xs = xm + 1024;
        if (u.tag == 2) {
            EPI_ROWS_BEGIN
                const int row = u.pm * 256 + rl; const float rs = rsqrtf(ssq[row] * (1.f / 1024.f) + NORM_EPS);
#pragma unroll
                for (int bj = 0; bj < 2; ++bj) { const f32x4 v0 = acc[ai][bj][m][0] * rs, v1 = acc[ai][bj][m][1] * rs;
                    u32x4 w; w.x = cvt_pk_bf16(v0[0], v0[1]); w.y = cvt_pk_bf16(v0[2], v0[3]); w.z = cvt_pk_bf16(v1[0], v1[1]); w.w = cvt_pk_bf16(v1[2], v1[3]);
                    *(u32x4*)(Qb + (size_t)row * DM + u.pn * 256 + bj * 128 + wc * 32 + fq * 8) = w; }
            EPI_ROWS_END
            return;
        }
        if (u.tag == 1) {
            EPI_ROWS_BEGIN
                const int row = u.pm * 256 + rl;
#pragma unroll
                for (int bj = 0; bj < 2; ++bj) { const f32x4 v0 = acc[ai][bj][m][0], v1 = acc[ai][bj][m][1];
                    u32x4 w; w.x = cvt_pk_bf16(v0[0], v0[1]); w.y = cvt_pk_bf16(v0[2], v0[3]); w.z = cvt_pk_bf16(v1[0], v1[1]); w.w = cvt_pk_bf16(v1[2], v1[3]);
                    *(u32x4*)(Ob + (size_t)row * DM + u.pn * 256 + bj * 128 + wc * 32 + fq * 8) = w; }
            EPI_ROWS_END
            return;
        }
        EPI_ROWS_BEGIN
            float v = -3.0e38f;
#pragma unroll
            for (int bj = 0; bj < 2; ++bj)
#pragma unroll
                for (int n = 0; n < 2; ++n)
#pragma unroll
                    for (int j = 0; j < 4; ++j) v = fmaxf(v, acc[ai][bj][m][n][j]);
            v = fmaxf(v, __shfl_xor(v, 16)); v = fmaxf(v, __shfl_xor(v, 32));
            if (fq == 0) xm[rl * 4 + wc] = v;
        EPI_ROWS_END
        WG_BAR();
        EPI_ROWS_BEGIN
            const f32x4 q = *(const LAS f32x4*)(xm + rl * 4); const float M = fmaxf(fmaxf(q[0], q[1]), fmaxf(q[2], q[3]));
            float sum = 0.f;
#pragma unroll
            for (int bj = 0; bj < 2; ++bj)
#pragma unroll
                for (int n = 0; n < 2; ++n)
#pragma unroll
                    for (int j = 0; j < 4; ++j) sum += __expf(acc[ai][bj][m][n][j] - M);
            sum += __shfl_xor(sum, 16); sum += __shfl_xor(sum, 32);
            if (fq == 0) xs[rl * 4 + wc] = sum;
        EPI_ROWS_END
        WG_BAR();
        EPI_ROWS_BEGIN
            const int row = u.pm * 256 + rl;
            const f32x4 q = *(const LAS f32x4*)(xm + rl * 4); const float M = fmaxf(fmaxf(q[0], q[1]), fmaxf(q[2], q[3]));
            const f32x4 qs = *(const LAS f32x4*)(xs + rl * 4); const float inv = __builtin_amdgcn_rcpf((qs[0] + qs[1]) + (qs[2] + qs[3]));
#pragma unroll
            for (int bj = 0; bj < 2; ++bj) { const f32x4 a0 = acc[ai][bj][m][0], a1 = acc[ai][bj][m][1];
                u32x4 w; w.x = cvt_pk_bf16(__expf(a0[0] - M) * inv, __expf(a0[1] - M) * inv); w.y = cvt_pk_bf16(__expf(a0[2] - M) * inv, __expf(a0[3] - M) * inv);
                w.z = cvt_pk_bf16(__expf(a1[0] - M) * inv, __expf(a1[1] - M) * inv); w.w = cvt_pk_bf16(__expf(a1[2] - M) * inv, __expf(a1[3] - M) * inv);
                *(u32x4*)(Pb + (size_t)row * DM + u.pn * 256 + bj * 128 + wc * 32 + fq * 8) = w; }
            asm volatile("" ::: "memory");
        EPI_ROWS_END
        WG_BAR();
    }
};

struct TJob { const float* src; const float* gain; bf16_t* dst; int K, ldsrc, col0, ncols, dst_ld, dst_row0, dst_k0, mode; float scale; int item0; };
struct Params { const float* in[37]; float* out; unsigned char* ws; TJob jobs[20]; int njobs, nitems, ph_lo, ph_hi, coop, nearly; };

__device__ __forceinline__ void transpose_item(const TJob& J, int item, LAS float* scr, int lane) {
    const int nblk = (J.ncols + 63) >> 6, kb = item / nblk, nb = item - kb * nblk, k0 = 64 * kb, n0 = 64 * nb;
    const int nq = (lane & 15) * 4; const bool nok = (n0 + nq) < J.ncols;
#pragma unroll
    for (int i = 0; i < 16; ++i) { const int kk = 4 * i + (lane >> 4);
        f32x4 v = (f32x4){0.f, 0.f, 0.f, 0.f};
        if (nok) { v = *(const f32x4*)(J.src + (size_t)(k0 + kk) * J.ldsrc + J.col0 + n0 + nq); float sc = J.scale; if (J.gain) sc *= J.gain[k0 + kk]; v = v * sc; }
        *(LAS f32x4*)(scr + kk * 64 + (nq ^ ((kk >> 3) << 3))) = v; }
    LDS_WAIT();
    const int c = lane & 7;
#pragma unroll
    for (int j = 0; j < 8; ++j) { const int nl = (lane >> 3) + 8 * j, n = n0 + nl; const LAS float* sp = scr + (8 * c) * 64 + (nl ^ (c << 3));
        if (n < J.ncols) { u32x4 o; o.x = cvt_pk_bf16(sp[0], sp[64]); o.y = cvt_pk_bf16(sp[128], sp[192]); o.z = cvt_pk_bf16(sp[256], sp[320]); o.w = cvt_pk_bf16(sp[384], sp[448]);
            const int dr = (J.mode ? ((n >> 7) * 256 + (n & 127)) : n) + J.dst_row0;
            *(u32x4*)(J.dst + (size_t)dr * J.dst_ld + J.dst_k0 + k0 + 8 * c) = o; } }
    LDS_WAIT();
}
__device__ __forceinline__ void row_to_bf16_ssq(const float* xrow, bf16_t* orow, float* ssq, int lane) {
    const f32x4* xr = (const f32x4*)xrow + lane; f32x4 v[4]; float s = 0.f;
#pragma unroll
    for (int j = 0; j < 4; ++j) { v[j] = xr[64 * j]; s += (v[j].x * v[j].x + v[j].y * v[j].y) + (v[j].z * v[j].z + v[j].w * v[j].w); }
    s = wave_sum(s); if (lane == 0) *ssq = s;
    u32x2* o8 = (u32x2*)orow + lane;
#pragma unroll
    for (int j = 0; j < 4; ++j) { u32x2 w; w.x = cvt_pk_bf16(v[j].x, v[j].y); w.y = cvt_pk_bf16(v[j].z, v[j].w); o8[64 * j] = w; }
}
__device__ __forceinline__ void rows4_to_bf16_ssq(const float* xrow, bf16_t* orow, float* ssq, int lane) {
    f32x4 v[4][4]; float s[4];
#pragma unroll
    for (int r = 0; r < 4; ++r)
#pragma unroll
        for (int j = 0; j < 4; ++j) v[r][j] = ((const f32x4*)(xrow + (size_t)r * DM) + lane)[64 * j];
#pragma unroll
    for (int r = 0; r < 4; ++r) { s[r] = 0.f;
#pragma unroll
        for (int j = 0; j < 4; ++j) s[r] += (v[r][j].x * v[r][j].x + v[r][j].y * v[r][j].y) + (v[r][j].z * v[r][j].z + v[r][j].w * v[r][j].w); }
#pragma unroll
    for (int o = 1; o < 64; o <<= 1) {
#pragma unroll
        for (int r = 0; r < 4; ++r) s[r] += __shfl_xor(s[r], o); }
    if (lane < 4) ssq[lane] = lane == 0 ? s[0] : (lane == 1 ? s[1] : (lane == 2 ? s[2] : s[3]));
#pragma unroll
    for (int r = 0; r < 4; ++r) { u32x2* o8 = (u32x2*)(orow + (size_t)r * DM) + lane;
#pragma unroll
        for (int j = 0; j < 4; ++j) { u32x2 w; w.x = cvt_pk_bf16(v[r][j].x, v[r][j].y); w.y = cvt_pk_bf16(v[r][j].z, v[r][j].w); o8[64 * j] = w; } }
}
__device__ __forceinline__ void phase_prep(const Params& P, LAS unsigned char* lds) {
    const int tid = threadIdx.x, lane = tid & 63, wave = tid >> 6; unsigned char* ws = P.ws;
    const int gw = blockIdx.x * 8 + wave, NGW = gridDim.x * 8;
    LAS float* scr = (LAS float*)(lds + wave * 16384);
    for (int it = gw; it < P.nearly; it += NGW) {
        int j = 0;
        while (j + 1 < P.njobs && it >= P.jobs[j + 1].item0) ++j;
        transpose_item(P.jobs[j], it - P.jobs[j].item0, scr, lane);
    }
    for (int m = gw * 4; m < NTOK; m += NGW * 4) rows4_to_bf16_ssq(P.in[0] + (size_t)m * DM, (bf16_t*)(ws + OFF_XB) + (size_t)m * DM, (float*)(ws + OFF_SSQ0) + m, lane);
    for (int m = gw * 4; m < MEMTOK; m += NGW * 4) rows4_to_bf16_ssq(P.in[1] + (size_t)m * DM, (bf16_t*)(ws + OFF_MEMB) + (size_t)m * DM, (float*)(ws + OFF_SSQM) + m, lane);
    const int gt = blockIdx.x * 512 + tid, NGT = gridDim.x * 512;
    for (int i = gt; i < 4 * NTOK; i += NGT) ((float*)(ws + OFF_SSQ1))[i] = 0.f;
    for (int i = gt; i < (int)(512 * 1024 / 16); i += NGT) ((u32x4*)(ws + OFF_FNG))[i] = (u32x4){0u, 0u, 0u, 0u};
    for (int i = gt; i < (int)(8 * MiB / 16); i += NGT) ((u32x4*)(ws + OFF_STATS))[i] = (u32x4){0u, 0u, 0u, 0u};
    for (int i = gt; i < 248 * 1024 / 8; i += NGT) ((u32x4*)(ws + OFF_WIN + (size_t)3848 * 2048))[i] = (u32x4){0u, 0u, 0u, 0u};
}

#define RLX_AGENT __ATOMIC_RELAXED, __HIP_MEMORY_SCOPE_AGENT
__device__ __forceinline__ float red16(float x) {
    x += dpp_f<0xB1>(x); x += dpp_f<0x4E>(x); x += dpp_f<0x141>(x); x += dpp_f<0x140>(x); return x;
}
#define RWA_COL(ty_, cv_, h_, rg_) ((ty_) == 0 ? 1664 + (cv_) * 8 : ((ty_) == 1 ? 1536 + (cv_) * 8 : ((ty_) == 2 ? 1600 + (cv_) * 8 : ((ty_) == 3 ? (h_) * 64 + (cv_) * 8 : ((ty_) == 4 ? 512 + (h_) * 64 + (cv_) * 8 : 1024 + (h_) * 64 + (rg_) * 32 + (cv_) * 8)))))
#define RWA_MAP(p_, lane_, h_, rg_) \
    int ty0, ty1, cv0, cv1, tq0, tq1; bool act0 = true, act1 = true; \
    if ((p_) == 0) { ty0 = 0; cv0 = (lane_) & 7; ty1 = 3; cv1 = (lane_) & 7; tq0 = tq1 = (lane_) >> 3; } \
    else if ((p_) == 1) { ty0 = 0; cv0 = 8 + ((lane_) & 7); ty1 = 4; cv1 = (lane_) & 7; tq0 = tq1 = (lane_) >> 3; } \
    else if ((p_) == 2) { ty0 = 1; cv0 = (lane_) & 7; ty1 = 2; cv1 = (lane_) & 7; tq0 = tq1 = (lane_) >> 3; } \
    else { ty0 = 5; cv0 = (lane_) & 3; tq0 = ((lane_) >> 2) & 7; act0 = (lane_) < 32; ty1 = 5; cv1 = 0; tq1 = 0; act1 = false; } \
    const int col0 = RWA_COL(ty0, cv0, h_, rg_), col1 = RWA_COL(ty1, cv1, h_, rg_);
__device__ __forceinline__ void rwkv_item(const Params& P, LAS unsigned char* lds, int item) {
    const int bh = item >> 1, rg = item & 1, b = bh >> 3, h = bh & 7; unsigned char* ws = P.ws;
    const bf16_t* Z = (const bf16_t*)(ws + OFF_Z); bf16_t* Yb = (bf16_t*)(ws + OFF_Y);
    unsigned long long* gran = (unsigned long long*)(ws + OFF_STATS);
    const float* mu = P.in[8]; const float* w0 = P.in[9]; const float* a0 = P.in[11]; const float* k_k = P.in[14]; const float* k_a = P.in[15]; const float* r_k = P.in[16];
    const float* gn_w = P.in[17]; const float* gn_b = P.in[18];
#define OPS_RR(s_) ((LAS float*)(lds + (s_) * 40960))
#define OPS_WW(s_) ((LAS float*)(lds + (s_) * 40960 + 8192))
#define OPS_BV(s_) ((LAS float*)(lds + (s_) * 40960 + 16384))
#define OPS_KM(s_) ((LAS float*)(lds + (s_) * 40960 + 24576))
#define OPS_KK(s_) ((LAS float*)(lds + (s_) * 40960 + 32768))
    LAS bf16_t* AW = (LAS bf16_t*)(lds + 81920); LAS bf16_t* AA = (LAS bf16_t*)(lds + 86528); LAS bf16_t* AG = (LAS bf16_t*)(lds + 91136);
    LAS float* KS = (LAS float*)(lds + 99840); LAS float* Aa = (LAS float*)(lds + 108032);
#define VV(s_) ((LAS float*)(lds + 116224 + (s_) * 4096))
#define YY(j_) ((LAS float*)(lds + 124416 + (j_) * 4096))
    LAS float* Gt = (LAS float*)(lds + 140800);
#define Q1B(j_) ((LAS bf16_t*)(lds + 144896 + (j_) * 2048))
#define Q2B(j_) ((LAS bf16_t*)(lds + 153088 + (j_) * 2048))
    LAS float* PRM = (LAS float*)(lds + 161280);
    LAS unsigned* GB = (LAS unsigned*)(lds + 162816);
    {
        const int tid = threadIdx.x;
        if (tid < 64) { PRM[tid] = k_k[h * 64 + tid]; PRM[64 + tid] = k_a[h * 64 + tid]; PRM[128 + tid] = r_k[h * 64 + tid]; PRM[192 + tid] = w0[h * 64 + tid]; PRM[256 + tid] = a0[h * 64 + tid]; }
        if (tid < 32) { PRM[320 + tid] = gn_w[h * 64 + rg * 32 + tid]; PRM[352 + tid] = gn_b[h * 64 + rg * 32 + tid]; }
        if (tid == 0) GB[0] = 0u;
    }
    bf16x8 bw[2][2], ba[2][2], bg[4];
    {
        const int lane = threadIdx.x & 63, fr = lane & 15, fq = lane >> 4, p = (threadIdx.x >> 6) & 3, kp = p >> 1;
#pragma unroll
        for (int q = 0; q < 2; ++q) { const int ch = h * 64 + (2 * kp + q) * 16 + fr;
#pragma unroll
            for (int ks = 0; ks < 2; ++ks) { bw[q][ks] = *(const bf16x8*)((const bf16_t*)(ws + OFF_W2T) + (size_t)ch * 64 + ks * 32 + fq * 8); ba[q][ks] = *(const bf16x8*)((const bf16_t*)(ws + OFF_A2T) + (size_t)ch * 64 + ks * 32 + fq * 8); } }
#pragma unroll
        for (int ks = 0; ks < 4; ++ks) bg[ks] = *(const bf16x8*)((const bf16_t*)(ws + OFF_G2T) + (size_t)(h * 64 + rg * 32 + kp * 16 + fr) * 128 + ks * 32 + fq * 8);
    }
    f32x2 S2[4] = {{0.f, 0.f}, {0.f, 0.f}, {0.f, 0.f}, {0.f, 0.f}};
    float muA[8], muB[8]; u32x4 pzA[4], pzB[4], ppA, ppB; unsigned gbgen = 0u; float ps1 = 0.f, ps2 = 0.f;
    {
        RWA_MAP(((int)(threadIdx.x >> 6)) & 3, (int)(threadIdx.x & 63), h, rg)
        (void)act0; (void)act1; (void)tq0; (void)tq1;
        const f32x4 m0 = *(const f32x4*)(mu + col0), m1 = *(const f32x4*)(mu + col0 + 4), n0 = *(const f32x4*)(mu + col1), n1 = *(const f32x4*)(mu + col1 + 4);
#pragma unroll
        for (int j = 0; j < 4; ++j) { muA[j] = m0[j]; muA[4 + j] = m1[j]; muB[j] = n0[j]; muB[4 + j] = n1[j]; }
    }
#define RW_PF1(cn, pz_, pp_, act_, tq_, col_) do { pp_ = (u32x4){0u, 0u, 0u, 0u}; _Pragma("unroll") for (int i_ = 0; i_ < 4; ++i_) pz_[i_] = pp_; \
        if (act_) { const size_t tok = (size_t)b * SEQ + (cn) * 32 + (tq_) * 4; if ((cn) * 32 + (tq_) * 4 > 0) pp_ = *(const u32x4*)(Z + (tok - 1) * ZLD + (col_)); \
            _Pragma("unroll") for (int i_ = 0; i_ < 4; ++i_) pz_[i_] = *(const u32x4*)(Z + (tok + i_) * ZLD + (col_)); } } while (0)
#define RW_PREFETCH(cn) do { RW_PF1(cn, pzA, ppA, act0, tq0, col0); RW_PF1(cn, pzB, ppB, act1, tq1, col1); } while (0)
#define GRP_BAR() do { asm volatile("s_waitcnt lgkmcnt(0)" ::: "memory"); gbgen += 1u; if (lane == 0) (void)__hip_atomic_fetch_add(GB, 1u, __ATOMIC_RELAXED, __HIP_MEMORY_SCOPE_WORKGROUP); \
        { unsigned sp_ = 0; while (__hip_atomic_load(GB, __ATOMIC_RELAXED, __HIP_MEMORY_SCOPE_WORKGROUP) < gbgen * 4u) { if (++sp_ > (1u << 24)) break; } } asm volatile("" ::: "memory"); } while (0)
    {
        RWA_MAP(((int)(threadIdx.x >> 6)) & 3, (int)(threadIdx.x & 63), h, rg)
        act0 = act0 && threadIdx.x >= 256; act1 = act1 && threadIdx.x >= 256;
        RW_PREFETCH(0);
    }
    WG_BAR();
#pragma unroll 1
    for (int it = 0; it < 131; ++it) {
        int tl_ = threadIdx.x; asm volatile("" : "+v"(tl_));
        const int tid = tl_, lane = tid & 63, wave = __builtin_amdgcn_readfirstlane(tid >> 6), fr = lane & 15, fq = lane >> 4;
        if (wave >= 4) {
            unsigned long long g0 = 0ull, g1 = 0ull;
            if (wave == 7 && it >= 3) {
                const unsigned long long* gb3 = gran + (((size_t)bh * 128 + (it - 3)) * 2) * 64 + (lane & 31) * 2 + (rg ^ 1) * 64;
                g0 = __hip_atomic_load(gb3, RLX_AGENT); g1 = __hip_atomic_load(gb3 + 1, RLX_AGENT);
            }
            if (it < 128) {
                const int c = it, os = c & 1, qj = c & 3;
                const int tidp = tid - 256, p = wave - 4, tt = p & 1, kp = p >> 1;
                RWA_MAP(p, lane, h, rg)
                LAS float* Rr = OPS_RR(os); LAS float* Ww = OPS_WW(os); LAS float* Bv = OPS_BV(os); LAS float* KM = OPS_KM(os); LAS float* KK = OPS_KK(os); LAS float* Vv = VV(os);
#define RWA_SEG(pz_, pp_, mu_, act_, ty_, cv_, tq_) do { if (act_) { _Pragma("unroll") for (int i = 0; i < 4; ++i) { \
                    const int t = (tq_) * 4 + i; const u32x4 zc = pz_[i], zp = (i == 0) ? pp_ : pz_[i > 0 ? i - 1 : 0]; \
                    float z[8]; const float c8[8] = {bflo(zc.x), bfhi(zc.x), bflo(zc.y), bfhi(zc.y), bflo(zc.z), bfhi(zc.z), bflo(zc.w), bfhi(zc.w)}; \
                    const float p8[8] = {bflo(zp.x), bfhi(zp.x), bflo(zp.y), bfhi(zp.y), bflo(zp.z), bfhi(zp.z), bflo(zp.w), bfhi(zp.w)}; \
                    _Pragma("unroll") for (int j = 0; j < 8; ++j) z[j] = c8[j] + (p8[j] - c8[j]) * mu_[j]; \
                    if ((ty_) >= 3) { LAS float* dst = (ty_) == 3 ? Rr + t * 64 + (cv_) * 8 : ((ty_) == 4 ? KS + t * 64 + (cv_) * 8 : Vv + t * 32 + (cv_) * 8); \
                        *(LAS f32x4*)dst = (f32x4){z[0], z[1], z[2], z[3]}; *(LAS f32x4*)(dst + 4) = (f32x4){z[4], z[5], z[6], z[7]}; } \
                    else { LAS bf16_t* dst; \
                        if ((ty_) == 1) { dst = AW + t * 72 + (cv_) * 8; _Pragma("unroll") for (int j = 0; j < 8; ++j) z[j] = 1.f - 2.f * __builtin_amdgcn_rcpf(__expf(2.f * z[j]) + 1.f); } \
                        else if ((ty_) == 2) dst = AA + t * 72 + (cv_) * 8; \
                        else { dst = AG + t * 136 + (cv_) * 8; _Pragma("unroll") for (int j = 0; j < 8; ++j) z[j] = fsigmoid(z[j]); } \
                        u32x4 w; w.x = cvt_pk_bf16(z[0], z[1]); w.y = cvt_pk_bf16(z[2], z[3]); w.z = cvt_pk_bf16(z[4], z[5]); w.w = cvt_pk_bf16(z[6], z[7]); \
                        *(LAS u32x4*)dst = w; } } } } while (0)
                RWA_SEG(pzA, ppA, muA, act0, ty0, cv0, tq0);
                RWA_SEG(pzB, ppB, muB, act1, ty1, cv1, tq1);
#undef RWA_SEG
                if (c < 127) RW_PREFETCH(c + 1);
                GRP_BAR();
                {
                    bf16x8 aw[2], aa[2];
#pragma unroll
                    for (int ks = 0; ks < 2; ++ks) { aw[ks] = *(const LAS bf16x8*)(AW + (tt * 16 + fr) * 72 + ks * 32 + fq * 8); aa[ks] = *(const LAS bf16x8*)(AA + (tt * 16 + fr) * 72 + ks * 32 + fq * 8); }
                    const int t = tt * 16 + fr;
#pragma unroll
                    for (int q = 0; q < 2; ++q) {
                        f32x4 cw = (f32x4){0.f, 0.f, 0.f, 0.f}, ca = cw;
#pragma unroll
                        for (int ks = 0; ks < 2; ++ks) { cw = __builtin_amdgcn_mfma_f32_16x16x32_bf16(bw[q][ks], aw[ks], cw, 0, 0, 0); ca = __builtin_amdgcn_mfma_f32_16x16x32_bf16(ba[q][ks], aa[ks], ca, 0, 0, 0); }
                        const int kl = (2 * kp + q) * 16 + fq * 4;
                        const f32x4 w0v = *(const LAS f32x4*)(PRM + 192 + kl), a0v = *(const LAS f32x4*)(PRM + 256 + kl);
                        f32x4 dw, av;
#pragma unroll
                        for (int j = 0; j < 4; ++j) { dw[j] = __expf(-0.6065306597f * fsigmoid(w0v[j] + cw[j])); av[j] = fsigmoid(a0v[j] + ca[j]); }
                        *(LAS f32x4*)(Ww + t * 64 + kl) = dw; *(LAS f32x4*)(Aa + t * 64 + kl) = av;
                    }
                    f32x4 cg_ = (f32x4){0.f, 0.f, 0.f, 0.f};
#pragma unroll
                    for (int ks = 0; ks < 4; ++ks) { const bf16x8 ag = *(const LAS bf16x8*)(AG + (tt * 16 + fr) * 136 + ks * 32 + fq * 8); cg_ = __builtin_amdgcn_mfma_f32_16x16x32_bf16(bg[ks], ag, cg_, 0, 0, 0); }
                    *(LAS f32x4*)(Gt + t * 32 + kp * 16 + fq * 4) = cg_;
                }
                GRP_BAR();
                {
                    const int t = tidp >> 3, k8 = tidp & 7, k0 = k8 * 8;
                    float ks8[8], a8[8], r8[8], kk8[8], km8[8], pk[8], pa[8], pr[8]; float n2 = 0.f, bon = 0.f;
#pragma unroll
                    for (int i = 0; i < 2; ++i) { const f32x4 x0 = *(const LAS f32x4*)(KS + t * 64 + k0 + 4 * i), x1 = *(const LAS f32x4*)(Aa + t * 64 + k0 + 4 * i), x2 = *(const LAS f32x4*)(Rr + t * 64 + k0 + 4 * i);
                        const f32x4 y0 = *(const LAS f32x4*)(PRM + k0 + 4 * i), y1 = *(const LAS f32x4*)(PRM + 64 + k0 + 4 * i), y2 = *(const LAS f32x4*)(PRM + 128 + k0 + 4 * i);
#pragma unroll
                        for (int j = 0; j < 4; ++j) { ks8[4 * i + j] = x0[j]; a8[4 * i + j] = x1[j]; r8[4 * i + j] = x2[j]; pk[4 * i + j] = y0[j]; pa[4 * i + j] = y1[j]; pr[4 * i + j] = y2[j]; } }
#pragma unroll
                    for (int i = 0; i < 8; ++i) { kk8[i] = ks8[i] * pk[i]; n2 += kk8[i] * kk8[i]; km8[i] = ks8[i] * (1.f + (a8[i] - 1.f) * pa[i]); bon += r8[i] * km8[i] * pr[i]; }
                    n2 = red8(n2); bon = red8(bon);
                    const float inv = 1.f / fmaxf(sqrtf(n2), 1e-12f);
                    f32x4 o0[2], o1[2], o2[2];
#pragma unroll
                    for (int i = 0; i < 8; ++i) { const float kn = kk8[i] * inv; o0[i >> 2][i & 3] = -kn; o1[i >> 2][i & 3] = km8[i]; o2[i >> 2][i & 3] = kn * a8[i]; }
#pragma unroll
                    for (int i = 0; i < 2; ++i) { *(LAS f32x4*)(KK + t * 64 + k0 + 4 * i) = o0[i]; *(LAS f32x4*)(KM + t * 64 + k0 + 4 * i) = o1[i]; *(LAS f32x4*)(Bv + t * 64 + k0 + 4 * i) = o2[i]; }
                    const int r4 = k8 * 4;
                    const f32x4 g4 = *(const LAS f32x4*)(Gt + t * 32 + r4), v4 = *(const LAS f32x4*)(Vv + t * 32 + r4), gw4 = *(const LAS f32x4*)(PRM + 320 + r4), gb4 = *(const LAS f32x4*)(PRM + 352 + r4);
                    u32x2 q1, q2;
                    q1.x = cvt_pk_bf16(g4[0] * gw4[0], g4[1] * gw4[1]); q1.y = cvt_pk_bf16(g4[2] * gw4[2], g4[3] * gw4[3]);
                    q2.x = cvt_pk_bf16(g4[0] * (gb4[0] + bon * v4[0]), g4[1] * (gb4[1] + bon * v4[1])); q2.y = cvt_pk_bf16(g4[2] * (gb4[2] + bon * v4[2]), g4[3] * (gb4[3] + bon * v4[3]));
                    *(LAS u32x2*)(Q1B(qj) + t * 32 + r4) = q1; *(LAS u32x2*)(Q2B(qj) + t * 32 + r4) = q2;
                }
            }
            if (wave == 7 && it >= 2) {
                const int t = lane & 31;
                float ns1 = 0.f, ns2 = 0.f;
                if (it <= 129) {
                    const int c = it - 2, yj = c & 3;
#pragma unroll
                    for (int i = 0; i < 8; ++i) { const f32x4 y = *(const LAS f32x4*)(YY(yj) + t * 32 + 4 * i); ns1 += (y[0] + y[1]) + (y[2] + y[3]); ns2 += (y[0] * y[0] + y[1] * y[1]) + (y[2] * y[2] + y[3] * y[3]); }
                    const unsigned long long ep = (unsigned long long)(unsigned)(c + 1) << 32;
                    unsigned long long* gbase = gran + (((size_t)bh * 128 + c) * 2) * 64 + t * 2;
                    if (lane < 32) { __hip_atomic_store(gbase + rg * 64, ep | __builtin_bit_cast(unsigned, ns1), RLX_AGENT); __hip_atomic_store(gbase + rg * 64 + 1, ep | __builtin_bit_cast(unsigned, ns2), RLX_AGENT); }
                }
                if (it >= 3) {
                    const int c = it - 3, yj = c & 3;
                    unsigned long long* gb3 = gran + (((size_t)bh * 128 + c) * 2) * 64 + t * 2 + (rg ^ 1) * 64;
                    unsigned spins = 0;
                    for (;;) {
                        const bool ok = ((g0 >> 32) == (unsigned long long)(unsigned)(c + 1)) && ((g1 >> 32) == (unsigned long long)(unsigned)(c + 1));
                        if (__all(ok)) break;
                        __builtin_amdgcn_s_sleep(2); if (++spins > (1u << 20)) break;
                        g0 = __hip_atomic_load(gb3, RLX_AGENT); g1 = __hip_atomic_load(gb3 + 1, RLX_AGENT);
                    }
                    const float s1 = ps1 + __builtin_bit_cast(float, (unsigned)g0), s2 = ps2 + __builtin_bit_cast(float, (unsigned)g1);
                    const float mean = s1 * (1.f / 64.f), var = fmaxf(s2 * (1.f / 64.f) - mean * mean, 0.f), rstd = rsqrtf(var + 64e-5f);
                    if (lane < 32) {
                        bf16_t* dst = Yb + ((size_t)b * SEQ + c * 32 + t) * DM + h * 64 + rg * 32;
#pragma unroll
                        for (int i = 0; i < 4; ++i) {
                            const f32x4 ya = *(const LAS f32x4*)(YY(yj) + t * 32 + 8 * i), yb = *(const LAS f32x4*)(YY(yj) + t * 32 + 8 * i + 4);
                            const u32x4 q1 = *(const LAS u32x4*)(Q1B(yj) + t * 32 + 8 * i), q2 = *(const LAS u32x4*)(Q2B(yj) + t * 32 + 8 * i);
                            u32x4 w;
                            w.x = cvt_pk_bf16((ya[0] - mean) * rstd * bflo(q1.x) + bflo(q2.x), (ya[1] - mean) * rstd * bfhi(q1.x) + bfhi(q2.x));
                            w.y = cvt_pk_bf16((ya[2] - mean) * rstd * bflo(q1.y) + bflo(q2.y), (ya[3] - mean) * rstd * bfhi(q1.y) + bfhi(q2.y));
                            w.z = cvt_pk_bf16((yb[0] - mean) * rstd * bflo(q1.z) + bflo(q2.z), (yb[1] - mean) * rstd * bfhi(q1.z) + bfhi(q2.z));
                            w.w = cvt_pk_bf16((yb[2] - mean) * rstd * bflo(q1.w) + bflo(q2.w), (yb[3] - mean) * rstd * bfhi(q1.w) + bfhi(q2.w));
                            *(u32x4*)(dst + 8 * i) = w;
                        }
                    }
                }
                ps1 = ns1; ps2 = ns2;
            }
        } else if (it >= 1 && it <= 128) {
            const int c = it - 1, os = c & 1, yj = c & 3, grp = tid >> 4, kq = tid & 15;
            LAS const unsigned char* ob = (LAS const unsigned char*)OPS_RR(os) + kq * 16;
            LAS const unsigned char* vp = (LAS const unsigned char*)VV(os) + grp * 8; LAS unsigned char* yp = (LAS unsigned char*)YY(yj) + grp * 8;
            f32x4 wA, bA, mA, kA, rA, wB, bB, mB, kB, rB; f32x2 vA, vB;
#define RW_LD(X, d) do { r##X = *(const LAS f32x4*)(ob + (d) * 256); w##X = *(const LAS f32x4*)(ob + (d) * 256 + 8192); b##X = *(const LAS f32x4*)(ob + (d) * 256 + 16384); m##X = *(const LAS f32x4*)(ob + (d) * 256 + 24576); \
                k##X = *(const LAS f32x4*)(ob + (d) * 256 + 32768); v##X = *(const LAS f32x2*)(vp + (d) * 128); } while (0)
#define RW_LVL(a_, b_, C) do { a_ += dpp_f<C>(a_); b_ += dpp_f<C>(b_); asm volatile("" : "+v"(a_), "+v"(b_)); } while (0)
#define RW_RED2(x) do { float a_ = x[0], b_ = x[1]; RW_LVL(a_, b_, 0xB1); RW_LVL(a_, b_, 0x4E); RW_LVL(a_, b_, 0x141); RW_LVL(a_, b_, 0x140); x = (f32x2){a_, b_}; } while (0)
#define RW_STEP(X, t) do { f32x2 sa = S2[0] * k##X[0]; sa = S2[1] * k##X[1] + sa; sa = S2[2] * k##X[2] + sa; sa = S2[3] * k##X[3] + sa; RW_RED2(sa); \
                _Pragma("unroll") for (int i = 0; i < 4; ++i) S2[i] = S2[i] * w##X[i] + (sa * b##X[i] + v##X * m##X[i]); \
                f32x2 y = S2[0] * r##X[0]; y = S2[1] * r##X[1] + y; y = S2[2] * r##X[2] + y; y = S2[3] * r##X[3] + y; RW_RED2(y); \
                if (kq == 0) *(LAS f32x2*)(yp + (t) * 128) = y; } while (0)
            RW_LD(A, 0);
#pragma unroll 1
            for (int t = 0; t < 32; t += 2) {
                RW_LD(B, 1); __builtin_amdgcn_sched_barrier(0);
                RW_STEP(A, 0); __builtin_amdgcn_sched_barrier(0);
                if (t == 30) { ob -= 30 * 256; vp -= 30 * 128; }
                RW_LD(A, 2); __builtin_amdgcn_sched_barrier(0);
                RW_STEP(B, 1); __builtin_amdgcn_sched_barrier(0);
                ob += 512; vp += 256; yp += 256;
            }
#undef RW_LD
#undef RW_STEP
#undef RW_RED2
#undef RW_LVL
        }
        WG_BAR();
    }
#undef RW_PREFETCH
#undef RW_PF1
#undef GRP_BAR
#undef OPS_RR
#undef OPS_WW
#undef OPS_BV
#undef OPS_KM
#undef OPS_KK
#undef VV
#undef YY
#undef Q1B
#undef Q2B
}

#define TRI(r, t) ((r) * 72 + (((((t) >> 3) ^ (((r) >> 3) & 7))) << 3) + ((t) & 7))
#define TRB(r, blk) ((r) * 72 + (((blk) ^ (((r) >> 3) & 7)) << 3))
__device__ __forceinline__ void mlstm_item(const Params& P, LAS unsigned char* lds, int bh) {
    const int tid = threadIdx.x, lane = tid & 63, wave = tid >> 6, fr = lane & 15, fq = lane >> 4;
    const int b = bh >> 2, h = bh & 3; unsigned char* ws = P.ws;
    const bf16_t* Z = (const bf16_t*)(ws + OFF_Z); bf16_t* Yb = (bf16_t*)(ws + OFF_Y); const float* IFb = (const float*)(ws + OFF_IF);
    const float* cw = P.in[19]; const float* cb = P.in[20]; const float ib = P.in[21][h], fb = P.in[22][h]; const float* mln = P.in[23];
    LAS bf16_t* Qs = (LAS bf16_t*)(lds); LAS bf16_t* Ks = (LAS bf16_t*)(lds + 17408); LAS bf16_t* KT = (LAS bf16_t*)(lds + 34816); LAS bf16_t* VT = (LAS bf16_t*)(lds + 53248);
    LAS bf16_t* VwT = (LAS bf16_t*)(lds + 71680); LAS bf16_t* Pp = (LAS bf16_t*)(lds + 90112); LAS bf16_t* Cb = (LAS bf16_t*)(lds + 99328);
    LAS float* F = (LAS float*)(lds + 134144);
    LAS float* ga = F, *gu = F + 64, *gwl = F + 128, *gwi = F + 192, *gei = F + 256, *dn = F + 320, *nq = F + 384, *lnx = F + 448  , *ns = F + 704  , *sc = F + 832;
    LAS float* CWL = (LAS float*)(lds + 138240);
    LAS float* CBL = CWL + 1024; LAS float* MLN = CWL + 1280;
    for (int i = tid; i < 1024; i += 512) { const int j = i >> 8, cc = i & 255; CWL[i] = cw[j * 1024 + (cc < 128 ? h * 128 + cc : 512 + h * 128 + cc - 128)]; }
    if (tid < 256) CBL[tid] = cb[tid < 128 ? h * 128 + tid : 512 + h * 128 + tid - 128];
    if (tid < 128) MLN[tid] = mln[h * 128 + tid];
    f32x4 Cacc[8];
#pragma unroll
    for (int i = 0; i < 8; ++i) Cacc[i] = (f32x4){0.f, 0.f, 0.f, 0.f};
    const int pcv = tid & 31, ptg = tid >> 5; const bool pisk = pcv >= 16; const int pc8 = (pcv & 15) * 8;
    const int pzcol = (pisk ? 2304 : 1792) + h * 128 + pc8;
    u32x4 rw[7], vx[2]; u32x2 ogp[4]; float pfb = 0.f, pfu = 0.f, pfp = 0.f, pfe = 0.f, pfm = 0.f;
#define ML_PF_QKV(cn) do { _Pragma("unroll") for (int d = 0; d < 7; ++d) { const int tl = (cn) * 64 + ptg * 4 - 3 + d; rw[d] = (u32x4){0u, 0u, 0u, 0u}; if (tl >= 0) rw[d] = *(const u32x4*)(Z + ((size_t)b * SEQ + tl) * ZLD + pzcol); } \
        _Pragma("unroll") for (int rep = 0; rep < 2; ++rep) { const int v = tid + rep * 512; vx[rep] = *(const u32x4*)(Z + ((size_t)b * SEQ + (cn) * 64 + (v >> 4)) * ZLD + 2816 + h * 128 + (v & 15) * 8); } } while (0)
#define ML_PF_IF(cn) do { if (wave == 0) { pfb = GS[(cn) * 64 + lane]; pfu = GS[4096 + (cn) * 64 + lane]; pfp = GS[8192 + (cn) * 64 + lane]; pfe = GS[12288 + (cn)]; pfm = GS[12352 + (cn)]; } } while (0)
#define ML_PF_OG(cn) do { _Pragma("unroll") for (int q = 0; q < 4; ++q) ogp[q] = *(const u32x2*)(Z + ((size_t)b * SEQ + (cn) * 64 + (wave & 3) * 16 + fr) * ZLD + 3328 + h * 128 + ((wave >> 2) * 4 + q) * 16 + fq * 4); } while (0)
    float* GS = (float*)(ws + OFF_GATES) + (size_t)bh * 12416;
    for (int cc = wave; cc < 64; cc += 8) {
        const size_t tk = (size_t)b * SEQ + cc * 64 + lane;
        const float ig = IFb[tk * 8 + h] + ib, fg = IFb[tk * 8 + 4 + h] + fb;
        const float lf = fminf(fg, 0.f) - __logf(1.f + __expf(-fabsf(fg)));
        float bc = lf;
#pragma unroll
        for (int o = 1; o < 64; o <<= 1) { const float t = __shfl_up(bc, o); if (lane >= o) bc += t; }
        const float bend = __shfl(bc, 63), u = ig - bc;
        float mc = bend + u;
#pragma unroll
        for (int o = 1; o < 64; o <<= 1) mc = fmaxf(mc, __shfl_xor(mc, o));
        float pm = u;
#pragma unroll
        for (int o = 1; o < 64; o <<= 1) { const float t = __shfl_up(pm, o); if (lane >= o) pm = fmaxf(pm, t); }
        GS[cc * 64 + lane] = bc; GS[4096 + cc * 64 + lane] = u; GS[8192 + cc * 64 + lane] = pm;
        if (lane == 0) { GS[12288 + cc] = bend; GS[12352 + cc] = mc; }
    }
    WG_BAR_ALL();
    ML_PF_IF(0); ML_PF_QKV(0); ML_PF_OG(0);
    for (int i = tid; i < 128 * 136 / 2; i += 512) ((LAS unsigned*)Cb)[i] = 0u;
    if (tid < 128) ns[tid] = 0.f;
    float mprev = 0.f;
    WG_BAR();
#pragma unroll 1
    for (int c = 0; c < 64; ++c) {
        int tl_ = threadIdx.x; asm volatile("" : "+v"(tl_));
        const int tid = tl_, lane = tid & 63, wave = tid >> 6, fr = lane & 15, fq = lane >> 4;
        const int pcv = tid & 31, ptg = tid >> 5; const bool pisk = pcv >= 16; const int pc8 = (pcv & 15) * 8;
        const int pzcol = (pisk ? 2304 : 1792) + h * 128 + pc8;
        const size_t tokc = (size_t)b * SEQ + c * 64;
        if (wave == 0) {
            const float bc = pfb, u = pfu, pm = pfp, bend = pfe, mc = pfm;
            ML_PF_IF((c + 1) & 63);
            const float lw = bend + u;
            const float mnew = fmaxf(bend + mprev, mc), dec = __expf(bend + mprev - mnew);
            const float linter = bc + mprev, mrow = fmaxf(linter, bc + pm);
            ga[lane] = bc - mrow; gu[lane] = u; gwl[lane] = __expf(lw - mnew); gwi[lane] = __expf(linter - mrow); gei[lane] = __expf(-mrow); dn[lane] = 0.f;
            if (lane == 0) { sc[0] = dec; sc[1] = mnew; }
        }
        WG_BAR();
        {
            const int tg = ptg; const bool isk = pisk; const int c8 = pc8, lch = (isk ? 128 : 0) + c8;
            float wt[4][8], bs[8];
#pragma unroll
            for (int j = 0; j < 4; ++j) { const f32x4 x0 = *(const LAS f32x4*)(CWL + j * 256 + lch), x1 = *(const LAS f32x4*)(CWL + j * 256 + lch + 4);
#pragma unroll
                for (int i = 0; i < 4; ++i) { wt[j][i] = x0[i]; wt[j][4 + i] = x1[i]; } }
            { const f32x4 x0 = *(const LAS f32x4*)(CBL + lch), x1 = *(const LAS f32x4*)(CBL + lch + 4);
#pragma unroll
              for (int i = 0; i < 4; ++i) { bs[i] = x0[i]; bs[4 + i] = x1[i]; } }
#pragma unroll
            for (int q = 0; q < 4; ++q) {
                const int t = tg * 4 + q; float o[8];
#pragma unroll
                for (int i = 0; i < 8; ++i) o[i] = bs[i];
#pragma unroll
                for (int j = 0; j < 4; ++j) { const u32x4 x = rw[3 + q - j]; const float x8[8] = {bflo(x.x), bfhi(x.x), bflo(x.y), bfhi(x.y), bflo(x.z), bfhi(x.z), bflo(x.w), bfhi(x.w)};
#pragma unroll
                    for (int i = 0; i < 8; ++i) o[i] += wt[j][i] * x8[i]; }
#pragma unroll
                for (int i = 0; i < 8; ++i) { o[i] = o[i] * fsigmoid(o[i]); if (!isk) o[i] *= 0.08838834764831845f; }
                u32x4 w; w.x = cvt_pk_bf16(o[0], o[1]); w.y = cvt_pk_bf16(o[2], o[3]); w.z = cvt_pk_bf16(o[4], o[5]); w.w = cvt_pk_bf16(o[6], o[7]);
                if (!isk) *(LAS u32x4*)(Qs + t * 136 + c8) = w;
                else { *(LAS u32x4*)(Ks + t * 136 + c8) = w;
#pragma unroll
                    for (int i = 0; i < 8; ++i) KT[TRI(c8 + i, t)] = f2bf(o[i]); }
            }
#pragma unroll
            for (int rep = 0; rep < 2; ++rep) {
                const int v = tid + rep * 512, t = v >> 4, v8 = (v & 15) * 8;
                const u32x4 x = vx[rep]; const float wl = gwl[t];
                const float x8[8] = {bflo(x.x), bfhi(x.x), bflo(x.y), bfhi(x.y), bflo(x.z), bfhi(x.z), bflo(x.w), bfhi(x.w)};
#pragma unroll
                for (int i = 0; i < 8; ++i) { VT[TRI(v8 + i, t)] = f2bf(x8[i]); VwT[TRI(v8 + i, t)] = f2bf(x8[i] * wl); }
            }
            if (c < 63) ML_PF_QKV(c + 1);
        }
        WG_BAR();
        const int st = wave & 3;
        bf16x8 qf[4];
#pragma unroll
        for (int ks = 0; ks < 4; ++ks) qf[ks] = *(const LAS bf16x8*)(Qs + (st * 16 + fr) * 136 + ks * 32 + fq * 8);
        {
            const int s = st * 16 + fr; const float gas = ga[s]; float dsum = 0.f;
#pragma unroll
            for (int q = 0; q < 2; ++q) {
                const int rt = (wave >> 2) * 2 + q; f32x4 a = (f32x4){0.f, 0.f, 0.f, 0.f};
#pragma unroll
                for (int ks = 0; ks < 4; ++ks) { const bf16x8 kf = *(const LAS bf16x8*)(Ks + (rt * 16 + fr) * 136 + ks * 32 + fq * 8); a = __builtin_amdgcn_mfma_f32_16x16x32_bf16(kf, qf[ks], a, 0, 0, 0); }
                const int r0 = rt * 16 + fq * 4; float p[4];
#pragma unroll
                for (int j = 0; j < 4; ++j) { p[j] = (r0 + j <= s) ? __expf(gas + gu[r0 + j]) * a[j] : 0.f; dsum += p[j]; }
                u32x2 w; w.x = cvt_pk_bf16(p[0], p[1]); w.y = cvt_pk_bf16(p[2], p[3]); *(LAS u32x2*)(Pp + s * 72 + r0) = w;
            }
            dsum += __shfl_xor(dsum, 16); dsum += __shfl_xor(dsum, 32);
            if (fq == 0) __hip_atomic_fetch_add(dn + s, dsum, __ATOMIC_RELAXED, __HIP_MEMORY_SCOPE_WORKGROUP);
            const int s2 = tid >> 3, kq = tid & 7; float a = 0.f;
#pragma unroll
            for (int i = 0; i < 16; ++i) a += ns[kq * 16 + i] * bf2f(Qs[s2 * 136 + kq * 16 + i]);
            a = red8(a); if (kq == 0) nq[s2] = a;
        }
        WG_BAR();
        {
            const int s = st * 16 + fr, vh = wave >> 2; const float wi = gwi[s];
            const float den = dn[s] + wi * nq[s], dinv = 1.f / fmaxf(fabsf(den), gei[s]);
            bf16x8 pf[2];
#pragma unroll
            for (int ks = 0; ks < 2; ++ks) pf[ks] = *(const LAS bf16x8*)(Pp + s * 72 + ks * 32 + fq * 8);
            f32x4 hv[4]; float s1 = 0.f, s2 = 0.f;
#pragma unroll
            for (int q = 0; q < 4; ++q) {
                const int vt = vh * 4 + q; f32x4 a = (f32x4){0.f, 0.f, 0.f, 0.f};
#pragma unroll
                for (int ks = 0; ks < 4; ++ks) { const bf16x8 cf = *(const LAS bf16x8*)(Cb + (vt * 16 + fr) * 136 + ks * 32 + fq * 8); a = __builtin_amdgcn_mfma_f32_16x16x32_bf16(cf, qf[ks], a, 0, 0, 0); }
                a = a * wi;
#pragma unroll
                for (int ks = 0; ks < 2; ++ks) { const bf16x8 vf = *(const LAS bf16x8*)(VT + TRB(vt * 16 + fr, ks * 4 + fq)); a = __builtin_amdgcn_mfma_f32_16x16x32_bf16(vf, pf[ks], a, 0, 0, 0); }
                a = a * dinv; hv[q] = a;
#pragma unroll
                for (int j = 0; j < 4; ++j) { s1 += a[j]; s2 += a[j] * a[j]; }
            }
            s1 += __shfl_xor(s1, 16); s1 += __shfl_xor(s1, 32); s2 += __shfl_xor(s2, 16); s2 += __shfl_xor(s2, 32);
            if (fq == 0) { lnx[s * 4 + vh * 2] = s1; lnx[s * 4 + vh * 2 + 1] = s2; }
            WG_BAR();
            const f32x4 l4 = *(const LAS f32x4*)(lnx + s * 4);
            const float mean = (l4[0] + l4[2]) * (1.f / 128.f), var = fmaxf((l4[1] + l4[3]) * (1.f / 128.f) - mean * mean, 0.f), rstd = rsqrtf(var + 1e-6f);
            const size_t tok = tokc + s;
#pragma unroll
            for (int q = 0; q < 4; ++q) {
                const int v0 = (vh * 4 + q) * 16 + fq * 4;
                const u32x2 og = ogp[q]; const f32x4 g4 = *(const LAS f32x4*)(MLN + v0);
                const float o0 = (hv[q][0] - mean) * rstd * g4[0] * fsigmoid(bflo(og.x)), o1 = (hv[q][1] - mean) * rstd * g4[1] * fsigmoid(bfhi(og.x));
                const float o2 = (hv[q][2] - mean) * rstd * g4[2] * fsigmoid(bflo(og.y)), o3 = (hv[q][3] - mean) * rstd * g4[3] * fsigmoid(bfhi(og.y));
                u32x2 w; w.x = cvt_pk_bf16(o0, o1); w.y = cvt_pk_bf16(o2, o3);
                *(u32x2*)(Yb + tok * DM + 512 + h * 128 + v0) = w;
            }
            if (c < 63) ML_PF_OG(c + 1);
        }
        WG_BAR();
        {
            const float dec = sc[0];
            bf16x8 vf[2];
#pragma unroll
            for (int ks = 0; ks < 2; ++ks) vf[ks] = *(const LAS bf16x8*)(VwT + TRB(wave * 16 + fr, ks * 4 + fq));
#pragma unroll
            for (int kt = 0; kt < 8; ++kt) {
                f32x4 a = Cacc[kt] * dec;
#pragma unroll
                for (int ks = 0; ks < 2; ++ks) { const bf16x8 kf = *(const LAS bf16x8*)(KT + TRB(kt * 16 + fr, ks * 4 + fq)); a = __builtin_amdgcn_mfma_f32_16x16x32_bf16(kf, vf[ks], a, 0, 0, 0); }
                Cacc[kt] = a;
                u32x2 w; w.x = cvt_pk_bf16(a[0], a[1]); w.y = cvt_pk_bf16(a[2], a[3]);
                *(LAS u32x2*)(Cb + (wave * 16 + fr) * 136 + kt * 16 + fq * 4) = w;
            }
            if (tid < 128) { float a = ns[tid] * dec;
                for (int l = 0; l < 64; ++l) a += gwl[l] * bf2f(Ks[l * 136 + tid]);
                ns[tid] = a; }
            mprev = sc[1];
        }
        WG_BAR();
    }
#undef ML_PF_QKV
#undef ML_PF_IF
#undef ML_PF_OG
}

struct SchedKV {
    const char* memb; const char* wk; const char* wv; int j;
    __device__ __forceinline__ bool next(int i, Unit& u) const {
        if (i != 0 || j < 0 || j >= 64) return false;
        const size_t ts = (size_t)256 * 1024 * 2;
        if (j < 32) { u.pm = j >> 2; u.pn = j & 3; u.A = memb + u.pm * ts; u.B = wk + u.pn * ts; u.tag = 0; }
        else { const int q = j - 32; u.pm = q >> 3; u.pn = q & 7; u.A = wv + u.pm * ts; u.B = memb + u.pn * ts; u.tag = 1; }
        u.nt = 16; return true;
    }
};
struct SchedMerge {
    const char* yb; const char* wup; int c;
    __device__ __forceinline__ bool next(int i, Unit& u) const {
        if (i >= 4) return false;
        const int T = c + 256 * (i >> 1), pass = i & 1; u.pm = T >> 2; u.pn = T & 3; u.tag = pass ? 3 : 1; u.nt = 8;
        const size_t ts = (size_t)256 * 1024 * 2;
        u.A = yb + u.pm * ts + pass * 1024; u.B = wup + u.pn * ts + pass * 1024;
        return true;
    }
};
struct SchedPanel {
    const char* A; const char* B; size_t tstep; int c;
    __device__ __forceinline__ bool next(int i, Unit& u) const {
        if (i >= 2) return false;
        u.pm = c >> 1; u.pn = 2 * (c & 1) + i; u.nt = 44; u.tag = 0;
        u.A = A + (size_t)u.pm * tstep; u.B = B + (size_t)u.pn * tstep; return true;
    }
};
struct SchedGate {
    const char* xb; const char* wg; int j0;
    __device__ __forceinline__ bool next(int i, Unit& u) const {
        const int j = j0 + 96 * i; if (j >= 1024) return false;
        u.pm = j >> 3; u.pn = j & 7; u.nt = 16; u.tag = 0;
        const size_t ts = (size_t)256 * 1024 * 2;
        u.A = xb + u.pm * ts; u.B = wg + u.pn * ts;
        return true;
    }
};
struct SchedAttn {
    const char* xb; const char* wq; const char* q; const char* p; const char* kb; const char* vt; int c;
    __device__ __forceinline__ bool next(int i, Unit& u) const {
        if (i >= 6) return false;
        const int pr = c + 256 * (i & 1), b = pr >> 6, h = (pr >> 4) & 3, qt = pr & 15, st = i >> 1;
        u.pm = b * 16 + qt; u.pn = h;
        const size_t ao = ((size_t)u.pm * 256 * 1024 + h * 256) * 2;
        if (st == 0) { u.A = xb + (size_t)u.pm * 256 * 1024 * 2; u.B = wq + (size_t)h * 256 * 1024 * 2; u.nt = 16; u.tag = 2; }
        else if (st == 1) { u.A = q + ao; u.B = kb + ((size_t)b * 256 * 1024 + h * 256) * 2; u.nt = 4; u.tag = 0; }
        else { u.A = p + ao; u.B = vt + (size_t)(b >> 2) * 2097152 + ((size_t)h * 256 * 1024 + (b & 3) * 256) * 2; u.nt = 4; u.tag = 1; }
        return true;
    }
};

#define XB_TMO      128
#define XB_XCNT(j)  (256  + 64 * (j))
#define XB_XSUB(j)  (1280 + 64 * (j))
#define XB_XGEN(j)  (2304 + 64 * (j))
#define XB_TOP      3328
#define XB_TOPGEN   3392
#define XCD_BAR_WORDS 3456
#define XB_SPIN_CAP (1u << 18)
__device__ __forceinline__ unsigned xb_ld(unsigned* p)              { return __hip_atomic_load(p, __ATOMIC_RELAXED, __HIP_MEMORY_SCOPE_AGENT); }
__device__ __forceinline__ unsigned xb_add(unsigned* p, unsigned v) { return __hip_atomic_fetch_add(p, v, __ATOMIC_RELAXED, __HIP_MEMORY_SCOPE_AGENT); }
__device__ __forceinline__ unsigned xb_xcc_id() { return (unsigned)__builtin_amdgcn_s_getreg((3 << 11) | 20) & 0xFu; }
#define XB_SPIN(cond, bar) do { unsigned _sp = 0; while (cond) { __builtin_amdgcn_s_sleep(1); \
    if ((++_sp & 255u) == 0u) { if (xb_ld(&(bar)[XB_TMO])) break; if (_sp > XB_SPIN_CAP) { atomicAdd(&(bar)[XB_TMO], 1u); break; } } } } while (0)
struct XcdBarrier { unsigned* bar; unsigned x; volatile LAS unsigned* st; };
__device__ __forceinline__ XcdBarrier xcd_barrier_post(unsigned* bar, volatile LAS unsigned* st) {
    XcdBarrier b; b.bar = bar; b.x = xb_xcc_id(); b.st = st;
    if (threadIdx.x == 0) (void)xb_add(&bar[XB_XCNT(b.x)], 1u);
    return b;
}
__device__ __forceinline__ void xcd_barrier_complete(unsigned* bar, unsigned x, unsigned& nloc, unsigned& nx) {
    const unsigned G = gridDim.x * gridDim.y * gridDim.z;
    unsigned sum, cnt, mine, sp = 0u;
    for (;;) {
        sum = 0u; cnt = 0u; mine = 0u;
#pragma unroll
        for (unsigned j = 0; j < 16; ++j) { const unsigned c = xb_ld(&bar[XB_XCNT(j)]); sum += c; cnt += (c > 0u) ? 1u : 0u; mine = (j == x) ? c : mine; }
        if (sum == G) break;
        __builtin_amdgcn_s_sleep(1);
        if ((++sp & 255u) == 0u) { if (xb_ld(&bar[XB_TMO])) break; if (sp > XB_SPIN_CAP) { atomicAdd(&bar[XB_TMO], 1u); break; } }
    }
    nloc = mine > 0u ? mine : 1u; nx = cnt > 0u ? cnt : 1u;
}
__device__ __forceinline__ void xcd_barrier(const XcdBarrier& b) {
    asm volatile("s_waitcnt vmcnt(0)" ::: "memory");
    __syncthreads();
    if (threadIdx.x == 0) {
        unsigned* bar = b.bar;
        __builtin_amdgcn_s_waitcnt(0);
        unsigned nloc = b.st[0], nx = b.st[1];
        if (nloc == 0u) { xcd_barrier_complete(bar, b.x, nloc, nx); b.st[0] = nloc; b.st[1] = nx; }
        const unsigned old = xb_add(&bar[XB_XSUB(b.x)], 1u);
        const unsigned gen = old / nloc;
        if (old + 1u == (gen + 1u) * nloc) {
            __builtin_amdgcn_fence(__ATOMIC_RELEASE, "agent");
            asm volatile("s_waitcnt vmcnt(0)" ::: "memory");
            const unsigned og = xb_add(&bar[XB_TOP], 1u);
            const unsigned tg = og / nx;
            if (og + 1u == (tg + 1u) * nx) xb_add(&bar[XB_TOPGEN], 1u);
            else XB_SPIN(xb_ld(&bar[XB_TOPGEN]) == tg, bar);
            __builtin_amdgcn_fence(__ATOMIC_ACQUIRE, "agent");
            xb_add(&bar[XB_XGEN(b.x)], 1u);
            asm volatile("s_waitcnt vmcnt(0)" ::: "memory");
        } else {
            XB_SPIN(xb_ld(&bar[XB_XGEN(b.x)]) == gen, bar);
            __builtin_amdgcn_fence(__ATOMIC_ACQUIRE, "agent");
            asm volatile("s_waitcnt vmcnt(0)" ::: "memory");
        }
    }
    __syncthreads();
}

__global__ void __launch_bounds__(512, 2) mega(Params P) {
    extern __shared__ __attribute__((aligned(16))) unsigned char smem[];
    LAS unsigned char* lds = (LAS unsigned char*)smem;
    unsigned char* ws = P.ws;
    const int G = gridDim.x, c = blockIdx.x, lo = P.ph_lo, hi = P.ph_hi;
    float* ssq0 = (float*)(ws + OFF_SSQ0); float* ssq1 = (float*)(ws + OFF_SSQ1); float* ssq2 = (float*)(ws + OFF_SSQ2); float* ssq3 = (float*)(ws + OFF_SSQ3); float* ssq4 = (float*)(ws + OFF_SSQ4);
    bf16_t* XB = (bf16_t*)(ws + OFF_XB); bf16_t* U = (bf16_t*)(ws + OFF_U);
#ifdef ONLY_PHASE
#define IN(k) ((k) == ONLY_PHASE && lo <= (k) && (k) < hi)
#else
#define IN(k) (lo <= (k) && (k) < hi)
#endif
    volatile LAS unsigned* bst = (volatile LAS unsigned*)(lds + 163776);
    if (threadIdx.x < 2) bst[threadIdx.x] = 0u;
    __syncthreads();
    XcdBarrier xbar; xbar.bar = (unsigned*)(ws + OFF_BARW); xbar.x = 0; xbar.st = bst;
    if (P.coop) xbar = xcd_barrier_post((unsigned*)(ws + OFF_BARW), bst);
    if (P.ph_hi > NPHASE) cg::this_grid().sync();
#define SEAM(k) do { if (P.coop && IN(k) && IN((k) + 1)) xcd_barrier(xbar); } while (0)
    const size_t TS1 = (size_t)256 * 1024 * 2, TSF = (size_t)256 * DFF * 2;

    if (IN(0)) { phase_prep(P, lds); }
    SEAM(0);
    if (IN(1)) {
        SchedStatic S{(const char*)XB, (const char*)(ws + OFF_WGU1), TS1, 128, 22, 16, G, c}; EpiSwiglu E{U, ssq0};
        gemm_phase(lds, 1024, S, E);
    }
    SEAM(1);
    if (IN(2)) {
        SchedStatic S{(const char*)U, (const char*)(ws + OFF_WD1), TSF, 128, 4, 44, G, c}; EpiResidX<1> E{P.in[0], nullptr, XB, ssq1, 0.5f};
        gemm_phase(lds, DFF, S, E);
    }
    SEAM(2);
    if (IN(3)) {
        SchedStatic S{(const char*)XB, (const char*)(ws + OFF_WIN), TS1, 128, 16, 16, G, c}; EpiRowScale<0> E{(bf16_t*)(ws + OFF_Z), ssq1, (float*)(ws + OFF_IF)};
        gemm_phase(lds, 1024, S, E);
    }
    SEAM(3);
    if (IN(4)) {
        if (c < 128) rwkv_item(P, lds, c);
        else if (c < 160) mlstm_item(P, lds, c - 128);
        else {
            if (c < 224) { SchedKV S{(const char*)(ws + OFF_MEMB), (const char*)(ws + OFF_WK), (const char*)(ws + OFF_WV), c - 160}; EpiKV E{(bf16_t*)(ws + OFF_KB), (bf16_t*)(ws + OFF_VT), (const float*)(ws + OFF_SSQM)};
                gemm_phase(lds, 1024, S, E); }
            {
                SchedGate S{(const char*)XB, (const char*)(ws + OFF_WG), c >= 224 ? c - 224 : c - 128}; EpiGate E{(bf16_t*)P.out, (bf16_t*)P.out + (size_t)NTOK * DM, ssq1};
                gemm_phase(lds, 1024, S, E); }
            const int wv_ = threadIdx.x >> 6, ln_ = threadIdx.x & 63; LAS float* scr = (LAS float*)(lds + wv_ * 16384);
            for (int it = P.nearly + (c - 160) * 8 + wv_; it < P.nitems; it += 96 * 8) {
                int j = 0;
                while (j + 1 < P.njobs && it >= P.jobs[j + 1].item0) ++j;
                transpose_item(P.jobs[j], it - P.jobs[j].item0, scr, ln_);
            }
        }
    }
    SEAM(4);
    if (IN(5)) {
        SchedMerge S{(const char*)(ws + OFF_Y), (const char*)(ws + OFF_WUP), c};
        EpiMerge2 E{(u32x4*)(ws + OFF_SCRS) + (size_t)c * 8192, (bf16_t*)(ws + OFF_MG), (const bf16_t*)P.out, (const bf16_t*)P.out + (size_t)NTOK * DM};
        if (c < 256) gemm_phase(lds, 1024, S, E);
    }
    SEAM(5);
    if (IN(6)) {
        SchedStatic S{(const char*)(ws + OFF_MG), (const char*)(ws + OFF_WOUT), TS1, 128, 4, 16, G, c}; EpiResidX<2> E{nullptr, P.out, XB, ssq2, 1.0f};
        gemm_phase(lds, 1024, S, E);
    }
    SEAM(6);
    if (IN(8)) {
        SchedAttn S{(const char*)XB, (const char*)(ws + OFF_WQ), (const char*)(ws + OFF_Q), (const char*)(ws + OFF_P), (const char*)(ws + OFF_KB), (const char*)(ws + OFF_VT), c};
        EpiAttn E{(bf16_t*)(ws + OFF_P), (bf16_t*)(ws + OFF_O), (bf16_t*)(ws + OFF_Q), ssq2};
        if (c < 256) gemm_phase(lds, 1024, S, E);
    }
    SEAM(8);
    if (IN(9)) {
        SchedStatic S{(const char*)(ws + OFF_O), (const char*)(ws + OFF_WO), TS1, 128, 4, 16, G, c}; EpiResid<true> E{P.out, P.out, XB, ssq3, 1.0f};
        gemm_phase(lds, 1024, S, E);
    }
    SEAM(9);
    if (IN(10)) {
        SchedStatic S{(const char*)XB, (const char*)(ws + OFF_WGU2), TS1, 128, 22, 16, G, c}; EpiSwiglu E{U, ssq3};
        gemm_phase(lds, 1024, S, E);
    }
    SEAM(10);
    if (IN(11)) {
        LAS float* rowss = (LAS float*)(lds + XCH_OFF); LAS float* rsv = rowss + 256;
        if (threadIdx.x < 256) rowss[threadIdx.x] = 0.f;
        __syncthreads();
        SchedPanel S{(const char*)U, (const char*)(ws + OFF_WD2), TSF, c}; EpiResidFin E{P.out, 0.5f};
        gemm_phase(lds, DFF, S, E);
        if (threadIdx.x < 256) {
            const int r = threadIdx.x, pm = c >> 1, me = c & 1;
            unsigned long long* g = (unsigned long long*)(ws + OFF_FNG) + (size_t)pm * 512;
            const float mine = rowss[r];
            __hip_atomic_store(g + me * 256 + r, (0x5EEDull << 32) | __builtin_bit_cast(unsigned, mine), __ATOMIC_RELAXED, __HIP_MEMORY_SCOPE_AGENT);
            unsigned long long o; unsigned spins = 0;
            for (;;) { o = __hip_atomic_load(g + (me ^ 1) * 256 + r, __ATOMIC_RELAXED, __HIP_MEMORY_SCOPE_AGENT);
                if (__all((o >> 32) == 0x5EEDull)) break;
                __builtin_amdgcn_s_sleep(2); if (++spins > (1u << 22)) break; }
            rsv[r] = rsqrtf((mine + __builtin_bit_cast(float, (unsigned)o)) * (1.f / 1024.f) + NORM_EPS);
        }
        __builtin_amdgcn_fence(__ATOMIC_ACQUIRE, "agent");
        __syncthreads();
        {
            const int pm = c >> 1, me = c & 1, cq = threadIdx.x & 127, rq = threadIdx.x >> 7; const float* fn = P.in[36];
            const f32x4 g4 = *(const f32x4*)(fn + me * 512 + cq * 4);
            float* base = P.out + (size_t)pm * 256 * DM + me * 512 + cq * 4;
#pragma unroll 4
            for (int r = rq; r < 256; r += 4) { f32x4* p4 = (f32x4*)(base + (size_t)r * DM); *p4 = *p4 * rsv[r] * g4; }
        }
    }
#undef IN
#undef SEAM
}

#ifdef MK_DBG_DUMP
__global__ void dbg_dump(const bf16_t* src, int ld, int mode, float* out) {
    const size_t i = (size_t)blockIdx.x * 256 + threadIdx.x; const size_t r = i >> 10; const int c = (int)(i & 1023);
    float v = bf2f(src[r * ld + c]);
    if (mode == 1) v += 2.f * bf2f(src[r * ld + c + 1024]) + 3.f * bf2f(src[r * ld + c + 2048]) + 5.f * bf2f(src[r * ld + c + 2816]);
    if (mode == 4) v = ((const float*)src)[i & 262143];
    if (mode == 2 && c >= 512) v = 0.f;
    if (mode == 3 && c < 512) v = 0.f;
    out[i] = v;
}
#endif
static void add_job(Params& p, const float* src, const float* gain, size_t dst_off, int K, int ldsrc, int col0, int ncols, int dst_ld, int dst_row0, int dst_k0, int mode, float scale) {
    TJob& j = p.jobs[p.njobs++]; j.src = src; j.gain = gain; j.dst = (bf16_t*)(p.ws + dst_off); j.K = K; j.ldsrc = ldsrc; j.col0 = col0; j.ncols = ncols; j.dst_ld = dst_ld; j.dst_row0 = dst_row0; j.dst_k0 = dst_k0;
    j.mode = mode; j.scale = scale; j.item0 = p.nitems; p.nitems += (K / 64) * ((ncols + 63) / 64);
}
extern "C" void kernel_launch(void* const* d_in, const int* in_sizes, int n_in, void* d_out, int out_size, void* d_ws, size_t ws_size, hipStream_t stream) {
    static int ready = 0;
    if (ready == 0) {
        if (n_in != 37 || out_size != NTOK * DM || ws_size < WS_END) { fprintf(stderr, "kernel_launch: unexpected shapes: n_in %d out %d ws %zu (need %zu); nothing launched\n", n_in, out_size, ws_size, (size_t)WS_END); ready = -1; return; }
        if (hipFuncSetAttribute((const void*)mega, hipFuncAttributeMaxDynamicSharedMemorySize, LDS_BYTES) != hipSuccess) { fprintf(stderr, "kernel_launch: hipFuncSetAttribute failed\n"); ready = -1; return; }
        int per_cu = 0; (void)hipOccupancyMaxActiveBlocksPerMultiprocessor(&per_cu, (const void*)mega, 512, LDS_BYTES); (void)hipGetLastError();
        if (per_cu < 1) fprintf(stderr, "kernel_launch: note: occupancy query says %d blocks per CU\n", per_cu);
        ready = 1;
    }
    if (ready < 0) return;
    Params p; memset(&p, 0, sizeof(p));
    for (int i = 0; i < 37; ++i) p.in[i] = (const float*)d_in[i];
    p.out = (float*)d_out; p.ws = (unsigned char*)d_ws;
    const float* const* in = p.in;
    add_job(p, in[3], in[2], OFF_WGU1, 1024, DFF, 0, DFF, 1024, 0, 0, 1, 1.f);
    add_job(p, in[4], in[2], OFF_WGU1, 1024, DFF, 0, DFF, 1024, 128, 0, 1, 1.f);
    add_job(p, in[5], nullptr, OFF_WD1, DFF, 1024, 0, 1024, DFF, 0, 0, 0, 1.f);
    add_job(p, in[7], in[6], OFF_WIN, 1024, 5896, 0, 3848, 1024, 0, 0, 0, 1.f);
    add_job(p, in[30], in[28], OFF_WK, 1024, 2048, 0, 1024, 1024, 0, 0, 0, 1.f);
    add_job(p, in[30], in[28], OFF_WV, 1024, 2048, 1024, 1024, 1024, 0, 0, 0, 1.f);
    add_job(p, in[10], nullptr, OFF_W2T, 64, 512, 0, 512, 64, 0, 0, 0, 1.f);
    add_job(p, in[12], nullptr, OFF_A2T, 64, 512, 0, 512, 64, 0, 0, 0, 1.f);
    add_job(p, in[13], nullptr, OFF_G2T, 128, 512, 0, 512, 128, 0, 0, 0, 1.f);
    add_job(p, in[7], in[6], OFF_WG, 1024, 5896, 3848, 2048, 1024, 0, 0, 0, 1.f);
    p.nearly = p.nitems;
    add_job(p, in[24], nullptr, OFF_WUP, 512, 1024, 0, 1024, 1024, 0, 0, 0, 1.f);
    add_job(p, in[25], nullptr, OFF_WUP, 512, 1024, 0, 1024, 1024, 0, 512, 0, 1.f);
    add_job(p, in[26], nullptr, OFF_WOUT, 1024, 1024, 0, 1024, 1024, 0, 0, 0, 1.f);
    add_job(p, in[29], in[27], OFF_WQ, 1024, 1024, 0, 1024, 1024, 0, 0, 0, 0.0625f);
    add_job(p, in[31], nullptr, OFF_WO, 1024, 1024, 0, 1024, 1024, 0, 0, 0, 1.f);
    add_job(p, in[33], in[32], OFF_WGU2, 1024, DFF, 0, DFF, 1024, 0, 0, 1, 1.f);
    add_job(p, in[34], in[32], OFF_WGU2, 1024, DFF, 0, DFF, 1024, 128, 0, 1, 1.f);
    add_job(p, in[35], nullptr, OFF_WD2, DFF, 1024, 0, 1024, DFF, 0, 0, 0, 1.f);
    const int grid = 256;
#if MK_PER_PHASE
    p.coop = 0;
    for (int ph = 0; ph < MK_DBG_HI; ++ph) { p.ph_lo = ph; p.ph_hi = ph + 1; hipLaunchKernelGGL(mega, dim3(grid), dim3(512), LDS_BYTES, stream, p); }
#ifdef MK_DBG_DUMP
    hipLaunchKernelGGL(dbg_dump, dim3(NTOK * 4), dim3(256), 0, stream, (const bf16_t*)(p.ws + MK_DBG_DUMP), MK_DBG_LD, MK_DBG_MODE, p.out);
#endif
#else
    p.coop = 1; p.ph_lo = 0; p.ph_hi = NPHASE;
    if (hipMemsetAsync((char*)d_ws + OFF_BARW, 0, XCD_BAR_WORDS * 4, stream) != hipSuccess) { fprintf(stderr, "kernel_launch: hipMemsetAsync failed\n"); return; }
    void* args[] = {&p};
    hipError_t e = hipLaunchCooperativeKernel((const void*)mega, dim3(grid), dim3(512), args, LDS_BYTES, stream);
    if (e != hipSuccess) fprintf(stderr, "kernel_launch: cooperative launch failed: %s\n", hipGetErrorString(e));
#endif
}
```

```cpp
#include <hip/hip_runtime.h>
#include <hip/hip_cooperative_groups.h>
#include <cstdio>
#include <cstdint>
#include <cstring>
namespace cg = cooperative_groups;

#define LAS __attribute__((address_space(3)))
typedef unsigned short bf16_t;
typedef short bf16x8 __attribute__((ext_vector_type(8)));
typedef float f32x4 __attribute__((ext_vector_type(4)));
typedef float f32x2 __attribute__((ext_vector_type(2)));
typedef unsigned u32x4 __attribute__((ext_vector_type(4)));
typedef unsigned u32x2 __attribute__((ext_vector_type(2)));

#ifndef MK_DBG_HI
#define MK_DBG_HI 13
#endif
#ifndef MK_PER_PHASE
#define MK_PER_PHASE 0
#endif

constexpr int NTOK = 32768, DM = 1024, SEQ = 4096, NB = 8, DFF = 2816, MEMTOK = 2048;
constexpr int ZLD = 3840;
constexpr float NORM_EPS = 1e-5f;
constexpr int NPHASE = 13;
constexpr int LDS_BYTES = 160 * 1024;
constexpr int XCH_OFF = 131072;

constexpr size_t MiB = 1048576;
constexpr size_t OFF_SSQ0 = 0, OFF_SSQ1 = 131072, OFF_SSQ2 = 262144, OFF_SSQ3 = 393216, OFF_SSQ4 = 524288, OFF_SSQM = 655360;
constexpr size_t OFF_IF = 1 * MiB;
constexpr size_t OFF_FNG = 452 * MiB;
constexpr size_t OFF_GATES = 2 * MiB;
constexpr size_t OFF_BARW = 720896;
constexpr size_t OFF_STATS = 444 * MiB;
constexpr size_t OFF_W = 4 * MiB;
constexpr size_t SZ_WGU = (size_t)5632 * 1024 * 2, SZ_WD = (size_t)1024 * 2816 * 2, SZ_WIN = (size_t)4096 * 1024 * 2, SZ_WG = (size_t)2048 * 1024 * 2, SZ_SQ = (size_t)1024 * 1024 * 2;
constexpr size_t OFF_WGU1 = OFF_W, OFF_WD1 = OFF_WGU1 + SZ_WGU, OFF_WIN = OFF_WD1 + SZ_WD, OFF_WG = OFF_WIN + SZ_WIN, OFF_WUP = OFF_WG + SZ_WG, OFF_WOUT = OFF_WUP + SZ_SQ,
                 OFF_WQ = OFF_WOUT + SZ_SQ, OFF_WK = OFF_WQ + SZ_SQ, OFF_WV = OFF_WK + SZ_SQ, OFF_WO = OFF_WV + SZ_SQ, OFF_WGU2 = OFF_WO + SZ_SQ, OFF_WD2 = OFF_WGU2 + SZ_WGU,
                 OFF_W2T = OFF_WD2 + SZ_WD, OFF_A2T = OFF_W2T + 65536, OFF_G2T = OFF_A2T + 65536, OFF_WEND = OFF_G2T + 131072;
static_assert(OFF_WEND <= 64 * MiB, "weights");
constexpr size_t OFF_XB = 64 * MiB, OFF_Y = 128 * MiB, OFF_MEMB = 192 * MiB, OFF_KB = 196 * MiB, OFF_VT = 200 * MiB, OFF_BIG = 204 * MiB, WS_END = 460 * MiB;
constexpr size_t OFF_U = OFF_BIG, OFF_Z = OFF_BIG, OFF_SCRS = OFF_BIG, OFF_SCRM = OFF_BIG + 32 * MiB, OFF_MG = OFF_BIG + 96 * MiB, OFF_Q = OFF_BIG, OFF_P = OFF_BIG + 64 * MiB, OFF_O = OFF_BIG + 128 * MiB;

typedef __bf16 bf16x2_t __attribute__((ext_vector_type(2)));
__device__ __forceinline__ unsigned cvt_pk_bf16(float lo, float hi) { f32x2 v = {lo, hi}; bf16x2_t b = __builtin_convertvector(v, bf16x2_t); return __builtin_bit_cast(unsigned, b); }
__device__ __forceinline__ float bflo(unsigned u) { return __builtin_bit_cast(float, u << 16); }
__device__ __forceinline__ float bfhi(unsigned u) { return __builtin_bit_cast(float, u & 0xffff0000u); }
__device__ __forceinline__ float bf2f(bf16_t b) { return __builtin_bit_cast(float, (unsigned)b << 16); }
__device__ __forceinline__ bf16_t f2bf(float f) { return (bf16_t)(cvt_pk_bf16(f, 0.f) & 0xffffu); }
__device__ __forceinline__ float fsigmoid(float x) { return __builtin_amdgcn_rcpf(1.f + __expf(-x)); }
__device__ __forceinline__ float wave_sum(float v) {
#pragma unroll
    for (int o = 1; o < 64; o <<= 1) v += __shfl_xor(v, o);
    return v;
}
template <int CTRL> __device__ __forceinline__ float dpp_f(float x) { return __builtin_bit_cast(float, __builtin_amdgcn_update_dpp(0, __builtin_bit_cast(int, x), CTRL, 0xF, 0xF, true)); }
__device__ __forceinline__ float red8(float x) {
    x += dpp_f<0xB1>(x); x += dpp_f<0x4E>(x); x += dpp_f<0x141>(x); return x;
}
#define LDS_WAIT() asm volatile("s_waitcnt lgkmcnt(0)" ::: "memory")
#define WG_BAR() do { asm volatile("s_waitcnt lgkmcnt(0)" ::: "memory"); __builtin_amdgcn_s_barrier(); asm volatile("" ::: "memory"); } while (0)
#define WG_BAR_ALL() do { asm volatile("s_waitcnt vmcnt(0) lgkmcnt(0)" ::: "memory"); __builtin_amdgcn_s_barrier(); asm volatile("" ::: "memory"); } while (0)

constexpr int BM = 256, BK = 64, HALF = 128, HTB = HALF * BK * 2;
__host__ __device__ __forceinline__ int lds_byte(int r, int c) { const int st = (r >> 4) * 2 + (c >> 5), rr = r & 15, cc = c & 31, ob = rr * 64 + cc * 2; return st * 1024 + (ob ^ (((ob >> 9) & 1) << 5)); }
__host__ __device__ __forceinline__ void stage_rc(int b, int& R, int& C) { const int st = b / 1024, sb = b % 1024, swz = sb ^ (((sb >> 9) & 1) << 5); R = (st >> 1) * 16 + swz / 64; C = (st & 1) * 32 + (swz % 64) / 2; }
__host__ __device__ __forceinline__ int perm32(int rho) { const int n = rho >> 4, i = rho & 15; return 8 * (i >> 2) + 4 * n + (i & 3); }

struct Unit { const char* A; const char* B; int nt, pm, pn, tag; };

__device__ __forceinline__ void tile_of(int L, int nM, int nN, int& pm, int& pn) {
    const int nwg = nM * nN; int wgid = L;
    { const int q = nwg / 8, r = nwg % 8, xcd = wgid % 8, off = wgid / 8; wgid = (xcd < r ? xcd * (q + 1) : r * (q + 1) + (xcd - r) * q) + off; }
    const int nig = 8 * nN, gid = wgid / nig, fm = gid * 8, gsz = (nM - fm) < 8 ? (nM - fm) : 8;
    pm = fm + ((wgid % nig) % gsz); pn = (wgid % nig) / gsz;
}
struct SchedStatic {
    const char* A; const char* B; size_t tstep; int nM, nN, nt, G, c;
    __device__ __forceinline__ bool next(int i, Unit& u) const {
        const long L = (long)i * G + c; if (L >= (long)nM * nN) return false;
        int pm, pn; tile_of((int)L, nM, nN, pm, pn);
        u.A = A + (size_t)pm * tstep; u.B = B + (size_t)pn * tstep; u.nt = nt; u.pm = pm; u.pn = pn; u.tag = 0; return true;
    }
};

template <class Epi, class Sched>
__device__ __forceinline__ void gemm_phase(LAS unsigned char* lds, const int ld, const Sched& S, const Epi& E) {
    const int tid = threadIdx.x, wid = __builtin_amdgcn_readfirstlane(tid >> 6), lane = tid & 63, wr = wid >> 2, wc = wid & 3, fr = lane & 15, fq = lane >> 4;
    unsigned voffA[2], voffB[2];
#pragma unroll
    for (int i = 0; i < 2; ++i) { int R, C; stage_rc(tid * 16 + i * 8192, R, C); const int Rb = (R & ~31) + perm32(R & 31);
        voffA[i] = (unsigned)(R * ld + C) * 2u; voffB[i] = (unsigned)(Rb * ld + C) * 2u; }
    const size_t kstep = (size_t)(BK * 2);
    const size_t hstep = (size_t)HALF * ld * 2;
    const unsigned ldsw = (unsigned)wid * 1024u;
    const int aoff = lds_byte(wr * 64 + fr, fq * 8), boff = lds_byte(wc * 32 + fr, fq * 8);
#define PG8_SA(b, h) (((b) * 2 + (h)) * HTB)
#define PG8_SB(b, h) ((4 + (b) * 2 + (h)) * HTB)
#define PG8_STAGE(bufoff, gbase, voff) do { _Pragma("unroll") for (int _i = 0; _i < 2; ++_i) \
        __builtin_amdgcn_global_load_lds((const unsigned*)((const char*)(gbase) + (voff)[_i]), (LAS unsigned*)(lds + (bufoff) + ldsw + _i * 8192), 16, 0, 0); } while (0)
#define PG8_LDA(dst, b, h) do { _Pragma("unroll") for (int m = 0; m < 4; ++m) _Pragma("unroll") for (int k = 0; k < 2; ++k) dst[m][k] = *(const LAS bf16x8*)(lds + PG8_SA(b, h) + aoff + m * 2048 + k * 1024); } while (0)
#define PG8_LDB(dst, b, h) do { _Pragma("unroll") for (int n = 0; n < 2; ++n) _Pragma("unroll") for (int k = 0; k < 2; ++k) dst[n][k] = *(const LAS bf16x8*)(lds + PG8_SB(b, h) + boff + n * 2048 + k * 1024); } while (0)
#define PG8_MMA(ai, bj, At, Bt) do { __builtin_amdgcn_s_setprio(1); _Pragma("unroll") for (int m = 0; m < 4; ++m) _Pragma("unroll") for (int n = 0; n < 2; ++n) _Pragma("unroll") for (int k = 0; k < 2; ++k) \
        acc[ai][bj][m][n] = __builtin_amdgcn_mfma_f32_16x16x32_bf16(Bt[n][k], At[m][k], acc[ai][bj][m][n], 0, 0, 0); __builtin_amdgcn_s_setprio(0); } while (0)
#define PG8_WAIT_V(n) asm volatile("s_waitcnt vmcnt(" #n ")" ::: "memory")
#define PG8_WAIT_L(n) asm volatile("s_waitcnt lgkmcnt(" #n ")" ::: "memory")
#define PG8_BAR __builtin_amdgcn_s_barrier()
#define PG8_SCHED __builtin_amdgcn_sched_barrier(0)
    Unit cur, nxt; int ui = 0;
    if (!S.next(0, cur)) return;
    f32x4 acc[2][2][4][2];
#pragma unroll
    for (int a = 0; a < 2; ++a)
#pragma unroll
        for (int b = 0; b < 2; ++b)
#pragma unroll
            for (int m = 0; m < 4; ++m)
#pragma unroll
                for (int n = 0; n < 2; ++n) acc[a][b][m][n] = (f32x4){0.f, 0.f, 0.f, 0.f};
    bf16x8 At[4][2], B0[2][2], B1[2][2];
    const char* cA = cur.A; const char* cB = cur.B; int nt = cur.nt; asm volatile("" : "+s"(nt));
    PG8_STAGE(PG8_SB(0, 0), cB, voffB); PG8_STAGE(PG8_SB(0, 1), cB + hstep, voffB); PG8_STAGE(PG8_SA(0, 0), cA, voffA); PG8_STAGE(PG8_SA(0, 1), cA + hstep, voffA);
    if (wr == 1) PG8_BAR;
    PG8_WAIT_V(2); PG8_BAR;
    PG8_STAGE(PG8_SB(1, 0), cB + kstep, voffB); PG8_STAGE(PG8_SA(1, 0), cA + kstep, voffA); PG8_STAGE(PG8_SB(1, 1), cB + hstep + kstep, voffB);
    PG8_WAIT_V(6); PG8_BAR;
#pragma unroll 1
    for (;;) {
        asm volatile("" : "+s"(ui));
        const bool has_next = S.next(ui + 1, nxt);
        const char* nA = has_next ? nxt.A : cA; const char* nB = has_next ? nxt.B : cB;
#pragma unroll 1
        for (int t = 0; t < nt; t += 2) {
            const bool last = (t == nt - 2);
            const char* a1 = cA + (size_t)(t + 1) * kstep;
            const char* a2 = last ? nA : cA + (size_t)(t + 2) * kstep; const char* b2 = last ? nB : cB + (size_t)(t + 2) * kstep;
            const char* a3 = a2 + kstep; const char* b3 = b2 + kstep;
            PG8_LDB(B0, 0, 0); PG8_LDB(B1, 0, 1); PG8_SCHED; PG8_LDA(At, 0, 0); PG8_STAGE(PG8_SA(1, 1), a1 + hstep, voffA);
            PG8_WAIT_V(8); PG8_WAIT_L(0); PG8_BAR; PG8_MMA(0, 0, At, B0); PG8_MMA(0, 1, At, B1); PG8_BAR; PG8_SCHED;
            PG8_LDA(At, 0, 1); PG8_STAGE(PG8_SB(0, 0), b2, voffB); PG8_STAGE(PG8_SB(0, 1), b2 + hstep, voffB); PG8_STAGE(PG8_SA(0, 0), a2, voffA);
            PG8_WAIT_V(8); PG8_WAIT_L(0); PG8_BAR; PG8_MMA(1, 0, At, B0); PG8_MMA(1, 1, At, B1); PG8_BAR; PG8_SCHED;
            PG8_LDB(B0, 1, 0); PG8_LDB(B1, 1, 1); PG8_SCHED; PG8_LDA(At, 1, 0); PG8_STAGE(PG8_SA(0, 1), a2 + hstep, voffA);
            PG8_WAIT_V(8); PG8_WAIT_L(0); PG8_BAR; PG8_MMA(0, 0, At, B0); PG8_MMA(0, 1, At, B1); PG8_BAR; PG8_SCHED;
            PG8_LDA(At, 1, 1); PG8_STAGE(PG8_SB(1, 0), b3, voffB); PG8_STAGE(PG8_SB(1, 1), b3 + hstep, voffB); PG8_STAGE(PG8_SA(1, 0), a3, voffA);
            PG8_WAIT_V(8); PG8_WAIT_L(0); PG8_BAR; PG8_MMA(1, 0, At, B0); PG8_MMA(1, 1, At, B1); PG8_BAR; PG8_SCHED;
        }
        if (wr == 0) PG8_BAR;
        E(acc, cur, wr, wc, fr, fq, lds);
        if (!has_next) break;
#pragma unroll
        for (int a = 0; a < 2; ++a)
#pragma unroll
            for (int b = 0; b < 2; ++b)
#pragma unroll
                for (int m = 0; m < 4; ++m)
#pragma unroll
                    for (int n = 0; n < 2; ++n) acc[a][b][m][n] = (f32x4){0.f, 0.f, 0.f, 0.f};
        cur = nxt; cA = nA; cB = nB; nt = cur.nt; asm volatile("" : "+s"(nt)); ++ui;
        if (wr == 1) PG8_BAR;
    }
    PG8_WAIT_V(0);
    PG8_BAR;
#undef PG8_SA
#undef PG8_SB
#undef PG8_STAGE
#undef PG8_LDA
#undef PG8_LDB
#undef PG8_MMA
#undef PG8_WAIT_V
#undef PG8_WAIT_L
#undef PG8_BAR
#undef PG8_SCHED
}

typedef f32x4 (&AccRef)[2][2][4][2];
#define EPI_ROWS_BEGIN _Pragma("unroll") for (int ai = 0; ai < 2; ++ai) _Pragma("unroll") for (int m = 0; m < 4; ++m) { const int rl = ai * 128 + wr * 64 + m * 16 + fr;
#define EPI_ROWS_END }

struct EpiSwiglu {
    bf16_t* U; const float* ssq;
    __device__ __forceinline__ void operator()(AccRef acc, const Unit& u, int wr, int wc, int fr, int fq, LAS unsigned char*) const {
        EPI_ROWS_BEGIN
            const int row = u.pm * 256 + rl; const float rs = rsqrtf(ssq[row] * (1.f / 1024.f) + NORM_EPS);
            float o[8];
#pragma unroll
            for (int n = 0; n < 2; ++n)
#pragma unroll
                for (int j = 0; j < 4; ++j) { const float g = acc[ai][0][m][n][j] * rs, up = acc[ai][1][m][n][j] * rs; o[n * 4 + j] = g * fsigmoid(g) * up; }
            u32x4 w; w.x = cvt_pk_bf16(o[0], o[1]); w.y = cvt_pk_bf16(o[2], o[3]); w.z = cvt_pk_bf16(o[4], o[5]); w.w = cvt_pk_bf16(o[6], o[7]);
            *(u32x4*)(U + (size_t)row * DFF + u.pn * 128 + wc * 32 + fq * 8) = w;
        EPI_ROWS_END
    }
};
template <bool WB> struct EpiResid {
    const float* xin; float* xout; bf16_t* xb; float* ssq; float scale;
    __device__ __forceinline__ void operator()(AccRef acc, const Unit& u, int wr, int wc, int fr, int fq, LAS unsigned char*) const {
        EPI_ROWS_BEGIN
            const int row = u.pm * 256 + rl; float ss = 0.f;
#pragma unroll
            for (int bj = 0; bj < 2; ++bj) {
                const size_t o = (size_t)row * DM + u.pn * 256 + bj * 128 + wc * 32 + fq * 8;
                f32x4 v0 = *(const f32x4*)(xin + o), v1 = *(const f32x4*)(xin + o + 4);
                v0 = v0 + acc[ai][bj][m][0] * scale; v1 = v1 + acc[ai][bj][m][1] * scale;
                *(f32x4*)(xout + o) = v0; *(f32x4*)(xout + o + 4) = v1;
                ss += v0[0] * v0[0] + v0[1] * v0[1] + v0[2] * v0[2] + v0[3] * v0[3] + v1[0] * v1[0] + v1[1] * v1[1] + v1[2] * v1[2] + v1[3] * v1[3];
                if (WB) { u32x4 w; w.x = cvt_pk_bf16(v0[0], v0[1]); w.y = cvt_pk_bf16(v0[2], v0[3]); w.z = cvt_pk_bf16(v1[0], v1[1]); w.w = cvt_pk_bf16(v1[2], v1[3]); *(u32x4*)(xb + o) = w; }
            }
            ss += __shfl_xor(ss, 16); ss += __shfl_xor(ss, 32);
            if (fq == 0) atomicAdd(ssq + row, ss);
        EPI_ROWS_END
    }
};
template <int MODE> struct EpiResidX {
    static constexpr bool ALIGN = true;
    const float* xin; float* xout; bf16_t* xb; float* ssq; float scale;
    __device__ __forceinline__ void operator()(AccRef acc, const Unit& u, int wr, int wc, int fr, int fq, LAS unsigned char*) const {
        EPI_ROWS_BEGIN
            const int row = u.pm * 256 + rl; float ss = 0.f;
#pragma unroll
            for (int bj = 0; bj < 2; ++bj) {
                const size_t o = (size_t)row * DM + u.pn * 256 + bj * 128 + wc * 32 + fq * 8;
                f32x4 v0, v1;
                if (MODE == 1) { v0 = *(const f32x4*)(xin + o); v1 = *(const f32x4*)(xin + o + 4); }
                else { const u32x4 xr = *(const u32x4*)(xb + o); v0 = (f32x4){bflo(xr.x), bfhi(xr.x), bflo(xr.y), bfhi(xr.y)}; v1 = (f32x4){bflo(xr.z), bfhi(xr.z), bflo(xr.w), bfhi(xr.w)}; }
                v0 = v0 + acc[ai][bj][m][0] * scale; v1 = v1 + acc[ai][bj][m][1] * scale;
                if (MODE == 2) { *(f32x4*)(xout + o) = v0; *(f32x4*)(xout + o + 4) = v1; }
                ss += v0[0] * v0[0] + v0[1] * v0[1] + v0[2] * v0[2] + v0[3] * v0[3] + v1[0] * v1[0] + v1[1] * v1[1] + v1[2] * v1[2] + v1[3] * v1[3];
                u32x4 w; w.x = cvt_pk_bf16(v0[0], v0[1]); w.y = cvt_pk_bf16(v0[2], v0[3]); w.z = cvt_pk_bf16(v1[0], v1[1]); w.w = cvt_pk_bf16(v1[2], v1[3]); *(u32x4*)(xb + o) = w;
            }
            ss += __shfl_xor(ss, 16); ss += __shfl_xor(ss, 32);
            if (fq == 0) atomicAdd(ssq + row, ss);
        EPI_ROWS_END
    }
};
struct EpiGate {
    static constexpr bool ALIGN = true;
    bf16_t* SA; bf16_t* SB; const float* ssq;
    __device__ __forceinline__ void operator()(AccRef acc, const Unit& u, int wr, int wc, int fr, int fq, LAS unsigned char*) const {
        bf16_t* base = (u.pn < 4 ? SA : SB) + (u.pn & 3) * 256 + wc * 32 + fq * 8;
        EPI_ROWS_BEGIN
            const int row = u.pm * 256 + rl; const float rs = rsqrtf(ssq[row] * (1.f / 1024.f) + NORM_EPS);
#pragma unroll
            for (int bj = 0; bj < 2; ++bj) { const f32x4 a0 = acc[ai][bj][m][0], a1 = acc[ai][bj][m][1];
                u32x4 w; w.x = cvt_pk_bf16(a0[0] * rs, a0[1] * rs); w.y = cvt_pk_bf16(a0[2] * rs, a0[3] * rs);
                w.z = cvt_pk_bf16(a1[0] * rs, a1[1] * rs); w.w = cvt_pk_bf16(a1[2] * rs, a1[3] * rs);
                *(u32x4*)(base + (size_t)row * DM + bj * 128) = w; }
        EPI_ROWS_END
    }
};
struct EpiMerge2 {
    static constexpr bool ALIGN = true;
    u32x4* scrM; bf16_t* MG; const bf16_t* SA; const bf16_t* SB;
    __device__ __forceinline__ void operator()(AccRef acc, const Unit& u, int wr, int wc, int fr, int fq, LAS unsigned char*) const {
        char* sM = (char*)scrM + (threadIdx.x >> 6) * 16384u + (threadIdx.x & 63) * 16u; asm volatile("" : "+v"(sM));
        const bf16_t* G = (u.tag == 1 ? SA : SB);
        EPI_ROWS_BEGIN
            const int row = u.pm * 256 + rl;
#pragma unroll
            for (int bj = 0; bj < 2; ++bj) {
                const int i = (ai * 4 + m) * 2 + bj; const f32x4 a0 = acc[ai][bj][m][0], a1 = acc[ai][bj][m][1];
                const size_t o = (size_t)row * DM + u.pn * 256 + bj * 128 + wc * 32 + fq * 8;
                const u32x4 sg = *(const u32x4*)(G + o);
                f32x4 m0 = (f32x4){fsigmoid(bflo(sg.x)) * a0[0], fsigmoid(bfhi(sg.x)) * a0[1], fsigmoid(bflo(sg.y)) * a0[2], fsigmoid(bfhi(sg.y)) * a0[3]};
                f32x4 m1 = (f32x4){fsigmoid(bflo(sg.z)) * a1[0], fsigmoid(bfhi(sg.z)) * a1[1], fsigmoid(bflo(sg.w)) * a1[2], fsigmoid(bfhi(sg.w)) * a1[3]};
                if (u.tag == 3) { const u32x4 pm_ = *(const u32x4*)(sM + i * 1024);
                    m0 = m0 + (f32x4){bflo(pm_.x), bfhi(pm_.x), bflo(pm_.y), bfhi(pm_.y)}; m1 = m1 + (f32x4){bflo(pm_.z), bfhi(pm_.z), bflo(pm_.w), bfhi(pm_.w)}; }
                u32x4 w; w.x = cvt_pk_bf16(m0[0], m0[1]); w.y = cvt_pk_bf16(m0[2], m0[3]); w.z = cvt_pk_bf16(m1[0], m1[1]); w.w = cvt_pk_bf16(m1[2], m1[3]);
                if (u.tag == 1) *(u32x4*)(sM + i * 1024) = w; else *(u32x4*)(MG + o) = w;
            }
            asm volatile("" ::: "memory");
        EPI_ROWS_END
    }
};
struct EpiResidFin {
    static constexpr bool ALIGN = true;
    float* x; const bf16_t* xb; float scale;
    __device__ __forceinline__ void operator()(AccRef acc, const Unit& u, int wr, int wc, int fr, int fq, LAS unsigned char* lds) const {
        LAS float* rowss = (LAS float*)(lds + XCH_OFF);
        EPI_ROWS_BEGIN
            const int row = u.pm * 256 + rl; float ss = 0.f;
#pragma unroll
            for (int bj = 0; bj < 2; ++bj) {
                const size_t o = (size_t)row * DM + u.pn * 256 + bj * 128 + wc * 32 + fq * 8;
                const u32x4 xr = *(const u32x4*)(xb + o);
                f32x4 v0 = (f32x4){bflo(xr.x), bfhi(xr.x), bflo(xr.y), bfhi(xr.y)}, v1 = (f32x4){bflo(xr.z), bfhi(xr.z), bflo(xr.w), bfhi(xr.w)};
                v0 = v0 + acc[ai][bj][m][0] * scale; v1 = v1 + acc[ai][bj][m][1] * scale;
                *(f32x4*)(x + o) = v0; *(f32x4*)(x + o + 4) = v1;
                ss += v0[0] * v0[0] + v0[1] * v0[1] + v0[2] * v0[2] + v0[3] * v0[3] + v1[0] * v1[0] + v1[1] * v1[1] + v1[2] * v1[2] + v1[3] * v1[3];
            }
            ss += __shfl_xor(ss, 16); ss += __shfl_xor(ss, 32);
            if (fq == 0) (void)__hip_atomic_fetch_add(rowss + rl, ss, __ATOMIC_RELAXED, __HIP_MEMORY_SCOPE_WORKGROUP);
        EPI_ROWS_END
    }
};
template <int MODE> struct EpiRowScale {
    bf16_t* O; const float* ssq; float* IFb;
    __device__ __forceinline__ void operator()(AccRef acc, const Unit& u, int wr, int wc, int fr, int fq, LAS unsigned char*) const {
        constexpr int LDO = MODE == 0 ? ZLD : DM;
        EPI_ROWS_BEGIN
            const int row = u.pm * 256 + rl; const float rs = rsqrtf(ssq[row] * (1.f / 1024.f) + NORM_EPS);
            if (MODE == 0 && u.pn == 15) {
                if (wc == 0 && fq == 0) { *(f32x4*)(IFb + (size_t)row * 8) = acc[ai][0][m][0] * rs; *(f32x4*)(IFb + (size_t)row * 8 + 4) = acc[ai][0][m][1] * rs; }
            } else {
#pragma unroll
                for (int bj = 0; bj < 2; ++bj) { const f32x4 v0 = acc[ai][bj][m][0] * rs, v1 = acc[ai][bj][m][1] * rs;
                    u32x4 w; w.x = cvt_pk_bf16(v0[0], v0[1]); w.y = cvt_pk_bf16(v0[2], v0[3]); w.z = cvt_pk_bf16(v1[0], v1[1]); w.w = cvt_pk_bf16(v1[2], v1[3]);
                    *(u32x4*)(O + (size_t)row * LDO + u.pn * 256 + bj * 128 + wc * 32 + fq * 8) = w; }
            }
        EPI_ROWS_END
    }
};
struct EpiKV {
    bf16_t* Kb; bf16_t* VT; const float* ssqm;
    __device__ __forceinline__ void operator()(AccRef acc, const Unit& u, int wr, int wc, int fr, int fq, LAS unsigned char*) const {
        EPI_ROWS_BEGIN
            const int row = u.pm * 256 + rl;
#pragma unroll
            for (int bj = 0; bj < 2; ++bj) {
                const int cl = bj * 128 + wc * 32 + fq * 8; f32x4 v0 = acc[ai][bj][m][0], v1 = acc[ai][bj][m][1]; bf16_t* dst;
                if (u.tag == 0) { const float rs = rsqrtf(ssqm[row] * (1.f / 1024.f) + NORM_EPS); v0 = v0 * rs; v1 = v1 * rs; dst = Kb + (size_t)row * DM + u.pn * 256 + cl; }
                else { const int tok = u.pn * 256 + cl; const f32x4 s0 = *(const f32x4*)(ssqm + tok), s1 = *(const f32x4*)(ssqm + tok + 4);
#pragma unroll
                    for (int j = 0; j < 4; ++j) { v0[j] *= rsqrtf(s0[j] * (1.f / 1024.f) + NORM_EPS); v1[j] *= rsqrtf(s1[j] * (1.f / 1024.f) + NORM_EPS); }
                    dst = VT + (size_t)(u.pn >> 2) * 1048576 + (size_t)row * 1024 + (u.pn & 3) * 256 + cl; }
                u32x4 w; w.x = cvt_pk_bf16(v0[0], v0[1]); w.y = cvt_pk_bf16(v0[2], v0[3]); w.z = cvt_pk_bf16(v1[0], v1[1]); w.w = cvt_pk_bf16(v1[2], v1[3]);
                *(u32x4*)dst = w;
            }
        EPI_ROWS_END
    }
};
struct EpiMerge {
    u32x4* scrS; f32x4* scrM; bf16_t* MG; const float* ssq;
    __device__ __forceinline__ void operator()(AccRef acc, const Unit& u, int wr, int wc, int fr, int fq, LAS unsigned char*) const {
        char* sS = (char*)scrS + (threadIdx.x >> 6) * 16384u + (threadIdx.x & 63) * 16u; char* sM = (char*)scrM + (threadIdx.x >> 6) * 16384u + (threadIdx.x & 63) * 16u; asm volatile("" : "+v"(sS), "+v"(sM));
        if (u.tag == 0 || u.tag == 2) {
            EPI_ROWS_BEGIN
                const int row = u.pm * 256 + rl; const float rs = rsqrtf(ssq[row] * (1.f / 1024.f) + NORM_EPS);
#pragma unroll
                for (int bj = 0; bj < 2; ++bj) {
                    const int i = (ai * 4 + m) * 2 + bj; const f32x4 a0 = acc[ai][bj][m][0], a1 = acc[ai][bj][m][1];
                    u32x4 w; w.x = cvt_pk_bf16(fsigmoid(a0[0] * rs), fsigmoid(a0[1] * rs)); w.y = cvt_pk_bf16(fsigmoid(a0[2] * rs), fsigmoid(a0[3] * rs));
                    w.z = cvt_pk_bf16(fsigmoid(a1[0] * rs), fsigmoid(a1[1] * rs)); w.w = cvt_pk_bf16(fsigmoid(a1[2] * rs), fsigmoid(a1[3] * rs));
                    *(u32x4*)(sS + i * 1024) = w;
                }
            EPI_ROWS_END
        } else if (u.tag == 1) {
            EPI_ROWS_BEGIN
#pragma unroll
                for (int bj = 0; bj < 2; ++bj) {
                    const int i = (ai * 4 + m) * 2 + bj; const f32x4 a0 = acc[ai][bj][m][0], a1 = acc[ai][bj][m][1];
                    const u32x4 sg = *(const u32x4*)(sS + i * 1024);
                    u32x4 pm_; pm_.x = cvt_pk_bf16(bflo(sg.x) * a0[0], bfhi(sg.x) * a0[1]); pm_.y = cvt_pk_bf16(bflo(sg.y) * a0[2], bfhi(sg.y) * a0[3]);
                    pm_.z = cvt_pk_bf16(bflo(sg.z) * a1[0], bfhi(sg.z) * a1[1]); pm_.w = cvt_pk_bf16(bflo(sg.w) * a1[2], bfhi(sg.w) * a1[3]);
                    *(u32x4*)(sM + i * 1024) = pm_;
                }
                asm volatile("" ::: "memory");
            EPI_ROWS_END
        } else {
            EPI_ROWS_BEGIN
                const int row = u.pm * 256 + rl;
#pragma unroll
                for (int bj = 0; bj < 2; ++bj) {
                    const int i = (ai * 4 + m) * 2 + bj; const f32x4 a0 = acc[ai][bj][m][0], a1 = acc[ai][bj][m][1];
                    const u32x4 sg = *(const u32x4*)(sS + i * 1024);
                    const u32x4 pm_ = *(const u32x4*)(sM + i * 1024);
                    f32x4 m0 = (f32x4){bflo(pm_.x), bfhi(pm_.x), bflo(pm_.y), bfhi(pm_.y)}, m1 = (f32x4){bflo(pm_.z), bfhi(pm_.z), bflo(pm_.w), bfhi(pm_.w)};
                    m0 = m0 + (f32x4){bflo(sg.x) * a0[0], bfhi(sg.x) * a0[1], bflo(sg.y) * a0[2], bfhi(sg.y) * a0[3]};
                    m1 = m1 + (f32x4){bflo(sg.z) * a1[0], bfhi(sg.z) * a1[1], bflo(sg.w) * a1[2], bfhi(sg.w) * a1[3]};
                    u32x4 w; w.x = cvt_pk_bf16(m0[0], m0[1]); w.y = cvt_pk_bf16(m0[2], m0[3]); w.z = cvt_pk_bf16(m1[0], m1[1]); w.w = cvt_pk_bf16(m1[2], m1[3]);
                    *(u32x4*)(MG + (size_t)row * DM + u.pn * 256 + bj * 128 + wc * 32 + fq * 8) = w;
                }
                asm volatile("" ::: "memory");
            EPI_ROWS_END
        }
    }
};
struct EpiAttn {
    bf16_t* Pb; bf16_t* Ob; bf16_t* Qb; const float* ssq;
    __device__ __forceinline__ void operator()(AccRef acc, const Unit& u, int wr, int wc, int fr, int fq, LAS unsigned char* lds) const {
        LAS float* xm = (LAS float*)(lds + XCH_OFF); LAS float* xs = xm + 1024;
        if (u.tag == 2) {
            EPI_ROWS_BEGIN
                const int row = u.pm * 256 + rl; const float rs = rsqrtf(ssq[row] * (1.f / 1024.f) + NORM_EPS);
#pragma unroll
                for (int bj = 0; bj < 2; ++bj) { const f32x4 v0 = acc[ai][bj][m][0] * rs, v1 = acc[ai][bj][m][1] * rs;
                    u32x4 w; w.x = cvt_pk_bf16(v0[0], v0[1]); w.y = cvt_pk_bf16(v0[2], v0[3]); w.z = cvt_pk_bf16(v1[0], v1[1]); w.w = cvt_pk_bf16(v1[2], v1[3]);
                    *(u32x4*)(Qb + (size_t)row * DM + u.pn * 256 + bj * 128 + wc * 32 + fq * 8) = w; }
            EPI_ROWS_END
            return;
        }
        if (u.tag == 1) {
            EPI_ROWS_BEGIN
                const int row = u.pm * 256 + rl;
#pragma unroll
                for (int bj = 0; bj < 2; ++bj) { const f32x4 v0 = acc[ai][bj][m][0], v1 = acc[ai][bj][m][1];
                    u32x4 w; w.x = cvt_pk_bf16(v0[0], v0[1]); w.y = cvt_pk_bf16(v0[2], v0[3]); w.z = cvt_pk_bf16(v1[0], v1[1]); w.w = cvt_pk_bf16(v1[2], v1[3]);
                    *(u32x4*)(Ob + (size_t)row * DM + u.pn * 256 + bj * 128 + wc * 32 + fq * 8) = w; }
            EPI_ROWS_END
            return;
        }
        EPI_ROWS_BEGIN
            float v = -3.0e38f;
#pragma unroll
            for (int bj = 0; bj < 2; ++bj)
#pragma unroll
                for (int n = 0; n < 2; ++n)
#pragma unroll
                    for (int j = 0; j < 4; ++j) v = fmaxf(v, acc[ai][bj][m][n][j]);
            v = fmaxf(v, __shfl_xor(v, 16)); v = fmaxf(v, __shfl_xor(v, 32));
            if (fq == 0) xm[rl * 4 + wc] = v;
        EPI_ROWS_END
        WG_BAR();
        EPI_ROWS_BEGIN
            const f32x4 q = *(const LAS f32x4*)(xm + rl * 4); const float M = fmaxf(fmaxf(q[0], q[1]), fmaxf(q[2], q[3]));
            float sum = 0.f;
#pragma unroll
            for (int bj = 0; bj < 2; ++bj)
#pragma unroll
                for (int n = 0; n < 2; ++n)
#pragma unroll
                    for (int j = 0; j < 4; ++j) sum += __expf(acc[ai][bj][m][n][j] - M);
            sum += __shfl_xor(sum, 16); sum += __shfl_xor(sum, 32);
            if (fq == 0) xs[rl * 4 + wc] = sum;
        EPI_ROWS_END
        WG_BAR();
        EPI_ROWS_BEGIN
            const int row = u.pm * 256 + rl;
            const f32x4 q = *(const LAS f32x4*)(xm + rl * 4); const float M = fmaxf(fmaxf(q[0], q[1]), fmaxf(q[2], q[3]));
            const f32x4 qs = *(const LAS f32x4*)(xs + rl * 4); const float inv = __builtin_amdgcn_rcpf((qs[0] + qs[1]) + (qs[2] + qs[3]));
#pragma unroll
            for (int bj = 0; bj < 2; ++bj) { const f32x4 a0 = acc[ai][bj][m][0], a1 = acc[ai][bj][m][1];
                u32x4 w; w.x = cvt_pk_bf16(__expf(a0[0] - M) * inv, __expf(a0[1] - M) * inv); w.y = cvt_pk_bf16(__expf(a0[2] - M) * inv, __expf(a0[3] - M) * inv);
                w.z = cvt_pk_bf16(__expf(a1[0] - M) * inv, __expf(a1[1] - M) * inv); w.w = cvt_pk_bf16(__expf(a1[2] - M) * inv, __expf(a1[3] - M) * inv);
                *(u32x4*)(Pb + (size_t)row * DM + u.pn * 256 + bj * 128 + wc * 32 + fq * 8) = w; }
            asm volatile("" ::: "memory");
        EPI_ROWS_END
        WG_BAR();
    }
};

struct TJob { const float* src; const float* gain; bf16_t* dst; int K, ldsrc, col0, ncols, dst_ld, dst_row0, dst_k0, mode; float scale; int item0; };
struct Params { const float* in[37]; float* out; unsigned char* ws; TJob jobs[20]; int njobs, nitems, ph_lo, ph_hi, coop, nearly; };

__device__ __forceinline__ void transpose_item(const TJob& J, int item, LAS float* scr, int lane) {
    const int nblk = (J.ncols + 63) >> 6, kb = item / nblk, nb = item - kb * nblk, k0 = 64 * kb, n0 = 64 * nb;
    const int nq = (lane & 15) * 4; const bool nok = (n0 + nq) < J.ncols;
#pragma unroll
    for (int i = 0; i < 16; ++i) { const int kk = 4 * i + (lane >> 4);
        f32x4 v = (f32x4){0.f, 0.f, 0.f, 0.f};
        if (nok) { v = *(const f32x4*)(J.src + (size_t)(k0 + kk) * J.ldsrc + J.col0 + n0 + nq); float sc = J.scale; if (J.gain) sc *= J.gain[k0 + kk]; v = v * sc; }
        *(LAS f32x4*)(scr + kk * 64 + (nq ^ ((kk >> 3) << 3))) = v; }
    LDS_WAIT();
    const int c = lane & 7;
#pragma unroll
    for (int j = 0; j < 8; ++j) { const int nl = (lane >> 3) + 8 * j, n = n0 + nl; const LAS float* sp = scr + (8 * c) * 64 + (nl ^ (c << 3));
        if (n < J.ncols) { u32x4 o; o.x = cvt_pk_bf16(sp[0], sp[64]); o.y = cvt_pk_bf16(sp[128], sp[192]); o.z = cvt_pk_bf16(sp[256], sp[320]); o.w = cvt_pk_bf16(sp[384], sp[448]);
            const int dr = (J.mode ? ((n >> 7) * 256 + (n & 127)) : n) + J.dst_row0;
            *(u32x4*)(J.dst + (size_t)dr * J.dst_ld + J.dst_k0 + k0 + 8 * c) = o; } }
    LDS_WAIT();
}
__device__ __forceinline__ void row_to_bf16_ssq(const float* xrow, bf16_t* orow, float* ssq, int lane) {
    const f32x4* xr = (const f32x4*)xrow + lane; f32x4 v[4]; float s = 0.f;
#pragma unroll
    for (int j = 0; j < 4; ++j) { v[j] = xr[64 * j]; s += (v[j].x * v[j].x + v[j].y * v[j].y) + (v[j].z * v[j].z + v[j].w * v[j].w); }
    s = wave_sum(s); if (lane == 0) *ssq = s;
    u32x2* o8 = (u32x2*)orow + lane;
#pragma unroll
    for (int j = 0; j < 4; ++j) { u32x2 w; w.x = cvt_pk_bf16(v[j].x, v[j].y); w.y = cvt_pk_bf16(v[j].z, v[j].w); o8[64 * j] = w; }
}
__device__ __forceinline__ void rows4_to_bf16_ssq(const float* xrow, bf16_t* orow, float* ssq, int lane) {
    f32x4 v[4][4]; float s[4];
#pragma unroll
    for (int r = 0; r < 4; ++r)
#pragma unroll
        for (int j = 0; j < 4; ++j) v[r][j] = ((const f32x4*)(xrow + (size_t)r * DM) + lane)[64 * j];
#pragma unroll
    for (int r = 0; r < 4; ++r) { s[r] = 0.f;
#pragma unroll
        for (int j = 0; j < 4; ++j) s[r] += (v[r][j].x * v[r][j].x + v[r][j].y * v[r][j].y) + (v[r][j].z * v[r][j].z + v[r][j].w * v[r][j].w); }
#pragma unroll
    for (int o = 1; o < 64; o <<= 1) {
#pragma unroll
        for (int r = 0; r < 4; ++r) s[r] += __shfl_xor(s[r], o); }
    if (lane < 4) ssq[lane] = lane == 0 ? s[0] : (lane == 1 ? s[1] : (lane == 2 ? s[2] : s[3]));
#pragma unroll
    for (int r = 0; r < 4; ++r) { u32x2* o8 = (u32x2*)(orow + (size_t)r * DM) + lane;
#pragma unroll
        for (int j = 0; j < 4; ++j) { u32x2 w; w.x = cvt_pk_bf16(v[r][j].x, v[r][j].y); w.y = cvt_pk_bf16(v[r][j].z, v[r][j].w); o8[64 * j] = w; } }
}
__device__ __forceinline__ void phase_prep(const Params& P, LAS unsigned char* lds) {
    const int tid = threadIdx.x, lane = tid & 63, wave = tid >> 6; unsigned char* ws = P.ws;
    const int gw = blockIdx.x * 8 + wave, NGW = gridDim.x * 8;
    LAS float* scr = (LAS float*)(lds + wave * 16384);
    for (int it = gw; it < P.nearly; it += NGW) {
        int j = 0;
        while (j + 1 < P.njobs && it >= P.jobs[j + 1].item0) ++j;
        transpose_item(P.jobs[j], it - P.jobs[j].item0, scr, lane);
    }
    for (int m = gw * 4; m < NTOK; m += NGW * 4) rows4_to_bf16_ssq(P.in[0] + (size_t)m * DM, (bf16_t*)(ws + OFF_XB) + (size_t)m * DM, (float*)(ws + OFF_SSQ0) + m, lane);
    for (int m = gw * 4; m < MEMTOK; m += NGW * 4) rows4_to_bf16_ssq(P.in[1] + (size_t)m * DM, (bf16_t*)(ws + OFF_MEMB) + (size_t)m * DM, (float*)(ws + OFF_SSQM) + m, lane);
    const int gt = blockIdx.x * 512 + tid, NGT = gridDim.x * 512;
    for (int i = gt; i < 4 * NTOK; i += NGT) ((float*)(ws + OFF_SSQ1))[i] = 0.f;
    for (int i = gt; i < (int)(512 * 1024 / 16); i += NGT) ((u32x4*)(ws + OFF_FNG))[i] = (u32x4){0u, 0u, 0u, 0u};
    for (int i = gt; i < (int)(8 * MiB / 16); i += NGT) ((u32x4*)(ws + OFF_STATS))[i] = (u32x4){0u, 0u, 0u, 0u};
    for (int i = gt; i < 248 * 1024 / 8; i += NGT) ((u32x4*)(ws + OFF_WIN + (size_t)3848 * 2048))[i] = (u32x4){0u, 0u, 0u, 0u};
}

#define RLX_AGENT __ATOMIC_RELAXED, __HIP_MEMORY_SCOPE_AGENT
__device__ __forceinline__ float red16(float x) {
    x += dpp_f<0xB1>(x); x += dpp_f<0x4E>(x); x += dpp_f<0x141>(x); x += dpp_f<0x140>(x); return x;
}
#define RWA_COL(ty_, cv_, h_, rg_) ((ty_) == 0 ? 1664 + (cv_) * 8 : ((ty_) == 1 ? 1536 + (cv_) * 8 : ((ty_) == 2 ? 1600 + (cv_) * 8 : ((ty_) == 3 ? (h_) * 64 + (cv_) * 8 : ((ty_) == 4 ? 512 + (h_) * 64 + (cv_) * 8 : 1024 + (h_) * 64 + (rg_) * 32 + (cv_) * 8)))))
#define RWA_MAP(p_, lane_, h_, rg_) \
    int ty0, ty1, cv0, cv1, tq0, tq1; bool act0 = true, act1 = true; \
    if ((p_) == 0) { ty0 = 0; cv0 = (lane_) & 7; ty1 = 3; cv1 = (lane_) & 7; tq0 = tq1 = (lane_) >> 3; } \
    else if ((p_) == 1) { ty0 = 0; cv0 = 8 + ((lane_) & 7); ty1 = 4; cv1 = (lane_) & 7; tq0 = tq1 = (lane_) >> 3; } \
    else if ((p_) == 2) { ty0 = 1; cv0 = (lane_) & 7; ty1 = 2; cv1 = (lane_) & 7; tq0 = tq1 = (lane_) >> 3; } \
    else { ty0 = 5; cv0 = (lane_) & 3; tq0 = ((lane_) >> 2) & 7; act0 = (lane_) < 32; ty1 = 5; cv1 = 0; tq1 = 0; act1 = false; } \
    const int col0 = RWA_COL(ty0, cv0, h_, rg_), col1 = RWA_COL(ty1, cv1, h_, rg_);
__device__ __forceinline__ void rwkv_item(const Params& P, LAS unsigned char* lds, int item) {
    const int bh = item >> 1, rg = item & 1, b = bh >> 3, h = bh & 7; unsigned char* ws = P.ws;
    const bf16_t* Z = (const bf16_t*)(ws + OFF_Z); bf16_t* Yb = (bf16_t*)(ws + OFF_Y);
    unsigned long long* gran = (unsigned long long*)(ws + OFF_STATS);
    const float* mu = P.in[8]; const float* w0 = P.in[9]; const float* a0 = P.in[11]; const float* k_k = P.in[14]; const float* k_a = P.in[15]; const float* r_k = P.in[16];
    const float* gn_w = P.in[17]; const float* gn_b = P.in[18];
#define OPS_RR(s_) ((LAS float*)(lds + (s_) * 40960))
#define OPS_WW(s_) ((LAS float*)(lds + (s_) * 40960 + 8192))
#define OPS_BV(s_) ((LAS float*)(lds + (s_) * 40960 + 16384))
#define OPS_KM(s_) ((LAS float*)(lds + (s_) * 40960 + 24576))
#define OPS_KK(s_) ((LAS float*)(lds + (s_) * 40960 + 32768))
    LAS bf16_t* AW = (LAS bf16_t*)(lds + 81920); LAS bf16_t* AA = (LAS bf16_t*)(lds + 86528); LAS bf16_t* AG = (LAS bf16_t*)(lds + 91136);
    LAS float* KS = (LAS float*)(lds + 99840); LAS float* Aa = (LAS float*)(lds + 108032);
#define VV(s_) ((LAS float*)(lds + 116224 + (s_) * 4096))
#define YY(j_) ((LAS float*)(lds + 124416 + (j_) * 4096))
    LAS float* Gt = (LAS float*)(lds + 140800);
#define Q1B(j_) ((LAS bf16_t*)(lds + 144896 + (j_) * 2048))
#define Q2B(j_) ((LAS bf16_t*)(lds + 153088 + (j_) * 2048))
    LAS float* PRM = (LAS float*)(lds + 161280);
    LAS unsigned* GB = (LAS unsigned*)(lds + 162816);
    {
        const int tid = threadIdx.x;
        if (tid < 64) { PRM[tid] = k_k[h * 64 + tid]; PRM[64 + tid] = k_a[h * 64 + tid]; PRM[128 + tid] = r_k[h * 64 + tid]; PRM[192 + tid] = w0[h * 64 + tid]; PRM[256 + tid] = a0[h * 64 + tid]; }
        if (tid < 32) { PRM[320 + tid] = gn_w[h * 64 + rg * 32 + tid]; PRM[352 + tid] = gn_b[h * 64 + rg * 32 + tid]; }
        if (tid == 0) GB[0] = 0u;
    }
    bf16x8 bw[2][2], ba[2][2], bg[4];
    {
        const int lane = threadIdx.x & 63, fr = lane & 15, fq = lane >> 4, p = (threadIdx.x >> 6) & 3, kp = p >> 1;
#pragma unroll
        for (int q = 0; q < 2; ++q) { const int ch = h * 64 + (2 * kp + q) * 16 + fr;
#pragma unroll
            for (int ks = 0; ks < 2; ++ks) { bw[q][ks] = *(const bf16x8*)((const bf16_t*)(ws + OFF_W2T) + (size_t)ch * 64 + ks * 32 + fq * 8); ba[q][ks] = *(const bf16x8*)((const bf16_t*)(ws + OFF_A2T) + (size_t)ch * 64 + ks * 32 + fq * 8); } }
#pragma unroll
        for (int ks = 0; ks < 4; ++ks) bg[ks] = *(const bf16x8*)((const bf16_t*)(ws + OFF_G2T) + (size_t)(h * 64 + rg * 32 + kp * 16 + fr) * 128 + ks * 32 + fq * 8);
    }
    f32x2 S2[4] = {{0.f, 0.f}, {0.f, 0.f}, {0.f, 0.f}, {0.f, 0.f}};
    float muA[8], muB[8]; u32x4 pzA[4], pzB[4], ppA, ppB; unsigned gbgen = 0u; float ps1 = 0.f, ps2 = 0.f;
    {
        RWA_MAP(((int)(threadIdx.x >> 6)) & 3, (int)(threadIdx.x & 63), h, rg)
        (void)act0; (void)act1; (void)tq0; (void)tq1;
        const f32x4 m0 = *(const f32x4*)(mu + col0), m1 = *(const f32x4*)(mu + col0 + 4), n0 = *(const f32x4*)(mu + col1), n1 = *(const f32x4*)(mu + col1 + 4);
#pragma unroll
        for (int j = 0; j < 4; ++j) { muA[j] = m0[j]; muA[4 + j] = m1[j]; muB[j] = n0[j]; muB[4 + j] = n1[j]; }
    }
#define RW_PF1(cn, pz_, pp_, act_, tq_, col_) do { pp_ = (u32x4){0u, 0u, 0u, 0u}; _Pragma("unroll") for (int i_ = 0; i_ < 4; ++i_) pz_[i_] = pp_; \
        if (act_) { const size_t tok = (size_t)b * SEQ + (cn) * 32 + (tq_) * 4; if ((cn) * 32 + (tq_) * 4 > 0) pp_ = *(const u32x4*)(Z + (tok - 1) * ZLD + (col_)); \
            _Pragma("unroll") for (int i_ = 0; i_ < 4; ++i_) pz_[i_] = *(const u32x4*)(Z + (tok + i_) * ZLD + (col_)); } } while (0)
#define RW_PREFETCH(cn) do { RW_PF1(cn, pzA, ppA, act0, tq0, col0); RW_PF1(cn, pzB, ppB, act1, tq1, col1); } while (0)
#define GRP_BAR() do { asm volatile("s_waitcnt lgkmcnt(0)" ::: "memory"); gbgen += 1u; if (lane == 0) (void)__hip_atomic_fetch_add(GB, 1u, __ATOMIC_RELAXED, __HIP_MEMORY_SCOPE_WORKGROUP); \
        { unsigned sp_ = 0; while (__hip_atomic_load(GB, __ATOMIC_RELAXED, __HIP_MEMORY_SCOPE_WORKGROUP) < gbgen * 4u) { if (++sp_ > (1u << 24)) break; } } asm volatile("" ::: "memory"); } while (0)
    {
        RWA_MAP(((int)(threadIdx.x >> 6)) & 3, (int)(threadIdx.x & 63), h, rg)
        act0 = act0 && threadIdx.x >= 256; act1 = act1 && threadIdx.x >= 256;
        RW_PREFETCH(0);
    }
    WG_BAR();
#pragma unroll 1
    for (int it = 0; it < 131; ++it) {
        int tl_ = threadIdx.x; asm volatile("" : "+v"(tl_));
        const int tid = tl_, lane = tid & 63, wave = __builtin_amdgcn_readfirstlane(tid >> 6), fr = lane & 15, fq = lane >> 4;
        if (wave >= 4) {
            unsigned long long g0 = 0ull, g1 = 0ull;
            if (wave == 7 && it >= 3) {
                const unsigned long long* gb3 = gran + (((size_t)bh * 128 + (it - 3)) * 2) * 64 + (lane & 31) * 2 + (rg ^ 1) * 64;
                g0 = __hip_atomic_load(gb3, RLX_AGENT); g1 = __hip_atomic_load(gb3 + 1, RLX_AGENT);
            }
            if (it < 128) {
                const int c = it, os = c & 1, qj = c & 3;
                const int tidp = tid - 256, p = wave - 4, tt = p & 1, kp = p >> 1;
                RWA_MAP(p, lane, h, rg)
                LAS float* Rr = OPS_RR(os); LAS float* Ww = OPS_WW(os); LAS float* Bv = OPS_BV(os); LAS float* KM = OPS_KM(os); LAS float* KK = OPS_KK(os); LAS float* Vv = VV(os);
#define RWA_SEG(pz_, pp_, mu_, act_, ty_, cv_, tq_) do { if (act_) { _Pragma("unroll") for (int i = 0; i < 4; ++i) { \
                    const int t = (tq_) * 4 + i; const u32x4 zc = pz_[i], zp = (i == 0) ? pp_ : pz_[i > 0 ? i - 1 : 0]; \
                    float z[8]; const float c8[8] = {bflo(zc.x), bfhi(zc.x), bflo(zc.y), bfhi(zc.y), bflo(zc.z), bfhi(zc.z), bflo(zc.w), bfhi(zc.w)}; \
                    const float p8[8] = {bflo(zp.x), bfhi(zp.x), bflo(zp.y), bfhi(zp.y), bflo(zp.z), bfhi(zp.z), bflo(zp.w), bfhi(zp.w)}; \
                    _Pragma("unroll") for (int j = 0; j < 8; ++j) z[j] = c8[j] + (p8[j] - c8[j]) * mu_[j]; \
                    if ((ty_) >= 3) { LAS float* dst = (ty_) == 3 ? Rr + t * 64 + (cv_) * 8 : ((ty_) == 4 ? KS + t * 64 + (cv_) * 8 : Vv + t * 32 + (cv_) * 8); \
                        *(LAS f32x4*)dst = (f32x4){z[0], z[1], z[2], z[3]}; *(LAS f32x4*)(dst + 4) = (f32x4){z[4], z[5], z[6], z[7]}; } \
                    else { LAS bf16_t* dst; \
                        if ((ty_) == 1) { dst = AW + t * 72 + (cv_) * 8; _Pragma("unroll") for (int j = 0; j < 8; ++j) z[j] = 1.f - 2.f * __builtin_amdgcn_rcpf(__expf(2.f * z[j]) + 1.f); } \
                        else if ((ty_) == 2) dst = AA + t * 72 + (cv_) * 8; \
                        else { dst = AG + t * 136 + (cv_) * 8; _Pragma("unroll") for (int j = 0; j < 8; ++j) z[j] = fsigmoid(z[j]); } \
                        u32x4 w; w.x = cvt_pk_bf16(z[0], z[1]); w.y = cvt_pk_bf16(z[2], z[3]); w.z = cvt_pk_bf16(z[4], z[5]); w.w = cvt_pk_bf16(z[6], z[7]); \
                        *(LAS u32x4*)dst = w; } } } } while (0)
                RWA_SEG(pzA, ppA, muA, act0, ty0, cv0, tq0);
                RWA_SEG(pzB, ppB, muB, act1, ty1, cv1, tq1);
#undef RWA_SEG
                if (c < 127) RW_PREFETCH(c + 1);
                GRP_BAR();
                {
                    bf16x8 aw[2], aa[2];
#pragma unroll
                    for (int ks = 0; ks < 2; ++ks) { aw[ks] = *(const LAS bf16x8*)(AW + (tt * 16 + fr) * 72 + ks * 32 + fq * 8); aa[ks] = *(const LAS bf16x8*)(AA + (tt * 16 + fr) * 72 + ks * 32 + fq * 8); }
                    const int t = tt * 16 + fr;
#pragma unroll
                    for (int q = 0; q < 2; ++q) {
                        f32x4 cw = (f32x4){0.f, 0.f, 0.f, 0.f}, ca = cw;
#pragma unroll
                        for (int ks = 0; ks < 2; ++ks) { cw = __builtin_amdgcn_mfma_f32_16x16x32_bf16(bw[q][ks], aw[ks], cw, 0, 0, 0); ca = __builtin_amdgcn_mfma_f32_16x16x32_bf16(ba[q][ks], aa[ks], ca, 0, 0, 0); }
                        const int kl = (2 * kp + q) * 16 + fq * 4;
                        const f32x4 w0v = *(const LAS f32x4*)(PRM + 192 + kl), a0v = *(const LAS f32x4*)(PRM + 256 + kl);
                        f32x4 dw, av;
#pragma unroll
                        for (int j = 0; j < 4; ++j) { dw[j] = __expf(-0.6065306597f * fsigmoid(w0v[j] + cw[j])); av[j] = fsigmoid(a0v[j] + ca[j]); }
                        *(LAS f32x4*)(Ww + t * 64 + kl) = dw; *(LAS f32x4*)(Aa + t * 64 + kl) = av;
                    }
                    f32x4 cg_ = (f32x4){0.f, 0.f, 0.f, 0.f};
#pragma unroll
                    for (int ks = 0; ks < 4; ++ks) { const bf16x8 ag = *(const LAS bf16x8*)(AG + (tt * 16 + fr) * 136 + ks * 32 + fq * 8); cg_ = __builtin_amdgcn_mfma_f32_16x16x32_bf16(bg[ks], ag, cg_, 0, 0, 0); }
                    *(LAS f32x4*)(Gt + t * 32 + kp * 16 + fq * 4) = cg_;
                }
                GRP_BAR();
                {
                    const int t = tidp >> 3, k8 = tidp & 7, k0 = k8 * 8;
                    float ks8[8], a8[8], r8[8], kk8[8], km8[8], pk[8], pa[8], pr[8]; float n2 = 0.f, bon = 0.f;
#pragma unroll
                    for (int i = 0; i < 2; ++i) { const f32x4 x0 = *(const LAS f32x4*)(KS + t * 64 + k0 + 4 * i), x1 = *(const LAS f32x4*)(Aa + t * 64 + k0 + 4 * i), x2 = *(const LAS f32x4*)(Rr + t * 64 + k0 + 4 * i);
                        const f32x4 y0 = *(const LAS f32x4*)(PRM + k0 + 4 * i), y1 = *(const LAS f32x4*)(PRM + 64 + k0 + 4 * i), y2 = *(const LAS f32x4*)(PRM + 128 + k0 + 4 * i);
#pragma unroll
                        for (int j = 0; j < 4; ++j) { ks8[4 * i + j] = x0[j]; a8[4 * i + j] = x1[j]; r8[4 * i + j] = x2[j]; pk[4 * i + j] = y0[j]; pa[4 * i + j] = y1[j]; pr[4 * i + j] = y2[j]; } }
#pragma unroll
                    for (int i = 0; i < 8; ++i) { kk8[i] = ks8[i] * pk[i]; n2 += kk8[i] * kk8[i]; km8[i] = ks8[i] * (1.f + (a8[i] - 1.f) * pa[i]); bon += r8[i] * km8[i] * pr[i]; }
                    n2 = red8(n2); bon = red8(bon);
                    const float inv = 1.f / fmaxf(sqrtf(n2), 1e-12f);
                    f32x4 o0[2], o1[2], o2[2];
#pragma unroll
                    for (int i = 0; i < 8; ++i) { const float kn = kk8[i] * inv; o0[i >> 2][i & 3] = -kn; o1[i >> 2][i & 3] = km8[i]; o2[i >> 2][i & 3] = kn * a8[i]; }
#pragma unroll
                    for (int i = 0; i < 2; ++i) { *(LAS f32x4*)(KK + t * 64 + k0 + 4 * i) = o0[i]; *(LAS f32x4*)(KM + t * 64 + k0 + 4 * i) = o1[i]; *(LAS f32x4*)(Bv + t * 64 + k0 + 4 * i) = o2[i]; }
                    const int r4 = k8 * 4;
                    const f32x4 g4 = *(const LAS f32x4*)(Gt + t * 32 + r4), v4 = *(const LAS f32x4*)(Vv + t * 32 + r4), gw4 = *(const LAS f32x4*)(PRM + 320 + r4), gb4 = *(const LAS f32x4*)(PRM + 352 + r4);
                    u32x2 q1, q2;
                    q1.x = cvt_pk_bf16(g4[0] * gw4[0], g4[1] * gw4[1]); q1.y = cvt_pk_bf16(g4[2] * gw4[2], g4[3] * gw4[3]);
                    q2.x = cvt_pk_bf16(g4[0] * (gb4[0] + bon * v4[0]), g4[1] * (gb4[1] + bon * v4[1])); q2.y = cvt_pk_bf16(g4[2] * (gb4[2] + bon * v4[2]), g4[3] * (gb4[3] + bon * v4[3]));
                    *(LAS u32x2*)(Q1B(qj) + t * 32 + r4) = q1; *(LAS u32x2*)(Q2B(qj) + t * 32 + r4) = q2;
                }
            }
            if (wave == 7 && it >= 2) {
                const int t = lane & 31;
                float ns1 = 0.f, ns2 = 0.f;
                if (it <= 129) {
                    const int c = it - 2, yj = c & 3;
#pragma unroll
                    for (int i = 0; i < 8; ++i) { const f32x4 y = *(const LAS f32x4*)(YY(yj) + t * 32 + 4 * i); ns1 += (y[0] + y[1]) + (y[2] + y[3]); ns2 += (y[0] * y[0] + y[1] * y[1]) + (y[2] * y[2] + y[3] * y[3]); }
                    const unsigned long long ep = (unsigned long long)(unsigned)(c + 1) << 32;
                    unsigned long long* gbase = gran + (((size_t)bh * 128 + c) * 2) * 64 + t * 2;
                    if (lane < 32) { __hip_atomic_store(gbase + rg * 64, ep | __builtin_bit_cast(unsigned, ns1), RLX_AGENT); __hip_atomic_store(gbase + rg * 64 + 1, ep | __builtin_bit_cast(unsigned, ns2), RLX_AGENT); }
                }
                if (it >= 3) {
                    const int c = it - 3, yj = c & 3;
                    unsigned long long* gb3 = gran + (((size_t)bh * 128 + c) * 2) * 64 + t * 2 + (rg ^ 1) * 64;
                    unsigned spins = 0;
                    for (;;) {
                        const bool ok = ((g0 >> 32) == (unsigned long long)(unsigned)(c + 1)) && ((g1 >> 32) == (unsigned long long)(unsigned)(c + 1));
                        if (__all(ok)) break;
                        __builtin_amdgcn_s_sleep(2); if (++spins > (1u << 20)) break;
                        g0 = __hip_atomic_load(gb3, RLX_AGENT); g1 = __hip_atomic_load(gb3 + 1, RLX_AGENT);
                    }
                    const float s1 = ps1 + __builtin_bit_cast(float, (unsigned)g0), s2 = ps2 + __builtin_bit_cast(float, (unsigned)g1);
                    const float mean = s1 * (1.f / 64.f), var = fmaxf(s2 * (1.f / 64.f) - mean * mean, 0.f), rstd = rsqrtf(var + 64e-5f);
                    if (lane < 32) {
                        bf16_t* dst = Yb + ((size_t)b * SEQ + c * 32 + t) * DM + h * 64 + rg * 32;
#pragma unroll
                        for (int i = 0; i < 4; ++i) {
                            const f32x4 ya = *(const LAS f32x4*)(YY(yj) + t * 32 + 8 * i), yb = *(const LAS f32x4*)(YY(yj) + t * 32 + 8 * i + 4);
                            const u32x4 q1 = *(const LAS u32x4*)(Q1B(yj) + t * 32 + 8 * i), q2 = *(const LAS u32x4*)(Q2B(yj) + t * 32 + 8 * i);
                            u32x4 w;
                            w.x = cvt_pk_bf16((ya[0] - mean) * rstd * bflo(q1.x) + bflo(q2.x), (ya[1] - mean) * rstd * bfhi(q1.x) + bfhi(q2.x));
                            w.y = cvt_pk_bf16((ya[2] - mean) * rstd * bflo(q1.y) + bflo(q2.y), (ya[3] - mean) * rstd * bfhi(q1.y) + bfhi(q2.y));
                            w.z = cvt_pk_bf16((yb[0] - mean) * rstd * bflo(q1.z) + bflo(q2.z), (yb[1] - mean) * rstd * bfhi(q1.z) + bfhi(q2.z));
                            w.w = cvt_pk_bf16((yb[2] - mean) * rstd * bflo(q1.w) + bflo(q2.w), (yb[3] - mean) * rstd * bfhi(q1.w) + bfhi(q2.w));
                            *(u32x4*)(dst + 8 * i) = w;
                        }
                    }
                }
                ps1 = ns1; ps2 = ns2;
            }
        } else if (it >= 1 && it <= 128) {
            const int c = it - 1, os = c & 1, yj = c & 3, grp = tid >> 4, kq = tid & 15;
            LAS const unsigned char* ob = (LAS const unsigned char*)OPS_RR(os) + kq * 16;
            LAS const unsigned char* vp = (LAS const unsigned char*)VV(os) + grp * 8; LAS unsigned char* yp = (LAS unsigned char*)YY(yj) + grp * 8;
            f32x4 wA, bA, mA, kA, rA, wB, bB, mB, kB, rB; f32x2 vA, vB;
#define RW_LD(X, d) do { r##X = *(const LAS f32x4*)(ob + (d) * 256); w##X = *(const LAS f32x4*)(ob + (d) * 256 + 8192); b##X = *(const LAS f32x4*)(ob + (d) * 256 + 16384); m##X = *(const LAS f32x4*)(ob + (d) * 256 + 24576); \
                k##X = *(const LAS f32x4*)(ob + (d) * 256 + 32768); v##X = *(const LAS f32x2*)(vp + (d) * 128); } while (0)
#define RW_LVL(a_, b_, C) do { a_ += dpp_f<C>(a_); b_ += dpp_f<C>(b_); asm volatile("" : "+v"(a_), "+v"(b_)); } while (0)
#define RW_RED2(x) do { float a_ = x[0], b_ = x[1]; RW_LVL(a_, b_, 0xB1); RW_LVL(a_, b_, 0x4E); RW_LVL(a_, b_, 0x141); RW_LVL(a_, b_, 0x140); x = (f32x2){a_, b_}; } while (0)
#define RW_STEP(X, t) do { f32x2 sa = S2[0] * k##X[0]; sa = S2[1] * k##X[1] + sa; sa = S2[2] * k##X[2] + sa; sa = S2[3] * k##X[3] + sa; RW_RED2(sa); \
                _Pragma("unroll") for (int i = 0; i < 4; ++i) S2[i] = S2[i] * w##X[i] + (sa * b##X[i] + v##X * m##X[i]); \
                f32x2 y = S2[0] * r##X[0]; y = S2[1] * r##X[1] + y; y = S2[2] * r##X[2] + y; y = S2[3] * r##X[3] + y; RW_RED2(y); \
                if (kq == 0) *(LAS f32x2*)(yp + (t) * 128) = y; } while (0)
            RW_LD(A, 0);
#pragma unroll 1
            for (int t = 0; t < 32; t += 2) {
                RW_LD(B, 1); __builtin_amdgcn_sched_barrier(0);
                RW_STEP(A, 0); __builtin_amdgcn_sched_barrier(0);
                if (t == 30) { ob -= 30 * 256; vp -= 30 * 128; }
                RW_LD(A, 2); __builtin_amdgcn_sched_barrier(0);
                RW_STEP(B, 1); __builtin_amdgcn_sched_barrier(0);
                ob += 512; vp += 256; yp += 256;
            }
#undef RW_LD
#undef RW_STEP
#undef RW_RED2
#undef RW_LVL
        }
        WG_BAR();
    }
#undef RW_PREFETCH
#undef RW_PF1
#undef GRP_BAR
#undef OPS_RR
#undef OPS_WW
#undef OPS_BV
#undef OPS_KM
#undef OPS_KK
#undef VV
#undef YY
#undef Q1B
#undef Q2B
}

#define TRI(r, t) ((r) * 72 + (((((t) >> 3) ^ (((r) >> 3) & 7))) << 3) + ((t) & 7))
#define TRB(r, blk) ((r) * 72 + (((blk) ^ (((r) >> 3) & 7)) << 3))
__device__ __forceinline__ void mlstm_item(const Params& P, LAS unsigned char* lds, int bh) {
    const int tid = threadIdx.x, lane = tid & 63, wave = tid >> 6, fr = lane & 15, fq = lane >> 4;
    const int b = bh >> 2, h = bh & 3; unsigned char* ws = P.ws;
    const bf16_t* Z = (const bf16_t*)(ws + OFF_Z); bf16_t* Yb = (bf16_t*)(ws + OFF_Y); const float* IFb = (const float*)(ws + OFF_IF);
    const float* cw = P.in[19]; const float* cb = P.in[20]; const float ib = P.in[21][h], fb = P.in[22][h]; const float* mln = P.in[23];
    LAS bf16_t* Qs = (LAS bf16_t*)(lds); LAS bf16_t* Ks = (LAS bf16_t*)(lds + 17408); LAS bf16_t* KT = (LAS bf16_t*)(lds + 34816); LAS bf16_t* VT = (LAS bf16_t*)(lds + 53248);
    LAS bf16_t* VwT = (LAS bf16_t*)(lds + 71680); LAS bf16_t* Pp = (LAS bf16_t*)(lds + 90112); LAS bf16_t* Cb = (LAS bf16_t*)(lds + 99328);
    LAS float* F = (LAS float*)(lds + 134144);
    LAS float* ga = F, *gu = F + 64, *gwl = F + 128, *gwi = F + 192, *gei = F + 256, *dn = F + 320, *nq = F + 384, *lnx = F + 448  , *ns = F + 704  , *sc = F + 832;
    LAS float* CWL = (LAS float*)(lds + 138240);
    LAS float* CBL = CWL + 1024; LAS float* MLN = CWL + 1280;
    for (int i = tid; i < 1024; i += 512) { const int j = i >> 8, cc = i & 255; CWL[i] = cw[j * 1024 + (cc < 128 ? h * 128 + cc : 512 + h * 128 + cc - 128)]; }
    if (tid < 256) CBL[tid] = cb[tid < 128 ? h * 128 + tid : 512 + h * 128 + tid - 128];
    if (tid < 128) MLN[tid] = mln[h * 128 + tid];
    f32x4 Cacc[8];
#pragma unroll
    for (int i = 0; i < 8; ++i) Cacc[i] = (f32x4){0.f, 0.f, 0.f, 0.f};
    const int pcv = tid & 31, ptg = tid >> 5; const bool pisk = pcv >= 16; const int pc8 = (pcv & 15) * 8;
    const int pzcol = (pisk ? 2304 : 1792) + h * 128 + pc8;
    u32x4 rw[7], vx[2]; u32x2 ogp[4]; float pfb = 0.f, pfu = 0.f, pfp = 0.f, pfe = 0.f, pfm = 0.f;
#define ML_PF_QKV(cn) do { _Pragma("unroll") for (int d = 0; d < 7; ++d) { const int tl = (cn) * 64 + ptg * 4 - 3 + d; rw[d] = (u32x4){0u, 0u, 0u, 0u}; if (tl >= 0) rw[d] = *(const u32x4*)(Z + ((size_t)b * SEQ + tl) * ZLD + pzcol); } \
        _Pragma("unroll") for (int rep = 0; rep < 2; ++rep) { const int v = tid + rep * 512; vx[rep] = *(const u32x4*)(Z + ((size_t)b * SEQ + (cn) * 64 + (v >> 4)) * ZLD + 2816 + h * 128 + (v & 15) * 8); } } while (0)
#define ML_PF_IF(cn) do { if (wave == 0) { pfb = GS[(cn) * 64 + lane]; pfu = GS[4096 + (cn) * 64 + lane]; pfp = GS[8192 + (cn) * 64 + lane]; pfe = GS[12288 + (cn)]; pfm = GS[12352 + (cn)]; } } while (0)
#define ML_PF_OG(cn) do { _Pragma("unroll") for (int q = 0; q < 4; ++q) ogp[q] = *(const u32x2*)(Z + ((size_t)b * SEQ + (cn) * 64 + (wave & 3) * 16 + fr) * ZLD + 3328 + h * 128 + ((wave >> 2) * 4 + q) * 16 + fq * 4); } while (0)
    float* GS = (float*)(ws + OFF_GATES) + (size_t)bh * 12416;
    for (int cc = wave; cc < 64; cc += 8) {
        const size_t tk = (size_t)b * SEQ + cc * 64 + lane;
        const float ig = IFb[tk * 8 + h] + ib, fg = IFb[tk * 8 + 4 + h] + fb;
        const float lf = fminf(fg, 0.f) - __logf(1.f + __expf(-fabsf(fg)));
        float bc = lf;
#pragma unroll
        for (int o = 1; o < 64; o <<= 1) { const float t = __shfl_up(bc, o); if (lane >= o) bc += t; }
        const float bend = __shfl(bc, 63), u = ig - bc;
        float mc = bend + u;
#pragma unroll
        for (int o = 1; o < 64; o <<= 1) mc = fmaxf(mc, __shfl_xor(mc, o));
        float pm = u;
#pragma unroll
        for (int o = 1; o < 64; o <<= 1) { const float t = __shfl_up(pm, o); if (lane >= o) pm = fmaxf(pm, t); }
        GS[cc * 64 + lane] = bc; GS[4096 + cc * 64 + lane] = u; GS[8192 + cc * 64 + lane] = pm;
        if (lane == 0) { GS[12288 + cc] = bend; GS[12352 + cc] = mc; }
    }
    WG_BAR_ALL();
    ML_PF_IF(0); ML_PF_QKV(0); ML_PF_OG(0);
    for (int i = tid; i < 128 * 136 / 2; i += 512) ((LAS unsigned*)Cb)[i] = 0u;
    if (tid < 128) ns[tid] = 0.f;
    float mprev = 0.f;
    WG_BAR();
#pragma unroll 1
    for (int c = 0; c < 64; ++c) {
        int tl_ = threadIdx.x; asm volatile("" : "+v"(tl_));
        const int tid = tl_, lane = tid & 63, wave = tid >> 6, fr = lane & 15, fq = lane >> 4;
        const int pcv = tid & 31, ptg = tid >> 5; const bool pisk = pcv >= 16; const int pc8 = (pcv & 15) * 8;
        const int pzcol = (pisk ? 2304 : 1792) + h * 128 + pc8;
        const size_t tokc = (size_t)b * SEQ + c * 64;
        if (wave == 0) {
            const float bc = pfb, u = pfu, pm = pfp, bend = pfe, mc = pfm;
            ML_PF_IF((c + 1) & 63);
            const float lw = bend + u;
            const float mnew = fmaxf(bend + mprev, mc), dec = __expf(bend + mprev - mnew);
            const float linter = bc + mprev, mrow = fmaxf(linter, bc + pm);
            ga[lane] = bc - mrow; gu[lane] = u; gwl[lane] = __expf(lw - mnew); gwi[lane] = __expf(linter - mrow); gei[lane] = __expf(-mrow); dn[lane] = 0.f;
            if (lane == 0) { sc[0] = dec; sc[1] = mnew; }
        }
        WG_BAR();
        {
            const int tg = ptg; const bool isk = pisk; const int c8 = pc8, lch = (isk ? 128 : 0) + c8;
            float wt[4][8], bs[8];
#pragma unroll
            for (int j = 0; j < 4; ++j) { const f32x4 x0 = *(const LAS f32x4*)(CWL + j * 256 + lch), x1 = *(const LAS f32x4*)(CWL + j * 256 + lch + 4);
#pragma unroll
                for (int i = 0; i < 4; ++i) { wt[j][i] = x0[i]; wt[j][4 + i] = x1[i]; } }
            { const f32x4 x0 = *(const LAS f32x4*)(CBL + lch), x1 = *(const LAS f32x4*)(CBL + lch + 4);
#pragma unroll
              for (int i = 0; i < 4; ++i) { bs[i] = x0[i]; bs[4 + i] = x1[i]; } }
#pragma unroll
            for (int q = 0; q < 4; ++q) {
                const int t = tg * 4 + q; float o[8];
#pragma unroll
                for (int i = 0; i < 8; ++i) o[i] = bs[i];
#pragma unroll
                for (int j = 0; j < 4; ++j) { const u32x4 x = rw[3 + q - j]; const float x8[8] = {bflo(x.x), bfhi(x.x), bflo(x.y), bfhi(x.y), bflo(x.z), bfhi(x.z), bflo(x.w), bfhi(x.w)};
#pragma unroll
                    for (int i = 0; i < 8; ++i) o[i] += wt[j][i] * x8[i]; }
#pragma unroll
                for (int i = 0; i < 8; ++i) { o[i] = o[i] * fsigmoid(o[i]); if (!isk) o[i] *= 0.08838834764831845f; }
                u32x4 w; w.x = cvt_pk_bf16(o[0], o[1]); w.y = cvt_pk_bf16(o[2], o[3]); w.z = cvt_pk_bf16(o[4], o[5]); w.w = cvt_pk_bf16(o[6], o[7]);
                if (!isk) *(LAS u32x4*)(Qs + t * 136 + c8) = w;
                else { *(LAS u32x4*)(Ks + t * 136 + c8) = w;
#pragma unroll
                    for (int i = 0; i < 8; ++i) KT[TRI(c8 + i, t)] = f2bf(o[i]); }
            }
#pragma unroll
            for (int rep = 0; rep < 2; ++rep) {
                const int v = tid + rep * 512, t = v >> 4, v8 = (v & 15) * 8;
                const u32x4 x = vx[rep]; const float wl = gwl[t];
                const float x8[8] = {bflo(x.x), bfhi(x.x), bflo(x.y), bfhi(x.y), bflo(x.z), bfhi(x.z), bflo(x.w), bfhi(x.w)};
#pragma unroll
                for (int i = 0; i < 8; ++i) { VT[TRI(v8 + i, t)] = f2bf(x8[i]); VwT[TRI(v8 + i, t)] = f2bf(x8[i] * wl); }
            }
            if (c < 63) ML_PF_QKV(c + 1);
        }
        WG_BAR();
        const int st = wave & 3;
        bf16x8 qf[4];
#pragma unroll
        for (int ks = 0; ks < 4; ++ks) qf[ks] = *(const LAS bf16x8*)(Qs + (st * 16 + fr) * 136 + ks * 32 + fq * 8);
        {
            const int s = st * 16 + fr; const float gas = ga[s]; float dsum = 0.f;
#pragma unroll
            for (int q = 0; q < 2; ++q) {
                const int rt = (wave >> 2) * 2 + q; f32x4 a = (f32x4){0.f, 0.f, 0.f, 0.f};
#pragma unroll
                for (int ks = 0; ks < 4; ++ks) { const bf16x8 kf = *(const LAS bf16x8*)(Ks + (rt * 16 + fr) * 136 + ks * 32 + fq * 8); a = __builtin_amdgcn_mfma_f32_16x16x32_bf16(kf, qf[ks], a, 0, 0, 0); }
                const int r0 = rt * 16 + fq * 4; float p[4];
#pragma unroll
                for (int j = 0; j < 4; ++j) { p[j] = (r0 + j <= s) ? __expf(gas + gu[r0 + j]) * a[j] : 0.f; dsum += p[j]; }
                u32x2 w; w.x = cvt_pk_bf16(p[0], p[1]); w.y = cvt_pk_bf16(p[2], p[3]); *(LAS u32x2*)(Pp + s * 72 + r0) = w;
            }
            dsum += __shfl_xor(dsum, 16); dsum += __shfl_xor(dsum, 32);
            if (fq == 0) __hip_atomic_fetch_add(dn + s, dsum, __ATOMIC_RELAXED, __HIP_MEMORY_SCOPE_WORKGROUP);
            const int s2 = tid >> 3, kq = tid & 7; float a = 0.f;
#pragma unroll
            for (int i = 0; i < 16; ++i) a += ns[kq * 16 + i] * bf2f(Qs[s2 * 136 + kq * 16 + i]);
            a = red8(a); if (kq == 0) nq[s2] = a;
        }
        WG_BAR();
        {
            const int s = st * 16 + fr, vh = wave >> 2; const float wi = gwi[s];
            const float den = dn[s] + wi * nq[s], dinv = 1.f / fmaxf(fabsf(den), gei[s]);
            bf16x8 pf[2];
#pragma unroll
            for (int ks = 0; ks < 2; ++ks) pf[ks] = *(const LAS bf16x8*)(Pp + s * 72 + ks * 32 + fq * 8);
            f32x4 hv[4]; float s1 = 0.f, s2 = 0.f;
#pragma unroll
            for (int q = 0; q < 4; ++q) {
                const int vt = vh * 4 + q; f32x4 a = (f32x4){0.f, 0.f, 0.f, 0.f};
#pragma unroll
                for (int ks = 0; ks < 4; ++ks) { const bf16x8 cf = *(const LAS bf16x8*)(Cb + (vt * 16 + fr) * 136 + ks * 32 + fq * 8); a = __builtin_amdgcn_mfma_f32_16x16x32_bf16(cf, qf[ks], a, 0, 0, 0); }
                a = a * wi;
#pragma unroll
                for (int ks = 0; ks < 2; ++ks) { const bf16x8 vf = *(const LAS bf16x8*)(VT + TRB(vt * 16 + fr, ks * 4 + fq)); a = __builtin_amdgcn_mfma_f32_16x16x32_bf16(vf, pf[ks], a, 0, 0, 0); }
                a = a * dinv; hv[q] = a;
#pragma unroll
                for (int j = 0; j < 4; ++j) { s1 += a[j]; s2 += a[j] * a[j]; }
            }
            s1 += __shfl_xor(s1, 16); s1 += __shfl_xor(s1, 32); s2 += __shfl_xor(s2, 16); s2 += __shfl_xor(s2, 32);
            if (fq == 0) { lnx[s * 4 + vh * 2] = s1; lnx[s * 4 + vh * 2 + 1] = s2; }
            WG_BAR();
            const f32x4 l4 = *(const LAS f32x4*)(lnx + s * 4);
            const float mean = (l4[0] + l4[2]) * (1.f / 128.f), var = fmaxf((l4[1] + l4[3]) * (1.f / 128.f) - mean * mean, 0.f), rstd = rsqrtf(var + 1e-6f);
            const size_t tok = tokc + s;
#pragma unroll
            for (int q = 0; q < 4; ++q) {
                const int v0 = (vh * 4 + q) * 16 + fq * 4;
                const u32x2 og = ogp[q]; const f32x4 g4 = *(const LAS f32x4*)(MLN + v0);
                const float o0 = (hv[q][0] - mean) * rstd * g4[0] * fsigmoid(bflo(og.x)), o1 = (hv[q][1] - mean) * rstd * g4[1] * fsigmoid(bfhi(og.x));
                const float o2 = (hv[q][2] - mean) * rstd * g4[2] * fsigmoid(bflo(og.y)), o3 = (hv[q][3] - mean) * rstd * g4[3] * fsigmoid(bfhi(og.y));
                u32x2 w; w.x = cvt_pk_bf16(o0, o1); w.y = cvt_pk_bf16(o2, o3);
                *(u32x2*)(Yb + tok * DM + 512 + h * 128 + v0) = w;
            }
            if (c < 63) ML_PF_OG(c + 1);
        }
        WG_BAR();
        {
            const float dec = sc[0];
            bf16x8 vf[2];
#pragma unroll
            for (int ks = 0; ks < 2; ++ks) vf[ks] = *(const LAS bf16x8*)(VwT + TRB(wave * 16 + fr, ks * 4 + fq));
#pragma unroll
            for (int kt = 0; kt < 8; ++kt) {
                f32x4 a = Cacc[kt] * dec;
#pragma unroll
                for (int ks = 0; ks < 2; ++ks) { const bf16x8 kf = *(const LAS bf16x8*)(KT + TRB(kt * 16 + fr, ks * 4 + fq)); a = __builtin_amdgcn_mfma_f32_16x16x32_bf16(kf, vf[ks], a, 0, 0, 0); }
                Cacc[kt] = a;
                u32x2 w; w.x = cvt_pk_bf16(a[0], a[1]); w.y = cvt_pk_bf16(a[2], a[3]);
                *(LAS u32x2*)(Cb + (wave * 16 + fr) * 136 + kt * 16 + fq * 4) = w;
            }
            if (tid < 128) { float a = ns[tid] * dec;
                for (int l = 0; l < 64; ++l) a += gwl[l] * bf2f(Ks[l * 136 + tid]);
                ns[tid] = a; }
            mprev = sc[1];
        }
        WG_BAR();
    }
#undef ML_PF_QKV
#undef ML_PF_IF
#undef ML_PF_OG
}

struct SchedKV {
    const char* memb; const char* wk; const char* wv; int j;
    __device__ __forceinline__ bool next(int i, Unit& u) const {
        if (i != 0 || j < 0 || j >= 64) return false;
        const size_t ts = (size_t)256 * 1024 * 2;
        if (j < 32) { u.pm = j >> 2; u.pn = j & 3; u.A = memb + u.pm * ts; u.B = wk + u.pn * ts; u.tag = 0; }
        else { const int q = j - 32; u.pm = q >> 3; u.pn = q & 7; u.A = wv + u.pm * ts; u.B = memb + u.pn * ts; u.tag = 1; }
        u.nt = 16; return true;
    }
};
struct SchedMerge {
    const char* yb; const char* wup; int c;
    __device__ __forceinline__ bool next(int i, Unit& u) const {
        if (i >= 4) return false;
        const int T = c + 256 * (i >> 1), pass = i & 1; u.pm = T >> 2; u.pn = T & 3; u.tag = pass ? 3 : 1; u.nt = 8;
        const size_t ts = (size_t)256 * 1024 * 2;
        u.A = yb + u.pm * ts + pass * 1024; u.B = wup + u.pn * ts + pass * 1024;
        return true;
    }
};
struct SchedPanel {
    const char* A; const char* B; size_t tstep; int c;
    __device__ __forceinline__ bool next(int i, Unit& u) const {
        if (i >= 2) return false;
        u.pm = c >> 1; u.pn = 2 * (c & 1) + i; u.nt = 44; u.tag = 0;
        u.A = A + (size_t)u.pm * tstep; u.B = B + (size_t)u.pn * tstep; return true;
    }
};
struct SchedGate {
    const char* xb; const char* wg; int j0;
    __device__ __forceinline__ bool next(int i, Unit& u) const {
        const int j = j0 + 96 * i; if (j >= 1024) return false;
        u.pm = j >> 3; u.pn = j & 7; u.nt = 16; u.tag = 0;
        const size_t ts = (size_t)256 * 1024 * 2;
        u.A = xb + u.pm * ts; u.B = wg + u.pn * ts;
        return true;
    }
};
struct SchedAttn {
    const char* xb; const char* wq; const char* q; const char* p; const char* kb; const char* vt; int c;
    __device__ __forceinline__ bool next(int i, Unit& u) const {
        if (i >= 6) return false;
        const int pr = c + 256 * (i & 1), b = pr >> 6, h = (pr >> 4) & 3, qt = pr & 15, st = i >> 1;
        u.pm = b * 16 + qt; u.pn = h;
        const size_t ao = ((size_t)u.pm * 256 * 1024 + h * 256) * 2;
        if (st == 0) { u.A = xb + (size_t)u.pm * 256 * 1024 * 2; u.B = wq + (size_t)h * 256 * 1024 * 2; u.nt = 16; u.tag = 2; }
        else if (st == 1) { u.A = q + ao; u.B = kb + ((size_t)b * 256 * 1024 + h * 256) * 2; u.nt = 4; u.tag = 0; }
        else { u.A = p + ao; u.B = vt + (size_t)(b >> 2) * 2097152 + ((size_t)h * 256 * 1024 + (b & 3) * 256) * 2; u.nt = 4; u.tag = 1; }
        return true;
    }
};

#define XB_TMO      128
#define XB_XCNT(j)  (256  + 64 * (j))
#define XB_XSUB(j)  (1280 + 64 * (j))
#define XB_XGEN(j)  (2304 + 64 * (j))
#define XB_TOP      3328
#define XB_TOPGEN   3392
#define XCD_BAR_WORDS 3456
#define XB_SPIN_CAP (1u << 18)
__device__ __forceinline__ unsigned xb_ld(unsigned* p)              { return __hip_atomic_load(p, __ATOMIC_RELAXED, __HIP_MEMORY_SCOPE_AGENT); }
__device__ __forceinline__ unsigned xb_add(unsigned* p, unsigned v) { return __hip_atomic_fetch_add(p, v, __ATOMIC_RELAXED, __HIP_MEMORY_SCOPE_AGENT); }
__device__ __forceinline__ unsigned xb_xcc_id() { return (unsigned)__builtin_amdgcn_s_getreg((3 << 11) | 20) & 0xFu; }
#define XB_SPIN(cond, bar) do { unsigned _sp = 0; while (cond) { __builtin_amdgcn_s_sleep(1); \
    if ((++_sp & 255u) == 0u) { if (xb_ld(&(bar)[XB_TMO])) break; if (_sp > XB_SPIN_CAP) { atomicAdd(&(bar)[XB_TMO], 1u); break; } } } } while (0)
struct XcdBarrier { unsigned* bar; unsigned x; volatile LAS unsigned* st; };
__device__ __forceinline__ XcdBarrier xcd_barrier_post(unsigned* bar, volatile LAS unsigned* st) {
    XcdBarrier b; b.bar = bar; b.x = xb_xcc_id(); b.st = st;
    if (threadIdx.x == 0) (void)xb_add(&bar[XB_XCNT(b.x)], 1u);
    return b;
}
__device__ __forceinline__ void xcd_barrier_complete(unsigned* bar, unsigned x, unsigned& nloc, unsigned& nx) {
    const unsigned G = gridDim.x * gridDim.y * gridDim.z;
    unsigned sum, cnt, mine, sp = 0u;
    for (;;) {
        sum = 0u; cnt = 0u; mine = 0u;
#pragma unroll
        for (unsigned j = 0; j < 16; ++j) { const unsigned c = xb_ld(&bar[XB_XCNT(j)]); sum += c; cnt += (c > 0u) ? 1u : 0u; mine = (j == x) ? c : mine; }
        if (sum == G) break;
        __builtin_amdgcn_s_sleep(1);
        if ((++sp & 255u) == 0u) { if (xb_ld(&bar[XB_TMO])) break; if (sp > XB_SPIN_CAP) { atomicAdd(&bar[XB_TMO], 1u); break; } }
    }
    nloc = mine > 0u ? mine : 1u; nx = cnt > 0u ? cnt : 1u;
}
__device__ __forceinline__ void xcd_barrier(const XcdBarrier& b) {
    asm volatile("s_waitcnt vmcnt(0)" ::: "memory");
    __syncthreads();
    if (threadIdx.x == 0) {
        unsigned* bar = b.bar;
        __builtin_amdgcn_s_waitcnt(0);
        unsigned nloc = b.st[0], nx = b.st[1];
        if (nloc == 0u) { xcd_barrier_complete(bar, b.x, nloc, nx); b.st[0] = nloc; b.st[1] = nx; }
        const unsigned old = xb_add(&bar[XB_XSUB(b.x)], 1u);
        const unsigned gen = old / nloc;
        if (old + 1u == (gen + 1u) * nloc) {
            __builtin_amdgcn_fence(__ATOMIC_RELEASE, "agent");
            asm volatile("s_waitcnt vmcnt(0)" ::: "memory");
            const unsigned og = xb_add(&bar[XB_TOP], 1u);
            const unsigned tg = og / nx;
            if (og + 1u == (tg + 1u) * nx) xb_add(&bar[XB_TOPGEN], 1u);
            else XB_SPIN(xb_ld(&bar[XB_TOPGEN]) == tg, bar);
            __builtin_amdgcn_fence(__ATOMIC_ACQUIRE, "agent");
            xb_add(&bar[XB_XGEN(b.x)], 1u);
            asm volatile("s_waitcnt vmcnt(0)" ::: "memory");
        } else {
            XB_SPIN(xb_ld(&bar[XB_XGEN(b.x)]) == gen, bar);
            __builtin_amdgcn_fence(__ATOMIC_ACQUIRE, "agent");
            asm volatile("s_waitcnt vmcnt(0)" ::: "memory");
        }
    }
    __syncthreads();
}

__global__ void __launch_bounds__(512, 2) mega(Params P) {
    extern __shared__ __attribute__((aligned(16))) unsigned char smem[];
    LAS unsigned char* lds = (LAS unsigned char*)smem;
    unsigned char* ws = P.ws;
    const int G = gridDim.x, c = blockIdx.x, lo = P.ph_lo, hi = P.ph_hi;
    float* ssq0 = (float*)(ws + OFF_SSQ0); float* ssq1 = (float*)(ws + OFF_SSQ1); float* ssq2 = (float*)(ws + OFF_SSQ2); float* ssq3 = (float*)(ws + OFF_SSQ3); float* ssq4 = (float*)(ws + OFF_SSQ4);
    bf16_t* XB = (bf16_t*)(ws + OFF_XB); bf16_t* U = (bf16_t*)(ws + OFF_U);
#ifdef ONLY_PHASE
#define IN(k) ((k) == ONLY_PHASE && lo <= (k) && (k) < hi)
#else
#define IN(k) (lo <= (k) && (k) < hi)
#endif
    volatile LAS unsigned* bst = (volatile LAS unsigned*)(lds + 163776);
    if (threadIdx.x < 2) bst[threadIdx.x] = 0u;
    __syncthreads();
    XcdBarrier xbar; xbar.bar = (unsigned*)(ws + OFF_BARW); xbar.x = 0; xbar.st = bst;
    if (P.coop) xbar = xcd_barrier_post((unsigned*)(ws + OFF_BARW), bst);
    if (P.ph_hi > NPHASE) cg::this_grid().sync();
#define SEAM(k) do { if (P.coop && IN(k) && IN((k) + 1)) xcd_barrier(xbar); } while (0)
    const size_t TS1 = (size_t)256 * 1024 * 2, TSF = (size_t)256 * DFF * 2;

    if (IN(0)) { phase_prep(P, lds); }
    SEAM(0);
    if (IN(1)) {
        SchedStatic S{(const char*)XB, (const char*)(ws + OFF_WGU1), TS1, 128, 22, 16, G, c}; EpiSwiglu E{U, ssq0};
        gemm_phase(lds, 1024, S, E);
    }
    SEAM(1);
    if (IN(2)) {
        SchedStatic S{(const char*)U, (const char*)(ws + OFF_WD1), TSF, 128, 4, 44, G, c}; EpiResidX<1> E{P.in[0], nullptr, XB, ssq1, 0.5f};
        gemm_phase(lds, DFF, S, E);
    }
    SEAM(2);
    if (IN(3)) {
        SchedStatic S{(const char*)XB, (const char*)(ws + OFF_WIN), TS1, 128, 16, 16, G, c}; EpiRowScale<0> E{(bf16_t*)(ws + OFF_Z), ssq1, (float*)(ws + OFF_IF)};
        gemm_phase(lds, 1024, S, E);
    }
    SEAM(3);
    if (IN(4)) {
        if (c < 128) rwkv_item(P, lds, c);
        else if (c < 160) mlstm_item(P, lds, c - 128);
        else {
            if (c < 224) { SchedKV S{(const char*)(ws + OFF_MEMB), (const char*)(ws + OFF_WK), (const char*)(ws + OFF_WV), c - 160}; EpiKV E{(bf16_t*)(ws + OFF_KB), (bf16_t*)(ws + OFF_VT), (const float*)(ws + OFF_SSQM)};
                gemm_phase(lds, 1024, S, E); }
            {
                SchedGate S{(const char*)XB, (const char*)(ws + OFF_WG), c >= 224 ? c - 224 : c - 128}; EpiGate E{(bf16_t*)P.out, (bf16_t*)P.out + (size_t)NTOK * DM, ssq1};
                gemm_phase(lds, 1024, S, E); }
            const int wv_ = threadIdx.x >> 6, ln_ = threadIdx.x & 63; LAS float* scr = (LAS float*)(lds + wv_ * 16384);
            for (int it = P.nearly + (c - 160) * 8 + wv_; it < P.nitems; it += 96 * 8) {
                int j = 0;
                while (j + 1 < P.njobs && it >= P.jobs[j + 1].item0) ++j;
                transpose_item(P.jobs[j], it - P.jobs[j].item0, scr, ln_);
            }
        }
    }
    SEAM(4);
    if (IN(5)) {
        SchedMerge S{(const char*)(ws + OFF_Y), (const char*)(ws + OFF_WUP), c};
        EpiMerge2 E{(u32x4*)(ws + OFF_SCRS) + (size_t)c * 8192, (bf16_t*)(ws + OFF_MG), (const bf16_t*)P.out, (const bf16_t*)P.out + (size_t)NTOK * DM};
        if (c < 256) gemm_phase(lds, 1024, S, E);
    }
    SEAM(5);
    if (IN(6)) {
        SchedStatic S{(const char*)(ws + OFF_MG), (const char*)(ws + OFF_WOUT), TS1, 128, 4, 16, G, c}; EpiResidX<3> E{nullptr, nullptr, XB, ssq2, 1.0f};
        gemm_phase(lds, 1024, S, E);
    }
    SEAM(6);
    if (IN(8)) {
        SchedAttn S{(const char*)XB, (const char*)(ws + OFF_WQ), (const char*)(ws + OFF_Q), (const char*)(ws + OFF_P), (const char*)(ws + OFF_KB), (const char*)(ws + OFF_VT), c};
        EpiAttn E{(bf16_t*)(ws + OFF_P), (bf16_t*)(ws + OFF_O), (bf16_t*)(ws + OFF_Q), ssq2};
        if (c < 256) gemm_phase(lds, 1024, S, E);
    }
    SEAM(8);
    if (IN(9)) {
        SchedStatic S{(const char*)(ws + OFF_O), (const char*)(ws + OFF_WO), TS1, 128, 4, 16, G, c}; EpiResidX<3> E{nullptr, nullptr, XB, ssq3, 1.0f};
        gemm_phase(lds, 1024, S, E);
    }
    SEAM(9);
    if (IN(10)) {
        SchedStatic S{(const char*)XB, (const char*)(ws + OFF_WGU2), TS1, 128, 22, 16, G, c}; EpiSwiglu E{U, ssq3};
        gemm_phase(lds, 1024, S, E);
    }
    SEAM(10);
    if (IN(11)) {
        LAS float* rowss = (LAS float*)(lds + XCH_OFF); LAS float* rsv = rowss + 256;
        if (threadIdx.x < 256) rowss[threadIdx.x] = 0.f;
        __syncthreads();
        SchedPanel S{(const char*)U, (const char*)(ws + OFF_WD2), TSF, c}; EpiResidFin E{P.out, XB, 0.5f};
        gemm_phase(lds, DFF, S, E);
        if (threadIdx.x < 256) {
            const int r = threadIdx.x, pm = c >> 1, me = c & 1;
            unsigned long long* g = (unsigned long long*)(ws + OFF_FNG) + (size_t)pm * 512;
            const float mine = rowss[r];
            __hip_atomic_store(g + me * 256 + r, (0x5EEDull << 32) | __builtin_bit_cast(unsigned, mine), __ATOMIC_RELAXED, __HIP_MEMORY_SCOPE_AGENT);
            unsigned long long o; unsigned spins = 0;
            for (;;) { o = __hip_atomic_load(g + (me ^ 1) * 256 + r, __ATOMIC_RELAXED, __HIP_MEMORY_SCOPE_AGENT);
                if (__all((o >> 32) == 0x5EEDull)) break;
                __builtin_amdgcn_s_sleep(2); if (++spins > (1u << 22)) break; }
            rsv[r] = rsqrtf((mine + __builtin_bit_cast(float, (unsigned)o)) * (1.f / 1024.f) + NORM_EPS);
        }
        __builtin_amdgcn_fence(__ATOMIC_ACQUIRE, "agent");
        __syncthreads();
        {
            const int pm = c >> 1, me = c & 1, cq = threadIdx.x & 127, rq = threadIdx.x >> 7; const float* fn = P.in[36];
            const f32x4 g4 = *(const f32x4*)(fn + me * 512 + cq * 4);
            float* base = P.out + (size_t)pm * 256 * DM + me * 512 + cq * 4;
#pragma unroll 4
            for (int r = rq; r < 256; r += 4) { f32x4* p4 = (f32x4*)(base + (size_t)r * DM); *p4 = *p4 * rsv[r] * g4; }
        }
    }
#undef IN
#undef SEAM
}

#ifdef MK_DBG_DUMP
__global__ void dbg_dump(const bf16_t* src, int ld, int mode, float* out) {
    const size_t i = (size_t)blockIdx.x * 256 + threadIdx.x; const size_t r = i >> 10; const int c = (int)(i & 1023);
    float v = bf2f(src[r * ld + c]);
    if (mode == 1) v += 2.f * bf2f(src[r * ld + c + 1024]) + 3.f * bf2f(src[r * ld + c + 2048]) + 5.f * bf2f(src[r * ld + c + 2816]);
    if (mode == 4) v = ((const float*)src)[i & 262143];
    if (mode == 2 && c >= 512) v = 0.f;
    if (mode == 3 && c < 512) v = 0.f;
    out[i] = v;
}
#endif
static void add_job(Params& p, const float* src, const float* gain, size_t dst_off, int K, int ldsrc, int col0, int ncols, int dst_ld, int dst_row0, int dst_k0, int mode, float scale) {
    TJob& j = p.jobs[p.njobs++]; j.src = src; j.gain = gain; j.dst = (bf16_t*)(p.ws + dst_off); j.K = K; j.ldsrc = ldsrc; j.col0 = col0; j.ncols = ncols; j.dst_ld = dst_ld; j.dst_row0 = dst_row0; j.dst_k0 = dst_k0;
    j.mode = mode; j.scale = scale; j.item0 = p.nitems; p.nitems += (K / 64) * ((ncols + 63) / 64);
}
extern "C" void kernel_launch(void* const* d_in, const int* in_sizes, int n_in, void* d_out, int out_size, void* d_ws, size_t ws_size, hipStream_t stream) {
    static int ready = 0;
    if (ready == 0) {
        if (n_in != 37 || out_size != NTOK * DM || ws_size < WS_END) { fprintf(stderr, "kernel_launch: unexpected shapes: n_in %d out %d ws %zu (need %zu); nothing launched\n", n_in, out_size, ws_size, (size_t)WS_END); ready = -1; return; }
        if (hipFuncSetAttribute((const void*)mega, hipFuncAttributeMaxDynamicSharedMemorySize, LDS_BYTES) != hipSuccess) { fprintf(stderr, "kernel_launch: hipFuncSetAttribute failed\n"); ready = -1; return; }
        int per_cu = 0; (void)hipOccupancyMaxActiveBlocksPerMultiprocessor(&per_cu, (const void*)mega, 512, LDS_BYTES); (void)hipGetLastError();
        if (per_cu < 1) fprintf(stderr, "kernel_launch: note: occupancy query says %d blocks per CU\n", per_cu);
        ready = 1;
    }
    if (ready < 0) return;
    Params p; memset(&p, 0, sizeof(p));
    for (int i = 0; i < 37; ++i) p.in[i] = (const float*)d_in[i];
    p.out = (float*)d_out; p.ws = (unsigned char*)d_ws;
    const float* const* in = p.in;
    add_job(p, in[3], in[2], OFF_WGU1, 1024, DFF, 0, DFF, 1024, 0, 0, 1, 1.f);
    add_job(p, in[4], in[2], OFF_WGU1, 1024, DFF, 0, DFF, 1024, 128, 0, 1, 1.f);
    add_job(p, in[5], nullptr, OFF_WD1, DFF, 1024, 0, 1024, DFF, 0, 0, 0, 1.f);
    add_job(p, in[7], in[6], OFF_WIN, 1024, 5896, 0, 3848, 1024, 0, 0, 0, 1.f);
    add_job(p, in[30], in[28], OFF_WK, 1024, 2048, 0, 1024, 1024, 0, 0, 0, 1.f);
    add_job(p, in[30], in[28], OFF_WV, 1024, 2048, 1024, 1024, 1024, 0, 0, 0, 1.f);
    add_job(p, in[10], nullptr, OFF_W2T, 64, 512, 0, 512, 64, 0, 0, 0, 1.f);
    add_job(p, in[12], nullptr, OFF_A2T, 64, 512, 0, 512, 64, 0, 0, 0, 1.f);
    add_job(p, in[13], nullptr, OFF_G2T, 128, 512, 0, 512, 128, 0, 0, 0, 1.f);
    add_job(p, in[7], in[6], OFF_WG, 1024, 5896, 3848, 2048, 1024, 0, 0, 0, 1.f);
    p.nearly = p.nitems;
    add_job(p, in[24], nullptr, OFF_WUP, 512, 1024, 0, 1024, 1024, 0, 0, 0, 1.f);
    add_job(p, in[25], nullptr, OFF_WUP, 512, 1024, 0, 1024, 1024, 0, 512, 0, 1.f);
    add_job(p, in[26], nullptr, OFF_WOUT, 1024, 1024, 0, 1024, 1024, 0, 0, 0, 1.f);
    add_job(p, in[29], in[27], OFF_WQ, 1024, 1024, 0, 1024, 1024, 0, 0, 0, 0.0625f);
    add_job(p, in[31], nullptr, OFF_WO, 1024, 1024, 0, 1024, 1024, 0, 0, 0, 1.f);
    add_job(p, in[33], in[32], OFF_WGU2, 1024, DFF, 0, DFF, 1024, 0, 0, 1, 1.f);
    add_job(p, in[34], in[32], OFF_WGU2, 1024, DFF, 0, DFF, 1024, 128, 0, 1, 1.f);
    add_job(p, in[35], nullptr, OFF_WD2, DFF, 1024, 0, 1024, DFF, 0, 0, 0, 1.f);
    const int grid = 256;
#if MK_PER_PHASE
    p.coop = 0;
    for (int ph = 0; ph < MK_DBG_HI; ++ph) { p.ph_lo = ph; p.ph_hi = ph + 1; hipLaunchKernelGGL(mega, dim3(grid), dim3(512), LDS_BYTES, stream, p); }
#ifdef MK_DBG_DUMP
    hipLaunchKernelGGL(dbg_dump, dim3(NTOK * 4), dim3(256), 0, stream, (const bf16_t*)(p.ws + MK_DBG_DUMP), MK_DBG_LD, MK_DBG_MODE, p.out);
#endif
#else
    p.coop = 1; p.ph_lo = 0; p.ph_hi = NPHASE;
    if (hipMemsetAsync((char*)d_ws + OFF_BARW, 0, XCD_BAR_WORDS * 4, stream) != hipSuccess) { fprintf(stderr, "kernel_launch: hipMemsetAsync failed\n"); return; }
    void* args[] = {&p};
    hipError_t e = hipLaunchCooperativeKernel((const void*)mega, dim3(grid), dim3(512), args, LDS_BYTES, stream);
    if (e != hipSuccess) fprintf(stderr, "kernel_launch: cooperative launch failed: %s\n", hipGetErrorString(e));
#endif
}
```

```cpp
#include <hip/hip_runtime.h>
#include <hip/hip_cooperative_groups.h>
#include <cstdio>
#include <cstdint>
#include <cstring>
namespace cg = cooperative_groups;

#define LAS __attribute__((address_space(3)))
typedef unsigned short bf16_t;
typedef short bf16x8 __attribute__((ext_vector_type(8)));
typedef float f32x4 __attribute__((ext_vector_type(4)));
typedef float f32x2 __attribute__((ext_vector_type(2)));
typedef unsigned u32x4 __attribute__((ext_vector_type(4)));
typedef unsigned u32x2 __attribute__((ext_vector_type(2)));

#ifndef MK_DBG_HI
#define MK_DBG_HI 13
#endif
#ifndef MK_PER_PHASE
#define MK_PER_PHASE 0
#endif

constexpr int NTOK = 32768, DM = 1024, SEQ = 4096, NB = 8, DFF = 2816, MEMTOK = 2048;
constexpr int ZLD = 3840;
constexpr float NORM_EPS = 1e-5f;
constexpr int NPHASE = 13;
constexpr int LDS_BYTES = 160 * 1024;
constexpr int XCH_OFF = 131072;

constexpr size_t MiB = 1048576;
constexpr size_t OFF_SSQ0 = 0, OFF_SSQ1 = 131072, OFF_SSQ2 = 262144, OFF_SSQ3 = 393216, OFF_SSQ4 = 524288, OFF_SSQM = 655360;
constexpr size_t OFF_IF = 1 * MiB;
constexpr size_t OFF_FNG = 452 * MiB;
constexpr size_t OFF_GATES = 2 * MiB;
constexpr size_t OFF_BARW = 720896;
constexpr size_t OFF_STATS = 444 * MiB;
constexpr size_t OFF_W = 4 * MiB;
constexpr size_t SZ_WGU = (size_t)5632 * 1024 * 2, SZ_WD = (size_t)1024 * 2816 * 2, SZ_WIN = (size_t)4096 * 1024 * 2, SZ_WG = (size_t)2048 * 1024 * 2, SZ_SQ = (size_t)1024 * 1024 * 2;
constexpr size_t OFF_WGU1 = OFF_W, OFF_WD1 = OFF_WGU1 + SZ_WGU, OFF_WIN = OFF_WD1 + SZ_WD, OFF_WG = OFF_WIN + SZ_WIN, OFF_WUP = OFF_WG + SZ_WG, OFF_WOUT = OFF_WUP + SZ_SQ,
                 OFF_WQ = OFF_WOUT + SZ_SQ, OFF_WK = OFF_WQ + SZ_SQ, OFF_WV = OFF_WK + SZ_SQ, OFF_WO = OFF_WV + SZ_SQ, OFF_WGU2 = OFF_WO + SZ_SQ, OFF_WD2 = OFF_WGU2 + SZ_WGU,
                 OFF_W2T = OFF_WD2 + SZ_WD, OFF_A2T = OFF_W2T + 65536, OFF_G2T = OFF_A2T + 65536, OFF_WEND = OFF_G2T + 131072;
static_assert(OFF_WEND <= 64 * MiB, "weights");
constexpr size_t OFF_XB = 64 * MiB, OFF_Y = 128 * MiB, OFF_MEMB = 192 * MiB, OFF_KB = 196 * MiB, OFF_VT = 200 * MiB, OFF_BIG = 204 * MiB, WS_END = 460 * MiB;
constexpr size_t OFF_U = OFF_BIG, OFF_Z = OFF_BIG, OFF_SCRS = OFF_BIG, OFF_SCRM = OFF_BIG + 32 * MiB, OFF_MG = OFF_BIG + 96 * MiB, OFF_Q = OFF_BIG, OFF_P = OFF_BIG + 64 * MiB, OFF_O = OFF_BIG + 128 * MiB;

typedef __bf16 bf16x2_t __attribute__((ext_vector_type(2)));
__device__ __forceinline__ unsigned cvt_pk_bf16(float lo, float hi) { f32x2 v = {lo, hi}; bf16x2_t b = __builtin_convertvector(v, bf16x2_t); return __builtin_bit_cast(unsigned, b); }
__device__ __forceinline__ float bflo(unsigned u) { return __builtin_bit_cast(float, u << 16); }
__device__ __forceinline__ float bfhi(unsigned u) { return __builtin_bit_cast(float, u & 0xffff0000u); }
__device__ __forceinline__ float bf2f(bf16_t b) { return __builtin_bit_cast(float, (unsigned)b << 16); }
__device__ __forceinline__ bf16_t f2bf(float f) { return (bf16_t)(cvt_pk_bf16(f, 0.f) & 0xffffu); }
__device__ __forceinline__ float fsigmoid(float x) { return __builtin_amdgcn_rcpf(1.f + __expf(-x)); }
__device__ __forceinline__ float wave_sum(float v) {
#pragma unroll
    for (int o = 1; o < 64; o <<= 1) v += __shfl_xor(v, o);
    return v;
}
template <int CTRL> __device__ __forceinline__ float dpp_f(float x) { return __builtin_bit_cast(float, __builtin_amdgcn_update_dpp(0, __builtin_bit_cast(int, x), CTRL, 0xF, 0xF, true)); }
__device__ __forceinline__ float red8(float x) {
    x += dpp_f<0xB1>(x); x += dpp_f<0x4E>(x); x += dpp_f<0x141>(x); return x;
}
#define LDS_WAIT() asm volatile("s_waitcnt lgkmcnt(0)" ::: "memory")
#define WG_BAR() do { asm volatile("s_waitcnt lgkmcnt(0)" ::: "memory"); __builtin_amdgcn_s_barrier(); asm volatile("" ::: "memory"); } while (0)
#define WG_BAR_ALL() do { asm volatile("s_waitcnt vmcnt(0) lgkmcnt(0)" ::: "memory"); __builtin_amdgcn_s_barrier(); asm volatile("" ::: "memory"); } while (0)

constexpr int BM = 256, BK = 64, HALF = 128, HTB = HALF * BK * 2;
__host__ __device__ __forceinline__ int lds_byte(int r, int c) { const int st = (r >> 4) * 2 + (c >> 5), rr = r & 15, cc = c & 31, ob = rr * 64 + cc * 2; return st * 1024 + (ob ^ (((ob >> 9) & 1) << 5)); }
__host__ __device__ __forceinline__ void stage_rc(int b, int& R, int& C) { const int st = b / 1024, sb = b % 1024, swz = sb ^ (((sb >> 9) & 1) << 5); R = (st >> 1) * 16 + swz / 64; C = (st & 1) * 32 + (swz % 64) / 2; }
__host__ __device__ __forceinline__ int perm32(int rho) { const int n = rho >> 4, i = rho & 15; return 8 * (i >> 2) + 4 * n + (i & 3); }

struct Unit { const char* A; const char* B; int nt, pm, pn, tag; };

__device__ __forceinline__ void tile_of(int L, int nM, int nN, int& pm, int& pn) {
    const int nwg = nM * nN; int wgid = L;
    { const int q = nwg / 8, r = nwg % 8, xcd = wgid % 8, off = wgid / 8; wgid = (xcd < r ? xcd * (q + 1) : r * (q + 1) + (xcd - r) * q) + off; }
    const int nig = 8 * nN, gid = wgid / nig, fm = gid * 8, gsz = (nM - fm) < 8 ? (nM - fm) : 8;
    pm = fm + ((wgid % nig) % gsz); pn = (wgid % nig) / gsz;
}
struct SchedStatic {
    const char* A; const char* B; size_t tstep; int nM, nN, nt, G, c;
    __device__ __forceinline__ bool next(int i, Unit& u) const {
        const long L = (long)i * G + c; if (L >= (long)nM * nN) return false;
        int pm, pn; tile_of((int)L, nM, nN, pm, pn);
        u.A = A + (size_t)pm * tstep; u.B = B + (size_t)pn * tstep; u.nt = nt; u.pm = pm; u.pn = pn; u.tag = 0; return true;
    }
};

template <class Epi, class Sched>
__device__ __forceinline__ void gemm_phase(LAS unsigned char* lds, const int ld, const Sched& S, const Epi& E) {
    const int tid = threadIdx.x, wid = __builtin_amdgcn_readfirstlane(tid >> 6), lane = tid & 63, wr = wid >> 2, wc = wid & 3, fr = lane & 15, fq = lane >> 4;
    unsigned voffA[2], voffB[2];
#pragma unroll
    for (int i = 0; i < 2; ++i) { int R, C; stage_rc(tid * 16 + i * 8192, R, C); const int Rb = (R & ~31) + perm32(R & 31);
        voffA[i] = (unsigned)(R * ld + C) * 2u; voffB[i] = (unsigned)(Rb * ld + C) * 2u; }
    const size_t kstep = (size_t)(BK * 2);
    const size_t hstep = (size_t)HALF * ld * 2;
    const unsigned ldsw = (unsigned)wid * 1024u;
    const int aoff = lds_byte(wr * 64 + fr, fq * 8), boff = lds_byte(wc * 32 + fr, fq * 8);
#define PG8_SA(b, h) (((b) * 2 + (h)) * HTB)
#define PG8_SB(b, h) ((4 + (b) * 2 + (h)) * HTB)
#define PG8_STAGE(bufoff, gbase, voff) do { _Pragma("unroll") for (int _i = 0; _i < 2; ++_i) \
        __builtin_amdgcn_global_load_lds((const unsigned*)((const char*)(gbase) + (voff)[_i]), (LAS unsigned*)(lds + (bufoff) + ldsw + _i * 8192), 16, 0, 0); } while (0)
#define PG8_LDA(dst, b, h) do { _Pragma("unroll") for (int m = 0; m < 4; ++m) _Pragma("unroll") for (int k = 0; k < 2; ++k) dst[m][k] = *(const LAS bf16x8*)(lds + PG8_SA(b, h) + aoff + m * 2048 + k * 1024); } while (0)
#define PG8_LDB(dst, b, h) do { _Pragma("unroll") for (int n = 0; n < 2; ++n) _Pragma("unroll") for (int k = 0; k < 2; ++k) dst[n][k] = *(const LAS bf16x8*)(lds + PG8_SB(b, h) + boff + n * 2048 + k * 1024); } while (0)
#define PG8_MMA(ai, bj, At, Bt) do { __builtin_amdgcn_s_setprio(1); _Pragma("unroll") for (int m = 0; m < 4; ++m) _Pragma("unroll") for (int n = 0; n < 2; ++n) _Pragma("unroll") for (int k = 0; k < 2; ++k) \
        acc[ai][bj][m][n] = __builtin_amdgcn_mfma_f32_16x16x32_bf16(Bt[n][k], At[m][k], acc[ai][bj][m][n], 0, 0, 0); __builtin_amdgcn_s_setprio(0); } while (0)
#define PG8_WAIT_V(n) asm volatile("s_waitcnt vmcnt(" #n ")" ::: "memory")
#define PG8_WAIT_L(n) asm volatile("s_waitcnt lgkmcnt(" #n ")" ::: "memory")
#define PG8_BAR __builtin_amdgcn_s_barrier()
#define PG8_SCHED __builtin_amdgcn_sched_barrier(0)
    Unit cur, nxt; int ui = 0;
    if (!S.next(0, cur)) return;
    f32x4 acc[2][2][4][2];
#pragma unroll
    for (int a = 0; a < 2; ++a)
#pragma unroll
        for (int b = 0; b < 2; ++b)
#pragma unroll
            for (int m = 0; m < 4; ++m)
#pragma unroll
                for (int n = 0; n < 2; ++n) acc[a][b][m][n] = (f32x4){0.f, 0.f, 0.f, 0.f};
    bf16x8 At[4][2], B0[2][2], B1[2][2];
    const char* cA = cur.A; const char* cB = cur.B; int nt = cur.nt; asm volatile("" : "+s"(nt));
    PG8_STAGE(PG8_SB(0, 0), cB, voffB); PG8_STAGE(PG8_SB(0, 1), cB + hstep, voffB); PG8_STAGE(PG8_SA(0, 0), cA, voffA); PG8_STAGE(PG8_SA(0, 1), cA + hstep, voffA);
    if (wr == 1) PG8_BAR;
    PG8_WAIT_V(2); PG8_BAR;
    PG8_STAGE(PG8_SB(1, 0), cB + kstep, voffB); PG8_STAGE(PG8_SA(1, 0), cA + kstep, voffA); PG8_STAGE(PG8_SB(1, 1), cB + hstep + kstep, voffB);
    PG8_WAIT_V(6); PG8_BAR;
#pragma unroll 1
    for (;;) {
        asm volatile("" : "+s"(ui));
        const bool has_next = S.next(ui + 1, nxt);
        const char* nA = has_next ? nxt.A : cA; const char* nB = has_next ? nxt.B : cB;
#pragma unroll 1
        for (int t = 0; t < nt; t += 2) {
            const bool last = (t == nt - 2);
            const char* a1 = cA + (size_t)(t + 1) * kstep;
            const char* a2 = last ? nA : cA + (size_t)(t + 2) * kstep; const char* b2 = last ? nB : cB + (size_t)(t + 2) * kstep;
            const char* a3 = a2 + kstep; const char* b3 = b2 + kstep;
            PG8_LDB(B0, 0, 0); PG8_LDB(B1, 0, 1); PG8_SCHED; PG8_LDA(At, 0, 0); PG8_STAGE(PG8_SA(1, 1), a1 + hstep, voffA);
            PG8_WAIT_V(8); PG8_WAIT_L(0); PG8_BAR; PG8_MMA(0, 0, At, B0); PG8_MMA(0, 1, At, B1); PG8_BAR; PG8_SCHED;
            PG8_LDA(At, 0, 1); PG8_STAGE(PG8_SB(0, 0), b2, voffB); PG8_STAGE(PG8_SB(0, 1), b2 + hstep, voffB); PG8_STAGE(PG8_SA(0, 0), a2, voffA);
            PG8_WAIT_V(8); PG8_WAIT_L(0); PG8_BAR; PG8_MMA(1, 0, At, B0); PG8_MMA(1, 1, At, B1); PG8_BAR; PG8_SCHED;
            PG8_LDB(B0, 1, 0); PG8_LDB(B1, 1, 1); PG8_SCHED; PG8_LDA(At, 1, 0); PG8_STAGE(PG8_SA(0, 1), a2 + hstep, voffA);
            PG8_WAIT_V(8); PG8_WAIT_L(0); PG8_BAR; PG8_MMA(0, 0, At, B0); PG8_MMA(0, 1, At, B1); PG8_BAR; PG8_SCHED;
            PG8_LDA(At, 1, 1); PG8_STAGE(PG8_SB(1, 0), b3, voffB); PG8_STAGE(PG8_SB(1, 1), b3 + hstep, voffB); PG8_STAGE(PG8_SA(1, 0), a3, voffA);
            PG8_WAIT_V(8); PG8_WAIT_L(0); PG8_BAR; PG8_MMA(1, 0, At, B0); PG8_MMA(1, 1, At, B1); PG8_BAR; PG8_SCHED;
        }
        if (wr == 0) PG8_BAR;
        E(acc, cur, wr, wc, fr, fq, lds);
        if (!has_next) break;
#pragma unroll
        for (int a = 0; a < 2; ++a)
#pragma unroll
            for (int b = 0; b < 2; ++b)
#pragma unroll
                for (int m = 0; m < 4; ++m)
#pragma unroll
                    for (int n = 0; n < 2; ++n) acc[a][b][m][n] = (f32x4){0.f, 0.f, 0.f, 0.f};
        cur = nxt; cA = nA; cB = nB; nt = cur.nt; asm volatile("" : "+s"(nt)); ++ui;
        if (wr == 1) PG8_BAR;
    }
    PG8_WAIT_V(0);
    PG8_BAR;
#undef PG8_SA
#undef PG8_SB
#undef PG8_STAGE
#undef PG8_LDA
#undef PG8_LDB
#undef PG8_MMA
#undef PG8_WAIT_V
#undef PG8_WAIT_L
#undef PG8_BAR
#undef PG8_SCHED
}

typedef f32x4 (&AccRef)[2][2][4][2];
#define EPI_ROWS_BEGIN _Pragma("unroll") for (int ai = 0; ai < 2; ++ai) _Pragma("unroll") for (int m = 0; m < 4; ++m) { const int rl = ai * 128 + wr * 64 + m * 16 + fr;
#define EPI_ROWS_END }

struct EpiSwiglu {
    bf16_t* U; const float* ssq;
    __device__ __forceinline__ void operator()(AccRef acc, const Unit& u, int wr, int wc, int fr, int fq, LAS unsigned char*) const {
        EPI_ROWS_BEGIN
            const int row = u.pm * 256 + rl; const float rs = rsqrtf(ssq[row] * (1.f / 1024.f) + NORM_EPS);
            float o[8];
#pragma unroll
            for (int n = 0; n < 2; ++n)
#pragma unroll
                for (int j = 0; j < 4; ++j) { const float g = acc[ai][0][m][n][j] * rs, up = acc[ai][1][m][n][j] * rs; o[n * 4 + j] = g * fsigmoid(g) * up; }
            u32x4 w; w.x = cvt_pk_bf16(o[0], o[1]); w.y = cvt_pk_bf16(o[2], o[3]); w.z = cvt_pk_bf16(o[4], o[5]); w.w = cvt_pk_bf16(o[6], o[7]);
            *(u32x4*)(U + (size_t)row * DFF + u.pn * 128 + wc * 32 + fq * 8) = w;
        EPI_ROWS_END
    }
};
template <bool WB> struct EpiResid {
    const float* xin; float* xout; bf16_t* xb; float* ssq; float scale;
    __device__ __forceinline__ void operator()(AccRef acc, const Unit& u, int wr, int wc, int fr, int fq, LAS unsigned char*) const {
        EPI_ROWS_BEGIN
            const int row = u.pm * 256 + rl; float ss = 0.f;
#pragma unroll
            for (int bj = 0; bj < 2; ++bj) {
                const size_t o = (size_t)row * DM + u.pn * 256 + bj * 128 + wc * 32 + fq * 8;
                f32x4 v0 = *(const f32x4*)(xin + o), v1 = *(const f32x4*)(xin + o + 4);
                v0 = v0 + acc[ai][bj][m][0] * scale; v1 = v1 + acc[ai][bj][m][1] * scale;
                *(f32x4*)(xout + o) = v0; *(f32x4*)(xout + o + 4) = v1;
                ss += v0[0] * v0[0] + v0[1] * v0[1] + v0[2] * v0[2] + v0[3] * v0[3] + v1[0] * v1[0] + v1[1] * v1[1] + v1[2] * v1[2] + v1[3] * v1[3];
                if (WB) { u32x4 w; w.x = cvt_pk_bf16(v0[0], v0[1]); w.y = cvt_pk_bf16(v0[2], v0[3]); w.z = cvt_pk_bf16(v1[0], v1[1]); w.w = cvt_pk_bf16(v1[2], v1[3]); *(u32x4*)(xb + o) = w; }
            }
            ss += __shfl_xor(ss, 16); ss += __shfl_xor(ss, 32);
            if (fq == 0) atomicAdd(ssq + row, ss);
        EPI_ROWS_END
    }
};
template <int MODE> struct EpiResidX {
    static constexpr bool ALIGN = true;
    const float* xin; float* xout; bf16_t* xb; float* ssq; float scale;
    __device__ __forceinline__ void operator()(AccRef acc, const Unit& u, int wr, int wc, int fr, int fq, LAS unsigned char*) const {
        EPI_ROWS_BEGIN
            const int row = u.pm * 256 + rl; float ss = 0.f;
#pragma unroll
            for (int bj = 0; bj < 2; ++bj) {
                const size_t o = (size_t)row * DM + u.pn * 256 + bj * 128 + wc * 32 + fq * 8;
                f32x4 v0, v1;
                if (MODE == 1) { v0 = *(const f32x4*)(xin + o); v1 = *(const f32x4*)(xin + o + 4); }
                else { const u32x4 xr = *(const u32x4*)(xb + o); v0 = (f32x4){bflo(xr.x), bfhi(xr.x), bflo(xr.y), bfhi(xr.y)}; v1 = (f32x4){bflo(xr.z), bfhi(xr.z), bflo(xr.w), bfhi(xr.w)}; }
                v0 = v0 + acc[ai][bj][m][0] * scale; v1 = v1 + acc[ai][bj][m][1] * scale;
                if (MODE == 2) { *(f32x4*)(xout + o) = v0; *(f32x4*)(xout + o + 4) = v1; }
                ss += v0[0] * v0[0] + v0[1] * v0[1] + v0[2] * v0[2] + v0[3] * v0[3] + v1[0] * v1[0] + v1[1] * v1[1] + v1[2] * v1[2] + v1[3] * v1[3];
                u32x4 w; w.x = cvt_pk_bf16(v0[0], v0[1]); w.y = cvt_pk_bf16(v0[2], v0[3]); w.z = cvt_pk_bf16(v1[0], v1[1]); w.w = cvt_pk_bf16(v1[2], v1[3]); *(u32x4*)(xb + o) = w;
            }
            ss += __shfl_xor(ss, 16); ss += __shfl_xor(ss, 32);
            if (fq == 0) atomicAdd(ssq + row, ss);
        EPI_ROWS_END
    }
};
struct EpiGate {
    static constexpr bool ALIGN = true;
    bf16_t* SA; bf16_t* SB; const float* ssq;
    __device__ __forceinline__ void operator()(AccRef acc, const Unit& u, int wr, int wc, int fr, int fq, LAS unsigned char*) const {
        bf16_t* base = (u.pn < 4 ? SA : SB) + (u.pn & 3) * 256 + wc * 32 + fq * 8;
        EPI_ROWS_BEGIN
            const int row = u.pm * 256 + rl; const float rs = rsqrtf(ssq[row] * (1.f / 1024.f) + NORM_EPS);
#pragma unroll
            for (int bj = 0; bj < 2; ++bj) { const f32x4 a0 = acc[ai][bj][m][0], a1 = acc[ai][bj][m][1];
                u32x4 w; w.x = cvt_pk_bf16(a0[0] * rs, a0[1] * rs); w.y = cvt_pk_bf16(a0[2] * rs, a0[3] * rs);
                w.z = cvt_pk_bf16(a1[0] * rs, a1[1] * rs); w.w = cvt_pk_bf16(a1[2] * rs, a1[3] * rs);
                *(u32x4*)(base + (size_t)row * DM + bj * 128) = w; }
        EPI_ROWS_END
    }
};
struct EpiMerge2 {
    static constexpr bool ALIGN = true;
    u32x4* scrM; bf16_t* MG; const bf16_t* SA; const bf16_t* SB;
    __device__ __forceinline__ void operator()(AccRef acc, const Unit& u, int wr, int wc, int fr, int fq, LAS unsigned char*) const {
        char* sM = (char*)scrM + (threadIdx.x >> 6) * 16384u + (threadIdx.x & 63) * 16u; asm volatile("" : "+v"(sM));
        const bf16_t* G = (u.tag == 1 ? SA : SB);
        EPI_ROWS_BEGIN
            const int row = u.pm * 256 + rl;
#pragma unroll
            for (int bj = 0; bj < 2; ++bj) {
                const int i = (ai * 4 + m) * 2 + bj; const f32x4 a0 = acc[ai][bj][m][0], a1 = acc[ai][bj][m][1];
                const size_t o = (size_t)row * DM + u.pn * 256 + bj * 128 + wc * 32 + fq * 8;
                const u32x4 sg = *(const u32x4*)(G + o);
                f32x4 m0 = (f32x4){fsigmoid(bflo(sg.x)) * a0[0], fsigmoid(bfhi(sg.x)) * a0[1], fsigmoid(bflo(sg.y)) * a0[2], fsigmoid(bfhi(sg.y)) * a0[3]};
                f32x4 m1 = (f32x4){fsigmoid(bflo(sg.z)) * a1[0], fsigmoid(bfhi(sg.z)) * a1[1], fsigmoid(bflo(sg.w)) * a1[2], fsigmoid(bfhi(sg.w)) * a1[3]};
                if (u.tag == 3) { const u32x4 pm_ = *(const u32x4*)(sM + i * 1024);
                    m0 = m0 + (f32x4){bflo(pm_.x), bfhi(pm_.x), bflo(pm_.y), bfhi(pm_.y)}; m1 = m1 + (f32x4){bflo(pm_.z), bfhi(pm_.z), bflo(pm_.w), bfhi(pm_.w)}; }
                u32x4 w; w.x = cvt_pk_bf16(m0[0], m0[1]); w.y = cvt_pk_bf16(m0[2], m0[3]); w.z = cvt_pk_bf16(m1[0], m1[1]); w.w = cvt_pk_bf16(m1[2], m1[3]);
                if (u.tag == 1) *(u32x4*)(sM + i * 1024) = w; else *(u32x4*)(MG + o) = w;
            }
            asm volatile("" ::: "memory");
        EPI_ROWS_END
    }
};
struct EpiResidFin {
    static constexpr bool ALIGN = true;
    float* x; bf16_t* xb; float scale;
    __device__ __forceinline__ void operator()(AccRef acc, const Unit& u, int wr, int wc, int fr, int fq, LAS unsigned char* lds) const {
        LAS float* rowss = (LAS float*)(lds + XCH_OFF);
        EPI_ROWS_BEGIN
            const int row = u.pm * 256 + rl; float ss = 0.f;
#pragma unroll
            for (int bj = 0; bj < 2; ++bj) {
                const size_t o = (size_t)row * DM + u.pn * 256 + bj * 128 + wc * 32 + fq * 8;
                const u32x4 xr = *(const u32x4*)(xb + o);
                f32x4 v0 = (f32x4){bflo(xr.x), bfhi(xr.x), bflo(xr.y), bfhi(xr.y)}, v1 = (f32x4){bflo(xr.z), bfhi(xr.z), bflo(xr.w), bfhi(xr.w)};
                v0 = v0 + acc[ai][bj][m][0] * scale; v1 = v1 + acc[ai][bj][m][1] * scale;
                { u32x4 w; w.x = cvt_pk_bf16(v0[0], v0[1]); w.y = cvt_pk_bf16(v0[2], v0[3]); w.z = cvt_pk_bf16(v1[0], v1[1]); w.w = cvt_pk_bf16(v1[2], v1[3]); *(u32x4*)(xb + o) = w; }
                ss += v0[0] * v0[0] + v0[1] * v0[1] + v0[2] * v0[2] + v0[3] * v0[3] + v1[0] * v1[0] + v1[1] * v1[1] + v1[2] * v1[2] + v1[3] * v1[3];
            }
            ss += __shfl_xor(ss, 16); ss += __shfl_xor(ss, 32);
            if (fq == 0) (void)__hip_atomic_fetch_add(rowss + rl, ss, __ATOMIC_RELAXED, __HIP_MEMORY_SCOPE_WORKGROUP);
        EPI_ROWS_END
    }
};
template <int MODE> struct EpiRowScale {
    bf16_t* O; const float* ssq; float* IFb;
    __device__ __forceinline__ void operator()(AccRef acc, const Unit& u, int wr, int wc, int fr, int fq, LAS unsigned char*) const {
        constexpr int LDO = MODE == 0 ? ZLD : DM;
        EPI_ROWS_BEGIN
            const int row = u.pm * 256 + rl; const float rs = rsqrtf(ssq[row] * (1.f / 1024.f) + NORM_EPS);
            if (MODE == 0 && u.pn == 15) {
                if (wc == 0 && fq == 0) { *(f32x4*)(IFb + (size_t)row * 8) = acc[ai][0][m][0] * rs; *(f32x4*)(IFb + (size_t)row * 8 + 4) = acc[ai][0][m][1] * rs; }
            } else {
#pragma unroll
                for (int bj = 0; bj < 2; ++bj) { const f32x4 v0 = acc[ai][bj][m][0] * rs, v1 = acc[ai][bj][m][1] * rs;
                    u32x4 w; w.x = cvt_pk_bf16(v0[0], v0[1]); w.y = cvt_pk_bf16(v0[2], v0[3]); w.z = cvt_pk_bf16(v1[0], v1[1]); w.w = cvt_pk_bf16(v1[2], v1[3]);
                    *(u32x4*)(O + (size_t)row * LDO + u.pn * 256 + bj * 128 + wc * 32 + fq * 8) = w; }
            }
        EPI_ROWS_END
    }
};
struct EpiKV {
    bf16_t* Kb; bf16_t* VT; const float* ssqm;
    __device__ __forceinline__ void operator()(AccRef acc, const Unit& u, int wr, int wc, int fr, int fq, LAS unsigned char*) const {
        EPI_ROWS_BEGIN
            const int row = u.pm * 256 + rl;
#pragma unroll
            for (int bj = 0; bj < 2; ++bj) {
                const int cl = bj * 128 + wc * 32 + fq * 8; f32x4 v0 = acc[ai][bj][m][0], v1 = acc[ai][bj][m][1]; bf16_t* dst;
                if (u.tag == 0) { const float rs = rsqrtf(ssqm[row] * (1.f / 1024.f) + NORM_EPS); v0 = v0 * rs; v1 = v1 * rs; dst = Kb + (size_t)row * DM + u.pn * 256 + cl; }
                else { const int tok = u.pn * 256 + cl; const f32x4 s0 = *(const f32x4*)(ssqm + tok), s1 = *(const f32x4*)(ssqm + tok + 4);
#pragma unroll
                    for (int j = 0; j < 4; ++j) { v0[j] *= rsqrtf(s0[j] * (1.f / 1024.f) + NORM_EPS); v1[j] *= rsqrtf(s1[j] * (1.f / 1024.f) + NORM_EPS); }
                    dst = VT + (size_t)(u.pn >> 2) * 1048576 + (size_t)row * 1024 + (u.pn & 3) * 256 + cl; }
                u32x4 w; w.x = cvt_pk_bf16(v0[0], v0[1]); w.y = cvt_pk_bf16(v0[2], v0[3]); w.z = cvt_pk_bf16(v1[0], v1[1]); w.w = cvt_pk_bf16(v1[2], v1[3]);
                *(u32x4*)dst = w;
            }
        EPI_ROWS_END
    }
};
struct EpiMerge {
    u32x4* scrS; f32x4* scrM; bf16_t* MG; const float* ssq;
    __device__ __forceinline__ void operator()(AccRef acc, const Unit& u, int wr, int wc, int fr, int fq, LAS unsigned char*) const {
        char* sS = (char*)scrS + (threadIdx.x >> 6) * 16384u + (threadIdx.x & 63) * 16u; char* sM = (char*)scrM + (threadIdx.x >> 6) * 16384u + (threadIdx.x & 63) * 16u; asm volatile("" : "+v"(sS), "+v"(sM));
        if (u.tag == 0 || u.tag == 2) {
            EPI_ROWS_BEGIN
                const int row = u.pm * 256 + rl; const float rs = rsqrtf(ssq[row] * (1.f / 1024.f) + NORM_EPS);
#pragma unroll
                for (int bj = 0; bj < 2; ++bj) {
                    const int i = (ai * 4 + m) * 2 + bj; const f32x4 a0 = acc[ai][bj][m][0], a1 = acc[ai][bj][m][1];
                    u32x4 w; w.x = cvt_pk_bf16(fsigmoid(a0[0] * rs), fsigmoid(a0[1] * rs)); w.y = cvt_pk_bf16(fsigmoid(a0[2] * rs), fsigmoid(a0[3] * rs));
                    w.z = cvt_pk_bf16(fsigmoid(a1[0] * rs), fsigmoid(a1[1] * rs)); w.w = cvt_pk_bf16(fsigmoid(a1[2] * rs), fsigmoid(a1[3] * rs));
                    *(u32x4*)(sS + i * 1024) = w;
                }
            EPI_ROWS_END
        } else if (u.tag == 1) {
            EPI_ROWS_BEGIN
#pragma unroll
                for (int bj = 0; bj < 2; ++bj) {
                    const int i = (ai * 4 + m) * 2 + bj; const f32x4 a0 = acc[ai][bj][m][0], a1 = acc[ai][bj][m][1];
                    const u32x4 sg = *(const u32x4*)(sS + i * 1024);
                    u32x4 pm_; pm_.x = cvt_pk_bf16(bflo(sg.x) * a0[0], bfhi(sg.x) * a0[1]); pm_.y = cvt_pk_bf16(bflo(sg.y) * a0[2], bfhi(sg.y) * a0[3]);
                    pm_.z = cvt_pk_bf16(bflo(sg.z) * a1[0], bfhi(sg.z) * a1[1]); pm_.w = cvt_pk_bf16(bflo(sg.w) * a1[2], bfhi(sg.w) * a1[3]);
                    *(u32x4*)(sM + i * 1024) = pm_;
                }
                asm volatile("" ::: "memory");
            EPI_ROWS_END
        } else {
            EPI_ROWS_BEGIN
                const int row = u.pm * 256 + rl;
#pragma unroll
                for (int bj = 0; bj < 2; ++bj) {
                    const int i = (ai * 4 + m) * 2 + bj; const f32x4 a0 = acc[ai][bj][m][0], a1 = acc[ai][bj][m][1];
                    const u32x4 sg = *(const u32x4*)(sS + i * 1024);
                    const u32x4 pm_ = *(const u32x4*)(sM + i * 1024);
                    f32x4 m0 = (f32x4){bflo(pm_.x), bfhi(pm_.x), bflo(pm_.y), bfhi(pm_.y)}, m1 = (f32x4){bflo(pm_.z), bfhi(pm_.z), bflo(pm_.w), bfhi(pm_.w)};
                    m0 = m0 + (f32x4){bflo(sg.x) * a0[0], bfhi(sg.x) * a0[1], bflo(sg.y) * a0[2], bfhi(sg.y) * a0[3]};
                    m1 = m1 + (f32x4){bflo(sg.z) * a1[0], bfhi(sg.z) * a1[1], bflo(sg.w) * a1[2], bfhi(sg.w) * a1[3]};
                    u32x4 w; w.x = cvt_pk_bf16(m0[0], m0[1]); w.y = cvt_pk_bf16(m0[2], m0[3]); w.z = cvt_pk_bf16(m1[0], m1[1]); w.w = cvt_pk_bf16(m1[2], m1[3]);
                    *(u32x4*)(MG + (size_t)row * DM + u.pn * 256 + bj * 128 + wc * 32 + fq * 8) = w;
                }
                asm volatile("" ::: "memory");
            EPI_ROWS_END
        }
    }
};
struct EpiAttn {
    bf16_t* Pb; bf16_t* Ob; bf16_t* Qb; const float* ssq;
    __device__ __forceinline__ void operator()(AccRef acc, const Unit& u, int wr, int wc, int fr, int fq, LAS unsigned char* lds) const {
        LAS float* xm = (LAS float*)(lds + XCH_OFF); LAS float* xs = xm + 1024;
        if (u.tag == 2) {
            EPI_ROWS_BEGIN
                const int row = u.pm * 256 + rl; const float rs = rsqrtf(ssq[row] * (1.f / 1024.f) + NORM_EPS);
#pragma unroll
                for (int bj = 0; bj < 2; ++bj) { const f32x4 v0 = acc[ai][bj][m][0] * rs, v1 = acc[ai][bj][m][1] * rs;
                    u32x4 w; w.x = cvt_pk_bf16(v0[0], v0[1]); w.y = cvt_pk_bf16(v0[2], v0[3]); w.z = cvt_pk_bf16(v1[0], v1[1]); w.w = cvt_pk_bf16(v1[2], v1[3]);
                    *(u32x4*)(Qb + (size_t)row * DM + u.pn * 256 + bj * 128 + wc * 32 + fq * 8) = w; }
            EPI_ROWS_END
            return;
        }
        if (u.tag == 1) {
            EPI_ROWS_BEGIN
                const int row = u.pm * 256 + rl;
#pragma unroll
                for (int bj = 0; bj < 2; ++bj) { const f32x4 v0 = acc[ai][bj][m][0], v1 = acc[ai][bj][m][1];
                    u32x4 w; w.x = cvt_pk_bf16(v0[0], v0[1]); w.y = cvt_pk_bf16(v0[2], v0[3]); w.z = cvt_pk_bf16(v1[0], v1[1]); w.w = cvt_pk_bf16(v1[2], v1[3]);
                    *(u32x4*)(Ob + (size_t)row * DM + u.pn * 256 + bj * 128 + wc * 32 + fq * 8) = w; }
            EPI_ROWS_END
            return;
        }
        EPI_ROWS_BEGIN
            float v = -3.0e38f;
#pragma unroll
            for (int bj = 0; bj < 2; ++bj)
#pragma unroll
                for (int n = 0; n < 2; ++n)
#pragma unroll
                    for (int j = 0; j < 4; ++j) v = fmaxf(v, acc[ai][bj][m][n][j]);
            v = fmaxf(v, __shfl_xor(v, 16)); v = fmaxf(v, __shfl_xor(v, 32));
            if (fq == 0) xm[rl * 4 + wc] = v;
        EPI_ROWS_END
        WG_BAR();
        EPI_ROWS_BEGIN
            const f32x4 q = *(const LAS f32x4*)(xm + rl * 4); const float M = fmaxf(fmaxf(q[0], q[1]), fmaxf(q[2], q[3]));
            float sum = 0.f;
#pragma unroll
            for (int bj = 0; bj < 2; ++bj)
#pragma unroll
                for (int n = 0; n < 2; ++n)
#pragma unroll
                    for (int j = 0; j < 4; ++j) sum += __expf(acc[ai][bj][m][n][j] - M);
            sum += __shfl_xor(sum, 16); sum += __shfl_xor(sum, 32);
            if (fq == 0) xs[rl * 4 + wc] = sum;
        EPI_ROWS_END
        WG_BAR();
        EPI_ROWS_BEGIN
            const int row = u.pm * 256 + rl;
            const f32x4 q = *(const LAS f32x4*)(xm + rl * 4); const float M = fmaxf(fmaxf(q[0], q[1]), fmaxf(q[2], q[3]));
            const f32x4 qs = *(const LAS f32x4*)(xs + rl * 4); const float inv = __builtin_amdgcn_rcpf((qs[0] + qs[1]) + (qs[2] + qs[3]));
#pragma unroll
            for (int bj = 0; bj < 2; ++bj) { const f32x4 a0 = acc[ai][bj][m][0], a1 = acc[ai][bj][m][1];
                u32x4 w; w.x = cvt_pk_bf16(__expf(a0[0] - M) * inv, __expf(a0[1] - M) * inv); w.y = cvt_pk_bf16(__expf(a0[2] - M) * inv, __expf(a0[3] - M) * inv);
                w.z = cvt_pk_bf16(__expf(a1[0] - M) * inv, __expf(a1[1] - M) * inv); w.w = cvt_pk_bf16(__expf(a1[2] - M) * inv, __expf(a1[3] - M) * inv);
                *(u32x4*)(Pb + (size_t)row * DM + u.pn * 256 + bj * 128 + wc * 32 + fq * 8) = w; }
            asm volatile("" ::: "memory");
        EPI_ROWS_END
        WG_BAR();
    }
};

struct TJob { const float* src; const float* gain; bf16_t* dst; int K, ldsrc, col0, ncols, dst_ld, dst_row0, dst_k0, mode; float scale; int item0; };
struct Params { const float* in[37]; float* out; unsigned char* ws; TJob jobs[20]; int njobs, nitems, ph_lo, ph_hi, coop, nearly; };

__device__ __forceinline__ void transpose_item(const TJob& J, int item, LAS float* scr, int lane) {
    const int nblk = (J.ncols + 63) >> 6, kb = item / nblk, nb = item - kb * nblk, k0 = 64 * kb, n0 = 64 * nb;
    const int nq = (lane & 15) * 4; const bool nok = (n0 + nq) < J.ncols;
#pragma unroll
    for (int i = 0; i < 16; ++i) { const int kk = 4 * i + (lane >> 4);
        f32x4 v = (f32x4){0.f, 0.f, 0.f, 0.f};
        if (nok) { v = *(const f32x4*)(J.src + (size_t)(k0 + kk) * J.ldsrc + J.col0 + n0 + nq); float sc = J.scale; if (J.gain) sc *= J.gain[k0 + kk]; v = v * sc; }
        *(LAS f32x4*)(scr + kk * 64 + (nq ^ ((kk >> 3) << 3))) = v; }
    LDS_WAIT();
    const int c = lane & 7;
#pragma unroll
    for (int j = 0; j < 8; ++j) { const int nl = (lane >> 3) + 8 * j, n = n0 + nl; const LAS float* sp = scr + (8 * c) * 64 + (nl ^ (c << 3));
        if (n < J.ncols) { u32x4 o; o.x = cvt_pk_bf16(sp[0], sp[64]); o.y = cvt_pk_bf16(sp[128], sp[192]); o.z = cvt_pk_bf16(sp[256], sp[320]); o.w = cvt_pk_bf16(sp[384], sp[448]);
            const int dr = (J.mode ? ((n >> 7) * 256 + (n & 127)) : n) + J.dst_row0;
            *(u32x4*)(J.dst + (size_t)dr * J.dst_ld + J.dst_k0 + k0 + 8 * c) = o; } }
    LDS_WAIT();
}
__device__ __forceinline__ void row_to_bf16_ssq(const float* xrow, bf16_t* orow, float* ssq, int lane) {
    const f32x4* xr = (const f32x4*)xrow + lane; f32x4 v[4]; float s = 0.f;
#pragma unroll
    for (int j = 0; j < 4; ++j) { v[j] = xr[64 * j]; s += (v[j].x * v[j].x + v[j].y * v[j].y) + (v[j].z * v[j].z + v[j].w * v[j].w); }
    s = wave_sum(s); if (lane == 0) *ssq = s;
    u32x2* o8 = (u32x2*)orow + lane;
#pragma unroll
    for (int j = 0; j < 4; ++j) { u32x2 w; w.x = cvt_pk_bf16(v[j].x, v[j].y); w.y = cvt_pk_bf16(v[j].z, v[j].w); o8[64 * j] = w; }
}
__device__ __forceinline__ void rows4_to_bf16_ssq(const float* xrow, bf16_t* orow, float* ssq, int lane) {
    f32x4 v[4][4]; float s[4];
#pragma unroll
    for (int r = 0; r < 4; ++r)
#pragma unroll
        for (int j = 0; j < 4; ++j) v[r][j] = ((const f32x4*)(xrow + (size_t)r * DM) + lane)[64 * j];
#pragma unroll
    for (int r = 0; r < 4; ++r) { s[r] = 0.f;
#pragma unroll
        for (int j = 0; j < 4; ++j) s[r] += (v[r][j].x * v[r][j].x + v[r][j].y * v[r][j].y) + (v[r][j].z * v[r][j].z + v[r][j].w * v[r][j].w); }
#pragma unroll
    for (int o = 1; o < 64; o <<= 1) {
#pragma unroll
        for (int r = 0; r < 4; ++r) s[r] += __shfl_xor(s[r], o); }
    if (lane < 4) ssq[lane] = lane == 0 ? s[0] : (lane == 1 ? s[1] : (lane == 2 ? s[2] : s[3]));
#pragma unroll
    for (int r = 0; r < 4; ++r) { u32x2* o8 = (u32x2*)(orow + (size_t)r * DM) + lane;
#pragma unroll
        for (int j = 0; j < 4; ++j) { u32x2 w; w.x = cvt_pk_bf16(v[r][j].x, v[r][j].y); w.y = cvt_pk_bf16(v[r][j].z, v[r][j].w); o8[64 * j] = w; } }
}
__device__ __forceinline__ void phase_prep(const Params& P, LAS unsigned char* lds) {
    const int tid = threadIdx.x, lane = tid & 63, wave = tid >> 6; unsigned char* ws = P.ws;
    const int gw = blockIdx.x * 8 + wave, NGW = gridDim.x * 8;
    LAS float* scr = (LAS float*)(lds + wave * 16384);
    for (int it = gw; it < P.nearly; it += NGW) {
        int j = 0;
        while (j + 1 < P.njobs && it >= P.jobs[j + 1].item0) ++j;
        transpose_item(P.jobs[j], it - P.jobs[j].item0, scr, lane);
    }
    for (int m = gw * 4; m < NTOK; m += NGW * 4) rows4_to_bf16_ssq(P.in[0] + (size_t)m * DM, (bf16_t*)(ws + OFF_XB) + (size_t)m * DM, (float*)(ws + OFF_SSQ0) + m, lane);
    for (int m = gw * 4; m < MEMTOK; m += NGW * 4) rows4_to_bf16_ssq(P.in[1] + (size_t)m * DM, (bf16_t*)(ws + OFF_MEMB) + (size_t)m * DM, (float*)(ws + OFF_SSQM) + m, lane);
    const int gt = blockIdx.x * 512 + tid, NGT = gridDim.x * 512;
    for (int i = gt; i < 4 * NTOK; i += NGT) ((float*)(ws + OFF_SSQ1))[i] = 0.f;
    for (int i = gt; i < (int)(512 * 1024 / 16); i += NGT) ((u32x4*)(ws + OFF_FNG))[i] = (u32x4){0u, 0u, 0u, 0u};
    for (int i = gt; i < (int)(8 * MiB / 16); i += NGT) ((u32x4*)(ws + OFF_STATS))[i] = (u32x4){0u, 0u, 0u, 0u};
    for (int i = gt; i < 248 * 1024 / 8; i += NGT) ((u32x4*)(ws + OFF_WIN + (size_t)3848 * 2048))[i] = (u32x4){0u, 0u, 0u, 0u};
}

#define RLX_AGENT __ATOMIC_RELAXED, __HIP_MEMORY_SCOPE_AGENT
__device__ __forceinline__ float red16(float x) {
    x += dpp_f<0xB1>(x); x += dpp_f<0x4E>(x); x += dpp_f<0x141>(x); x += dpp_f<0x140>(x); return x;
}
#define RWA_COL(ty_, cv_, h_, rg_) ((ty_) == 0 ? 1664 + (cv_) * 8 : ((ty_) == 1 ? 1536 + (cv_) * 8 : ((ty_) == 2 ? 1600 + (cv_) * 8 : ((ty_) == 3 ? (h_) * 64 + (cv_) * 8 : ((ty_) == 4 ? 512 + (h_) * 64 + (cv_) * 8 : 1024 + (h_) * 64 + (rg_) * 32 + (cv_) * 8)))))
#define RWA_MAP(p_, lane_, h_, rg_) \
    int ty0, ty1, cv0, cv1, tq0, tq1; bool act0 = true, act1 = true; \
    if ((p_) == 0) { ty0 = 0; cv0 = (lane_) & 7; ty1 = 3; cv1 = (lane_) & 7; tq0 = tq1 = (lane_) >> 3; } \
    else if ((p_) == 1) { ty0 = 0; cv0 = 8 + ((lane_) & 7); ty1 = 4; cv1 = (lane_) & 7; tq0 = tq1 = (lane_) >> 3; } \
    else if ((p_) == 2) { ty0 = 1; cv0 = (lane_) & 7; ty1 = 2; cv1 = (lane_) & 7; tq0 = tq1 = (lane_) >> 3; } \
    else { ty0 = 5; cv0 = (lane_) & 3; tq0 = ((lane_) >> 2) & 7; act0 = (lane_) < 32; ty1 = 5; cv1 = 0; tq1 = 0; act1 = false; } \
    const int col0 = RWA_COL(ty0, cv0, h_, rg_), col1 = RWA_COL(ty1, cv1, h_, rg_);
__device__ __forceinline__ void rwkv_item(const Params& P, LAS unsigned char* lds, int item) {
    const int bh = item >> 1, rg = item & 1, b = bh >> 3, h = bh & 7; unsigned char* ws = P.ws;
    const bf16_t* Z = (const bf16_t*)(ws + OFF_Z); bf16_t* Yb = (bf16_t*)(ws + OFF_Y);
    unsigned long long* gran = (unsigned long long*)(ws + OFF_STATS);
    const float* mu = P.in[8]; const float* w0 = P.in[9]; const float* a0 = P.in[11]; const float* k_k = P.in[14]; const float* k_a = P.in[15]; const float* r_k = P.in[16];
    const float* gn_w = P.in[17]; const float* gn_b = P.in[18];
#define OPS_RR(s_) ((LAS float*)(lds + (s_) * 40960))
#define OPS_WW(s_) ((LAS float*)(lds + (s_) * 40960 + 8192))
#define OPS_BV(s_) ((LAS float*)(lds + (s_) * 40960 + 16384))
#define OPS_KM(s_) ((LAS float*)(lds + (s_) * 40960 + 24576))
#define OPS_KK(s_) ((LAS float*)(lds + (s_) * 40960 + 32768))
    LAS bf16_t* AW = (LAS bf16_t*)(lds + 81920); LAS bf16_t* AA = (LAS bf16_t*)(lds + 86528); LAS bf16_t* AG = (LAS bf16_t*)(lds + 91136);
    LAS float* KS = (LAS float*)(lds + 99840); LAS float* Aa = (LAS float*)(lds + 108032);
#define VV(s_) ((LAS float*)(lds + 116224 + (s_) * 4096))
#define YY(j_) ((LAS float*)(lds + 124416 + (j_) * 4096))
    LAS float* Gt = (LAS float*)(lds + 140800);
#define Q1B(j_) ((LAS bf16_t*)(lds + 144896 + (j_) * 2048))
#define Q2B(j_) ((LAS bf16_t*)(lds + 153088 + (j_) * 2048))
    LAS float* PRM = (LAS float*)(lds + 161280);
    LAS unsigned* GB = (LAS unsigned*)(lds + 162816);
    {
        const int tid = threadIdx.x;
        if (tid < 64) { PRM[tid] = k_k[h * 64 + tid]; PRM[64 + tid] = k_a[h * 64 + tid]; PRM[128 + tid] = r_k[h * 64 + tid]; PRM[192 + tid] = w0[h * 64 + tid]; PRM[256 + tid] = a0[h * 64 + tid]; }
        if (tid < 32) { PRM[320 + tid] = gn_w[h * 64 + rg * 32 + tid]; PRM[352 + tid] = gn_b[h * 64 + rg * 32 + tid]; }
        if (tid == 0) GB[0] = 0u;
    }
    bf16x8 bw[2][2], ba[2][2], bg[4];
    {
        const int lane = threadIdx.x & 63, fr = lane & 15, fq = lane >> 4, p = (threadIdx.x >> 6) & 3, kp = p >> 1;
#pragma unroll
        for (int q = 0; q < 2; ++q) { const int ch = h * 64 + (2 * kp + q) * 16 + fr;
#pragma unroll
            for (int ks = 0; ks < 2; ++ks) { bw[q][ks] = *(const bf16x8*)((const bf16_t*)(ws + OFF_W2T) + (size_t)ch * 64 + ks * 32 + fq * 8); ba[q][ks] = *(const bf16x8*)((const bf16_t*)(ws + OFF_A2T) + (size_t)ch * 64 + ks * 32 + fq * 8); } }
#pragma unroll
        for (int ks = 0; ks < 4; ++ks) bg[ks] = *(const bf16x8*)((const bf16_t*)(ws + OFF_G2T) + (size_t)(h * 64 + rg * 32 + kp * 16 + fr) * 128 + ks * 32 + fq * 8);
    }
    f32x2 S2[4] = {{0.f, 0.f}, {0.f, 0.f}, {0.f, 0.f}, {0.f, 0.f}};
    float muA[8], muB[8]; u32x4 pzA[4], pzB[4], ppA, ppB; unsigned gbgen = 0u; float ps1 = 0.f, ps2 = 0.f;
    {
        RWA_MAP(((int)(threadIdx.x >> 6)) & 3, (int)(threadIdx.x & 63), h, rg)
        (void)act0; (void)act1; (void)tq0; (void)tq1;
        const f32x4 m0 = *(const f32x4*)(mu + col0), m1 = *(const f32x4*)(mu + col0 + 4), n0 = *(const f32x4*)(mu + col1), n1 = *(const f32x4*)(mu + col1 + 4);
#pragma unroll
        for (int j = 0; j < 4; ++j) { muA[j] = m0[j]; muA[4 + j] = m1[j]; muB[j] = n0[j]; muB[4 + j] = n1[j]; }
    }
#define RW_PF1(cn, pz_, pp_, act_, tq_, col_) do { pp_ = (u32x4){0u, 0u, 0u, 0u}; _Pragma("unroll") for (int i_ = 0; i_ < 4; ++i_) pz_[i_] = pp_; \
        if (act_) { const size_t tok = (size_t)b * SEQ + (cn) * 32 + (tq_) * 4; if ((cn) * 32 + (tq_) * 4 > 0) pp_ = *(const u32x4*)(Z + (tok - 1) * ZLD + (col_)); \
            _Pragma("unroll") for (int i_ = 0; i_ < 4; ++i_) pz_[i_] = *(const u32x4*)(Z + (tok + i_) * ZLD + (col_)); } } while (0)
#define RW_PREFETCH(cn) do { RW_PF1(cn, pzA, ppA, act0, tq0, col0); RW_PF1(cn, pzB, ppB, act1, tq1, col1); } while (0)
#define GRP_BAR() do { asm volatile("s_waitcnt lgkmcnt(0)" ::: "memory"); gbgen += 1u; if (lane == 0) (void)__hip_atomic_fetch_add(GB, 1u, __ATOMIC_RELAXED, __HIP_MEMORY_SCOPE_WORKGROUP); \
        { unsigned sp_ = 0; while (__hip_atomic_load(GB, __ATOMIC_RELAXED, __HIP_MEMORY_SCOPE_WORKGROUP) < gbgen * 4u) { if (++sp_ > (1u << 24)) break; } } asm volatile("" ::: "memory"); } while (0)
    {
        RWA_MAP(((int)(threadIdx.x >> 6)) & 3, (int)(threadIdx.x & 63), h, rg)
        act0 = act0 && threadIdx.x >= 256; act1 = act1 && threadIdx.x >= 256;
        RW_PREFETCH(0);
    }
    WG_BAR();
#pragma unroll 1
    for (int it = 0; it < 131; ++it) {
        int tl_ = threadIdx.x; asm volatile("" : "+v"(tl_));
        const int tid = tl_, lane = tid & 63, wave = __builtin_amdgcn_readfirstlane(tid >> 6), fr = lane & 15, fq = lane >> 4;
        if (wave >= 4) {
            unsigned long long g0 = 0ull, g1 = 0ull;
            if (wave == 7 && it >= 3) {
                const unsigned long long* gb3 = gran + (((size_t)bh * 128 + (it - 3)) * 2) * 64 + (lane & 31) * 2 + (rg ^ 1) * 64;
                g0 = __hip_atomic_load(gb3, RLX_AGENT); g1 = __hip_atomic_load(gb3 + 1, RLX_AGENT);
            }
            if (it < 128) {
                const int c = it, os = c & 1, qj = c & 3;
                const int tidp = tid - 256, p = wave - 4, tt = p & 1, kp = p >> 1;
                RWA_MAP(p, lane, h, rg)
                LAS float* Rr = OPS_RR(os); LAS float* Ww = OPS_WW(os); LAS float* Bv = OPS_BV(os); LAS float* KM = OPS_KM(os); LAS float* KK = OPS_KK(os); LAS float* Vv = VV(os);
#define RWA_SEG(pz_, pp_, mu_, act_, ty_, cv_, tq_) do { if (act_) { _Pragma("unroll") for (int i = 0; i < 4; ++i) { \
                    const int t = (tq_) * 4 + i; const u32x4 zc = pz_[i], zp = (i == 0) ? pp_ : pz_[i > 0 ? i - 1 : 0]; \
                    float z[8]; const float c8[8] = {bflo(zc.x), bfhi(zc.x), bflo(zc.y), bfhi(zc.y), bflo(zc.z), bfhi(zc.z), bflo(zc.w), bfhi(zc.w)}; \
                    const float p8[8] = {bflo(zp.x), bfhi(zp.x), bflo(zp.y), bfhi(zp.y), bflo(zp.z), bfhi(zp.z), bflo(zp.w), bfhi(zp.w)}; \
                    _Pragma("unroll") for (int j = 0; j < 8; ++j) z[j] = c8[j] + (p8[j] - c8[j]) * mu_[j]; \
                    if ((ty_) >= 3) { LAS float* dst = (ty_) == 3 ? Rr + t * 64 + (cv_) * 8 : ((ty_) == 4 ? KS + t * 64 + (cv_) * 8 : Vv + t * 32 + (cv_) * 8); \
                        *(LAS f32x4*)dst = (f32x4){z[0], z[1], z[2], z[3]}; *(LAS f32x4*)(dst + 4) = (f32x4){z[4], z[5], z[6], z[7]}; } \
                    else { LAS bf16_t* dst; \
                        if ((ty_) == 1) { dst = AW + t * 72 + (cv_) * 8; _Pragma("unroll") for (int j = 0; j < 8; ++j) z[j] = 1.f - 2.f * __builtin_amdgcn_rcpf(__expf(2.f * z[j]) + 1.f); } \
                        else if ((ty_) == 2) dst = AA + t * 72 + (cv_) * 8; \
                        else { dst = AG + t * 136 + (cv_) * 8; _Pragma("unroll") for (int j = 0; j < 8; ++j) z[j] = fsigmoid(z[j]); } \
                        u32x4 w; w.x = cvt_pk_bf16(z[0], z[1]); w.y = cvt_pk_bf16(z[2], z[3]); w.z = cvt_pk_bf16(z[4], z[5]); w.w = cvt_pk_bf16(z[6], z[7]); \
                        *(LAS u32x4*)dst = w; } } } } while (0)
                RWA_SEG(pzA, ppA, muA, act0, ty0, cv0, tq0);
                RWA_SEG(pzB, ppB, muB, act1, ty1, cv1, tq1);
#undef RWA_SEG
                if (c < 127) RW_PREFETCH(c + 1);
                GRP_BAR();
                {
                    bf16x8 aw[2], aa[2];
#pragma unroll
                    for (int ks = 0; ks < 2; ++ks) { aw[ks] = *(const LAS bf16x8*)(AW + (tt * 16 + fr) * 72 + ks * 32 + fq * 8); aa[ks] = *(const LAS bf16x8*)(AA + (tt * 16 + fr) * 72 + ks * 32 + fq * 8); }
                    const int t = tt * 16 + fr;
#pragma unroll
                    for (int q = 0; q < 2; ++q) {
                        f32x4 cw = (f32x4){0.f, 0.f, 0.f, 0.f}, ca = cw;
#pragma unroll
                        for (int ks = 0; ks < 2; ++ks) { cw = __builtin_amdgcn_mfma_f32_16x16x32_bf16(bw[q][ks], aw[ks], cw, 0, 0, 0); ca = __builtin_amdgcn_mfma_f32_16x16x32_bf16(ba[q][ks], aa[ks], ca, 0, 0, 0); }
                        const int kl = (2 * kp + q) * 16 + fq * 4;
                        const f32x4 w0v = *(const LAS f32x4*)(PRM + 192 + kl), a0v = *(const LAS f32x4*)(PRM + 256 + kl);
                        f32x4 dw, av;
#pragma unroll
                        for (int j = 0; j < 4; ++j) { dw[j] = __expf(-0.6065306597f * fsigmoid(w0v[j] + cw[j])); av[j] = fsigmoid(a0v[j] + ca[j]); }
                        *(LAS f32x4*)(Ww + t * 64 + kl) = dw; *(LAS f32x4*)(Aa + t * 64 + kl) = av;
                    }
                    f32x4 cg_ = (f32x4){0.f, 0.f, 0.f, 0.f};
#pragma unroll
                    for (int ks = 0; ks < 4; ++ks) { const bf16x8 ag = *(const LAS bf16x8*)(AG + (tt * 16 + fr) * 136 + ks * 32 + fq * 8); cg_ = __builtin_amdgcn_mfma_f32_16x16x32_bf16(bg[ks], ag, cg_, 0, 0, 0); }
                    *(LAS f32x4*)(Gt + t * 32 + kp * 16 + fq * 4) = cg_;
                }
                GRP_BAR();
                {
                    const int t = tidp >> 3, k8 = tidp & 7, k0 = k8 * 8;
                    float ks8[8], a8[8], r8[8], kk8[8], km8[8], pk[8], pa[8], pr[8]; float n2 = 0.f, bon = 0.f;
#pragma unroll
                    for (int i = 0; i < 2; ++i) { const f32x4 x0 = *(const LAS f32x4*)(KS + t * 64 + k0 + 4 * i), x1 = *(const LAS f32x4*)(Aa + t * 64 + k0 + 4 * i), x2 = *(const LAS f32x4*)(Rr + t * 64 + k0 + 4 * i);
                        const f32x4 y0 = *(const LAS f32x4*)(PRM + k0 + 4 * i), y1 = *(const LAS f32x4*)(PRM + 64 + k0 + 4 * i), y2 = *(const LAS f32x4*)(PRM + 128 + k0 + 4 * i);
#pragma unroll
                        for (int j = 0; j < 4; ++j) { ks8[4 * i + j] = x0[j]; a8[4 * i + j] = x1[j]; r8[4 * i + j] = x2[j]; pk[4 * i + j] = y0[j]; pa[4 * i + j] = y1[j]; pr[4 * i + j] = y2[j]; } }
#pragma unroll
                    for (int i = 0; i < 8; ++i) { kk8[i] = ks8[i] * pk[i]; n2 += kk8[i] * kk8[i]; km8[i] = ks8[i] * (1.f + (a8[i] - 1.f) * pa[i]); bon += r8[i] * km8[i] * pr[i]; }
                    n2 = red8(n2); bon = red8(bon);
                    const float inv = 1.f / fmaxf(sqrtf(n2), 1e-12f);
                    f32x4 o0[2], o1[2], o2[2];
#pragma unroll
                    for (int i = 0; i < 8; ++i) { const float kn = kk8[i] * inv; o0[i >> 2][i & 3] = -kn; o1[i >> 2][i & 3] = km8[i]; o2[i >> 2][i & 3] = kn * a8[i]; }
#pragma unroll
                    for (int i = 0; i < 2; ++i) { *(LAS f32x4*)(KK + t * 64 + k0 + 4 * i) = o0[i]; *(LAS f32x4*)(KM + t * 64 + k0 + 4 * i) = o1[i]; *(LAS f32x4*)(Bv + t * 64 + k0 + 4 * i) = o2[i]; }
                    const int r4 = k8 * 4;
                    const f32x4 g4 = *(const LAS f32x4*)(Gt + t * 32 + r4), v4 = *(const LAS f32x4*)(Vv + t * 32 + r4), gw4 = *(const LAS f32x4*)(PRM + 320 + r4), gb4 = *(const LAS f32x4*)(PRM + 352 + r4);
                    u32x2 q1, q2;
                    q1.x = cvt_pk_bf16(g4[0] * gw4[0], g4[1] * gw4[1]); q1.y = cvt_pk_bf16(g4[2] * gw4[2], g4[3] * gw4[3]);
                    q2.x = cvt_pk_bf16(g4[0] * (gb4[0] + bon * v4[0]), g4[1] * (gb4[1] + bon * v4[1])); q2.y = cvt_pk_bf16(g4[2] * (gb4[2] + bon * v4[2]), g4[3] * (gb4[3] + bon * v4[3]));
                    *(LAS u32x2*)(Q1B(qj) + t * 32 + r4) = q1; *(LAS u32x2*)(Q2B(qj) + t * 32 + r4) = q2;
                }
            }
            if (wave == 7 && it >= 2) {
                const int t = lane & 31;
                float ns1 = 0.f, ns2 = 0.f;
                if (it <= 129) {
                    const int c = it - 2, yj = c & 3;
#pragma unroll
                    for (int i = 0; i < 8; ++i) { const f32x4 y = *(const LAS f32x4*)(YY(yj) + t * 32 + 4 * i); ns1 += (y[0] + y[1]) + (y[2] + y[3]); ns2 += (y[0] * y[0] + y[1] * y[1]) + (y[2] * y[2] + y[3] * y[3]); }
                    const unsigned long long ep = (unsigned long long)(unsigned)(c + 1) << 32;
                    unsigned long long* gbase = gran + (((size_t)bh * 128 + c) * 2) * 64 + t * 2;
                    if (lane < 32) { __hip_atomic_store(gbase + rg * 64, ep | __builtin_bit_cast(unsigned, ns1), RLX_AGENT); __hip_atomic_store(gbase + rg * 64 + 1, ep | __builtin_bit_cast(unsigned, ns2), RLX_AGENT); }
                }
                if (it >= 3) {
                    const int c = it - 3, yj = c & 3;
                    unsigned long long* gb3 = gran + (((size_t)bh * 128 + c) * 2) * 64 + t * 2 + (rg ^ 1) * 64;
                    unsigned spins = 0;
                    for (;;) {
                        const bool ok = ((g0 >> 32) == (unsigned long long)(unsigned)(c + 1)) && ((g1 >> 32) == (unsigned long long)(unsigned)(c + 1));
                        if (__all(ok)) break;
                        __builtin_amdgcn_s_sleep(2); if (++spins > (1u << 20)) break;
                        g0 = __hip_atomic_load(gb3, RLX_AGENT); g1 = __hip_atomic_load(gb3 + 1, RLX_AGENT);
                    }
                    const float s1 = ps1 + __builtin_bit_cast(float, (unsigned)g0), s2 = ps2 + __builtin_bit_cast(float, (unsigned)g1);
                    const float mean = s1 * (1.f / 64.f), var = fmaxf(s2 * (1.f / 64.f) - mean * mean, 0.f), rstd = rsqrtf(var + 64e-5f);
                    if (lane < 32) {
                        bf16_t* dst = Yb + ((size_t)b * SEQ + c * 32 + t) * DM + h * 64 + rg * 32;
#pragma unroll
                        for (int i = 0; i < 4; ++i) {
                            const f32x4 ya = *(const LAS f32x4*)(YY(yj) + t * 32 + 8 * i), yb = *(const LAS f32x4*)(YY(yj) + t * 32 + 8 * i + 4);
                            const u32x4 q1 = *(const LAS u32x4*)(Q1B(yj) + t * 32 + 8 * i), q2 = *(const LAS u32x4*)(Q2B(yj) + t * 32 + 8 * i);
                            u32x4 w;
                            w.x = cvt_pk_bf16((ya[0] - mean) * rstd * bflo(q1.x) + bflo(q2.x), (ya[1] - mean) * rstd * bfhi(q1.x) + bfhi(q2.x));
                            w.y = cvt_pk_bf16((ya[2] - mean) * rstd * bflo(q1.y) + bflo(q2.y), (ya[3] - mean) * rstd * bfhi(q1.y) + bfhi(q2.y));
                            w.z = cvt_pk_bf16((yb[0] - mean) * rstd * bflo(q1.z) + bflo(q2.z), (yb[1] - mean) * rstd * bfhi(q1.z) + bfhi(q2.z));
                            w.w = cvt_pk_bf16((yb[2] - mean) * rstd * bflo(q1.w) + bflo(q2.w), (yb[3] - mean) * rstd * bfhi(q1.w) + bfhi(q2.w));
                            *(u32x4*)(dst + 8 * i) = w;
                        }
                    }
                }
                ps1 = ns1; ps2 = ns2;
            }
        } else if (it >= 1 && it <= 128) {
            const int c = it - 1, os = c & 1, yj = c & 3, grp = tid >> 4, kq = tid & 15;
            LAS const unsigned char* ob = (LAS const unsigned char*)OPS_RR(os) + kq * 16;
            LAS const unsigned char* vp = (LAS const unsigned char*)VV(os) + grp * 8; LAS unsigned char* yp = (LAS unsigned char*)YY(yj) + grp * 8;
            f32x4 wA, bA, mA, kA, rA, wB, bB, mB, kB, rB; f32x2 vA, vB;
#define RW_LD(X, d) do { r##X = *(const LAS f32x4*)(ob + (d) * 256); w##X = *(const LAS f32x4*)(ob + (d) * 256 + 8192); b##X = *(const LAS f32x4*)(ob + (d) * 256 + 16384); m##X = *(const LAS f32x4*)(ob + (d) * 256 + 24576); \
                k##X = *(const LAS f32x4*)(ob + (d) * 256 + 32768); v##X = *(const LAS f32x2*)(vp + (d) * 128); } while (0)
#define RW_LVL(a_, b_, C) do { a_ += dpp_f<C>(a_); b_ += dpp_f<C>(b_); asm volatile("" : "+v"(a_), "+v"(b_)); } while (0)
#define RW_RED2(x) do { float a_ = x[0], b_ = x[1]; RW_LVL(a_, b_, 0xB1); RW_LVL(a_, b_, 0x4E); RW_LVL(a_, b_, 0x141); RW_LVL(a_, b_, 0x140); x = (f32x2){a_, b_}; } while (0)
#define RW_STEP(X, t) do { f32x2 sa = S2[0] * k##X[0]; sa = S2[1] * k##X[1] + sa; sa = S2[2] * k##X[2] + sa; sa = S2[3] * k##X[3] + sa; RW_RED2(sa); \
                _Pragma("unroll") for (int i = 0; i < 4; ++i) S2[i] = S2[i] * w##X[i] + (sa * b##X[i] + v##X * m##X[i]); \
                f32x2 y = S2[0] * r##X[0]; y = S2[1] * r##X[1] + y; y = S2[2] * r##X[2] + y; y = S2[3] * r##X[3] + y; RW_RED2(y); \
                if (kq == 0) *(LAS f32x2*)(yp + (t) * 128) = y; } while (0)
            RW_LD(A, 0);
#pragma unroll 1
            for (int t = 0; t < 32; t += 2) {
                RW_LD(B, 1); __builtin_amdgcn_sched_barrier(0);
                RW_STEP(A, 0); __builtin_amdgcn_sched_barrier(0);
                if (t == 30) { ob -= 30 * 256; vp -= 30 * 128; }
                RW_LD(A, 2); __builtin_amdgcn_sched_barrier(0);
                RW_STEP(B, 1); __builtin_amdgcn_sched_barrier(0);
                ob += 512; vp += 256; yp += 256;
            }
#undef RW_LD
#undef RW_STEP
#undef RW_RED2
#undef RW_LVL
        }
        WG_BAR();
    }
#undef RW_PREFETCH
#undef RW_PF1
#undef GRP_BAR
#undef OPS_RR
#undef OPS_WW
#undef OPS_BV
#undef OPS_KM
#undef OPS_KK
#undef VV
#undef YY
#undef Q1B
#undef Q2B
}

#define TRI(r, t) ((r) * 72 + (((((t) >> 3) ^ (((r) >> 3) & 7))) << 3) + ((t) & 7))
#define TRB(r, blk) ((r) * 72 + (((blk) ^ (((r) >> 3) & 7)) << 3))
__device__ __forceinline__ void mlstm_item(const Params& P, LAS unsigned char* lds, int bh) {
    const int tid = threadIdx.x, lane = tid & 63, wave = tid >> 6, fr = lane & 15, fq = lane >> 4;
    const int b = bh >> 2, h = bh & 3; unsigned char* ws = P.ws;
    const bf16_t* Z = (const bf16_t*)(ws + OFF_Z); bf16_t* Yb = (bf16_t*)(ws + OFF_Y); const float* IFb = (const float*)(ws + OFF_IF);
    const float* cw = P.in[19]; const float* cb = P.in[20]; const float ib = P.in[21][h], fb = P.in[22][h]; const float* mln = P.in[23];
    LAS bf16_t* Qs = (LAS bf16_t*)(lds); LAS bf16_t* Ks = (LAS bf16_t*)(lds + 17408); LAS bf16_t* KT = (LAS bf16_t*)(lds + 34816); LAS bf16_t* VT = (LAS bf16_t*)(lds + 53248);
    LAS bf16_t* VwT = (LAS bf16_t*)(lds + 71680); LAS bf16_t* Pp = (LAS bf16_t*)(lds + 90112); LAS bf16_t* Cb = (LAS bf16_t*)(lds + 99328);
    LAS float* F = (LAS float*)(lds + 134144);
    LAS float* ga = F, *gu = F + 64, *gwl = F + 128, *gwi = F + 192, *gei = F + 256, *dn = F + 320, *nq = F + 384, *lnx = F + 448  , *ns = F + 704  , *sc = F + 832;
    LAS float* CWL = (LAS float*)(lds + 138240);
    LAS float* CBL = CWL + 1024; LAS float* MLN = CWL + 1280;
    for (int i = tid; i < 1024; i += 512) { const int j = i >> 8, cc = i & 255; CWL[i] = cw[j * 1024 + (cc < 128 ? h * 128 + cc : 512 + h * 128 + cc - 128)]; }
    if (tid < 256) CBL[tid] = cb[tid < 128 ? h * 128 + tid : 512 + h * 128 + tid - 128];
    if (tid < 128) MLN[tid] = mln[h * 128 + tid];
    f32x4 Cacc[8];
#pragma unroll
    for (int i = 0; i < 8; ++i) Cacc[i] = (f32x4){0.f, 0.f, 0.f, 0.f};
    const int pcv = tid & 31, ptg = tid >> 5; const bool pisk = pcv >= 16; const int pc8 = (pcv & 15) * 8;
    const int pzcol = (pisk ? 2304 : 1792) + h * 128 + pc8;
    u32x4 rw[7], vx[2]; u32x2 ogp[4]; float pfb = 0.f, pfu = 0.f, pfp = 0.f, pfe = 0.f, pfm = 0.f;
#define ML_PF_QKV(cn) do { _Pragma("unroll") for (int d = 0; d < 7; ++d) { const int tl = (cn) * 64 + ptg * 4 - 3 + d; rw[d] = (u32x4){0u, 0u, 0u, 0u}; if (tl >= 0) rw[d] = *(const u32x4*)(Z + ((size_t)b * SEQ + tl) * ZLD + pzcol); } \
        _Pragma("unroll") for (int rep = 0; rep < 2; ++rep) { const int v = tid + rep * 512; vx[rep] = *(const u32x4*)(Z + ((size_t)b * SEQ + (cn) * 64 + (v >> 4)) * ZLD + 2816 + h * 128 + (v & 15) * 8); } } while (0)
#define ML_PF_IF(cn) do { if (wave == 0) { pfb = GS[(cn) * 64 + lane]; pfu = GS[4096 + (cn) * 64 + lane]; pfp = GS[8192 + (cn) * 64 + lane]; pfe = GS[12288 + (cn)]; pfm = GS[12352 + (cn)]; } } while (0)
#define ML_PF_OG(cn) do { _Pragma("unroll") for (int q = 0; q < 4; ++q) ogp[q] = *(const u32x2*)(Z + ((size_t)b * SEQ + (cn) * 64 + (wave & 3) * 16 + fr) * ZLD + 3328 + h * 128 + ((wave >> 2) * 4 + q) * 16 + fq * 4); } while (0)
    float* GS = (float*)(ws + OFF_GATES) + (size_t)bh * 12416;
    for (int cc = wave; cc < 64; cc += 8) {
        const size_t tk = (size_t)b * SEQ + cc * 64 + lane;
        const float ig = IFb[tk * 8 + h] + ib, fg = IFb[tk * 8 + 4 + h] + fb;
        const float lf = fminf(fg, 0.f) - __logf(1.f + __expf(-fabsf(fg)));
        float bc = lf;
#pragma unroll
        for (int o = 1; o < 64; o <<= 1) { const float t = __shfl_up(bc, o); if (lane >= o) bc += t; }
        const float bend = __shfl(bc, 63), u = ig - bc;
        float mc = bend + u;
#pragma unroll
        for (int o = 1; o < 64; o <<= 1) mc = fmaxf(mc, __shfl_xor(mc, o));
        float pm = u;
#pragma unroll
        for (int o = 1; o < 64; o <<= 1) { const float t = __shfl_up(pm, o); if (lane >= o) pm = fmaxf(pm, t); }
        GS[cc * 64 + lane] = bc; GS[4096 + cc * 64 + lane] = u; GS[8192 + cc * 64 + lane] = pm;
        if (lane == 0) { GS[12288 + cc] = bend; GS[12352 + cc] = mc; }
    }
    WG_BAR_ALL();
    ML_PF_IF(0); ML_PF_QKV(0); ML_PF_OG(0);
    for (int i = tid; i < 128 * 136 / 2; i += 512) ((LAS unsigned*)Cb)[i] = 0u;
    if (tid < 128) ns[tid] = 0.f;
    float mprev = 0.f;
    WG_BAR();
#pragma unroll 1
    for (int c = 0; c < 64; ++c) {
        int tl_ = threadIdx.x; asm volatile("" : "+v"(tl_));
        const int tid = tl_, lane = tid & 63, wave = tid >> 6, fr = lane & 15, fq = lane >> 4;
        const int pcv = tid & 31, ptg = tid >> 5; const bool pisk = pcv >= 16; const int pc8 = (pcv & 15) * 8;
        const int pzcol = (pisk ? 2304 : 1792) + h * 128 + pc8;
        const size_t tokc = (size_t)b * SEQ + c * 64;
        if (wave == 0) {
            const float bc = pfb, u = pfu, pm = pfp, bend = pfe, mc = pfm;
            ML_PF_IF((c + 1) & 63);
            const float lw = bend + u;
            const float mnew = fmaxf(bend + mprev, mc), dec = __expf(bend + mprev - mnew);
            const float linter = bc + mprev, mrow = fmaxf(linter, bc + pm);
            ga[lane] = bc - mrow; gu[lane] = u; gwl[lane] = __expf(lw - mnew); gwi[lane] = __expf(linter - mrow); gei[lane] = __expf(-mrow); dn[lane] = 0.f;
            if (lane == 0) { sc[0] = dec; sc[1] = mnew; }
        }
        WG_BAR();
        {
            const int tg = ptg; const bool isk = pisk; const int c8 = pc8, lch = (isk ? 128 : 0) + c8;
            float wt[4][8], bs[8];
#pragma unroll
            for (int j = 0; j < 4; ++j) { const f32x4 x0 = *(const LAS f32x4*)(CWL + j * 256 + lch), x1 = *(const LAS f32x4*)(CWL + j * 256 + lch + 4);
#pragma unroll
                for (int i = 0; i < 4; ++i) { wt[j][i] = x0[i]; wt[j][4 + i] = x1[i]; } }
            { const f32x4 x0 = *(const LAS f32x4*)(CBL + lch), x1 = *(const LAS f32x4*)(CBL + lch + 4);
#pragma unroll
              for (int i = 0; i < 4; ++i) { bs[i] = x0[i]; bs[4 + i] = x1[i]; } }
#pragma unroll
            for (int q = 0; q < 4; ++q) {
                const int t = tg * 4 + q; float o[8];
#pragma unroll
                for (int i = 0; i < 8; ++i) o[i] = bs[i];
#pragma unroll
                for (int j = 0; j < 4; ++j) { const u32x4 x = rw[3 + q - j]; const float x8[8] = {bflo(x.x), bfhi(x.x), bflo(x.y), bfhi(x.y), bflo(x.z), bfhi(x.z), bflo(x.w), bfhi(x.w)};
#pragma unroll
                    for (int i = 0; i < 8; ++i) o[i] += wt[j][i] * x8[i]; }
#pragma unroll
                for (int i = 0; i < 8; ++i) { o[i] = o[i] * fsigmoid(o[i]); if (!isk) o[i] *= 0.08838834764831845f; }
                u32x4 w; w.x = cvt_pk_bf16(o[0], o[1]); w.y = cvt_pk_bf16(o[2], o[3]); w.z = cvt_pk_bf16(o[4], o[5]); w.w = cvt_pk_bf16(o[6], o[7]);
                if (!isk) *(LAS u32x4*)(Qs + t * 136 + c8) = w;
                else { *(LAS u32x4*)(Ks + t * 136 + c8) = w;
#pragma unroll
                    for (int i = 0; i < 8; ++i) KT[TRI(c8 + i, t)] = f2bf(o[i]); }
            }
#pragma unroll
            for (int rep = 0; rep < 2; ++rep) {
                const int v = tid + rep * 512, t = v >> 4, v8 = (v & 15) * 8;
                const u32x4 x = vx[rep]; const float wl = gwl[t];
                const float x8[8] = {bflo(x.x), bfhi(x.x), bflo(x.y), bfhi(x.y), bflo(x.z), bfhi(x.z), bflo(x.w), bfhi(x.w)};
#pragma unroll
                for (int i = 0; i < 8; ++i) { VT[TRI(v8 + i, t)] = f2bf(x8[i]); VwT[TRI(v8 + i, t)] = f2bf(x8[i] * wl); }
            }
            if (c < 63) ML_PF_QKV(c + 1);
        }
        WG_BAR();
        const int st = wave & 3;
        bf16x8 qf[4];
#pragma unroll
        for (int ks = 0; ks < 4; ++ks) qf[ks] = *(const LAS bf16x8*)(Qs + (st * 16 + fr) * 136 + ks * 32 + fq * 8);
        {
            const int s = st * 16 + fr; const float gas = ga[s]; float dsum = 0.f;
#pragma unroll
            for (int q = 0; q < 2; ++q) {
                const int rt = (wave >> 2) * 2 + q; f32x4 a = (f32x4){0.f, 0.f, 0.f, 0.f};
#pragma unroll
                for (int ks = 0; ks < 4; ++ks) { const bf16x8 kf = *(const LAS bf16x8*)(Ks + (rt * 16 + fr) * 136 + ks * 32 + fq * 8); a = __builtin_amdgcn_mfma_f32_16x16x32_bf16(kf, qf[ks], a, 0, 0, 0); }
                const int r0 = rt * 16 + fq * 4; float p[4];
#pragma unroll
                for (int j = 0; j < 4; ++j) { p[j] = (r0 + j <= s) ? __expf(gas + gu[r0 + j]) * a[j] : 0.f; dsum += p[j]; }
                u32x2 w; w.x = cvt_pk_bf16(p[0], p[1]); w.y = cvt_pk_bf16(p[2], p[3]); *(LAS u32x2*)(Pp + s * 72 + r0) = w;
            }
            dsum += __shfl_xor(dsum, 16); dsum += __shfl_xor(dsum, 32);
            if (fq == 0) __hip_atomic_fetch_add(dn + s, dsum, __ATOMIC_RELAXED, __HIP_MEMORY_SCOPE_WORKGROUP);
            const int s2 = tid >> 3, kq = tid & 7; float a = 0.f;
#pragma unroll
            for (int i = 0; i < 16; ++i) a += ns[kq * 16 + i] * bf2f(Qs[s2 * 136 + kq * 16 + i]);
            a = red8(a); if (kq == 0) nq[s2] = a;
        }
        WG_BAR();
        {
            const int s = st * 16 + fr, vh = wave >> 2; const float wi = gwi[s];
            const float den = dn[s] + wi * nq[s], dinv = 1.f / fmaxf(fabsf(den), gei[s]);
            bf16x8 pf[2];
#pragma unroll
            for (int ks = 0; ks < 2; ++ks) pf[ks] = *(const LAS bf16x8*)(Pp + s * 72 + ks * 32 + fq * 8);
            f32x4 hv[4]; float s1 = 0.f, s2 = 0.f;
#pragma unroll
            for (int q = 0; q < 4; ++q) {
                const int vt = vh * 4 + q; f32x4 a = (f32x4){0.f, 0.f, 0.f, 0.f};
#pragma unroll
                for (int ks = 0; ks < 4; ++ks) { const bf16x8 cf = *(const LAS bf16x8*)(Cb + (vt * 16 + fr) * 136 + ks * 32 + fq * 8); a = __builtin_amdgcn_mfma_f32_16x16x32_bf16(cf, qf[ks], a, 0, 0, 0); }
                a = a * wi;
#pragma unroll
                for (int ks = 0; ks < 2; ++ks) { const bf16x8 vf = *(const LAS bf16x8*)(VT + TRB(vt * 16 + fr, ks * 4 + fq)); a = __builtin_amdgcn_mfma_f32_16x16x32_bf16(vf, pf[ks], a, 0, 0, 0); }
                a = a * dinv; hv[q] = a;
#pragma unroll
                for (int j = 0; j < 4; ++j) { s1 += a[j]; s2 += a[j] * a[j]; }
            }
            s1 += __shfl_xor(s1, 16); s1 += __shfl_xor(s1, 32); s2 += __shfl_xor(s2, 16); s2 += __shfl_xor(s2, 32);
            if (fq == 0) { lnx[s * 4 + vh * 2] = s1; lnx[s * 4 + vh * 2 + 1] = s2; }
            WG_BAR();
            const f32x4 l4 = *(const LAS f32x4*)(lnx + s * 4);
            const float mean = (l4[0] + l4[2]) * (1.f / 128.f), var = fmaxf((l4[1] + l4[3]) * (1.f / 128.f) - mean * mean, 0.f), rstd = rsqrtf(var + 1e-6f);
            const size_t tok = tokc + s;
#pragma unroll
            for (int q = 0; q < 4; ++q) {
                const int v0 = (vh * 4 + q) * 16 + fq * 4;
                const u32x2 og = ogp[q]; const f32x4 g4 = *(const LAS f32x4*)(MLN + v0);
                const float o0 = (hv[q][0] - mean) * rstd * g4[0] * fsigmoid(bflo(og.x)), o1 = (hv[q][1] - mean) * rstd * g4[1] * fsigmoid(bfhi(og.x));
                const float o2 = (hv[q][2] - mean) * rstd * g4[2] * fsigmoid(bflo(og.y)), o3 = (hv[q][3] - mean) * rstd * g4[3] * fsigmoid(bfhi(og.y));
                u32x2 w; w.x = cvt_pk_bf16(o0, o1); w.y = cvt_pk_bf16(o2, o3);
                *(u32x2*)(Yb + tok * DM + 512 + h * 128 + v0) = w;
            }
            if (c < 63) ML_PF_OG(c + 1);
        }
        WG_BAR();
        {
            const float dec = sc[0];
            bf16x8 vf[2];
#pragma unroll
            for (int ks = 0; ks < 2; ++ks) vf[ks] = *(const LAS bf16x8*)(VwT + TRB(wave * 16 + fr, ks * 4 + fq));
#pragma unroll
            for (int kt = 0; kt < 8; ++kt) {
                f32x4 a = Cacc[kt] * dec;
#pragma unroll
                for (int ks = 0; ks < 2; ++ks) { const bf16x8 kf = *(const LAS bf16x8*)(KT + TRB(kt * 16 + fr, ks * 4 + fq)); a = __builtin_amdgcn_mfma_f32_16x16x32_bf16(kf, vf[ks], a, 0, 0, 0); }
                Cacc[kt] = a;
                u32x2 w; w.x = cvt_pk_bf16(a[0], a[1]); w.y = cvt_pk_bf16(a[2], a[3]);
                *(LAS u32x2*)(Cb + (wave * 16 + fr) * 136 + kt * 16 + fq * 4) = w;
            }
            if (tid < 128) { float a = ns[tid] * dec;
                for (int l = 0; l < 64; ++l) a += gwl[l] * bf2f(Ks[l * 136 + tid]);
                ns[tid] = a; }
            mprev = sc[1];
        }
        WG_BAR();
    }
#undef ML_PF_QKV
#undef ML_PF_IF
#undef ML_PF_OG
}

struct SchedKV {
    const char* memb; const char* wk; const char* wv; int j;
    __device__ __forceinline__ bool next(int i, Unit& u) const {
        if (i != 0 || j < 0 || j >= 64) return false;
        const size_t ts = (size_t)256 * 1024 * 2;
        if (j < 32) { u.pm = j >> 2; u.pn = j & 3; u.A = memb + u.pm * ts; u.B = wk + u.pn * ts; u.tag = 0; }
        else { const int q = j - 32; u.pm = q >> 3; u.pn = q & 7; u.A = wv + u.pm * ts; u.B = memb + u.pn * ts; u.tag = 1; }
        u.nt = 16; return true;
    }
};
struct SchedMerge {
    const char* yb; const char* wup; int c;
    __device__ __forceinline__ bool next(int i, Unit& u) const {
        if (i >= 4) return false;
        const int T = c + 256 * (i >> 1), pass = i & 1; u.pm = T >> 2; u.pn = T & 3; u.tag = pass ? 3 : 1; u.nt = 8;
        const size_t ts = (size_t)256 * 1024 * 2;
        u.A = yb + u.pm * ts + pass * 1024; u.B = wup + u.pn * ts + pass * 1024;
        return true;
    }
};
struct SchedPanel {
    const char* A; const char* B; size_t tstep; int c;
    __device__ __forceinline__ bool next(int i, Unit& u) const {
        if (i >= 2) return false;
        u.pm = c >> 1; u.pn = 2 * (c & 1) + i; u.nt = 44; u.tag = 0;
        u.A = A + (size_t)u.pm * tstep; u.B = B + (size_t)u.pn * tstep; return true;
    }
};
struct SchedGate {
    const char* xb; const char* wg; int j0;
    __device__ __forceinline__ bool next(int i, Unit& u) const {
        const int j = j0 + 96 * i; if (j >= 1024) return false;
        u.pm = j >> 3; u.pn = j & 7; u.nt = 16; u.tag = 0;
        const size_t ts = (size_t)256 * 1024 * 2;
        u.A = xb + u.pm * ts; u.B = wg + u.pn * ts;
        return true;
    }
};
struct SchedAttn {
    const char* xb; const char* wq; const char* q; const char* p; const char* kb; const char* vt; int c;
    __device__ __forceinline__ bool next(int i, Unit& u) const {
        if (i >= 6) return false;
        const int pr = c + 256 * (i & 1), b = pr >> 6, h = (pr >> 4) & 3, qt = pr & 15, st = i >> 1;
        u.pm = b * 16 + qt; u.pn = h;
        const size_t ao = ((size_t)u.pm * 256 * 1024 + h * 256) * 2;
        if (st == 0) { u.A = xb + (size_t)u.pm * 256 * 1024 * 2; u.B = wq + (size_t)h * 256 * 1024 * 2; u.nt = 16; u.tag = 2; }
        else if (st == 1) { u.A = q + ao; u.B = kb + ((size_t)b * 256 * 1024 + h * 256) * 2; u.nt = 4; u.tag = 0; }
        else { u.A = p + ao; u.B = vt + (size_t)(b >> 2) * 2097152 + ((size_t)h * 256 * 1024 + (b & 3) * 256) * 2; u.nt = 4; u.tag = 1; }
        return true;
    }
};

#define XB_TMO      128
#define XB_XCNT(j)  (256  + 64 * (j))
#define XB_XSUB(j)  (1280 + 64 * (j))
#define XB_XGEN(j)  (2304 + 64 * (j))
#define XB_TOP      3328
#define XB_TOPGEN   3392
#define XCD_BAR_WORDS 3456
#define XB_SPIN_CAP (1u << 18)
__device__ __forceinline__ unsigned xb_ld(unsigned* p)              { return __hip_atomic_load(p, __ATOMIC_RELAXED, __HIP_MEMORY_SCOPE_AGENT); }
__device__ __forceinline__ unsigned xb_add(unsigned* p, unsigned v) { return __hip_atomic_fetch_add(p, v, __ATOMIC_RELAXED, __HIP_MEMORY_SCOPE_AGENT); }
__device__ __forceinline__ unsigned xb_xcc_id() { return (unsigned)__builtin_amdgcn_s_getreg((3 << 11) | 20) & 0xFu; }
#define XB_SPIN(cond, bar) do { unsigned _sp = 0; while (cond) { __builtin_amdgcn_s_sleep(1); \
    if ((++_sp & 255u) == 0u) { if (xb_ld(&(bar)[XB_TMO])) break; if (_sp > XB_SPIN_CAP) { atomicAdd(&(bar)[XB_TMO], 1u); break; } } } } while (0)
struct XcdBarrier { unsigned* bar; unsigned x; volatile LAS unsigned* st; };
__device__ __forceinline__ XcdBarrier xcd_barrier_post(unsigned* bar, volatile LAS unsigned* st) {
    XcdBarrier b; b.bar = bar; b.x = xb_xcc_id(); b.st = st;
    if (threadIdx.x == 0) (void)xb_add(&bar[XB_XCNT(b.x)], 1u);
    return b;
}
__device__ __forceinline__ void xcd_barrier_complete(unsigned* bar, unsigned x, unsigned& nloc, unsigned& nx) {
    const unsigned G = gridDim.x * gridDim.y * gridDim.z;
    unsigned sum, cnt, mine, sp = 0u;
    for (;;) {
        sum = 0u; cnt = 0u; mine = 0u;
#pragma unroll
        for (unsigned j = 0; j < 16; ++j) { const unsigned c = xb_ld(&bar[XB_XCNT(j)]); sum += c; cnt += (c > 0u) ? 1u : 0u; mine = (j == x) ? c : mine; }
        if (sum == G) break;
        __builtin_amdgcn_s_sleep(1);
        if ((++sp & 255u) == 0u) { if (xb_ld(&bar[XB_TMO])) break; if (sp > XB_SPIN_CAP) { atomicAdd(&bar[XB_TMO], 1u); break; } }
    }
    nloc = mine > 0u ? mine : 1u; nx = cnt > 0u ? cnt : 1u;
}
__device__ __forceinline__ void xcd_barrier(const XcdBarrier& b) {
    asm volatile("s_waitcnt vmcnt(0)" ::: "memory");
    __syncthreads();
    if (threadIdx.x == 0) {
        unsigned* bar = b.bar;
        __builtin_amdgcn_s_waitcnt(0);
        unsigned nloc = b.st[0], nx = b.st[1];
        if (nloc == 0u) { xcd_barrier_complete(bar, b.x, nloc, nx); b.st[0] = nloc; b.st[1] = nx; }
        const unsigned old = xb_add(&bar[XB_XSUB(b.x)], 1u);
        const unsigned gen = old / nloc;
        if (old + 1u == (gen + 1u) * nloc) {
            __builtin_amdgcn_fence(__ATOMIC_RELEASE, "agent");
            asm volatile("s_waitcnt vmcnt(0)" ::: "memory");
            const unsigned og = xb_add(&bar[XB_TOP], 1u);
            const unsigned tg = og / nx;
            if (og + 1u == (tg + 1u) * nx) xb_add(&bar[XB_TOPGEN], 1u);
            else XB_SPIN(xb_ld(&bar[XB_TOPGEN]) == tg, bar);
            __builtin_amdgcn_fence(__ATOMIC_ACQUIRE, "agent");
            xb_add(&bar[XB_XGEN(b.x)], 1u);
            asm volatile("s_waitcnt vmcnt(0)" ::: "memory");
        } else {
            XB_SPIN(xb_ld(&bar[XB_XGEN(b.x)]) == gen, bar);
            __builtin_amdgcn_fence(__ATOMIC_ACQUIRE, "agent");
            asm volatile("s_waitcnt vmcnt(0)" ::: "memory");
        }
    }
    __syncthreads();
}

__global__ void __launch_bounds__(512, 2) mega(Params P) {
    extern __shared__ __attribute__((aligned(16))) unsigned char smem[];
    LAS unsigned char* lds = (LAS unsigned char*)smem;
    unsigned char* ws = P.ws;
    const int G = gridDim.x, c = blockIdx.x, lo = P.ph_lo, hi = P.ph_hi;
    float* ssq0 = (float*)(ws + OFF_SSQ0); float* ssq1 = (float*)(ws + OFF_SSQ1); float* ssq2 = (float*)(ws + OFF_SSQ2); float* ssq3 = (float*)(ws + OFF_SSQ3); float* ssq4 = (float*)(ws + OFF_SSQ4);
    bf16_t* XB = (bf16_t*)(ws + OFF_XB); bf16_t* U = (bf16_t*)(ws + OFF_U);
#ifdef ONLY_PHASE
#define IN(k) ((k) == ONLY_PHASE && lo <= (k) && (k) < hi)
#else
#define IN(k) (lo <= (k) && (k) < hi)
#endif
    volatile LAS unsigned* bst = (volatile LAS unsigned*)(lds + 163776);
    if (threadIdx.x < 2) bst[threadIdx.x] = 0u;
    __syncthreads();
    XcdBarrier xbar; xbar.bar = (unsigned*)(ws + OFF_BARW); xbar.x = 0; xbar.st = bst;
    if (P.coop) xbar = xcd_barrier_post((unsigned*)(ws + OFF_BARW), bst);
    if (P.ph_hi > NPHASE) cg::this_grid().sync();
#define SEAM(k) do { if (P.coop && IN(k) && IN((k) + 1)) xcd_barrier(xbar); } while (0)
    const size_t TS1 = (size_t)256 * 1024 * 2, TSF = (size_t)256 * DFF * 2;

    if (IN(0)) { phase_prep(P, lds); }
    SEAM(0);
    if (IN(1)) {
        SchedStatic S{(const char*)XB, (const char*)(ws + OFF_WGU1), TS1, 128, 22, 16, G, c}; EpiSwiglu E{U, ssq0};
        gemm_phase(lds, 1024, S, E);
    }
    SEAM(1);
    if (IN(2)) {
        SchedStatic S{(const char*)U, (const char*)(ws + OFF_WD1), TSF, 128, 4, 44, G, c}; EpiResidX<1> E{P.in[0], nullptr, XB, ssq1, 0.5f};
        gemm_phase(lds, DFF, S, E);
    }
    SEAM(2);
    if (IN(3)) {
        SchedStatic S{(const char*)XB, (const char*)(ws + OFF_WIN), TS1, 128, 16, 16, G, c}; EpiRowScale<0> E{(bf16_t*)(ws + OFF_Z), ssq1, (float*)(ws + OFF_IF)};
        gemm_phase(lds, 1024, S, E);
    }
    SEAM(3);
    if (IN(4)) {
        if (c < 128) rwkv_item(P, lds, c);
        else if (c < 160) mlstm_item(P, lds, c - 128);
        else {
            if (c < 224) { SchedKV S{(const char*)(ws + OFF_MEMB), (const char*)(ws + OFF_WK), (const char*)(ws + OFF_WV), c - 160}; EpiKV E{(bf16_t*)(ws + OFF_KB), (bf16_t*)(ws + OFF_VT), (const float*)(ws + OFF_SSQM)};
                gemm_phase(lds, 1024, S, E); }
            {
                SchedGate S{(const char*)XB, (const char*)(ws + OFF_WG), c >= 224 ? c - 224 : c - 128}; EpiGate E{(bf16_t*)P.out, (bf16_t*)P.out + (size_t)NTOK * DM, ssq1};
                gemm_phase(lds, 1024, S, E); }
            const int wv_ = threadIdx.x >> 6, ln_ = threadIdx.x & 63; LAS float* scr = (LAS float*)(lds + wv_ * 16384);
            for (int it = P.nearly + (c - 160) * 8 + wv_; it < P.nitems; it += 96 * 8) {
                int j = 0;
                while (j + 1 < P.njobs && it >= P.jobs[j + 1].item0) ++j;
                transpose_item(P.jobs[j], it - P.jobs[j].item0, scr, ln_);
            }
        }
    }
    SEAM(4);
    if (IN(5)) {
        SchedMerge S{(const char*)(ws + OFF_Y), (const char*)(ws + OFF_WUP), c};
        EpiMerge2 E{(u32x4*)(ws + OFF_SCRS) + (size_t)c * 8192, (bf16_t*)(ws + OFF_MG), (const bf16_t*)P.out, (const bf16_t*)P.out + (size_t)NTOK * DM};
        if (c < 256) gemm_phase(lds, 1024, S, E);
    }
    SEAM(5);
    if (IN(6)) {
        SchedStatic S{(const char*)(ws + OFF_MG), (const char*)(ws + OFF_WOUT), TS1, 128, 4, 16, G, c}; EpiResidX<3> E{nullptr, nullptr, XB, ssq2, 1.0f};
        gemm_phase(lds, 1024, S, E);
    }
    SEAM(6);
    if (IN(8)) {
        SchedAttn S{(const char*)XB, (const char*)(ws + OFF_WQ), (const char*)(ws + OFF_Q), (const char*)(ws + OFF_P), (const char*)(ws + OFF_KB), (const char*)(ws + OFF_VT), c};
        EpiAttn E{(bf16_t*)(ws + OFF_P), (bf16_t*)(ws + OFF_O), (bf16_t*)(ws + OFF_Q), ssq2};
        if (c < 256) gemm_phase(lds, 1024, S, E);
    }
    SEAM(8);
    if (IN(9)) {
        SchedStatic S{(const char*)(ws + OFF_O), (const char*)(ws + OFF_WO), TS1, 128, 4, 16, G, c}; EpiResidX<3> E{nullptr, nullptr, XB, ssq3, 1.0f};
        gemm_phase(lds, 1024, S, E);
    }
    SEAM(9);
    if (IN(10)) {
        SchedStatic S{(const char*)XB, (const char*)(ws + OFF_WGU2), TS1, 128, 22, 16, G, c}; EpiSwiglu E{U, ssq3};
        gemm_phase(lds, 1024, S, E);
    }
    SEAM(10);
    if (IN(11)) {
        LAS float* rowss = (LAS float*)(lds + XCH_OFF); LAS float* rsv = rowss + 256;
        if (threadIdx.x < 256) rowss[threadIdx.x] = 0.f;
        __syncthreads();
        SchedPanel S{(const char*)U, (const char*)(ws + OFF_WD2), TSF, c}; EpiResidFin E{P.out, XB, 0.5f};
        gemm_phase(lds, DFF, S, E);
        if (threadIdx.x < 256) {
            const int r = threadIdx.x, pm = c >> 1, me = c & 1;
            unsigned long long* g = (unsigned long long*)(ws + OFF_FNG) + (size_t)pm * 512;
            const float mine = rowss[r];
            __hip_atomic_store(g + me * 256 + r, (0x5EEDull << 32) | __builtin_bit_cast(unsigned, mine), __ATOMIC_RELAXED, __HIP_MEMORY_SCOPE_AGENT);
            unsigned long long o; unsigned spins = 0;
            for (;;) { o = __hip_atomic_load(g + (me ^ 1) * 256 + r, __ATOMIC_RELAXED, __HIP_MEMORY_SCOPE_AGENT);
                if (__all((o >> 32) == 0x5EEDull)) break;
                __builtin_amdgcn_s_sleep(2); if (++spins > (1u << 22)) break; }
            rsv[r] = rsqrtf((mine + __builtin_bit_cast(float, (unsigned)o)) * (1.f / 1024.f) + NORM_EPS);
        }
        __builtin_amdgcn_fence(__ATOMIC_ACQUIRE, "agent");
        __syncthreads();
        {
            const int pm = c >> 1, me = c & 1, cq = threadIdx.x & 63, rq = threadIdx.x >> 6; const float* fn = P.in[36];
            const f32x4 g0 = *(const f32x4*)(fn + me * 512 + cq * 8), g1 = *(const f32x4*)(fn + me * 512 + cq * 8 + 4);
            const size_t off = (size_t)pm * 256 * DM + me * 512 + cq * 8;
#pragma unroll 4
            for (int r = rq; r < 256; r += 8) { const u32x4 xr = *(const u32x4*)(XB + off + (size_t)r * DM); const float rs = rsv[r];
                *(f32x4*)(P.out + off + (size_t)r * DM) = (f32x4){bflo(xr.x), bfhi(xr.x), bflo(xr.y), bfhi(xr.y)} * rs * g0;
                *(f32x4*)(P.out + off + (size_t)r * DM + 4) = (f32x4){bflo(xr.z), bfhi(xr.z), bflo(xr.w), bfhi(xr.w)} * rs * g1; }
        }
    }
#undef IN
#undef SEAM
}

#ifdef MK_DBG_DUMP
__global__ void dbg_dump(const bf16_t* src, int ld, int mode, float* out) {
    const size_t i = (size_t)blockIdx.x * 256 + threadIdx.x; const size_t r = i >> 10; const int c = (int)(i & 1023);
    float v = bf2f(src[r * ld + c]);
    if (mode == 1) v += 2.f * bf2f(src[r * ld + c + 1024]) + 3.f * bf2f(src[r * ld + c + 2048]) + 5.f * bf2f(src[r * ld + c + 2816]);
    if (mode == 4) v = ((const float*)src)[i & 262143];
    if (mode == 2 && c >= 512) v = 0.f;
    if (mode == 3 && c < 512) v = 0.f;
    out[i] = v;
}
#endif
static void add_job(Params& p, const float* src, const float* gain, size_t dst_off, int K, int ldsrc, int col0, int ncols, int dst_ld, int dst_row0, int dst_k0, int mode, float scale) {
    TJob& j = p.jobs[p.njobs++]; j.src = src; j.gain = gain; j.dst = (bf16_t*)(p.ws + dst_off); j.K = K; j.ldsrc = ldsrc; j.col0 = col0; j.ncols = ncols; j.dst_ld = dst_ld; j.dst_row0 = dst_row0; j.dst_k0 = dst_k0;
    j.mode = mode; j.scale = scale; j.item0 = p.nitems; p.nitems += (K / 64) * ((ncols + 63) / 64);
}
extern "C" void kernel_launch(void* const* d_in, const int* in_sizes, int n_in, void* d_out, int out_size, void* d_ws, size_t ws_size, hipStream_t stream) {
    static int ready = 0;
    if (ready == 0) {
        if (n_in != 37 || out_size != NTOK * DM || ws_size < WS_END) { fprintf(stderr, "kernel_launch: unexpected shapes: n_in %d out %d ws %zu (need %zu); nothing launched\n", n_in, out_size, ws_size, (size_t)WS_END); ready = -1; return; }
        if (hipFuncSetAttribute((const void*)mega, hipFuncAttributeMaxDynamicSharedMemorySize, LDS_BYTES) != hipSuccess) { fprintf(stderr, "kernel_launch: hipFuncSetAttribute failed\n"); ready = -1; return; }
        int per_cu = 0; (void)hipOccupancyMaxActiveBlocksPerMultiprocessor(&per_cu, (const void*)mega, 512, LDS_BYTES); (void)hipGetLastError();
        if (per_cu < 1) fprintf(stderr, "kernel_launch: note: occupancy query says %d blocks per CU\n", per_cu);
        ready = 1;
    }
    if (ready < 0) return;
    Params p; memset(&p, 0, sizeof(p));
    for (int i = 0; i < 37; ++i) p.in[i] = (const float*)d_in[i];
    p.out = (float*)d_out; p.ws = (unsigned char*)d_ws;
    const float* const* in = p.in;
    add_job(p, in[3], in[2], OFF_WGU1, 1024, DFF, 0, DFF, 1024, 0, 0, 1, 1.f);
    add_job(p, in[4], in[2], OFF_WGU1, 1024, DFF, 0, DFF, 1024, 128, 0, 1, 1.f);
    add_job(p, in[5], nullptr, OFF_WD1, DFF, 1024, 0, 1024, DFF, 0, 0, 0, 1.f);
    add_job(p, in[7], in[6], OFF_WIN, 1024, 5896, 0, 3848, 1024, 0, 0, 0, 1.f);
    add_job(p, in[30], in[28], OFF_WK, 1024, 2048, 0, 1024, 1024, 0, 0, 0, 1.f);
    add_job(p, in[30], in[28], OFF_WV, 1024, 2048, 1024, 1024, 1024, 0, 0, 0, 1.f);
    add_job(p, in[10], nullptr, OFF_W2T, 64, 512, 0, 512, 64, 0, 0, 0, 1.f);
    add_job(p, in[12], nullptr, OFF_A2T, 64, 512, 0, 512, 64, 0, 0, 0, 1.f);
    add_job(p, in[13], nullptr, OFF_G2T, 128, 512, 0, 512, 128, 0, 0, 0, 1.f);
    add_job(p, in[7], in[6], OFF_WG, 1024, 5896, 3848, 2048, 1024, 0, 0, 0, 1.f);
    p.nearly = p.nitems;
    add_job(p, in[24], nullptr, OFF_WUP, 512, 1024, 0, 1024, 1024, 0, 0, 0, 1.f);
    add_job(p, in[25], nullptr, OFF_WUP, 512, 1024, 0, 1024, 1024, 0, 512, 0, 1.f);
    add_job(p, in[26], nullptr, OFF_WOUT, 1024, 1024, 0, 1024, 1024, 0, 0, 0, 1.f);
    add_job(p, in[29], in[27], OFF_WQ, 1024, 1024, 0, 1024, 1024, 0, 0, 0, 0.0625f);
    add_job(p, in[31], nullptr, OFF_WO, 1024, 1024, 0, 1024, 1024, 0, 0, 0, 1.f);
    add_job(p, in[33], in[32], OFF_WGU2, 1024, DFF, 0, DFF, 1024, 0, 0, 1, 1.f);
    add_job(p, in[34], in[32], OFF_WGU2, 1024, DFF, 0, DFF, 1024, 128, 0, 1, 1.f);
    add_job(p, in[35], nullptr, OFF_WD2, DFF, 1024, 0, 1024, DFF, 0, 0, 0, 1.f);
    const int grid = 256;
#if MK_PER_PHASE
    p.coop = 0;
    for (int ph = 0; ph < MK_DBG_HI; ++ph) { p.ph_lo = ph; p.ph_hi = ph + 1; hipLaunchKernelGGL(mega, dim3(grid), dim3(512), LDS_BYTES, stream, p); }
#ifdef MK_DBG_DUMP
    hipLaunchKernelGGL(dbg_dump, dim3(NTOK * 4), dim3(256), 0, stream, (const bf16_t*)(p.ws + MK_DBG_DUMP), MK_DBG_LD, MK_DBG_MODE, p.out);
#endif
#else
    p.coop = 1; p.ph_lo = 0; p.ph_hi = NPHASE;
    if (hipMemsetAsync((char*)d_ws + OFF_BARW, 0, XCD_BAR_WORDS * 4, stream) != hipSuccess) { fprintf(stderr, "kernel_launch: hipMemsetAsync failed\n"); return; }
    void* args[] = {&p};
    hipError_t e = hipLaunchCooperativeKernel((const void*)mega, dim3(grid), dim3(512), args, LDS_BYTES, stream);
    if (e != hipSuccess) fprintf(stderr, "kernel_launch: cooperative launch failed: %s\n", hipGetErrorString(e));
#endif
}
```
